# Optimizing an MI355X kernel written in HIP

```python
import math
import functools
import jax
import jax.numpy as jnp
from jax import lax
import numpy as np

D_MODEL = 1024
BATCH = 2
SEQ = 16384
DEPTH = 4

GRID_W = 64
CTX_LEN = 256

POOL_WIDTH = D_MODEL // 4
POOL_WINDOWS = (2, 4, 8, 16)
POOL_GROUPS = len(POOL_WINDOWS)
POOL_GROUP_DIM = POOL_WIDTH // POOL_GROUPS

HYENA_WIDTH = D_MODEL // 4
HYENA_SHORT = 3
HYENA_BANDS = 16
HYENA_EMB = 1 + 2 * HYENA_BANDS
HYENA_FILTER_HIDDEN = 64
HYENA_TARGET = 1e-2
HYENA_FAST_DECAY_PCT = 0.3
HYENA_SLOW_DECAY_PCT = 1.5

DIFF_HEADS = 4
DIFF_WIDTH = D_MODEL // 2
DIFF_V_DIM = DIFF_WIDTH // DIFF_HEADS
DIFF_HEAD_DIM = DIFF_V_DIM // 2
DIFF_QK_WIDTH = DIFF_HEADS * 2 * DIFF_HEAD_DIM
ROPE_FREQS = DIFF_HEAD_DIM // 4
ROPE_THETA = 10000.0
Q_BLOCK = 128

MIX_WIDTH = POOL_WIDTH + HYENA_WIDTH + DIFF_WIDTH
HYENA_OFF = POOL_WIDTH
ATT_OFF = POOL_WIDTH + 3 * HYENA_WIDTH
IN_WIDTH = ATT_OFF + 2 * DIFF_QK_WIDTH + DIFF_WIDTH

D_FF = ((8 * D_MODEL // 3 + 127) // 128) * 128
N_EXPERTS = 8
TOP_K = 2
D_FF_EXPERT = 7 * D_MODEL // 2
N_DENSE = (DEPTH + 1) // 2
N_MOE = DEPTH // 2
EPS = 1e-6

kernel_name = "hybrid_pool_hyena_diffattn_moe_dit"


def rmsnorm(x, g):
    xf = x.astype(jnp.float32)
    y = xf * lax.rsqrt(jnp.mean(xf * xf, axis=-1, keepdims=True) + EPS)
    return (y * g.astype(jnp.float32)).astype(x.dtype)


def modulate(x, shift, scale):
    return x * (1.0 + scale) + shift


def axial_rope_tables(L):
    rows = L // GRID_W
    row = jnp.repeat(jnp.arange(rows, dtype=jnp.float32), GRID_W)
    col = jnp.broadcast_to(jnp.arange(GRID_W, dtype=jnp.float32), (rows, GRID_W)).reshape(-1)
    inv_freq = jnp.power(ROPE_THETA, -jnp.arange(ROPE_FREQS, dtype=jnp.float32) / ROPE_FREQS)
    ang = jnp.stack([row, col], axis=-1)[:, :, None] * inv_freq
    return jnp.cos(ang), jnp.sin(ang)


def apply_axial_rope(x, cos, sin):
    shp = x.shape
    xr = x.astype(jnp.float32).reshape(shp[:-1] + (2, 2, ROPE_FREQS))
    a, b = xr[..., 0, :], xr[..., 1, :]
    c, s = cos[:, None, None], sin[:, None, None]
    out = jnp.stack([a * c - b * s, b * c + a * s], axis=-2)
    return out.reshape(shp).astype(x.dtype)


def attn_qkv(z_att, qk_g, rope):
    B, L, _ = z_att.shape
    q = z_att[..., :DIFF_QK_WIDTH].reshape(B, L, DIFF_HEADS, 2, DIFF_HEAD_DIM)
    k = z_att[..., DIFF_QK_WIDTH:2 * DIFF_QK_WIDTH].reshape(B, L, DIFF_HEADS, 2, DIFF_HEAD_DIM)
    v = z_att[..., 2 * DIFF_QK_WIDTH:].reshape(B, L, DIFF_HEADS, DIFF_V_DIM)
    q = rmsnorm(q, qk_g[0])
    k = rmsnorm(k, qk_g[1])
    if rope is not None:
        q = apply_axial_rope(q, rope[0], rope[1])
        k = apply_axial_rope(k, rope[0], rope[1])
    return q, k.transpose(0, 2, 3, 1, 4), v.transpose(0, 2, 1, 3)


def diff_lambda_value(lv, lam_init):
    lv = lv.astype(jnp.float32)
    return jnp.exp(jnp.sum(lv[0] * lv[1])) - jnp.exp(jnp.sum(lv[2] * lv[3])) + lam_init


def diff_attend(q, k, v, lam):
    s = jnp.einsum("bqhmd,bhmkd->bhmqk", q, k, preferred_element_type=jnp.float32) * (DIFF_HEAD_DIM ** -0.5)
    p = jax.nn.softmax(s, axis=-1)
    w = p[:, :, 0] - lam * p[:, :, 1]
    return jnp.einsum("bhqk,bhkd->bqhd", w.astype(v.dtype), v)


def diff_attend_blocks(q, k, v, lam):
    B, L = q.shape[:2]
    nb = L // Q_BLOCK
    qb = jnp.moveaxis(q.reshape((B, nb, Q_BLOCK) + q.shape[2:]), 1, 0)
    o = lax.map(lambda qblk: diff_attend(qblk, k, v, lam), qb)
    return jnp.moveaxis(o, 0, 1).reshape(B, L, DIFF_HEADS, DIFF_V_DIM)


def pool_mix(z, lin, scale):
    B, L, _ = z.shape
    zg = z.reshape(B, L, POOL_GROUPS, POOL_GROUP_DIM).astype(jnp.float32)
    cs = jnp.concatenate([jnp.zeros_like(zg[:, :1]), jnp.cumsum(zg, axis=1)], axis=1)
    t = jnp.arange(L)
    pooled = []
    for g, win in enumerate(POOL_WINDOWS):
        lo = jnp.clip(t - win // 2, 0, L)
        hi = jnp.clip(t + win // 2, 0, L)
        cnt = (hi - lo).astype(jnp.float32)[None, :, None]
        pooled.append((cs[:, hi, g] - cs[:, lo, g]) / cnt)
    d = (jnp.stack(pooled, axis=2) - zg).astype(z.dtype)
    y = jnp.einsum("blgc,gce->blge", d, lin).reshape(B, L, POOL_WIDTH)
    return y * scale


def short_conv(z, w, b):
    L = z.shape[1]
    pad = HYENA_SHORT // 2
    zp = jnp.pad(z, ((0, 0), (pad, HYENA_SHORT - 1 - pad), (0, 0)))
    y = b
    for j in range(HYENA_SHORT):
        y = y + zp[:, j:j + L] * w[j]
    return y


def hyena_filter(L, w1, b1, f1, w2, b2, f2, w3):
    f32 = jnp.float32
    t = jnp.linspace(0.0, 1.0, L, dtype=f32)[:, None]
    w = (2.0 * math.pi / L) * jnp.arange(L, dtype=f32)[:, None]
    bands = jnp.linspace(1e-4, HYENA_BANDS - 1, HYENA_BANDS, dtype=f32)[None, :]
    feat = jnp.concatenate([t, jnp.cos(bands * w), -jnp.sin(bands * w)], axis=-1)
    h = jnp.sin(f1.astype(f32) * (feat @ w1.astype(f32) + b1.astype(f32)))
    h = jnp.sin(f2.astype(f32) * (h @ w2.astype(f32) + b2.astype(f32)))
    h = (h @ w3.astype(f32)).reshape(L, 2, HYENA_WIDTH)
    max_decay = math.log(1.0 / HYENA_TARGET) / HYENA_FAST_DECAY_PCT
    min_decay = math.log(1.0 / HYENA_TARGET) / HYENA_SLOW_DECAY_PCT
    deltas = jnp.linspace(min_decay, max_decay, HYENA_WIDTH, dtype=f32)
    h = h * jnp.exp(-t * deltas)[:, None, :]
    k = jnp.concatenate([h[:, 0], jnp.zeros((1, HYENA_WIDTH), f32), jnp.flip(h[1:, 1], axis=0)], axis=0)
    return k / jnp.sum(jnp.abs(k), axis=0, keepdims=True)


def long_conv(u, k):
    L = u.shape[1]
    n = 2 * L
    uf = jnp.fft.rfft(u.astype(jnp.float32), n=n, axis=1)
    kf = jnp.fft.rfft(k, n=n, axis=0)
    return jnp.fft.irfft(uf * kf[None], n=n, axis=1)[:, :L].astype(u.dtype)


def hyena_mix(z, sw, sb, filt, bias):
    L = z.shape[1]
    x0, x1, v = jnp.split(short_conv(z, sw, sb), 3, axis=-1)
    v = v * x1
    y = long_conv(v, hyena_filter(L, *filt)) + v * bias
    return y * x0


def mix_merge(z, att, lam_init, pool_lin, pool_scale, sw, sb, filt, hy_bias, subln_g, w_out):
    B, L, _ = z.shape
    y_pool = pool_mix(z[..., :POOL_WIDTH], pool_lin, pool_scale)
    y_hy = hyena_mix(z[..., HYENA_OFF:ATT_OFF], sw, sb, filt, hy_bias)
    y_att = (rmsnorm(att, subln_g) * (1.0 - lam_init)).reshape(B, L, DIFF_WIDTH)
    return jnp.concatenate([y_pool, y_hy, y_att], axis=-1) @ w_out


def swiglu(u, w_gate, w_up, w_down):
    return (jax.nn.silu(u @ w_gate) * (u @ w_up)) @ w_down


def moe_swiglu(u, router_w, w_gate, w_up, w_down):
    shp = u.shape
    ut = u.reshape(-1, shp[-1])
    logits = jnp.matmul(ut, router_w, preferred_element_type=jnp.float32)
    top_val, top_idx = lax.top_k(logits, TOP_K)
    gate = jax.nn.softmax(top_val, axis=-1)
    comb = jnp.einsum("nk,nke->ne", gate, jax.nn.one_hot(top_idx, N_EXPERTS, dtype=jnp.float32))
    y = jnp.zeros(ut.shape, jnp.float32)
    for e in range(N_EXPERTS):
        he = jax.nn.silu(ut @ w_gate[e]) * (ut @ w_up[e])
        y = y + comb[:, e:e + 1] * (he @ w_down[e])
    return y.astype(u.dtype).reshape(shp)


def setup_inputs(seed: int = 0) -> dict:
    key = jax.random.key(seed)
    ks = iter(jax.random.split(key, 40))

    def nrm(shape, scale):
        return scale * jax.random.normal(next(ks), shape, jnp.float32)

    def gain(shape, scale):
        return 1.0 + nrm(shape, scale)

    D = D_MODEL
    return {
        "x": nrm((BATCH, SEQ, D), 1.0),
        "c": nrm((BATCH, D), 1.0),
        "ctx": nrm((BATCH, CTX_LEN, D), 1.0),
        "c_ctx": nrm((D,), 1.0),
        "mod_w": nrm((DEPTH, D, 6 * D), 0.5 * D ** -0.5),
        "mod_b": nrm((DEPTH, 6 * D), 0.01),
        "norm1_g": gain((DEPTH, D), 0.05),
        "norm2_g": gain((DEPTH, D), 0.05),
        "w_in": nrm((DEPTH, D, IN_WIDTH), D ** -0.5),
        "w_out": nrm((DEPTH, MIX_WIDTH, D), MIX_WIDTH ** -0.5),
        "pool_lin": nrm((DEPTH, POOL_GROUPS, POOL_GROUP_DIM, POOL_GROUP_DIM), POOL_GROUP_DIM ** -0.5),
        "pool_scale": gain((DEPTH, POOL_WIDTH), 0.1),
        "hy_short_w": nrm((DEPTH, HYENA_SHORT, 3 * HYENA_WIDTH), HYENA_SHORT ** -0.5),
        "hy_short_b": nrm((DEPTH, 3 * HYENA_WIDTH), 0.02),
        "hy_f_w1": nrm((DEPTH, HYENA_EMB, HYENA_FILTER_HIDDEN), HYENA_EMB ** -0.5),
        "hy_f_b1": nrm((DEPTH, HYENA_FILTER_HIDDEN), 0.1),
        "hy_f_freq1": gain((DEPTH, HYENA_FILTER_HIDDEN), 0.01),
        "hy_f_w2": nrm((DEPTH, HYENA_FILTER_HIDDEN, HYENA_FILTER_HIDDEN), HYENA_FILTER_HIDDEN ** -0.5),
        "hy_f_b2": nrm((DEPTH, HYENA_FILTER_HIDDEN), 0.1),
        "hy_f_freq2": gain((DEPTH, HYENA_FILTER_HIDDEN), 0.01),
        "hy_f_w3": nrm((DEPTH, HYENA_FILTER_HIDDEN, 2 * HYENA_WIDTH), HYENA_FILTER_HIDDEN ** -0.5),
        "hy_bias": nrm((DEPTH, HYENA_WIDTH), 1.0),
        "qk_norm_g": gain((DEPTH, 2, DIFF_HEAD_DIM), 0.05),
        "diff_lambda": nrm((DEPTH, 4, DIFF_HEAD_DIM), 0.1),
        "subln_g": gain((DEPTH, DIFF_V_DIM), 0.05),
        "ffn_w_gate": nrm((N_DENSE, D, D_FF), D ** -0.5),
        "ffn_w_up": nrm((N_DENSE, D, D_FF), D ** -0.5),
        "ffn_w_down": nrm((N_DENSE, D_FF, D), D_FF ** -0.5),
        "router_w": nrm((N_MOE, D, N_EXPERTS), D ** -0.5),
        "moe_w_gate": nrm((N_MOE, N_EXPERTS, D, D_FF_EXPERT), D ** -0.5),
        "moe_w_up": nrm((N_MOE, N_EXPERTS, D, D_FF_EXPERT), D ** -0.5),
        "moe_w_down": nrm((N_MOE, N_EXPERTS, D_FF_EXPERT, D), D_FF_EXPERT ** -0.5),
    }


def reference(x, c, ctx, c_ctx, mod_w, mod_b, norm1_g, norm2_g, w_in, w_out,
              pool_lin, pool_scale, hy_short_w, hy_short_b, hy_f_w1, hy_f_b1, hy_f_freq1,
              hy_f_w2, hy_f_b2, hy_f_freq2, hy_f_w3, hy_bias, qk_norm_g, diff_lambda, subln_g,
              ffn_w_gate, ffn_w_up, ffn_w_down, router_w, moe_w_gate, moe_w_up, moe_w_down):
    L = x.shape[1]
    rope = axial_rope_tables(L)
    silu_c = jax.nn.silu(c)[:, None, :]
    silu_cc = jax.nn.silu(c_ctx)
    h = ctx
    for i in range(DEPTH):
        last = i == DEPTH - 1
        m_lat = jnp.split(silu_c @ mod_w[i] + mod_b[i], 6, axis=-1)
        m_ctx = jnp.split(silu_cc @ mod_w[i] + mod_b[i], 6, axis=-1)
        lam_init = 0.8 - 0.6 * math.exp(-0.3 * i)
        lam = diff_lambda_value(diff_lambda[i], lam_init)
        filt = (hy_f_w1[i], hy_f_b1[i], hy_f_freq1[i], hy_f_w2[i], hy_f_b2[i], hy_f_freq2[i], hy_f_w3[i])
        merge = functools.partial(mix_merge, lam_init=lam_init, pool_lin=pool_lin[i], pool_scale=pool_scale[i],
                                  sw=hy_short_w[i], sb=hy_short_b[i], filt=filt, hy_bias=hy_bias[i],
                                  subln_g=subln_g[i], w_out=w_out[i])
        z_lat = modulate(rmsnorm(x, norm1_g[i]), m_lat[0], m_lat[1]) @ w_in[i]
        z_ctx = modulate(rmsnorm(h, norm1_g[i]), m_ctx[0], m_ctx[1]) @ w_in[i]
        q_l, k_l, v_l = attn_qkv(z_lat[..., ATT_OFF:], qk_norm_g[i], rope)
        q_c, k_c, v_c = attn_qkv(z_ctx[..., ATT_OFF:], qk_norm_g[i], None)
        att_lat = diff_attend_blocks(q_l, jnp.concatenate([k_c, k_l], axis=3),
                                     jnp.concatenate([v_c, v_l], axis=2), lam)
        x = x + m_lat[2] * merge(z_lat, att_lat)
        if not last:
            att_ctx = diff_attend(q_c, k_c, v_c, lam)
            h = h + m_ctx[2] * merge(z_ctx, att_ctx)
        if i % 2 == 0:
            j = i // 2
            ffn = functools.partial(swiglu, w_gate=ffn_w_gate[j], w_up=ffn_w_up[j], w_down=ffn_w_down[j])
        else:
            j = i // 2
            ffn = functools.partial(moe_swiglu, router_w=router_w[j], w_gate=moe_w_gate[j],
                                    w_up=moe_w_up[j], w_down=moe_w_down[j])
        x = x + m_lat[5] * ffn(modulate(rmsnorm(x, norm2_g[i]), m_lat[3], m_lat[4]))
        if not last:
            h = h + m_ctx[5] * ffn(modulate(rmsnorm(h, norm2_g[i]), m_ctx[3], m_ctx[4]))
    return x
```

```cpp
#include <hip/hip_runtime.h>
#include <cstdio>
#include <cstdint>

#ifndef MK_ONE_LAUNCH
#define MK_ONE_LAUNCH 1
#endif
#ifndef PH_MASK
#define PH_MASK 0xFFFF
#endif
#define PHEN(n) (((PH_MASK) >> (n)) & 1)
#define DUP_ATT 0
#define DUP_HY 0
#define DUP_POOL 0
#define DUP_PREP 0
#define DUP_PREPB 0
#define DUP_GEMM 0
#define DUP_ADD 0

#define GAS __attribute__((address_space(1)))
#define LAS __attribute__((address_space(3)))
typedef unsigned short bf16;
typedef unsigned v4u __attribute__((ext_vector_type(4)));
typedef unsigned v2u __attribute__((ext_vector_type(2)));
typedef float f32x4 __attribute__((ext_vector_type(4)));
typedef float f32x2 __attribute__((ext_vector_type(2)));
typedef float f32x16 __attribute__((ext_vector_type(16)));
typedef short bf16x8 __attribute__((ext_vector_type(8)));
typedef short s16x4 __attribute__((ext_vector_type(4)));
typedef short v4i16_t __attribute__((ext_vector_type(4)));

constexpr int DM = 1024, NB = 2, SEQ = 16384, DEPTH = 4, CTXL = 256;
constexpr int RB = CTXL + SEQ;
constexpr int MROWS = NB * RB;
constexpr int TPB = RB / 256;
constexpr int INW = 2560, Q_OFF = 1024, K_OFF = 1536, V_OFF = 2048;
constexpr int DFF = 2816, DFE = 3584, NEXP = 8;
constexpr int NWAVES = 8, NTHR = 512;
constexpr int SEGCAP = MROWS;
constexpr float C2 = 0.125f * 1.4426950408889634f;

constexpr size_t MiB = 1u << 20;
constexpr size_t WS_CTL = 0, CTL_ZERO_BYTES = 1 * MiB;
constexpr size_t WS_MODP = 1 * MiB;
constexpr size_t WS_MOD = 4 * MiB;
constexpr size_t WS_ROPE = 4 * MiB + 512 * 1024;
constexpr size_t WS_H2C = 4 * MiB + 640 * 1024;
constexpr size_t WS_KCTX = 5 * MiB;
constexpr size_t WS_HCTX = 6 * MiB;
constexpr size_t WS_H2 = 8 * MiB;
constexpr size_t WS_RTOK = 12 * MiB;
constexpr size_t WS_RGATE = 15 * MiB;
constexpr size_t WS_RREC = 18 * MiB;
constexpr size_t WS_RRECG = 18 * MiB + 256 * 1024;
constexpr size_t WS_CNTB = 18 * MiB + 512 * 1024;
constexpr size_t WS_H2B = 19 * MiB;
constexpr size_t WS_W = 32 * MiB;
constexpr size_t WS_WIN = WS_W, WS_WOUT = WS_W + 5 * MiB, WS_WUP = WS_W + 8 * MiB, WS_WDN = WS_W + 120 * MiB;
constexpr size_t WS_XN = 224 * MiB;
constexpr size_t WS_Z = 289 * MiB;
constexpr size_t WS_ZT = 452 * MiB;
constexpr size_t WS_ZTC = WS_ZT + 48 * MiB;
constexpr size_t WS_Y = 501 * MiB;
constexpr size_t WS_HF = 566 * MiB;
constexpr size_t WS_HID = 289 * MiB;
constexpr size_t WS_AG = 772 * MiB;
constexpr size_t WS_SLAB = 910 * MiB;
constexpr size_t WS_END = 974 * MiB;

constexpr int CW_TMO = 0, CW_BAR = 4096, CW_MOECNT = 8192;

constexpr int LDS_BYTES = 159744;
constexpr int MISC_OFF = 155648;
constexpr int TAB_OFF = MISC_OFF + 256;

__device__ __forceinline__ unsigned f2bf(float f) { unsigned u = __builtin_bit_cast(unsigned, f); return (u + 0x7fffu + ((u >> 16) & 1u)) >> 16; }
__device__ __forceinline__ unsigned pk2(float lo, float hi) { return f2bf(lo) | (f2bf(hi) << 16); }
__device__ __forceinline__ float bf2f(bf16 b) { return __builtin_bit_cast(float, (unsigned)b << 16); }
template <int CTRL> __device__ __forceinline__ float dpp_f(float v) { return __builtin_bit_cast(float, __builtin_amdgcn_mov_dpp(__builtin_bit_cast(int, v), CTRL, 0xf, 0xf, true)); }
__device__ __forceinline__ float xor1_f(float v) { return dpp_f<0xB1>(v); }
__device__ __forceinline__ float xor2_f(float v) { return dpp_f<0x4E>(v); }
__device__ __forceinline__ float xor16_f(float v) { return __builtin_bit_cast(float, __builtin_amdgcn_ds_swizzle(__builtin_bit_cast(int, v), 0x401F)); }
__device__ __forceinline__ float xor32_f(float v) { auto rr = __builtin_amdgcn_permlane32_swap(__builtin_bit_cast(unsigned, v), __builtin_bit_cast(unsigned, v), false, false);
    return __builtin_bit_cast(float, (unsigned)rr[0]) == v ? __builtin_bit_cast(float, (unsigned)rr[1]) : __builtin_bit_cast(float, (unsigned)rr[0]); }
__device__ __forceinline__ float sum32_f(float v) { auto rr = __builtin_amdgcn_permlane32_swap(__builtin_bit_cast(unsigned, v), __builtin_bit_cast(unsigned, v), false, false);
    return __builtin_bit_cast(float, (unsigned)rr[0]) + __builtin_bit_cast(float, (unsigned)rr[1]); }
__device__ __forceinline__ float wave_sum(float v) {
    v += xor1_f(v); v += xor2_f(v); v += dpp_f<0x141>(v)  ; v += dpp_f<0x140>(v)  ; v += xor16_f(v);
    auto rr = __builtin_amdgcn_permlane32_swap(__builtin_bit_cast(unsigned, v), __builtin_bit_cast(unsigned, v), false, false);
    return __builtin_bit_cast(float, (unsigned)rr[0]) + __builtin_bit_cast(float, (unsigned)rr[1]);
}
__device__ __forceinline__ float sin_rev(float r) { return __builtin_amdgcn_sinf(__builtin_amdgcn_fractf(r)); }
__device__ __forceinline__ float cos_rev(float r) { return __builtin_amdgcn_cosf(__builtin_amdgcn_fractf(r)); }
__device__ __forceinline__ float sin_rad(float x) { return sin_rev(x * 0.15915494309189535f); }
__device__ __forceinline__ int fresh_tid() { int t = threadIdx.x; asm volatile("" : "+v"(t)); return t; }
template <class T> __device__ __forceinline__ T* fresh_ptr(T* p) { asm volatile("" : "+s"(p)); return p; }
#define LDS_WAIT() asm volatile("s_waitcnt lgkmcnt(0)" ::: "memory")
#define VM_WAIT() asm volatile("s_waitcnt vmcnt(0)" ::: "memory")

namespace pg8 {
typedef unsigned short bf16_t;
typedef unsigned u32x4 __attribute__((ext_vector_type(4)));
constexpr int BM = 256, BK = 64, HALF = 128, HTB = HALF * BK * 2, STAGE_BYTES = 8 * HTB, NXCD = 8, WGM = 8;
__host__ __device__ __forceinline__ int lds_byte(int r, int c) { const int st = (r >> 4) * 2 + (c >> 5), rr = r & 15, cc = c & 31, ob = rr * 64 + cc * 2; return st * 1024 + (ob ^ (((ob >> 9) & 1) << 5)); }
__host__ __device__ __forceinline__ void stage_rc(int b, int& R, int& C) { const int st = b / 1024, sb = b % 1024, swz = sb ^ (((sb >> 9) & 1) << 5); R = (st >> 1) * 16 + swz / 64; C = (st & 1) * 32 + (swz % 64) / 2; }
__host__ __device__ __forceinline__ int perm32(int rho) { const int n = rho >> 4, i = rho & 15; return 8 * (i >> 2) + 4 * n + (i & 3); }
struct Unit { int pm, pn, ko, nt, sl; };
struct Gemm { const bf16_t* A; const bf16_t* Bt; int M, N, K; };
struct StaticOrder {
    int nM, nN, nwg, G, c;
    int ntk;
    __host__ __device__ void init(int M, int N, int K, int G_, int c_) { nM = M / BM; nN = N / BM; nwg = nM * nN; G = G_; c = c_; ntk = K / BK; }
    __host__ __device__ __forceinline__ bool next(int i, Unit& u) const { return map((long)i * G + c, u); }
    __host__ __device__ __forceinline__ bool map(long L, Unit& u) const {
        if (L >= nwg) return false; u.ko = 0; u.nt = ntk; u.sl = -1;
        int wgid = (int)L; { const int q = nwg / NXCD, r = nwg % NXCD, xcd = wgid % NXCD, off = wgid / NXCD; wgid = (xcd < r ? xcd * (q + 1) : r * (q + 1) + (xcd - r) * q) + off; }
        const int nig = WGM * nN, gid = wgid / nig, fm = gid * WGM, gsz = (nM - fm) < WGM ? (nM - fm) : WGM;
        u.pm = fm + ((wgid % nig) % gsz); u.pn = (wgid % nig) / gsz; return true;
    }
    __device__ __forceinline__ void a_ready(const Unit&) const {}
    __device__ __forceinline__ void done(const Unit&) const {}
};
__device__ __forceinline__ unsigned cvt_pk_bf16(float lo, float hi) { unsigned r; asm volatile("v_cvt_pk_bf16_f32 %0, %1, %2" : "=v"(r) : "v"(lo), "v"(hi)); return r; }

template <class Epi, class Sched, bool ALIGN_EPI = false, bool SP2 = false>
__device__ __forceinline__ void gemm_phase(LAS unsigned char* lds, const Gemm g, const Sched& S, const Epi& E) {
    const int tid = fresh_tid(), wid = __builtin_amdgcn_readfirstlane(tid >> 6), lane = tid & 63, wr = wid >> 2, wc = wid & 3, fr = lane & 15, fq = lane >> 4;
    const int K = g.K;
    unsigned voffA[2], voffB[2];
#pragma unroll
    for (int i = 0; i < 2; ++i) { int R, C; stage_rc(tid * 16 + i * 8192, R, C); const int Rb = Epi::PERM ? ((R & ~31) + perm32(R & 31)) : R;
        voffA[i] = (unsigned)(R * K + C) * 2u; voffB[i] = (unsigned)(Rb * K + C) * 2u; }
    const size_t kstep = (size_t)(BK * 2);
    const size_t hstep = (size_t)HALF * K * 2;
    const size_t tstep = 2 * hstep;
    const unsigned ldsw = (unsigned)wid * 1024u;
    const int aoff = lds_byte(wr * 64 + fr, fq * 8), boff = lds_byte(wc * 32 + fr, fq * 8);
#define PG8_SA(b, h) (((b) * 2 + (h)) * HTB)
#define PG8_SB(b, h) ((4 + (b) * 2 + (h)) * HTB)
#define PG8_STAGE(bufoff, gbase, voff) do { _Pragma("unroll") for (int _i = 0; _i < 2; ++_i) \
        __builtin_amdgcn_global_load_lds((const unsigned*)((const char*)(gbase) + (voff)[_i]), (LAS unsigned*)(lds + (bufoff) + ldsw + _i * 8192), 16, 0, 0); } while (0)
#define PG8_LDA(dst, b, h) do { _Pragma("unroll") for (int m = 0; m < 4; ++m) _Pragma("unroll") for (int k = 0; k < 2; ++k) dst[m][k] = *(const LAS bf16x8*)(lds + PG8_SA(b, h) + aoff + m * 2048 + k * 1024); } while (0)
#define PG8_LDB(dst, b, h) do { _Pragma("unroll") for (int n = 0; n < 2; ++n) _Pragma("unroll") for (int k = 0; k < 2; ++k) dst[n][k] = *(const LAS bf16x8*)(lds + PG8_SB(b, h) + boff + n * 2048 + k * 1024); } while (0)
#define PG8_MMA(ai, bj, At, Bt) do { __builtin_amdgcn_s_setprio(1); _Pragma("unroll") for (int m = 0; m < 4; ++m) _Pragma("unroll") for (int n = 0; n < 2; ++n) _Pragma("unroll") for (int k = 0; k < 2; ++k) \
        acc[ai][bj][m][n] = __builtin_amdgcn_mfma_f32_16x16x32_bf16(Bt[n][k], At[m][k], acc[ai][bj][m][n], 0, 0, 0); __builtin_amdgcn_s_setprio(0); } while (0)
#define PG8_WAIT_V(n) asm volatile("s_waitcnt vmcnt(" #n ")" ::: "memory")
#define PG8_WAIT_L(n) asm volatile("s_waitcnt lgkmcnt(" #n ")" ::: "memory")
#define PG8_BAR __builtin_amdgcn_s_barrier()
#define PG8_SCHED __builtin_amdgcn_sched_barrier(0)
    Unit cur, nxt; int ui = 0;
    if (!S.next(0, cur)) return;
    f32x4 acc[2][2][4][2];
#pragma unroll
    for (int a = 0; a < 2; ++a)
#pragma unroll
        for (int b = 0; b < 2; ++b)
#pragma unroll
            for (int m = 0; m < 4; ++m)
#pragma unroll
                for (int n = 0; n < 2; ++n) acc[a][b][m][n] = (f32x4){0.f, 0.f, 0.f, 0.f};
    bf16x8 At[4][2], B0[2][2], B1[2][2];
    const char* cA = (const char*)g.A + (size_t)cur.pm * tstep + (size_t)cur.ko * 2; const char* cB = (const char*)g.Bt + (size_t)cur.pn * tstep + (size_t)cur.ko * 2;
    S.a_ready(cur);
    if constexpr (SP2) {
        PG8_STAGE(PG8_SB(0, 0), cB, voffB); PG8_STAGE(PG8_SB(0, 1), cB + hstep, voffB); PG8_STAGE(PG8_SA(0, 0), cA, voffA); PG8_STAGE(PG8_SA(0, 1), cA + hstep, voffA);
        if (wr == 1) PG8_BAR;
        PG8_WAIT_V(2); PG8_BAR;
        PG8_STAGE(PG8_SB(1, 0), cB + kstep, voffB); PG8_STAGE(PG8_SA(1, 0), cA + kstep, voffA); PG8_STAGE(PG8_SB(1, 1), cB + hstep + kstep, voffB);
        PG8_WAIT_V(6); PG8_BAR;
    } else {
        PG8_STAGE(PG8_SB(0, 0), cB, voffB); PG8_STAGE(PG8_SA(0, 0), cA, voffA); PG8_STAGE(PG8_SB(0, 1), cB + hstep, voffB); PG8_STAGE(PG8_SA(0, 1), cA + hstep, voffA);
        if (wr == 1) PG8_BAR;
        PG8_WAIT_V(4); PG8_BAR;
        PG8_STAGE(PG8_SB(1, 0), cB + kstep, voffB); PG8_STAGE(PG8_SA(1, 0), cA + kstep, voffA); PG8_STAGE(PG8_SB(1, 1), cB + hstep + kstep, voffB);
        PG8_WAIT_V(6); PG8_BAR;
    }
    for (;;) {
        const bool has_next = S.next(ui + 1, nxt);
        const char* nA = has_next ? (const char*)g.A + (size_t)nxt.pm * tstep + (size_t)nxt.ko * 2 : cA; const char* nB = has_next ? (const char*)g.Bt + (size_t)nxt.pn * tstep + (size_t)nxt.ko * 2 : cB;
        const int nt = cur.nt;
        for (int t = 0; t < nt; t += 2) {
            const bool last = (t == nt - 2);
            const char* a1 = cA + (size_t)(t + 1) * kstep;
            const char* a2 = last ? nA : cA + (size_t)(t + 2) * kstep; const char* b2 = last ? nB : cB + (size_t)(t + 2) * kstep;
            const char* a3 = a2 + kstep; const char* b3 = b2 + kstep;
            if (last && has_next) S.a_ready(nxt);
            if constexpr (SP2) {
            PG8_LDB(B0, 0, 0); PG8_LDB(B1, 0, 1); PG8_SCHED; PG8_LDA(At, 0, 0); PG8_STAGE(PG8_SA(1, 1), a1 + hstep, voffA);
            PG8_WAIT_V(8); PG8_WAIT_L(0); PG8_BAR; PG8_MMA(0, 0, At, B0); PG8_MMA(0, 1, At, B1); PG8_BAR; PG8_SCHED;
            PG8_LDA(At, 0, 1); PG8_STAGE(PG8_SB(0, 0), b2, voffB); PG8_STAGE(PG8_SB(0, 1), b2 + hstep, voffB); PG8_STAGE(PG8_SA(0, 0), a2, voffA);
            PG8_WAIT_V(8); PG8_WAIT_L(0); PG8_BAR; PG8_MMA(1, 0, At, B0); PG8_MMA(1, 1, At, B1); PG8_BAR; PG8_SCHED;
            PG8_LDB(B0, 1, 0); PG8_LDB(B1, 1, 1); PG8_SCHED; PG8_LDA(At, 1, 0); PG8_STAGE(PG8_SA(0, 1), a2 + hstep, voffA);
            PG8_WAIT_V(8); PG8_WAIT_L(0); PG8_BAR; PG8_MMA(0, 0, At, B0); PG8_MMA(0, 1, At, B1); PG8_BAR; PG8_SCHED;
            PG8_LDA(At, 1, 1); PG8_STAGE(PG8_SB(1, 0), b3, voffB); PG8_STAGE(PG8_SB(1, 1), b3 + hstep, voffB); PG8_STAGE(PG8_SA(1, 0), a3, voffA);
            PG8_WAIT_V(8); PG8_WAIT_L(0); PG8_BAR; PG8_MMA(1, 0, At, B0); PG8_MMA(1, 1, At, B1); PG8_BAR; PG8_SCHED;
            } else {
            PG8_LDB(B0, 0, 0); PG8_SCHED; PG8_LDA(At, 0, 0); PG8_STAGE(PG8_SA(1, 1), a1 + hstep, voffA);
            PG8_WAIT_L(8); PG8_BAR; PG8_WAIT_L(0); PG8_MMA(0, 0, At, B0); PG8_BAR; PG8_SCHED;
            PG8_LDB(B1, 0, 1); PG8_STAGE(PG8_SB(0, 0), b2, voffB);
            PG8_BAR; PG8_WAIT_L(0); PG8_MMA(0, 1, At, B1); PG8_BAR;
            PG8_LDA(At, 0, 1); PG8_STAGE(PG8_SA(0, 0), a2, voffA);
            PG8_BAR; PG8_WAIT_L(0); PG8_MMA(1, 0, At, B0); PG8_BAR; PG8_SCHED;
            PG8_STAGE(PG8_SB(0, 1), b2 + hstep, voffB);
            PG8_WAIT_V(6); PG8_BAR; PG8_MMA(1, 1, At, B1); PG8_BAR;
            PG8_LDB(B0, 1, 0); PG8_SCHED; PG8_LDA(At, 1, 0); PG8_STAGE(PG8_SA(0, 1), a2 + hstep, voffA);
            PG8_WAIT_L(8); PG8_BAR; PG8_WAIT_L(0); PG8_MMA(0, 0, At, B0); PG8_BAR; PG8_SCHED;
            PG8_LDB(B1, 1, 1); PG8_STAGE(PG8_SB(1, 0), b3, voffB);
            PG8_BAR; PG8_WAIT_L(0); PG8_MMA(0, 1, At, B1); PG8_BAR;
            PG8_LDA(At, 1, 1); PG8_STAGE(PG8_SA(1, 0), a3, voffA);
            PG8_BAR; PG8_WAIT_L(0); PG8_MMA(1, 0, At, B0); PG8_BAR; PG8_SCHED;
            PG8_STAGE(PG8_SB(1, 1), b3 + hstep, voffB);
            PG8_WAIT_V(6); PG8_BAR; PG8_MMA(1, 1, At, B1); PG8_BAR;
            }
        }
        if constexpr (ALIGN_EPI) { if (wr == 0) PG8_BAR; }
        E(acc, cur, wr, wc, fr, fq); S.done(cur);
        if (!has_next) break;
#pragma unroll
        for (int a = 0; a < 2; ++a)
#pragma unroll
            for (int b = 0; b < 2; ++b)
#pragma unroll
                for (int m = 0; m < 4; ++m)
#pragma unroll
                    for (int n = 0; n < 2; ++n) acc[a][b][m][n] = (f32x4){0.f, 0.f, 0.f, 0.f};
        cur = nxt; cA = nA; cB = nB; ++ui;
        if constexpr (ALIGN_EPI) { if (wr == 1) PG8_BAR; }
    }
    PG8_WAIT_V(0);
    if constexpr (!ALIGN_EPI) { if (wr == 0) PG8_BAR; }
    PG8_BAR;
#undef PG8_SA
#undef PG8_SB
#undef PG8_STAGE
#undef PG8_LDA
#undef PG8_LDB
#undef PG8_MMA
#undef PG8_WAIT_V
#undef PG8_WAIT_L
#undef PG8_BAR
#undef PG8_SCHED
}
}

#define XB_TMO      128
#define XB_XCNT(j)  (256  + 64 * (j))
#define XB_XSUB(j)  (1280 + 64 * (j))
#define XB_XGEN(j)  (2304 + 64 * (j))
#define XB_TOP      3328
#define XB_TOPGEN   3392
#define XCD_BAR_WORDS 3456
#define XB_SPIN_CAP (1u << 18)
__device__ __forceinline__ unsigned xb_ld(unsigned* p)              { return __hip_atomic_load(p, __ATOMIC_RELAXED, __HIP_MEMORY_SCOPE_AGENT); }
__device__ __forceinline__ unsigned xb_add(unsigned* p, unsigned v) { return __hip_atomic_fetch_add(p, v, __ATOMIC_RELAXED, __HIP_MEMORY_SCOPE_AGENT); }
__device__ __forceinline__ unsigned xb_xcc_id() { return (unsigned)__builtin_amdgcn_s_getreg((3 << 11) | 20) & 0xFu; }
#define XB_SPIN(cond, bar) do { unsigned _sp = 0; while (cond) { __builtin_amdgcn_s_sleep(1); \
    if ((++_sp & 255u) == 0u) { if (xb_ld(&(bar)[XB_TMO])) break; if (_sp > XB_SPIN_CAP) { atomicAdd(&(bar)[XB_TMO], 1u); break; } } } } while (0)
struct XcdBarrier { unsigned* bar; unsigned x; volatile LAS unsigned* st; };
__device__ __forceinline__ XcdBarrier xcd_barrier_post(unsigned* bar, volatile LAS unsigned* st) {
    XcdBarrier b; b.bar = bar; b.x = xb_xcc_id(); b.st = st;
    if (threadIdx.x == 0) (void)xb_add(&bar[XB_XCNT(b.x)], 1u);
    return b;
}
__device__ __forceinline__ void xcd_barrier_complete(unsigned* bar, unsigned x, unsigned& nloc, unsigned& nx) {
    const unsigned G = gridDim.x * gridDim.y * gridDim.z;
    unsigned sum, cnt, mine, sp = 0u;
    for (;;) {
        sum = 0u; cnt = 0u; mine = 0u;
#pragma unroll
        for (unsigned j = 0; j < 16; ++j) { const unsigned c = xb_ld(&bar[XB_XCNT(j)]); sum += c; cnt += (c > 0u) ? 1u : 0u; mine = (j == x) ? c : mine; }
        if (sum == G) break;
        __builtin_amdgcn_s_sleep(1);
        if ((++sp & 255u) == 0u) { if (xb_ld(&bar[XB_TMO])) break; if (sp > XB_SPIN_CAP) { atomicAdd(&bar[XB_TMO], 1u); break; } }
    }
    nloc = mine > 0u ? mine : 1u; nx = cnt > 0u ? cnt : 1u;
}
__device__ __forceinline__ void xcd_barrier(const XcdBarrier& b) {
    asm volatile("s_waitcnt vmcnt(0)" ::: "memory");
    __syncthreads();
    if (threadIdx.x == 0) {
        unsigned* bar = b.bar;
        __builtin_amdgcn_s_waitcnt(0);
        unsigned nloc = b.st[0], nx = b.st[1];
        if (nloc == 0u) { xcd_barrier_complete(bar, b.x, nloc, nx); b.st[0] = nloc; b.st[1] = nx; }
        const unsigned old = xb_add(&bar[XB_XSUB(b.x)], 1u);
        const unsigned gen = old / nloc;
        if (old + 1u == (gen + 1u) * nloc) {
            __builtin_amdgcn_fence(__ATOMIC_RELEASE, "agent");
            asm volatile("s_waitcnt vmcnt(0)" ::: "memory");
            const unsigned og = xb_add(&bar[XB_TOP], 1u);
            const unsigned tg = og / nx;
            if (og + 1u == (tg + 1u) * nx) xb_add(&bar[XB_TOPGEN], 1u);
            else XB_SPIN(xb_ld(&bar[XB_TOPGEN]) == tg, bar);
            __builtin_amdgcn_fence(__ATOMIC_ACQUIRE, "agent");
            xb_add(&bar[XB_XGEN(b.x)], 1u);
            asm volatile("s_waitcnt vmcnt(0)" ::: "memory");
        } else {
            XB_SPIN(xb_ld(&bar[XB_XGEN(b.x)]) == gen, bar);
            __builtin_amdgcn_fence(__ATOMIC_ACQUIRE, "agent");
            asm volatile("s_waitcnt vmcnt(0)" ::: "memory");
        }
    }
    __syncthreads();
}

__device__ __forceinline__ const float* xrow_in(int R, const float* xlat, const float* hctx) {
    const int b = R / RB, rr = R - b * RB;
    return rr < CTXL ? hctx + (size_t)(b * CTXL + rr) * DM : xlat + (size_t)(b * SEQ + rr - CTXL) * DM;
}
__device__ __forceinline__ float* xrow_out(int R, float* xlat, float* hctx) {
    const int b = R / RB, rr = R - b * RB;
    return rr < CTXL ? hctx + (size_t)(b * CTXL + rr) * DM : xlat + (size_t)(b * SEQ + rr - CTXL) * DM;
}
__device__ __forceinline__ int row_set(int R) { const int b = R / RB, rr = R - b * RB; return rr < CTXL ? 2 : b; }

__device__ __forceinline__ int qk_perm(int c) {
    const int bj = c >> 7, wc = (c >> 5) & 3, fq = (c >> 3) & 3, n = (c >> 2) & 1, j = c & 3;
    return 64 * wc + 32 * (fq >> 1) + 16 * bj + 8 * (fq & 1) + 4 * n + j;
}
struct EpiIn {
    static constexpr bool PERM = true;
    bf16* Z; bf16* ZT; bf16* ZTC; const float* ropec; const float* ropes; const float* qkg;
    __device__ __forceinline__ void operator()(const f32x4 (&acc)[2][2][4][2], const pg8::Unit& u, int wr, int wc, int fr, int fq) const {
        const int b = u.pm / TPB, jt = u.pm - b * TPB; const bool isctx = (jt == 0);
        if (u.pn == 0 || u.pn >= 8) {
#pragma unroll
            for (int ai = 0; ai < 2; ++ai)
#pragma unroll
                for (int m = 0; m < 4; ++m) { const int r = 128 * ai + 64 * wr + 16 * m + fr; bf16* rowp = Z + (size_t)(u.pm * 256 + r) * INW + u.pn * 256 + 32 * wc + 8 * fq;
#pragma unroll
                    for (int bj = 0; bj < 2; ++bj) { const f32x4 v0 = acc[ai][bj][m][0], v1 = acc[ai][bj][m][1];
                        v4u w; w.x = pg8::cvt_pk_bf16(v0[0], v0[1]); w.y = pg8::cvt_pk_bf16(v0[2], v0[3]); w.z = pg8::cvt_pk_bf16(v1[0], v1[1]); w.w = pg8::cvt_pk_bf16(v1[2], v1[3]);
                        *(v4u*)(rowp + bj * 128) = w; } }
        } else if (u.pn <= 3) {
            bf16* base = isctx ? ZTC + (size_t)b * 768 * CTXL : ZT + (size_t)b * 768 * SEQ + (size_t)(jt - 1) * 256;
            const size_t cstride = isctx ? CTXL : SEQ;
#pragma unroll
            for (int bj = 0; bj < 2; ++bj)
#pragma unroll
                for (int n = 0; n < 2; ++n)
#pragma unroll
                    for (int j = 0; j < 4; ++j) { const int ch = 256 * (u.pn - 1) + 128 * bj + 32 * wc + 8 * fq + 4 * n + j; bf16* cp = base + (size_t)ch * cstride;
#pragma unroll
                        for (int ai = 0; ai < 2; ++ai)
#pragma unroll
                            for (int m = 0; m < 4; ++m) { const int r = 128 * ai + 64 * wr + 16 * m + fr; cp[r] = (bf16)f2bf(acc[ai][bj][m][n][j]); } }
        } else {
            const int which = (u.pn >= 6) ? 1 : 0; const float osc = which ? 1.0f : C2;
            const int axis = fq >> 1, f0 = 8 * (fq & 1);
            float ga[2][4], gb[2][4];
#pragma unroll
            for (int n = 0; n < 2; ++n)
#pragma unroll
                for (int j = 0; j < 4; ++j) { ga[n][j] = qkg[which * 64 + 32 * axis + f0 + 4 * n + j]; gb[n][j] = qkg[which * 64 + 32 * axis + 16 + f0 + 4 * n + j]; }
#pragma unroll
            for (int ai = 0; ai < 2; ++ai)
#pragma unroll
                for (int m = 0; m < 4; ++m) {
                    const int r = 128 * ai + 64 * wr + 16 * m + fr;
                    float ss = 0.f;
#pragma unroll
                    for (int bj = 0; bj < 2; ++bj)
#pragma unroll
                        for (int n = 0; n < 2; ++n) { const f32x4 x = acc[ai][bj][m][n]; ss += (x[0] * x[0] + x[1] * x[1]) + (x[2] * x[2] + x[3] * x[3]); }
                    ss += xor16_f(ss); ss = sum32_f(ss);
                    const float rinv = __builtin_amdgcn_rsqf(ss * (1.0f / 64.0f) + 1e-6f);
                    f32x4 cv[2], sv[2];
                    if (!isctx) { const int t = (jt - 1) * 256 + r; const int pos = axis ? (t & 63) : (t >> 6);
                        cv[0] = *(const f32x4*)(ropec + pos * 16 + f0); cv[1] = *(const f32x4*)(ropec + pos * 16 + f0 + 4);
                        sv[0] = *(const f32x4*)(ropes + pos * 16 + f0); sv[1] = *(const f32x4*)(ropes + pos * 16 + f0 + 4); }
                    else { cv[0] = cv[1] = (f32x4){1.f, 1.f, 1.f, 1.f}; sv[0] = sv[1] = (f32x4){0.f, 0.f, 0.f, 0.f}; }
                    float oa[8], ob[8];
#pragma unroll
                    for (int n = 0; n < 2; ++n)
#pragma unroll
                        for (int j = 0; j < 4; ++j) { const float a = acc[ai][0][m][n][j] * rinv * ga[n][j], bb = acc[ai][1][m][n][j] * rinv * gb[n][j];
                            oa[4 * n + j] = (a * cv[n][j] - bb * sv[n][j]) * osc; ob[4 * n + j] = (bb * cv[n][j] + a * sv[n][j]) * osc; }
                    bf16* rowp = Z + (size_t)(u.pm * 256 + r) * INW + u.pn * 256 + 64 * wc + 32 * axis + f0;
                    v4u w; w.x = pg8::cvt_pk_bf16(oa[0], oa[1]); w.y = pg8::cvt_pk_bf16(oa[2], oa[3]); w.z = pg8::cvt_pk_bf16(oa[4], oa[5]); w.w = pg8::cvt_pk_bf16(oa[6], oa[7]);
                    *(v4u*)(rowp) = w;
                    w.x = pg8::cvt_pk_bf16(ob[0], ob[1]); w.y = pg8::cvt_pk_bf16(ob[2], ob[3]); w.z = pg8::cvt_pk_bf16(ob[4], ob[5]); w.w = pg8::cvt_pk_bf16(ob[6], ob[7]);
                    *(v4u*)(rowp + 16) = w;
                }
        }
    }
};
struct EpiRes {
    static constexpr bool PERM = false;
    const float* xin; float* xout; float* hctx; const float* gate; int ntk_full; float* slab; float gsc;
    __device__ __forceinline__ void operator()(const f32x4 (&acc)[2][2][4][2], const pg8::Unit& u, int wr, int wc, int fr, int fq) const {
        const int b = u.pm / TPB, jt = u.pm - b * TPB; const bool isctx = (jt == 0); const int set = isctx ? 2 : b;
        const int col0 = u.pn * 256 + wc * 32 + 4 * fq;
        f32x4 gv[2][2];
#pragma unroll
        for (int bj = 0; bj < 2; ++bj)
#pragma unroll
            for (int n = 0; n < 2; ++n) gv[bj][n] = *(const f32x4*)(gate + set * 6144 + col0 + bj * 128 + n * 16) * gsc;
        const unsigned long long coff = (unsigned long long)(b * CTXL) * DM * 4, loff = (unsigned long long)(b * SEQ + (jt - 1) * 256) * DM * 4;
        const unsigned long long ia = isctx ? (unsigned long long)hctx + coff : (unsigned long long)xin + loff, oa = isctx ? (unsigned long long)hctx + coff : (unsigned long long)xout + loff;
        const GAS char* ib = (const GAS char*)ia; GAS char* ob = (GAS char*)oa;
        const unsigned lo = (unsigned)((64 * wr + fr) * DM + col0) * 4u;
        if (u.nt == ntk_full) {
#pragma unroll
            for (int ai = 0; ai < 2; ++ai)
#pragma unroll
                for (int m = 0; m < 4; ++m) { const unsigned off = lo + (unsigned)(128 * ai + 16 * m) * DM * 4u;
#pragma unroll
                    for (int bj = 0; bj < 2; ++bj)
#pragma unroll
                        for (int n = 0; n < 2; ++n) { const f32x4 xi = *(const GAS f32x4*)(ib + off + (bj * 128 + n * 16) * 4); *(GAS f32x4*)(ob + off + (bj * 128 + n * 16) * 4) = xi + gv[bj][n] * acc[ai][bj][m][n]; }
                    if (m == 3) asm volatile("" ::: "memory"); }
        } else {
            int fr_ = fr; asm volatile("" : "+v"(fr_));
            GAS float* sp = (GAS float*)(slab + (size_t)u.sl * 65536) + (unsigned)((64 * wr + fr_) * 256 + wc * 32 + 4 * fq);
#pragma unroll
            for (int ai = 0; ai < 2; ++ai)
#pragma unroll
                for (int m = 0; m < 4; ++m)
#pragma unroll
                    for (int bj = 0; bj < 2; ++bj)
#pragma unroll
                        for (int n = 0; n < 2; ++n) *(GAS f32x4*)(sp + (128 * ai + 16 * m) * 256 + bj * 128 + n * 16) = gv[bj][n] * acc[ai][bj][m][n];
        }
    }
};
__device__ __forceinline__ float silu_mul(float g, float u) { return g * u * __builtin_amdgcn_rcpf(1.0f + __builtin_amdgcn_exp2f(-1.4426950408889634f * g)); }
struct EpiGlu {
    static constexpr bool PERM = true;
    bf16* H; int ldh; int NT;
    __device__ __forceinline__ void operator()(const f32x4 (&acc)[2][2][4][2], const pg8::Unit& u, int wr, int wc, int fr, int fq) const {
        const int nt = u.pn % NT;
#pragma unroll
        for (int ai = 0; ai < 2; ++ai)
#pragma unroll
            for (int m = 0; m < 4; ++m) { const int r = 128 * ai + 64 * wr + 16 * m + fr; bf16* rowp = H + (size_t)(u.pm * 256 + r) * ldh + nt * 128 + 32 * wc + 8 * fq;
                float o[8];
#pragma unroll
                for (int n = 0; n < 2; ++n)
#pragma unroll
                    for (int j = 0; j < 4; ++j) o[4 * n + j] = silu_mul(acc[ai][0][m][n][j], acc[ai][1][m][n][j]);
                v4u w; w.x = pg8::cvt_pk_bf16(o[0], o[1]); w.y = pg8::cvt_pk_bf16(o[2], o[3]); w.z = pg8::cvt_pk_bf16(o[4], o[5]); w.w = pg8::cvt_pk_bf16(o[6], o[7]);
                *(v4u*)rowp = w; }
    }
};
__device__ __forceinline__ void k_quarter(int ntk, int kq, int& ko, int& nt) {
    const int pairs = ntk >> 1; int start = 0, len = 0;
#pragma unroll
    for (int q = 0; q < 4; ++q) { const int l = (pairs + 3 - q) >> 2; if (q < kq) start += l; if (q == kq) len = l; }
    ko = start * 128; nt = len * 2;
}
struct SplitTailOrder {
    pg8::StaticOrder S; int nN, nmain;
    __device__ __forceinline__ void init(int N, int K, int G, int c) { S.init(NB * SEQ, N, K, G, c); nN = N / 256; nmain = (NB * SEQ / 256) * nN; }
    __device__ __forceinline__ bool next(int i, pg8::Unit& u) const {
        const long L = (long)i * S.G + S.c;
        if (L < nmain) { S.map(L, u); u.pm += 1 + (u.pm >= SEQ / 256 ? 1 : 0); return true; }
        const int Lt = (int)(L - nmain); if (Lt >= 2 * nN * 4) return false;
        const int kq = Lt & 3, r = Lt >> 2; u.pn = r % nN; u.pm = (r / nN) * TPB; k_quarter(S.ntk, kq, u.ko, u.nt); u.sl = ((r / nN) * 4 + u.pn) * 4 + kq; return true;
    }
    __device__ __forceinline__ void a_ready(const pg8::Unit&) const {}
    __device__ __forceinline__ void done(const pg8::Unit&) const {}
};
struct MoeOrder {
    int G, c, NT, tlo, nunits; const LAS int* tab; int ntk;
    __device__ __forceinline__ bool next(int i, pg8::Unit& u) const {
        const int L = i * G + c; if (L >= nunits) return false;
        const int tau = tlo + L / NT, nt = L - (L / NT) * NT;
        int s = 0;
#pragma unroll
        for (int q = 1; q < 16; ++q) s += (tab[q] <= tau) ? 1 : 0;
        u.pm = tau; u.pn = (s & 7) * NT + nt; u.ko = 0; u.nt = ntk; u.sl = -1; return true;
    }
    __device__ __forceinline__ void a_ready(const pg8::Unit&) const {}
    __device__ __forceinline__ void done(const pg8::Unit&) const {}
};
struct MoeDownOrder {
    int G, c, k, nmain, ntailu; const LAS int* tab;
    __device__ __forceinline__ void init(int G_, int c_, int k_, const LAS int* tab_) { G = G_; c = c_; k = k_; tab = tab_; nmain = (tab[64 + 8 * k + 8] - tab[64 + 8 * k]) * 4; ntailu = tab[112 + k] * 16; }
    __device__ __forceinline__ bool next(int i, pg8::Unit& u) const {
        const int L = i * G + c;
        if (L < nmain) { const int mu = tab[64 + 8 * k] + (L >> 2); int s = 0;
#pragma unroll
            for (int q = 1; q < 16; ++q) s += (tab[64 + q] <= mu) ? 1 : 0;
            u.pm = tab[s] + (mu - tab[64 + s]); u.pn = (s & 7) * 4 + (L & 3); u.ko = 0; u.nt = DFE / 64; u.sl = -1; return true; }
        const int Lt = L - nmain; if (Lt >= ntailu) return false;
        const int s = tab[96 + 8 * k + (Lt >> 4)]; u.pm = tab[s + 1] - 1; u.pn = (s & 7) * 4 + ((Lt >> 2) & 3); k_quarter(DFE / 64, Lt & 3, u.ko, u.nt); u.sl = 8 * 16 * k + Lt; return true;
    }
    __device__ __forceinline__ void a_ready(const pg8::Unit&) const {}
    __device__ __forceinline__ void done(const pg8::Unit&) const {}
};
struct EpiMoeDown {
    static constexpr bool PERM = false;
    float* xlat; float* hctx; const float* gate; const int* rtok; const float* rgate; const LAS int* tab; float* slab; float gsc;
    __device__ __forceinline__ void operator()(const f32x4 (&acc)[2][2][4][2], const pg8::Unit& u, int wr, int wc, int fr, int fq) const {
        const int tau = u.pm; int s = 0;
#pragma unroll
        for (int q = 1; q < 16; ++q) s += (tab[q] <= tau) ? 1 : 0;
        const int idx0 = (tau - tab[s]) * 256, cnt = tab[32 + s];
        const int col0 = (u.pn & 3) * 256 + wc * 32 + 4 * fq;
        const bool full = (u.nt == DFE / 64);
        if (full) {
            int Rr[8]; float gt[8]; bool ok[8];
#pragma unroll
            for (int q = 0; q < 8; ++q) { const int idx = idx0 + 128 * (q >> 2) + 64 * wr + 16 * (q & 3) + fr; ok[q] = idx < cnt; const int ic = ok[q] ? idx : idx0;
                Rr[q] = rtok[(size_t)s * SEGCAP + ic]; gt[q] = rgate[(size_t)s * SEGCAP + ic] * gsc; }
#pragma unroll
            for (int rp = 0; rp < 4; ++rp) {
                f32x4 gv[2][2][2], xi[2][2][2]; float* xp[2];
#pragma unroll
                for (int j = 0; j < 2; ++j) { const int q = 2 * rp + j; xp[j] = xrow_out(Rr[q], xlat, hctx) + col0; const float* gp = gate + row_set(Rr[q]) * 6144 + col0;
#pragma unroll
                    for (int bj = 0; bj < 2; ++bj)
#pragma unroll
                        for (int n = 0; n < 2; ++n) { gv[j][bj][n] = *(const f32x4*)(gp + bj * 128 + n * 16); xi[j][bj][n] = *(const f32x4*)(xp[j] + bj * 128 + n * 16); } }
#pragma unroll
                for (int j = 0; j < 2; ++j) { const int q = 2 * rp + j;
                    if (ok[q]) {
#pragma unroll
                        for (int bj = 0; bj < 2; ++bj)
#pragma unroll
                            for (int n = 0; n < 2; ++n) *(f32x4*)(xp[j] + bj * 128 + n * 16) = xi[j][bj][n] + gv[j][bj][n] * gt[q] * acc[q >> 2][bj][q & 3][n]; } }
            }
        } else {
#pragma unroll
        for (int ai = 0; ai < 2; ++ai)
#pragma unroll
            for (int m = 0; m < 4; ++m) { const int idx = idx0 + 128 * ai + 64 * wr + 16 * m + fr;
                if (idx < cnt) { const int R = rtok[(size_t)s * SEGCAP + idx]; const float gt = rgate[(size_t)s * SEGCAP + idx] * gsc;
                    const float* gp = gate + row_set(R) * 6144 + col0;
#pragma unroll
                    for (int bj = 0; bj < 2; ++bj)
#pragma unroll
                        for (int n = 0; n < 2; ++n) { const f32x4 gv = *(const f32x4*)(gp + bj * 128 + n * 16); const f32x4 v = gv * gt * acc[ai][bj][m][n];
                            int fr_ = fr; asm volatile("" : "+v"(fr_));
                            *(GAS f32x4*)((GAS char*)(slab + (size_t)u.sl * 65536) + (unsigned)(((128 * ai + 64 * wr + 16 * m + fr_) * 256 + wc * 32 + 4 * fq + bj * 128 + n * 16) * 4)) = v; } } }
        }
    }
};

__device__ __forceinline__ void transpose_item(const float* colp  , int ldw, int K, bf16* WT, int kb, int n0, int lane) {
    const int hh = lane >> 5, m = lane & 31, k0 = 64 * kb + 32 * hh;
    f32x4 v[32];
#pragma unroll
    for (int i = 0; i < 32; ++i) v[i] = *(const f32x4*)(colp + (size_t)(k0 + i) * ldw);
    bf16* dp = WT + (size_t)(n0 + 4 * m) * K + k0;
#pragma unroll
    for (int jj = 0; jj < 4; ++jj)
#pragma unroll
        for (int h8 = 0; h8 < 4; ++h8) { v4u o; o.x = pk2(v[8 * h8][jj], v[8 * h8 + 1][jj]); o.y = pk2(v[8 * h8 + 2][jj], v[8 * h8 + 3][jj]); o.z = pk2(v[8 * h8 + 4][jj], v[8 * h8 + 5][jj]); o.w = pk2(v[8 * h8 + 6][jj], v[8 * h8 + 7][jj]);
            *(v4u*)(dp + (size_t)jj * K + 8 * h8) = o; }
}
__device__ __forceinline__ int src_in_col(int nd) { const int t = nd >> 8, c = nd & 255; return (t >= 4 && t <= 7) ? (t * 256 + qk_perm(c)) : nd; }

struct Args { const float* in[32]; float* out; unsigned char* ws; int ph_lo, ph_hi; };
constexpr int PTAB_OFF = MISC_OFF + 1024;
__device__ __forceinline__ const float* inptr(LAS unsigned char* lds, int k) {
    const LAS unsigned* p = (const LAS unsigned*)(lds + PTAB_OFF) + 2 * k;
    const unsigned lo = (unsigned)__builtin_amdgcn_readfirstlane((int)p[0]), hi = (unsigned)__builtin_amdgcn_readfirstlane((int)p[1]);
    return (const float*)(const GAS float*)(((unsigned long long)hi << 32) | lo);
}
#define AIN(k) inptr(lds, (k))

__device__ __forceinline__ float block_sum(float v, LAS float* red, int wave, int lane) {
    v = wave_sum(v);
    if (lane == 0) red[wave] = v;
    __syncthreads();
    float s = 0.f;
#pragma unroll
    for (int w = 0; w < NWAVES; ++w) s += red[w];
    __syncthreads();
    return s;
}

__device__ __forceinline__ void phase_prep_a(const Args& a, int li, LAS unsigned char* lds, int G, int bx) {
    const int tid = fresh_tid(), lane = tid & 63, wave = __builtin_amdgcn_readfirstlane(tid >> 6);
    const int gw = bx * NWAVES + wave, NGW = G * NWAVES;
    unsigned char* ws = fresh_ptr(a.ws);
    const bool moe = (li & 1) != 0; const int lj = li >> 1;
    {
        bf16* win_t = (bf16*)(ws + WS_WIN); bf16* wout_t = (bf16*)(ws + WS_WOUT); bf16* wup_t = (bf16*)(ws + WS_WUP); bf16* wdn_t = (bf16*)(ws + WS_WDN);
        const float* w_in = AIN(8) + (size_t)li * DM * INW; const float* w_out = AIN(9) + (size_t)li * DM * DM;
        constexpr int I_IN = 16 * 20, I_OUT = 16 * 8, I_UPD = 16 * 44, I_DND = 44 * 8, I_UPE = 16 * 56, I_DNE = 56 * 8;
        const int NIT = moe ? (I_IN + I_OUT + NEXP * (I_UPE + I_DNE)) : (I_IN + I_OUT + I_UPD + I_DND);
        const int m4 = 4 * (lane & 31);
        for (int it = gw; it < NIT; it += NGW) {
            int r = it;
            if (r < I_IN) { const int nb = r % 20; transpose_item(w_in + src_in_col(128 * nb + m4), INW, DM, win_t, r / 20, 128 * nb, lane); continue; } r -= I_IN;
            if (r < I_OUT) { const int nb = r % 8; transpose_item(w_out + 128 * nb + m4, DM, DM, wout_t, r / 8, 128 * nb, lane); continue; } r -= I_OUT;
            if (!moe) {
                if (r < I_UPD) { const int nb = r % 44; const float* W = (nb & 1) ? AIN(26) : AIN(25);
                    transpose_item(W + (size_t)lj * DM * DFF + (nb >> 1) * 128 + m4, DFF, DM, wup_t, r / 44, 128 * nb, lane); continue; } r -= I_UPD;
                { const int nb = r % 8; transpose_item(AIN(27) + (size_t)lj * DFF * DM + 128 * nb + m4, DM, DFF, wdn_t, r / 8, 128 * nb, lane); }
            } else {
                if (r < NEXP * I_UPE) { const int e = r / I_UPE, r2 = r % I_UPE, nb = r2 % 56; const size_t wo = (size_t)(lj * NEXP + e) * DM * DFE;
                    const float* W = (nb & 1) ? AIN(30) : AIN(29);
                    transpose_item(W + wo + (nb >> 1) * 128 + m4, DFE, DM, wup_t + (size_t)e * 2 * DFE * DM, r2 / 56, 128 * nb, lane); continue; } r -= NEXP * I_UPE;
                const int e = r / I_DNE, r2 = r % I_DNE, nb = r2 % 8;
                transpose_item(AIN(31) + (size_t)(lj * NEXP + e) * DFE * DM + 128 * nb + m4, DM, DFE, wdn_t + (size_t)e * DM * DFE, r2 / 8, 128 * nb, lane);
            }
        }
    }
    if (li == 0) for (int l = 0; l < DEPTH; ++l) {
        const float* w1 = AIN(14) + l * 33 * 64; const float* w2 = AIN(17) + l * 64 * 64;
        const float bb1 = AIN(15)[l * 64 + lane], ff1 = AIN(16)[l * 64 + lane], bb2 = AIN(18)[l * 64 + lane], ff2 = AIN(19)[l * 64 + lane];
        float w1c[33], w2c[64];
#pragma unroll
        for (int q = 0; q < 33; ++q) w1c[q] = w1[q * 64 + lane];
#pragma unroll
        for (int q = 0; q < 64; ++q) w2c[q] = w2[q * 64 + lane];
        bf16* H2B = (bf16*)(ws + WS_H2B) + (size_t)l * (SEQ + CTXL) * 64;
        for (int tt = gw; tt < SEQ + CTXL; tt += NGW) {
            const int L = tt < SEQ ? SEQ : CTXL, t = tt < SEQ ? tt : tt - SEQ;
            float feat = 0.f;
            if (lane == 0) feat = (float)t / (float)(L - 1);
            else if (lane <= 32) { const int jb = (lane - 1) & 15; const float rev = (float)((jb * t) & (L - 1)) / (float)L + 1e-4f * (1.0f - (float)jb * (1.0f / 15.0f)) * (float)t / (float)L;
                feat = lane <= 16 ? __builtin_amdgcn_cosf(__builtin_amdgcn_fractf(rev)) : -__builtin_amdgcn_sinf(__builtin_amdgcn_fractf(rev)); }
            float z1 = 0.f;
#pragma unroll
            for (int q = 0; q < 33; ++q) z1 += __builtin_bit_cast(float, __builtin_amdgcn_readlane(__builtin_bit_cast(int, feat), q)) * w1c[q];
            const float h1 = sin_rad(ff1 * (z1 + bb1));
            float z2 = 0.f;
#pragma unroll
            for (int q = 0; q < 64; ++q) z2 += __builtin_bit_cast(float, __builtin_amdgcn_readlane(__builtin_bit_cast(int, h1), q)) * w2c[q];
            H2B[(size_t)tt * 64 + lane] = (bf16)f2bf(sin_rad(ff2 * (z2 + bb2)));
        }
    }
    if (li == 0) {
        __syncthreads();
        LAS float* sv = (LAS float*)lds;
        for (int idx = tid; idx < 3 * DM; idx += NTHR) { const int s = idx >> 10, k = idx & 1023; const float v = s < 2 ? AIN(1)[s * DM + k] : AIN(3)[k];
            sv[idx] = v * __builtin_amdgcn_rcpf(1.0f + __builtin_amdgcn_exp2f(-1.4426950408889634f * v)); }
        __syncthreads();
        float* MODP = (float*)(ws + WS_MODP);
        for (int it = bx; it < 4 * 8 * 12; it += G) {
            const int l = it / 96, q = (it / 12) & 7, jc = it % 12, j = jc * 512 + tid;
            const float* wp = AIN(4) + ((size_t)l * DM + q * 128) * 6144 + j;
            float a0 = 0.f, a1 = 0.f, a2 = 0.f;
#pragma unroll 8
            for (int k = 0; k < 128; ++k) { const float w = wp[(size_t)k * 6144]; a0 += sv[q * 128 + k] * w; a1 += sv[DM + q * 128 + k] * w; a2 += sv[2 * DM + q * 128 + k] * w; }
            float* dp = MODP + (size_t)((q * 4 + l) * 3) * 6144 + j;
            dp[0] = a0; dp[6144] = a1; dp[2 * 6144] = a2;
        }
        const int gid = bx * NTHR + tid;
        if (gid < 4096) { const int pos = gid >> 4, f = gid & 15; const float inv = __builtin_amdgcn_exp2f(-(float)f * 0.83048202372184059f);
            const float rev = (float)pos * inv * 0.15915494309189535f; float* RT = (float*)(ws + WS_ROPE);
            RT[gid] = __builtin_amdgcn_cosf(__builtin_amdgcn_fractf(rev)); RT[4096 + gid] = __builtin_amdgcn_sinf(__builtin_amdgcn_fractf(rev)); }
        const f32x4* cs = (const f32x4*)AIN(2); f32x4* cd = (f32x4*)(ws + WS_HCTX);
        for (int idx = gid; idx < NB * CTXL * DM / 4; idx += G * NTHR) cd[idx] = cs[idx];
        __syncthreads();
    }
}

__device__ __forceinline__ int fidx(int i) { return i + (i >> 7); }
__device__ __forceinline__ void fft4_index(int b, int q, int& i, int& j) {
    if (q >= 64) { j = b & (q - 1); i = ((b & ~(q - 1)) << 2) + j; }
    else { const int rr = b & 127, qq = b >> 7; j = qq & (q - 1); i = rr * 128 + ((qq & ~(q - 1)) << 2) + j; }
}
__device__ __forceinline__ f32x2 cmulf(f32x2 a, f32x2 w) { return (f32x2){a.x * w.x - a.y * w.y, a.x * w.y + a.y * w.x}; }
__device__ __forceinline__ void fft_fwd(LAS f32x2* X, int tid) {
    for (int p = 0; p < 7; ++p) {
        const int h = 8192 >> (2 * p), q = h >> 1; const float inv2h = 0.5f / (float)h;
#pragma unroll 2
        for (int r = 0; r < 8; ++r) { int i, j; fft4_index(tid + NTHR * r, q, i, j);
            const float ang = (float)j * inv2h; const f32x2 w1 = {__builtin_amdgcn_cosf(ang), -__builtin_amdgcn_sinf(ang)}; const f32x2 w2 = cmulf(w1, w1);
            const int i0 = fidx(i), i1 = fidx(i + q), i2 = fidx(i + 2 * q), i3 = fidx(i + 3 * q);
            const f32x2 x0 = X[i0], x1 = X[i1], x2 = X[i2], x3 = X[i3];
            const f32x2 a0 = x0 + x2, a1 = x1 + x3, d02 = cmulf(x0 - x2, w1), t13 = cmulf(x1 - x3, w1); const f32x2 d13 = {t13.y, -t13.x};
            X[i0] = a0 + a1; X[i1] = cmulf(a0 - a1, w2); X[i2] = d02 + d13; X[i3] = cmulf(d02 - d13, w2); }
        __syncthreads();
    }
}
__device__ __forceinline__ void fft_inv(LAS f32x2* X, int tid) {
    for (int p = 6; p >= 0; --p) {
        const int h = 8192 >> (2 * p), q = h >> 1; const float inv2h = 0.5f / (float)h;
#pragma unroll 2
        for (int r = 0; r < 8; ++r) { int i, j; fft4_index(tid + NTHR * r, q, i, j);
            const float ang = (float)j * inv2h; const f32x2 w1 = {__builtin_amdgcn_cosf(ang), __builtin_amdgcn_sinf(ang)}; const f32x2 w2 = cmulf(w1, w1);
            const int i0 = fidx(i), i1 = fidx(i + q), i2 = fidx(i + 2 * q), i3 = fidx(i + 3 * q);
            const f32x2 b0 = X[i0], b1 = X[i1], b2 = X[i2], b3 = X[i3];
            const f32x2 t1 = cmulf(b1, w2), t3 = cmulf(b3, w2); const f32x2 a0 = b0 + t1, a1 = b0 - t1, a2 = b2 + t3, a3 = b2 - t3;
            const f32x2 u2 = cmulf(a2, w1), v3 = cmulf(a3, w1); const f32x2 u3 = {-v3.y, v3.x};
            X[i0] = a0 + u2; X[i2] = a0 - u2; X[i1] = a1 + u3; X[i3] = a1 - u3; }
        __syncthreads();
    }
}
__device__ __forceinline__ int brev14(int k) { return (int)(__builtin_bitreverse32((unsigned)k) >> 18); }
constexpr int FFT_AUX = 133120;

__device__ __forceinline__ void phase_prep_b(const Args& a, int li, LAS unsigned char* lds, int G, int bx) {
    const int tid = fresh_tid(), lane = tid & 63, wave = __builtin_amdgcn_readfirstlane(tid >> 6);
    unsigned char* ws = fresh_ptr(a.ws);
    if (li == 0) {
        const float* MODP = (const float*)(ws + WS_MODP); float* MOD = (float*)(ws + WS_MOD);
        for (int idx = bx * NTHR + tid; idx < 4 * 3 * 6144; idx += G * NTHR) { const int l = idx / 18432, j = idx % 6144; float s = AIN(5)[l * 6144 + j];
#pragma unroll
            for (int q = 0; q < 8; ++q) s += MODP[(size_t)q * 73728 + idx];
            MOD[idx] = s; }
    }
    LAS f32x2* X = (LAS f32x2*)lds; LAS float* Xf = (LAS float*)lds;
    LAS float* w3c = (LAS float*)(lds + FFT_AUX); LAS float* red = w3c + 128; LAS float* kc = (LAS float*)(lds + FFT_AUX + 1024);
    const bf16* H2 = (const bf16*)(ws + WS_H2B) + (size_t)li * (SEQ + CTXL) * 64; const bf16* H2C = H2 + (size_t)SEQ * 64;
    const float* w3 = AIN(20) + (size_t)li * 64 * 512;
    const float min_decay = 3.0701134573253945f, max_decay = 15.350567286626973f;
    for (int c0 = bx; c0 < 256; c0 += G) { const int c = G == 256 ? (((c0 & 7) << 5) | (c0 >> 3)) : c0;
        if (tid < 128) w3c[tid] = w3[(tid & 63) * 512 + (tid >> 6) * 256 + c];
        __syncthreads();
        const float delta = min_decay + (float)c * ((max_decay - min_decay) / 255.0f);
        float asum = 0.f;
#pragma unroll 2
        for (int r = 0; r < 32; ++r) { const int t = tid + NTHR * r; const v4u* hr = (const v4u*)(H2 + (size_t)t * 64);
            float df = 0.f, db = 0.f;
#pragma unroll
            for (int q = 0; q < 8; ++q) { const v4u hw = hr[q];
#pragma unroll
                for (int e = 0; e < 4; ++e) { const float h0 = __builtin_bit_cast(float, hw[e] << 16), h1 = __builtin_bit_cast(float, hw[e] & 0xffff0000u);
                    df += h0 * w3c[8 * q + 2 * e] + h1 * w3c[8 * q + 2 * e + 1]; db += h0 * w3c[64 + 8 * q + 2 * e] + h1 * w3c[64 + 8 * q + 2 * e + 1]; } }
            const float dec = __builtin_amdgcn_exp2f(-1.4426950408889634f * delta * ((float)t * (1.0f / 16383.0f)));
            df *= dec; db *= dec;
            Xf[2 * fidx(t >> 1) + (t & 1)] = df; asum += __builtin_fabsf(df);
            if (t >= 1) { const int n = 32768 - t; Xf[2 * fidx(n >> 1) + (n & 1)] = db; asum += __builtin_fabsf(db); } }
        if (tid == 0) Xf[2 * fidx(8192)] = 0.f;
        const float S1 = block_sum(asum, red, wave, lane);
        fft_fwd(X, tid);
        const float scale = 1.0f / (S1 * 16384.0f);
        f32x4* HF = (f32x4*)(ws + WS_HF) + (size_t)c * 8193;
        for (int k = tid; k <= 8192; k += NTHR) {
            const f32x2 A = X[fidx(brev14(k))], B = X[fidx(brev14((16384 - k) & 16383))]; f32x4 o;
            if (k == 0) o = (f32x4){A.x + A.y, 0.f, A.x - A.y, 0.f};
            else { const float Ex = 0.5f * (A.x + B.x), Ey = 0.5f * (A.y - B.y), Ox = 0.5f * (A.y + B.y), Oy = -0.5f * (A.x - B.x);
                const float ang = (float)k * (1.0f / 32768.0f), wc = __builtin_amdgcn_cosf(ang), wsn = -__builtin_amdgcn_sinf(ang);
                const float px = Ox * wc - Oy * wsn, py = Ox * wsn + Oy * wc;
                o = (f32x4){Ex + px, Ey + py, Ex - px, -(Ey - py)}; }
            HF[k] = o * scale; }
        __syncthreads();
        float as2 = 0.f;
        if (tid < CTXL) { const int t = tid; const v4u* hr = (const v4u*)(H2C + (size_t)t * 64); float df = 0.f, db = 0.f;
#pragma unroll
            for (int q = 0; q < 8; ++q) { const v4u hw = hr[q];
#pragma unroll
                for (int e = 0; e < 4; ++e) { const float h0 = __builtin_bit_cast(float, hw[e] << 16), h1 = __builtin_bit_cast(float, hw[e] & 0xffff0000u);
                    df += h0 * w3c[8 * q + 2 * e] + h1 * w3c[8 * q + 2 * e + 1]; db += h0 * w3c[64 + 8 * q + 2 * e] + h1 * w3c[64 + 8 * q + 2 * e + 1]; } }
            const float dec = __builtin_amdgcn_exp2f(-1.4426950408889634f * delta * ((float)t * (1.0f / 255.0f)));
            df *= dec; db *= dec; kc[t] = df; as2 += __builtin_fabsf(df);
            if (t >= 1) { kc[512 - t] = db; as2 += __builtin_fabsf(db); } else kc[256] = 0.f; }
        const float S2 = block_sum(as2, red, wave, lane);
        ((float*)(ws + WS_KCTX))[(size_t)c * 512 + tid] = kc[tid] / S2;
        __syncthreads();
    }
}

__device__ __forceinline__ void norm_load(const float* xr, int lane, f32x4 (&v)[4]) {
    const f32x4* xp = (const f32x4*)xr + lane;
#pragma unroll
    for (int j = 0; j < 4; ++j) v[j] = xp[64 * j];
}
__device__ __forceinline__ void norm_finish(f32x4 (&v)[4], const float* xr, const float* modl, int set, int which, const f32x4 (&g)[4], int lane, bf16* dst, f32x4 (&o)[4], const float* pend = nullptr) {
    float ss = 0.f;
#pragma unroll
    for (int j = 0; j < 4; ++j) {
        if (pend) { const f32x4* pp = (const f32x4*)(pend + (size_t)j * 4 * 65536) + lane; v[j] = (((v[j] + pp[0]) + pp[16384]) + pp[2 * 16384]) + pp[3 * 16384]; ((f32x4*)xr)[lane + 64 * j] = v[j]; }
        ss += (v[j].x * v[j].x + v[j].y * v[j].y) + (v[j].z * v[j].z + v[j].w * v[j].w); }
    const float rinv = __builtin_amdgcn_rsqf(wave_sum(ss) * (1.0f / DM) + 1e-6f);
    const f32x4* sh = (const f32x4*)(modl + set * 6144 + which * DM) + lane; const f32x4* sc = (const f32x4*)(modl + set * 6144 + (which + 1) * DM) + lane;
    v2u* dp = (v2u*)dst + lane;
#pragma unroll
    for (int j = 0; j < 4; ++j) { const f32x4 y = v[j] * rinv * g[j]; o[j] = y * (sc[64 * j] + 1.0f) + sh[64 * j];
        v2u w; w.x = pk2(o[j].x, o[j].y); w.y = pk2(o[j].z, o[j].w); dp[64 * j] = w; }
}
__device__ __forceinline__ const float* ctx_pending(const Args& a, int R) {
    const int b = R / RB, rr = R - b * RB; return rr < CTXL ? (const float*)(fresh_ptr(a.ws) + WS_SLAB) + (size_t)b * 16 * 65536 + rr * 256 : nullptr; }
__device__ __forceinline__ void norm_finish_lds(f32x4 (&v)[4], const float* xr, const LAS f32x4* mt, int set, const f32x4 (&g)[4], int lane, bf16* dst, const float* pend) {
    float ss = 0.f;
#pragma unroll
    for (int j = 0; j < 4; ++j) {
        if (pend) { const f32x4* pp = (const f32x4*)(pend + (size_t)j * 4 * 65536) + lane; v[j] = (((v[j] + pp[0]) + pp[16384]) + pp[2 * 16384]) + pp[3 * 16384]; ((f32x4*)xr)[lane + 64 * j] = v[j]; }
        ss += (v[j].x * v[j].x + v[j].y * v[j].y) + (v[j].z * v[j].z + v[j].w * v[j].w); }
    const float rinv = __builtin_amdgcn_rsqf(wave_sum(ss) * (1.0f / DM) + 1e-6f);
    const LAS f32x4* sh = mt + set * 512 + lane; const LAS f32x4* sc = sh + 256;
    v2u* dp = (v2u*)dst + lane;
#pragma unroll
    for (int j = 0; j < 4; ++j) { const f32x4 y = v[j] * rinv * g[j]; const f32x4 o = y * (sc[64 * j] + 1.0f) + sh[64 * j];
        v2u w; w.x = pk2(o.x, o.y); w.y = pk2(o.z, o.w); dp[64 * j] = w; }
}
__device__ __forceinline__ void phase_norm(const Args& a, int li, int which  , const float* xlat, LAS unsigned char* lds, int G, int bx) {
    const int tid = fresh_tid(), lane = tid & 63, wave = __builtin_amdgcn_readfirstlane(tid >> 6);
    const int gw = bx * NWAVES + wave, NGW = G * NWAVES;
    unsigned char* ws = fresh_ptr(a.ws); const float* modl = (const float*)(ws + WS_MOD) + (size_t)li * 3 * 6144; const float* hctx = (const float*)(ws + WS_HCTX);
    const float* gsrc = (which == 0 ? AIN(6) : AIN(7)) + li * DM; bf16* XN = (bf16*)(ws + WS_XN);
    LAS f32x4* mt = (LAS f32x4*)lds;
    __syncthreads();
    for (int idx = tid; idx < 3 * 512; idx += NTHR) { const int set = idx >> 9, rem = idx & 511; mt[idx] = ((const f32x4*)(modl + set * 6144 + which * DM))[rem]; }
    f32x4 g[4];
#pragma unroll
    for (int j = 0; j < 4; ++j) g[j] = ((const f32x4*)gsrc)[lane + 64 * j];
    __syncthreads();
    const bool pending = (which == 3) || (li & 1);
    constexpr int NR = 9;
    for (int R = gw; R < MROWS; R += NR * NGW) {
        f32x4 v[NR][4]; const float* xr[NR]; int Rq[NR];
#pragma unroll
        for (int q = 0; q < NR; ++q) { Rq[q] = R + q * NGW; xr[q] = xrow_in(Rq[q] < MROWS ? Rq[q] : R, xlat, hctx); norm_load(xr[q], lane, v[q]); }
#pragma unroll
        for (int q = 0; q < NR; ++q) if (Rq[q] < MROWS) norm_finish_lds(v[q], xr[q], mt, row_set(Rq[q]), g, lane, XN + (size_t)Rq[q] * DM, pending ? ctx_pending(a, Rq[q]) : nullptr); }
    __syncthreads();
}
__device__ __forceinline__ void phase_norm_router(const Args& a, int li, const float* xlat, LAS unsigned char* lds, int G, int bx) {
    const int tid = fresh_tid(), lane = tid & 63, wave = __builtin_amdgcn_readfirstlane(tid >> 6);
    unsigned char* ws = fresh_ptr(a.ws); const float* modl = (const float*)(ws + WS_MOD) + (size_t)li * 3 * 6144; const float* hctx = (const float*)(ws + WS_HCTX);
    const float* gsrc = AIN(7) + li * DM; bf16* XN = (bf16*)(ws + WS_XN); const int lj = li >> 1;
    const float* rw = AIN(28) + (size_t)lj * DM * NEXP;
    LAS float* rwT = (LAS float*)lds;
    LAS int* re = (LAS int*)(lds + 32768);
    LAS float* rg = (LAS float*)(lds + 32768 + 2048);
    LAS int* lcnt = (LAS int*)(lds + 32768 + 4096);
    for (int idx = tid; idx < DM * NEXP; idx += NTHR) rwT[(idx & 7) * DM + (idx >> 3)] = rw[idx];
    if (tid < 32) lcnt[tid] = 0;
    __syncthreads();
    const int RPB = (MROWS + G - 1) / G, R0 = bx * RPB; int nrows = MROWS - R0; nrows = nrows > RPB ? RPB : nrows; nrows = nrows < 0 ? 0 : nrows;
    f32x4 g[4];
#pragma unroll
    for (int j = 0; j < 4; ++j) g[j] = ((const f32x4*)gsrc)[lane + 64 * j];
    f32x4 vnext[4];
    if (wave < nrows) norm_load(xrow_in(R0 + wave, xlat, hctx), lane, vnext);
    for (int i = wave; i < nrows; i += NWAVES) { const int R = R0 + i; f32x4 o[4], v[4];
#pragma unroll
        for (int j = 0; j < 4; ++j) v[j] = vnext[j];
        if (i + NWAVES < nrows) norm_load(xrow_in(R + NWAVES, xlat, hctx), lane, vnext);
        norm_finish(v, xrow_in(R, xlat, hctx), modl, row_set(R), 3, g, lane, XN + (size_t)R * DM, o, ctx_pending(a, R));
        float lg[8];
#pragma unroll
        for (int e = 0; e < 8; ++e) { float s = 0.f;
#pragma unroll
            for (int j = 0; j < 4; ++j) { const f32x4 w = *(const LAS f32x4*)(rwT + e * DM + 4 * lane + 256 * j); s += (o[j].x * w.x + o[j].y * w.y) + (o[j].z * w.z + o[j].w * w.w); }
            lg[e] = wave_sum(s); }
        int e0 = 0; float v0 = lg[0];
#pragma unroll
        for (int e = 1; e < 8; ++e) if (lg[e] > v0) { v0 = lg[e]; e0 = e; }
        int e1 = -1; float v1 = -3.0e38f;
#pragma unroll
        for (int e = 0; e < 8; ++e) if (e != e0 && lg[e] > v1) { v1 = lg[e]; e1 = e; }
        if (lane == 0) { re[i] = e0 | (e1 << 8); rg[i] = 1.0f / (1.0f + __expf(v1 - v0)); }
    }
    __syncthreads();
    if (tid < nrows) { const int w = re[tid], e0 = w & 255, e1 = w >> 8; int r0 = 0, r1 = 0;
        for (int j = 0; j < tid; ++j) { const int wj = re[j]; r0 += ((wj & 255) == e0) ? 1 : 0; r1 += ((wj >> 8) == e1) ? 1 : 0; }
        ((int*)(ws + WS_RREC))[R0 + tid] = e0 | (e1 << 4) | (r0 << 8) | (r1 << 20); ((float*)(ws + WS_RRECG))[R0 + tid] = rg[tid]; }
    if (tid < 16) { int c = 0; for (int j = 0; j < nrows; ++j) { const int wj = re[j]; c += ((tid < 8 ? (wj & 255) : (wj >> 8)) == (tid & 7)) ? 1 : 0; }
        ((int*)(ws + WS_CNTB))[bx * 16 + tid] = c; }
    __syncthreads();
}
__device__ __forceinline__ void moe_tables(const Args& a, int lj, LAS unsigned char* lds, int G, int bx) {
    LAS int* tab = (LAS int*)(lds + TAB_OFF); const int tid = fresh_tid(); const int* cntb = (const int*)(fresh_ptr(a.ws) + WS_CNTB);
    if (tid < 16) { tab[32 + tid] = 0; tab[116 + tid] = 0; }
    __syncthreads();
    { const int sg = tid & 15; int c = 0, below = 0;
        for (int b = tid >> 4; b < G; b += NTHR / 16) { const int v = cntb[b * 16 + sg]; c += v; below += b < bx ? v : 0; }
        atomicAdd((int*)(tab + 32 + sg), c); atomicAdd((int*)(tab + 116 + sg), below); }
    __syncthreads();
    if (tid == 0) { int tb = 0, tm = 0, n0 = 0, n1 = 0;
        for (int s = 0; s < 16; ++s) { const int c = tab[32 + s]; const int nt = (c + 255) >> 8;
            tab[s] = tb; tab[64 + s] = tm; tb += nt; tm += nt > 0 ? nt - 1 : 0;
            if (nt > 0) { if (s < 8) tab[96 + n0++] = s; else tab[104 + n1++] = s; } }
        tab[16] = tb; tab[80] = tm; tab[112] = n0; tab[113] = n1; }
    __syncthreads();
    (void)lj;
}
__device__ __forceinline__ void phase_moe_gather(const Args& a, int li, LAS unsigned char* lds, int G, int bx) {
    const int tid = fresh_tid(), lane = tid & 63, wave = __builtin_amdgcn_readfirstlane(tid >> 6);
    moe_tables(a, li >> 1, lds, G, bx);
    const LAS int* tab = (const LAS int*)(lds + TAB_OFF);
    unsigned char* ws = fresh_ptr(a.ws);
    int* rtok = (int*)(ws + WS_RTOK); float* rgate = (float*)(ws + WS_RGATE); const int* rec = (const int*)(ws + WS_RREC); const float* recg = (const float*)(ws + WS_RRECG);
    const bf16* XN = (const bf16*)(ws + WS_XN); bf16* AG = (bf16*)(ws + WS_AG);
    const int RPB = (MROWS + G - 1) / G, R0 = bx * RPB; int nrows = MROWS - R0; nrows = nrows > RPB ? RPB : nrows; nrows = nrows < 0 ? 0 : nrows;
    for (int it0 = wave; it0 < 2 * nrows; it0 += 4 * NWAVES) {
        int Rr[4], sg[4], ix[4]; float gg[4]; bool ok[4]; v4u x0[4], x1[4];
#pragma unroll
        for (int u = 0; u < 4; ++u) { const int it = it0 + u * NWAVES; ok[u] = it < 2 * nrows; const int itc = ok[u] ? it : it0; const int k = itc & 1; Rr[u] = R0 + (itc >> 1);
            const int w = rec[Rr[u]]; const float g0 = recg[Rr[u]];
            const int e = k ? ((w >> 4) & 15) : (w & 15), rk = k ? (w >> 20) : ((w >> 8) & 4095); sg[u] = k * 8 + e; ix[u] = tab[116 + sg[u]] + rk; gg[u] = k ? 1.0f - g0 : g0; }
#pragma unroll
        for (int u = 0; u < 4; ++u) { const v4u* sp = (const v4u*)(XN + (size_t)Rr[u] * DM) + lane; x0[u] = sp[0]; x1[u] = sp[64]; }
#pragma unroll
        for (int u = 0; u < 4; ++u) if (ok[u]) {
            if (lane == 0) { rtok[(size_t)sg[u] * SEGCAP + ix[u]] = Rr[u]; rgate[(size_t)sg[u] * SEGCAP + ix[u]] = gg[u]; }
            v4u* dp = (v4u*)(AG + ((size_t)tab[sg[u]] * 256 + ix[u]) * DM) + lane; dp[0] = x0[u]; dp[64] = x1[u]; }
    }
}
__device__ __forceinline__ void phase_moe_fix(const Args& a, int li, int k, LAS unsigned char* lds, int G, int bx) {
    const int tid = fresh_tid(), lane = tid & 63, wave = __builtin_amdgcn_readfirstlane(tid >> 6);
    const int gw = bx * NWAVES + wave, NGW = G * NWAVES;
    moe_tables(a, li >> 1, lds, G, bx);
    const LAS int* tab = (const LAS int*)(lds + TAB_OFF);
    const int nt = tab[112 + k]; const int* rtok = (const int*)(fresh_ptr(a.ws) + WS_RTOK); const float* slab = (const float*)(fresh_ptr(a.ws) + WS_SLAB);
    float* hctx = (float*)(fresh_ptr(a.ws) + WS_HCTX);
    for (int it = gw; it < nt * 256; it += NGW) { const int jl = it >> 8, r = it & 255, s = tab[96 + 8 * k + jl];
        const int idx = (tab[s + 1] - 1 - tab[s]) * 256 + r; if (idx >= tab[32 + s]) continue;
        const int R = rtok[(size_t)s * SEGCAP + idx]; f32x4* xp = (f32x4*)xrow_out(R, a.out, hctx) + lane;
        const f32x4* sp = (const f32x4*)(slab + (size_t)((k * 8 + jl) * 16) * 65536 + r * 256) + lane;
#pragma unroll
        for (int j = 0; j < 4; ++j) { const f32x4* pp = sp + (size_t)j * 4 * 16384; xp[64 * j] = (((xp[64 * j] + pp[0]) + pp[16384]) + pp[2 * 16384]) + pp[3 * 16384]; } }
}

constexpr int PL_ZT = 0, PL_DT = 40960, PL_LIN = 74752;
__device__ __forceinline__ void pool_load_lin(const Args& a, int li, LAS unsigned char* lds) {
    LAS bf16* linT = (LAS bf16*)(lds + PL_LIN); const float* src = AIN(10) + (size_t)li * 4 * 64 * 64;
    for (int idx = fresh_tid(); idx < 4 * 4096; idx += NTHR) { const int g = idx >> 12, c = (idx >> 6) & 63, e = idx & 63; linT[(g * 64 + e) * 72 + c] = (bf16)f2bf(src[idx]); }
    __syncthreads();
}
__device__ __forceinline__ void pool_unit(const Args& a, int li, int p, LAS unsigned char* lds) {
    const int tid = fresh_tid(), lane = tid & 63, r32 = lane & 31, hi = lane >> 5, wave = __builtin_amdgcn_readfirstlane(tid >> 6);
    const bf16* Z = (const bf16*)(fresh_ptr(a.ws) + WS_Z); bf16* Y = (bf16*)(fresh_ptr(a.ws) + WS_Y);
    const int b = p >> 8, t0 = (p & 255) * 64, rowbase = b * RB + CTXL;
    LAS bf16* zt = (LAS bf16*)(lds + PL_ZT); LAS bf16* dt = (LAS bf16*)(lds + PL_DT); const LAS bf16* linT = (const LAS bf16*)(lds + PL_LIN);
    for (int idx = tid; idx < 80 * 32; idx += NTHR) { const int row = idx >> 5, ch8 = idx & 31, t = t0 - 8 + row; v4u w = {0u, 0u, 0u, 0u};
        if (t >= 0 && t < SEQ) w = *(const v4u*)(Z + (size_t)(rowbase + t) * INW + ch8 * 8);
        *(LAS v4u*)(zt + row * 256 + ch8 * 8) = w; }
    __syncthreads();
    { const int ch = tid & 255, th = tid >> 8, hw = 1 << (ch >> 6), tb = t0 + 32 * th; const LAS bf16* zc = zt + ch;
        float s = 0.f;
        for (int q = -hw; q < hw; ++q) s += bf2f(zc[(32 * th + 8 + q) * 256]);
#pragma unroll 4
        for (int tt = 0; tt < 32; ++tt) { const int t = tb + tt, rel = 32 * th + tt + 8; int lo = t - hw; lo = lo < 0 ? 0 : lo; int hq = t + hw; hq = hq > SEQ ? SEQ : hq;
            dt[(32 * th + tt) * 264 + ch] = (bf16)f2bf(s * __builtin_amdgcn_rcpf((float)(hq - lo)) - bf2f(zc[rel * 256]));
            s += bf2f(zc[(rel + hw) * 256]) - bf2f(zc[(rel - hw) * 256]); } }
    __syncthreads();
    { const int g = wave >> 1, th = wave & 1;
        bf16x8 bfr[4], afr[2][4];
#pragma unroll
        for (int ks = 0; ks < 4; ++ks) { bfr[ks] = *(const LAS bf16x8*)(dt + (32 * th + r32) * 264 + g * 64 + 16 * ks + 8 * hi);
#pragma unroll
            for (int mt = 0; mt < 2; ++mt) afr[mt][ks] = *(const LAS bf16x8*)(linT + (g * 64 + 32 * mt + r32) * 72 + 16 * ks + 8 * hi); }
        f32x16 acc[2];
#pragma unroll
        for (int mt = 0; mt < 2; ++mt) {
#pragma unroll
            for (int r = 0; r < 16; ++r) acc[mt][r] = 0.f;
#pragma unroll
            for (int ks = 0; ks < 4; ++ks) acc[mt] = __builtin_amdgcn_mfma_f32_32x32x16_bf16(afr[mt][ks], bfr[ks], acc[mt], 0, 0, 0); }
        const float* ps = AIN(11) + li * 256 + g * 64;
        bf16* yp = Y + (size_t)(rowbase + t0 + 32 * th + r32) * DM + g * 64;
#pragma unroll
        for (int mt = 0; mt < 2; ++mt)
#pragma unroll
            for (int rq = 0; rq < 4; ++rq) { const int e0 = 32 * mt + 8 * rq + 4 * hi; const f32x4 sc = *(const f32x4*)(ps + e0);
                v2u w; w.x = pk2(acc[mt][4 * rq] * sc.x, acc[mt][4 * rq + 1] * sc.y); w.y = pk2(acc[mt][4 * rq + 2] * sc.z, acc[mt][4 * rq + 3] * sc.w);
                *(v2u*)(yp + e0) = w; }
    }
    __syncthreads();
}
__device__ __forceinline__ void pool_ctx_pair(const Args& a, int li, int cp, LAS unsigned char* lds) {
    const int tid = fresh_tid();
    const bf16* Z = (const bf16*)(fresh_ptr(a.ws) + WS_Z); bf16* Y = (bf16*)(fresh_ptr(a.ws) + WS_Y);
    LAS float* dm = (LAS float*)(lds + PL_ZT);
    const int ct = 2 * cp + (tid >> 8), b = ct >> 8, t = ct & 255, ch = tid & 255, hw = 1 << (ch >> 6), rowbase = b * RB;
    int lo = t - hw; lo = lo < 0 ? 0 : lo; int hq = t + hw; hq = hq > CTXL ? CTXL : hq; float s = 0.f;
    for (int q = lo; q < hq; ++q) s += bf2f(Z[(size_t)(rowbase + q) * INW + ch]);
    dm[tid] = s / (float)(hq - lo) - bf2f(Z[(size_t)(rowbase + t) * INW + ch]);
    __syncthreads();
    { const int g = ch >> 6, eo = ch & 63; const float* lin = AIN(10) + (size_t)li * 4 * 64 * 64 + g * 4096 + eo; const LAS float* dr = dm + (tid >> 8) * 256 + g * 64; float acc = 0.f;
#pragma unroll 8
        for (int c = 0; c < 64; ++c) acc += dr[c] * lin[c * 64];
        Y[(size_t)(rowbase + t) * DM + ch] = (bf16)f2bf(acc * AIN(11)[li * 256 + ch]); }
    __syncthreads();
}

__device__ __forceinline__ void sconv2(const bf16* zr, int t0, int L, float w0, float w1, float w2, float sb, float& y0, float& y1) {
    const unsigned pr = *(const unsigned*)(zr + t0); const float z0 = __builtin_bit_cast(float, pr << 16), z1 = __builtin_bit_cast(float, pr & 0xffff0000u);
    const float zm = t0 > 0 ? bf2f(zr[t0 - 1]) : 0.f, zp = (t0 + 2 < L) ? bf2f(zr[t0 + 2]) : 0.f;
    y0 = sb + zm * w0 + z0 * w1 + z1 * w2; y1 = sb + z0 * w0 + z1 * w1 + zp * w2;
}
__device__ __forceinline__ void sconv8(const bf16* zr, int t0, int L, float w0, float w1, float w2, float sb, float (&y)[8]) {
    const v4u w = *(const v4u*)(zr + t0); float z[10];
    z[0] = t0 > 0 ? bf2f(zr[t0 - 1]) : 0.f; z[9] = (t0 + 8 < L) ? bf2f(zr[t0 + 8]) : 0.f;
#pragma unroll
    for (int e = 0; e < 4; ++e) { z[1 + 2 * e] = __builtin_bit_cast(float, w[e] << 16); z[2 + 2 * e] = __builtin_bit_cast(float, w[e] & 0xffff0000u); }
#pragma unroll
    for (int e = 0; e < 8; ++e) y[e] = sb + z[e] * w0 + z[e + 1] * w1 + z[e + 2] * w2;
}
__device__ __forceinline__ void hyena_unit(const Args& a, int li, int c, LAS unsigned char* lds) {
    const int tid = fresh_tid();
    unsigned char* ws = fresh_ptr(a.ws); const bf16* ZT = (const bf16*)(ws + WS_ZT); const bf16* ZTC = (const bf16*)(ws + WS_ZTC); bf16* Y = (bf16*)(ws + WS_Y);
    const float* sw = AIN(12) + (size_t)li * 3 * 768; const float* sbp = AIN(13) + (size_t)li * 768; const float hb = AIN(21)[li * 256 + c];
    const float a0 = sw[c], a1 = sw[768 + c], a2 = sw[1536 + c], ab = sbp[c];
    const float b0 = sw[256 + c], b1 = sw[768 + 256 + c], b2 = sw[1536 + 256 + c], bb = sbp[256 + c];
    const float c0 = sw[512 + c], c1 = sw[768 + 512 + c], c2 = sw[1536 + 512 + c], cb = sbp[512 + c];
    LAS f32x2* X = (LAS f32x2*)lds;
    const f32x4* HF = (const f32x4*)(ws + WS_HF) + (size_t)c * 8193;
    for (int b = 0; b < NB; ++b) {
        const bf16* px0 = ZT + (size_t)(b * 768 + c) * SEQ; const bf16* px1 = ZT + (size_t)(b * 768 + 256 + c) * SEQ; const bf16* pv = ZT + (size_t)(b * 768 + 512 + c) * SEQ;
        float u[4][8];
#pragma unroll
        for (int r = 0; r < 4; ++r) { const int m = tid + NTHR * r; float vv[8], gg[8];
            sconv8(pv, 8 * m, SEQ, c0, c1, c2, cb, vv); sconv8(px1, 8 * m, SEQ, b0, b1, b2, bb, gg);
#pragma unroll
            for (int e = 0; e < 8; ++e) u[r][e] = vv[e] * gg[e];
            const int i0 = fidx(4 * m), i1 = fidx(4 * m + 8192);
#pragma unroll
            for (int q = 0; q < 4; ++q) { X[i0 + q] = (f32x2){u[r][2 * q], u[r][2 * q + 1]}; X[i1 + q] = (f32x2){0.f, 0.f}; } }
        __syncthreads();
        fft_fwd(X, tid);
        for (int k0 = tid; k0 <= 8192; k0 += 4 * NTHR) {
            f32x4 Hq[4];
#pragma unroll
            for (int q = 0; q < 4; ++q) Hq[q] = HF[k0 + q * NTHR <= 8192 ? k0 + q * NTHR : k0];
#pragma unroll
            for (int q = 0; q < 4; ++q) { const int k = k0 + q * NTHR; if (k > 8192) break;
            const int pa = fidx(brev14(k)), pb = fidx(brev14((16384 - k) & 16383));
            const f32x2 A = X[pa], B = X[pb]; const f32x4 H = Hq[q];
            if (k == 0) { const float Y0 = (A.x + A.y) * H.x, YN = (A.x - A.y) * H.z; X[pa] = (f32x2){0.5f * (Y0 + YN), 0.5f * (Y0 - YN)}; }
            else { const float Ex = 0.5f * (A.x + B.x), Ey = 0.5f * (A.y - B.y), Ox = 0.5f * (A.y + B.y), Oy = -0.5f * (A.x - B.x);
                const float ang = (float)k * (1.0f / 32768.0f), wc = __builtin_amdgcn_cosf(ang), wsn = -__builtin_amdgcn_sinf(ang);
                const float px = Ox * wc - Oy * wsn, py = Ox * wsn + Oy * wc;
                const float Xkx = Ex + px, Xky = Ey + py, Xnx = Ex - px, Xny = -(Ey - py);
                const float Ykx = Xkx * H.x - Xky * H.y, Yky = Xkx * H.y + Xky * H.x, Ynx = Xnx * H.z - Xny * H.w, Yny = Xnx * H.w + Xny * H.z;
                const float Epx = 0.5f * (Ykx + Ynx), Epy = 0.5f * (Yky - Yny), Dx = Ykx - Ynx, Dy = Yky + Yny;
                const float Opx = 0.5f * (Dx * wc + Dy * wsn), Opy = 0.5f * (Dy * wc - Dx * wsn);
                X[pa] = (f32x2){Epx - Opy, Epy + Opx};
                if (k != 8192) X[pb] = (f32x2){Epx + Opy, -Epy + Opx}; } } }
        __syncthreads();
        fft_inv(X, tid);
#pragma unroll
        for (int r = 0; r < 4; ++r) { const int m = tid + NTHR * r; float xx[8];
            sconv8(px0, 8 * m, SEQ, a0, a1, a2, ab, xx);
            const int i0 = fidx(4 * m); const f32x2 y0 = X[i0], y1 = X[i0 + 1], y2 = X[i0 + 2], y3 = X[i0 + 3];
            const float yv[8] = {y0.x, y0.y, y1.x, y1.y, y2.x, y2.y, y3.x, y3.y};
            bf16* yp = Y + (size_t)(b * RB + CTXL + 8 * m) * DM + 256 + c;
#pragma unroll
            for (int e = 0; e < 8; ++e) yp[(size_t)e * DM] = (bf16)f2bf((yv[e] + u[r][e] * hb) * xx[e]); }
        __syncthreads();
    }
    {
        LAS float* kc = (LAS float*)lds; LAS float* uc = kc + 512;
        kc[tid] = ((const float*)(ws + WS_KCTX))[(size_t)c * 512 + tid];
        const int b = tid >> 8, t = tid & 255, te = t & ~1;
        const bf16* px0 = ZTC + (size_t)(b * 768 + c) * CTXL; const bf16* px1 = ZTC + (size_t)(b * 768 + 256 + c) * CTXL; const bf16* pv = ZTC + (size_t)(b * 768 + 512 + c) * CTXL;
        float v0, v1, g0, g1, x00, x01;
        sconv2(pv, te, CTXL, c0, c1, c2, cb, v0, v1); sconv2(px1, te, CTXL, b0, b1, b2, bb, g0, g1); sconv2(px0, te, CTXL, a0, a1, a2, ab, x00, x01);
        const float u = (t & 1) ? v1 * g1 : v0 * g0, x0v = (t & 1) ? x01 : x00;
        uc[tid] = u;
        __syncthreads();
        float y = 0.f;
#pragma unroll 8
        for (int s = 0; s < CTXL; ++s) y += kc[(t - s) & 511] * uc[b * 256 + s];
        Y[(size_t)(b * RB + t) * DM + 256 + c] = (bf16)f2bf((y + u * hb) * x0v);
        __syncthreads();
    }
}

__device__ __forceinline__ void glds16(const void* gsrc, unsigned lds_dst) { unsigned keep;
    asm volatile("s_mov_b32 %0, m0\n\ts_mov_b32 m0, %2\n\ts_nop 0\n\tglobal_load_lds_dwordx4 %1, off\n\ts_mov_b32 m0, %0" : "=&s"(keep) : "v"(gsrc), "s"(lds_dst) : "memory"); }
__device__ __forceinline__ s16x4 vtr(const LAS unsigned char* p) { return __builtin_bit_cast(s16x4, __builtin_amdgcn_ds_read_tr16_b64_v4i16((LAS v4i16_t*)p)); }
typedef __bf16 bf16x2n __attribute__((ext_vector_type(2)));
__device__ __forceinline__ unsigned cvtpk_s(float lo, float hi) { f32x2 v = {lo, hi}; bf16x2n b = __builtin_convertvector(v, bf16x2n); return __builtin_bit_cast(unsigned, b); }
__device__ __forceinline__ int crow(int r, int hi) { return (r & 3) + 8 * (r >> 2) + 4 * hi; }
#define ATT_WAIT_BAR(N) asm volatile("s_waitcnt vmcnt(" #N ") lgkmcnt(0)\n\ts_barrier" ::: "memory")
constexpr int ATT_WS = 98304;
__device__ __forceinline__ void attn_unit(LAS unsigned char* lds, const bf16* Z, int qrow0, int krow0, int NT, int h, float negb, float lam, float oscale, const float* sg, bf16* Y) {
    const int tid = fresh_tid(), lane = tid & 63, r32 = lane & 31, hi = lane >> 5; const int wid = __builtin_amdgcn_readfirstlane(tid >> 6); const int mp = wid >> 2, wq = wid & 3;
    const unsigned lds0 = (unsigned)(uintptr_t)lds;
    const int dr = lane >> 4, dsl = lane & 15;
    const bf16* ks0 = Z + (size_t)(krow0 + 4 * wid + dr) * INW + K_OFF + h * 128 + (dsl ^ ((4 * wid + dr) & 15)) * 8;
    const bf16* vs0 = Z + (size_t)(krow0 + 4 * wid + dr) * INW + V_OFF + h * 128 + (dsl ^ (dr << 2)) * 8;
#define DMA_K(t) do { const size_t off_ = (size_t)(t) * 64 * INW; const unsigned sb_ = lds0 + (unsigned)((t) % 3) * 16384u + wid * 1024; \
        glds16(ks0 + off_, (unsigned)__builtin_amdgcn_readfirstlane(sb_)); glds16(ks0 + off_ + (size_t)32 * INW, (unsigned)__builtin_amdgcn_readfirstlane(sb_ + 8192)); } while (0)
#define DMA_V(t) do { const size_t off_ = (size_t)(t) * 64 * INW; const unsigned sb_ = lds0 + 49152u + (unsigned)((t) & 1) * 16384u + wid * 1024; \
        glds16(vs0 + off_, (unsigned)__builtin_amdgcn_readfirstlane(sb_)); glds16(vs0 + off_ + (size_t)32 * INW, (unsigned)__builtin_amdgcn_readfirstlane(sb_ + 8192)); } while (0)
    int kof[4], vof[4];
    { const int g1 = (lane >> 4) & 1, q = (lane & 15) >> 2, p = lane & 3;
#pragma unroll
        for (int d0 = 0; d0 < 4; ++d0) { kof[d0] = r32 * 256 + (((mp * 8 + 2 * d0 + hi) ^ (r32 & 15)) << 4);
            vof[d0] = 49152 + (4 * hi + q) * 256 + (((4 * d0 + 2 * g1 + (p >> 1)) ^ (q << 2)) << 4) + (p & 1) * 8; } }
    bf16x8 qr[4];
    { const bf16* qp = Z + (size_t)(qrow0 + wq * 32 + r32) * INW + Q_OFF + h * 128 + mp * 64 + hi * 8;
#pragma unroll
        for (int d0 = 0; d0 < 4; ++d0) qr[d0] = *(const bf16x8*)(qp + d0 * 16); }
    DMA_K(0); DMA_K(1);
    if (mp) __builtin_amdgcn_s_setprio(1);
    f32x16 o[4];
#pragma unroll
    for (int d0 = 0; d0 < 4; ++d0)
#pragma unroll
        for (int r = 0; r < 16; ++r) o[d0][r] = 0.f;
    const f32x16 zero16 = {0.f, 0.f, 0.f, 0.f, 0.f, 0.f, 0.f, 0.f, 0.f, 0.f, 0.f, 0.f, 0.f, 0.f, 0.f, 0.f};
    float l_reg = 0.f;
    v4u pw[4];
    (void)negb;
#define ATT_QK(P0, P1, t) do { const LAS unsigned char* kp_ = lds + ((t) % 3) * 16384; \
        { bf16x8 kf_[4]; _Pragma("unroll") for (int d0 = 0; d0 < 4; ++d0) kf_[d0] = *(const LAS bf16x8*)(kp_ + kof[d0]); \
          P0 = __builtin_amdgcn_mfma_f32_32x32x16_bf16(kf_[0], qr[0], zero16, 0, 0, 0); \
          _Pragma("unroll") for (int d0 = 1; d0 < 4; ++d0) P0 = __builtin_amdgcn_mfma_f32_32x32x16_bf16(kf_[d0], qr[d0], P0, 0, 0, 0); } \
        { bf16x8 kf_[4]; _Pragma("unroll") for (int d0 = 0; d0 < 4; ++d0) kf_[d0] = *(const LAS bf16x8*)(kp_ + kof[d0] + 8192); \
          P1 = __builtin_amdgcn_mfma_f32_32x32x16_bf16(kf_[0], qr[0], zero16, 0, 0, 0); \
          _Pragma("unroll") for (int d0 = 1; d0 < 4; ++d0) P1 = __builtin_amdgcn_mfma_f32_32x32x16_bf16(kf_[d0], qr[d0], P1, 0, 0, 0); } } while (0)
#define ATT_EXP(P0, P1) do { float sa_ = 0.f, sb_ = 0.f; \
        _Pragma("unroll") for (int r = 0; r < 16; ++r) { P0[r] = __builtin_amdgcn_exp2f(P0[r]); P1[r] = __builtin_amdgcn_exp2f(P1[r]); sa_ += P0[r]; sb_ += P1[r]; } \
        l_reg += sa_ + sb_; } while (0)
#define ATT_PACK(P0, P1) do { \
        _Pragma("unroll") for (int q = 0; q < 4; ++q) { pw[0][q] = cvtpk_s(P0[2 * q], P0[2 * q + 1]); pw[1][q] = cvtpk_s(P0[8 + 2 * q], P0[8 + 2 * q + 1]); \
            pw[2][q] = cvtpk_s(P1[2 * q], P1[2 * q + 1]); pw[3][q] = cvtpk_s(P1[8 + 2 * q], P1[8 + 2 * q + 1]); } } while (0)
#define VTR(dst, addr, off) dst = vtr((const LAS unsigned char*)(addr) + (off))
#define ATT_VLOAD(V, t, d0) do { const unsigned va_ = lds0 + (unsigned)((t) & 1) * 16384u + (unsigned)vof[d0]; \
        VTR(V[0], va_, 0); VTR(V[1], va_, 2048); VTR(V[2], va_, 4096); VTR(V[3], va_, 6144); VTR(V[4], va_, 8192); VTR(V[5], va_, 10240); VTR(V[6], va_, 12288); VTR(V[7], va_, 14336); } while (0)
#define ATT_LGKM(n) asm volatile("s_waitcnt lgkmcnt(" #n ")" ::: "memory")
#define VFR(V, ks) (bf16x8){V[2 * (ks)][0], V[2 * (ks)][1], V[2 * (ks)][2], V[2 * (ks)][3], V[2 * (ks) + 1][0], V[2 * (ks) + 1][1], V[2 * (ks) + 1][2], V[2 * (ks) + 1][3]}
#define ATT_PVX(V, d0, P, B) do { \
        _Pragma("unroll") for (int ks = 0; ks < 4; ++ks) { o[d0] = __builtin_amdgcn_mfma_f32_32x32x16_bf16(__builtin_bit_cast(bf16x8, pw[ks]), VFR(V, ks), o[d0], 0, 0, 0); \
            P[B + 2 * ks] = __builtin_amdgcn_exp2f(P[B + 2 * ks]); P[B + 2 * ks + 1] = __builtin_amdgcn_exp2f(P[B + 2 * ks + 1]); sa_ += P[B + 2 * ks]; sb_ += P[B + 2 * ks + 1]; } \
        _Pragma("unroll") for (int ks = 0; ks < 4; ++ks) { __builtin_amdgcn_sched_group_barrier(0x008, 1, 0); __builtin_amdgcn_sched_group_barrier(0x400, 2, 0); __builtin_amdgcn_sched_group_barrier(0x002, 2, 0); } \
        __builtin_amdgcn_sched_barrier(0); } while (0)
#define ATT_PVONLY(V, d0) do { _Pragma("unroll") for (int ks = 0; ks < 4; ++ks) o[d0] = __builtin_amdgcn_mfma_f32_32x32x16_bf16(__builtin_bit_cast(bf16x8, pw[ks]), VFR(V, ks), o[d0], 0, 0, 0); __builtin_amdgcn_sched_barrier(0); } while (0)
#define ATT_TOP(t) do { if ((t) + 1 < NT) ATT_WAIT_BAR(2); else ATT_WAIT_BAR(0); DMA_V(t); if ((t) + 2 < NT) DMA_K((t) + 2); } while (0)
    { f32x16 p0, p1;
        ATT_TOP(0); ATT_QK(p0, p1, 0); ATT_EXP(p0, p1); ATT_PACK(p0, p1); }
    s16x4 va[8], vb[8];
    for (int t = 1; t < NT; ++t) {
        f32x16 p0, p1; float sa_ = 0.f, sb_ = 0.f;
        ATT_TOP(t);
        ATT_VLOAD(va, t - 1, 0); __builtin_amdgcn_sched_barrier(0);
        ATT_QK(p0, p1, t); __builtin_amdgcn_sched_barrier(0);
        ATT_VLOAD(vb, t - 1, 1); ATT_LGKM(8); __builtin_amdgcn_sched_barrier(0);
        ATT_PVX(va, 0, p0, 0);
        ATT_VLOAD(va, t - 1, 2); ATT_LGKM(8); __builtin_amdgcn_sched_barrier(0);
        ATT_PVX(vb, 1, p0, 8);
        ATT_VLOAD(vb, t - 1, 3); ATT_LGKM(8); __builtin_amdgcn_sched_barrier(0);
        ATT_PVX(va, 2, p1, 0);
        ATT_LGKM(0); __builtin_amdgcn_sched_barrier(0);
        ATT_PVX(vb, 3, p1, 8);
        l_reg += sa_ + sb_;
        ATT_PACK(p0, p1); }
    ATT_WAIT_BAR(0);
    ATT_VLOAD(va, NT - 1, 0); ATT_VLOAD(vb, NT - 1, 1); ATT_LGKM(8); ATT_PVONLY(va, 0);
    ATT_VLOAD(va, NT - 1, 2); ATT_LGKM(8); ATT_PVONLY(vb, 1);
    ATT_VLOAD(vb, NT - 1, 3); ATT_LGKM(8); ATT_PVONLY(va, 2);
    ATT_LGKM(0); ATT_PVONLY(vb, 3);
#undef ATT_EXP
#undef VTR
#undef ATT_VLOAD
#undef ATT_LGKM
#undef VFR
#undef ATT_PVX
#undef ATT_PVONLY
#undef ATT_PACK
#undef ATT_TOP
#undef ATT_QK
#undef ATT_PV
#undef DMA_K
#undef DMA_V
    __builtin_amdgcn_s_setprio(0);
    { auto rr = __builtin_amdgcn_permlane32_swap(__float_as_uint(l_reg), __float_as_uint(l_reg), false, false); l_reg = __uint_as_float(rr[0]) + __uint_as_float(rr[1]); }
    LAS float* wsf = (LAS float*)(lds + ATT_WS) + wid * 64;
    if (hi == 0) wsf[r32] = l_reg;
    LDS_WAIT();
    float rl[16];
#pragma unroll
    for (int r = 0; r < 16; ++r) rl[r] = __builtin_amdgcn_rcpf(wsf[crow(r, hi)]) * (mp ? lam : 1.0f);
    ATT_WAIT_BAR(0);
    LAS float* stg = (LAS float*)lds + wq * (32 * 132);
    if (mp == 1) {
#pragma unroll
        for (int d0 = 0; d0 < 4; ++d0)
#pragma unroll
            for (int r = 0; r < 16; ++r) stg[crow(r, hi) * 132 + d0 * 32 + r32] = o[d0][r] * rl[r];
    }
    ATT_WAIT_BAR(0);
    if (mp == 0) {
#pragma unroll
        for (int d0 = 0; d0 < 4; ++d0)
#pragma unroll
            for (int r = 0; r < 16; ++r) { const int ix = crow(r, hi) * 132 + d0 * 32 + r32; stg[ix] = o[d0][r] * rl[r] - stg[ix]; }
        LDS_WAIT();
        const int q = lane >> 1, half = lane & 1; const LAS float* rp = stg + q * 132 + half * 64;
        f32x4 v[16]; float ss = 0.f;
#pragma unroll
        for (int i = 0; i < 16; ++i) { v[i] = *(const LAS f32x4*)(rp + 4 * i); ss += (v[i].x * v[i].x + v[i].y * v[i].y) + (v[i].z * v[i].z + v[i].w * v[i].w); }
        ss += xor1_f(ss);
        const float rinv = __builtin_amdgcn_rsqf(ss * (1.0f / 128.0f) + 1e-6f) * oscale;
        bf16* yp = Y + (size_t)(qrow0 + wq * 32 + q) * DM + 512 + h * 128 + half * 64;
        const f32x4* sgp = (const f32x4*)(sg + half * 64);
#pragma unroll
        for (int i = 0; i < 8; ++i) { const f32x4 a0 = v[2 * i] * sgp[2 * i] * rinv, a1 = v[2 * i + 1] * sgp[2 * i + 1] * rinv;
            v4u w; w.x = pk2(a0.x, a0.y); w.y = pk2(a0.z, a0.w); w.z = pk2(a1.x, a1.y); w.w = pk2(a1.z, a1.w); *(v4u*)(yp + 8 * i) = w; }
    }
    ATT_WAIT_BAR(0);
}

__device__ __forceinline__ void attn_unit16(LAS unsigned char* lds, const bf16* Z, int qrow0, int krow0, int NT, int h, float lam, float oscale, const float* sg, bf16* Y) {
    const int tid = fresh_tid(), lane = tid & 63, r16 = lane & 15, g = lane >> 4; const int wid = __builtin_amdgcn_readfirstlane(tid >> 6); const int mp = wid >> 2, wq = wid & 3;
    const unsigned lds0 = (unsigned)(uintptr_t)lds;
    const int dr = lane >> 4, dsl = lane & 15;
    const bf16* ks0 = Z + (size_t)(krow0 + 4 * wid + dr) * INW + K_OFF + h * 128 + (dsl ^ ((4 * wid + dr) & 15)) * 8;
    const bf16* vs0 = Z + (size_t)(krow0 + 4 * wid + dr) * INW + V_OFF + h * 128 + (dsl ^ (dr << 2) ^ ((wid & 1) << 1)) * 8;
#define DMA_K(t) do { const size_t off_ = (size_t)(t) * 64 * INW; const unsigned sb_ = lds0 + (unsigned)((t) % 3) * 16384u + wid * 1024; \
        glds16(ks0 + off_, (unsigned)__builtin_amdgcn_readfirstlane(sb_)); glds16(ks0 + off_ + (size_t)32 * INW, (unsigned)__builtin_amdgcn_readfirstlane(sb_ + 8192)); } while (0)
#define DMA_V(t) do { const size_t off_ = (size_t)(t) * 64 * INW; const unsigned sb_ = lds0 + 49152u + (unsigned)((t) & 1) * 16384u + wid * 1024; \
        glds16(vs0 + off_, (unsigned)__builtin_amdgcn_readfirstlane(sb_)); glds16(vs0 + off_ + (size_t)32 * INW, (unsigned)__builtin_amdgcn_readfirstlane(sb_ + 8192)); } while (0)
    int kof[2];
    kof[0] = r16 * 256 + (((mp * 8 + g) ^ r16) << 4); kof[1] = r16 * 256 + (((mp * 8 + 4 + g) ^ r16) << 4);
    const int q4 = r16 >> 2, pq = r16 & 3;
    const int vrow = 49152 + (4 * g + q4) * 256 + (pq & 1) * 8, vx = (q4 << 2) ^ ((g & 1) << 1) ^ (pq >> 1);
    bf16x8 qf[2][2];
    { const bf16* qp = Z + (size_t)(qrow0 + wq * 32 + r16) * INW + Q_OFF + h * 128 + mp * 64 + g * 8;
#pragma unroll
        for (int qb = 0; qb < 2; ++qb)
#pragma unroll
            for (int ks = 0; ks < 2; ++ks) qf[qb][ks] = *(const bf16x8*)(qp + (size_t)qb * 16 * INW + ks * 32); }
    DMA_K(0); DMA_K(1);
    if (mp) __builtin_amdgcn_s_setprio(1);
    f32x4 o[2][8];
#pragma unroll
    for (int qb = 0; qb < 2; ++qb)
#pragma unroll
        for (int db = 0; db < 8; ++db) o[qb][db] = (f32x4){0.f, 0.f, 0.f, 0.f};
    const f32x4 zero4 = {0.f, 0.f, 0.f, 0.f};
    float l0 = 0.f, l1 = 0.f;
    v4u pw[2][2];
    f32x4 S[4][2];
#define ATT_QK(t) do { const LAS unsigned char* kp_ = lds + ((t) % 3) * 16384; \
        _Pragma("unroll") for (int kh = 0; kh < 2; ++kh) { bf16x8 kf_[2][2]; \
            _Pragma("unroll") for (int kb = 0; kb < 2; ++kb) _Pragma("unroll") for (int ks = 0; ks < 2; ++ks) kf_[kb][ks] = *(const LAS bf16x8*)(kp_ + kof[ks] + (2 * kh + kb) * 4096); \
            _Pragma("unroll") for (int kb = 0; kb < 2; ++kb) _Pragma("unroll") for (int qb = 0; qb < 2; ++qb) { \
                S[2 * kh + kb][qb] = __builtin_amdgcn_mfma_f32_16x16x32_bf16(kf_[kb][0], qf[qb][0], zero4, 0, 0, 0); \
                S[2 * kh + kb][qb] = __builtin_amdgcn_mfma_f32_16x16x32_bf16(kf_[kb][1], qf[qb][1], S[2 * kh + kb][qb], 0, 0, 0); } } } while (0)
#define ATT_EXPB(kb) do { _Pragma("unroll") for (int r = 0; r < 4; ++r) { S[kb][0][r] = __builtin_amdgcn_exp2f(S[kb][0][r]); S[kb][1][r] = __builtin_amdgcn_exp2f(S[kb][1][r]); sa_ += S[kb][0][r]; sb_ += S[kb][1][r]; } } while (0)
#define ATT_PACK() do { _Pragma("unroll") for (int qb = 0; qb < 2; ++qb) _Pragma("unroll") for (int s_ = 0; s_ < 2; ++s_) { \
        pw[qb][s_][0] = cvtpk_s(S[2 * s_][qb][0], S[2 * s_][qb][1]); pw[qb][s_][1] = cvtpk_s(S[2 * s_][qb][2], S[2 * s_][qb][3]); \
        pw[qb][s_][2] = cvtpk_s(S[2 * s_ + 1][qb][0], S[2 * s_ + 1][qb][1]); pw[qb][s_][3] = cvtpk_s(S[2 * s_ + 1][qb][2], S[2 * s_ + 1][qb][3]); } } while (0)
#define ATT_VLOAD(V, t, dg) do { const LAS unsigned char* vp_ = lds + ((t) & 1) * 16384 + vrow; \
        _Pragma("unroll") for (int dbl = 0; dbl < 2; ++dbl) { const int va_ = ((2 * (2 * (dg) + dbl)) ^ vx) << 4; \
            _Pragma("unroll") for (int s_ = 0; s_ < 2; ++s_) { V[(dbl * 2 + s_) * 2] = vtr(vp_ + va_ + s_ * 8192); V[(dbl * 2 + s_) * 2 + 1] = vtr(vp_ + va_ + s_ * 8192 + 4096); } } } while (0)
#define VFR(V, i) (bf16x8){V[2 * (i)][0], V[2 * (i)][1], V[2 * (i)][2], V[2 * (i)][3], V[2 * (i) + 1][0], V[2 * (i) + 1][1], V[2 * (i) + 1][2], V[2 * (i) + 1][3]}
#define ATT_PVG(V, dg) do { _Pragma("unroll") for (int dbl = 0; dbl < 2; ++dbl) _Pragma("unroll") for (int qb = 0; qb < 2; ++qb) _Pragma("unroll") for (int s_ = 0; s_ < 2; ++s_) \
            o[qb][2 * (dg) + dbl] = __builtin_amdgcn_mfma_f32_16x16x32_bf16(__builtin_bit_cast(bf16x8, pw[qb][s_]), VFR(V, dbl * 2 + s_), o[qb][2 * (dg) + dbl], 0, 0, 0); } while (0)
#define ATT_PVX(V, dg) do { ATT_PVG(V, dg); ATT_EXPB(dg); \
        _Pragma("unroll") for (int i_ = 0; i_ < 4; ++i_) { __builtin_amdgcn_sched_group_barrier(0x008, 2, 0); __builtin_amdgcn_sched_group_barrier(0x400, 2, 0); __builtin_amdgcn_sched_group_barrier(0x002, 2, 0); } \
        __builtin_amdgcn_sched_barrier(0); } while (0)
#define ATT_TOP(t) do { if ((t) + 1 < NT) ATT_WAIT_BAR(2); else ATT_WAIT_BAR(0); DMA_V(t); if ((t) + 2 < NT) DMA_K((t) + 2); } while (0)
#define ATT_LGKM(n) asm volatile("s_waitcnt lgkmcnt(" #n ")" ::: "memory")
    { float sa_ = 0.f, sb_ = 0.f; ATT_TOP(0); ATT_QK(0); ATT_EXPB(0); ATT_EXPB(1); ATT_EXPB(2); ATT_EXPB(3); l0 += sa_; l1 += sb_; ATT_PACK(); }
    s16x4 va[8], vb[8];
    for (int t = 1; t < NT; ++t) {
        float sa_ = 0.f, sb_ = 0.f;
        ATT_TOP(t);
        ATT_VLOAD(va, t - 1, 0); __builtin_amdgcn_sched_barrier(0);
        ATT_QK(t); __builtin_amdgcn_sched_barrier(0);
        ATT_VLOAD(vb, t - 1, 1); ATT_LGKM(8); __builtin_amdgcn_sched_barrier(0);
        ATT_PVX(va, 0);
        ATT_VLOAD(va, t - 1, 2); ATT_LGKM(8); __builtin_amdgcn_sched_barrier(0);
        ATT_PVX(vb, 1);
        ATT_VLOAD(vb, t - 1, 3); ATT_LGKM(8); __builtin_amdgcn_sched_barrier(0);
        ATT_PVX(va, 2);
        ATT_LGKM(0); __builtin_amdgcn_sched_barrier(0);
        ATT_PVX(vb, 3);
        l0 += sa_; l1 += sb_;
        ATT_PACK(); }
    ATT_WAIT_BAR(0);
    ATT_VLOAD(va, NT - 1, 0); ATT_VLOAD(vb, NT - 1, 1); ATT_LGKM(8); ATT_PVG(va, 0); __builtin_amdgcn_sched_barrier(0);
    ATT_VLOAD(va, NT - 1, 2); ATT_LGKM(8); ATT_PVG(vb, 1); __builtin_amdgcn_sched_barrier(0);
    ATT_VLOAD(vb, NT - 1, 3); ATT_LGKM(8); ATT_PVG(va, 2); __builtin_amdgcn_sched_barrier(0);
    ATT_LGKM(0); ATT_PVG(vb, 3);
#undef DMA_K
#undef DMA_V
#undef ATT_QK
#undef ATT_EXPB
#undef ATT_PACK
#undef ATT_VLOAD
#undef VFR
#undef ATT_PVG
#undef ATT_PVX
#undef ATT_TOP
#undef ATT_LGKM
    __builtin_amdgcn_s_setprio(0);
    l0 += xor16_f(l0); l0 = sum32_f(l0); l1 += xor16_f(l1); l1 = sum32_f(l1);
    LAS float* wsf = (LAS float*)(lds + ATT_WS) + wid * 64;
    if (g == 0) { wsf[r16] = l0; wsf[16 + r16] = l1; }
    LDS_WAIT();
    float rl[2][4];
#pragma unroll
    for (int qb = 0; qb < 2; ++qb)
#pragma unroll
        for (int r = 0; r < 4; ++r) rl[qb][r] = __builtin_amdgcn_rcpf(wsf[16 * qb + 4 * g + r]) * (mp ? lam : 1.0f);
    ATT_WAIT_BAR(0);
    LAS float* stg = (LAS float*)lds + wq * (32 * 132);
    if (mp == 1) {
#pragma unroll
        for (int qb = 0; qb < 2; ++qb)
#pragma unroll
            for (int db = 0; db < 8; ++db)
#pragma unroll
                for (int r = 0; r < 4; ++r) stg[(16 * qb + 4 * g + r) * 132 + 16 * db + r16] = o[qb][db][r] * rl[qb][r];
    }
    ATT_WAIT_BAR(0);
    if (mp == 0) {
#pragma unroll
        for (int qb = 0; qb < 2; ++qb)
#pragma unroll
            for (int db = 0; db < 8; ++db)
#pragma unroll
                for (int r = 0; r < 4; ++r) { const int ix = (16 * qb + 4 * g + r) * 132 + 16 * db + r16; stg[ix] = o[qb][db][r] * rl[qb][r] - stg[ix]; }
        LDS_WAIT();
        const int q = lane >> 1, half = lane & 1; const LAS float* rp = stg + q * 132 + half * 64;
        f32x4 v[16]; float ss = 0.f;
#pragma unroll
        for (int i = 0; i < 16; ++i) { v[i] = *(const LAS f32x4*)(rp + 4 * i); ss += (v[i].x * v[i].x + v[i].y * v[i].y) + (v[i].z * v[i].z + v[i].w * v[i].w); }
        ss += xor1_f(ss);
        const float rinv = __builtin_amdgcn_rsqf(ss * (1.0f / 128.0f) + 1e-6f) * oscale;
        bf16* yp = Y + (size_t)(qrow0 + wq * 32 + q) * DM + 512 + h * 128 + half * 64;
        const f32x4* sgp = (const f32x4*)(sg + half * 64);
#pragma unroll
        for (int i = 0; i < 8; ++i) { const f32x4 a0 = v[2 * i] * sgp[2 * i] * rinv, a1 = v[2 * i + 1] * sgp[2 * i + 1] * rinv;
            v4u w; w.x = pk2(a0.x, a0.y); w.y = pk2(a0.z, a0.w); w.z = pk2(a1.x, a1.y); w.w = pk2(a1.z, a1.w); *(v4u*)(yp + 8 * i) = w; }
    }
    ATT_WAIT_BAR(0);
}

__device__ __forceinline__ void phase_mixers(const Args& a, int li, LAS unsigned char* lds, int G, int bx) {
    unsigned char* ws = fresh_ptr(a.ws);
    for (int rep = 0; rep <= DUP_HY; ++rep) if (PHEN(13)) for (int c = bx; c < 256; c += G) hyena_unit(a, li, G == 256 ? (((c & 7) << 5) | (c >> 3)) : c, lds);
    for (int rep = 0; rep <= DUP_POOL; ++rep) if (PHEN(14)) { pool_load_lin(a, li, lds);
    for (int p = bx; p < 512; p += G) pool_unit(a, li, p, lds);
    for (int cp = bx; cp < 256; cp += G) pool_ctx_pair(a, li, cp, lds); }
    if (!PHEN(15)) return;
    const float* qkg = AIN(22) + li * 128; const float* dl = AIN(23) + li * 256; const float* sg = AIN(24) + li * 128;
    float mq = 0.f, mk = 0.f, d1 = 0.f, d2 = 0.f;
    for (int q = 0; q < 64; ++q) { mq = __builtin_fmaxf(mq, __builtin_fabsf(qkg[q])); mk = __builtin_fmaxf(mk, __builtin_fabsf(qkg[64 + q])); d1 += dl[q] * dl[64 + q]; d2 += dl[128 + q] * dl[192 + q]; }
    const float lam_init = 0.8f - 0.6f * __expf(-0.3f * (float)li);
    const float lam = __expf(d1) - __expf(d2) + lam_init;
    const float negb = -(64.0f * mq * mk * C2);
    const bf16* Z = (const bf16*)(ws + WS_Z); bf16* Y = (bf16*)(ws + WS_Y);
    for (int rep = 0; rep <= DUP_ATT; ++rep)
    for (int i = 0; i * G + bx < 1024; ++i) {
        int bh, qb;
        if (G == 256) { const int vcu = (bx & 7) * 32 + (bx >> 3); bh = vcu >> 5; qb = (vcu & 31) + 32 * i; } else { const int u = i * G + bx; bh = u >> 7; qb = u & 127; }
        const int b = bh >> 2, h = bh & 3;
        attn_unit16(lds, Z, b * RB + CTXL + qb * 128, b * RB, RB / 64, h, lam, 1.0f - lam_init, sg, Y);
    }
    if (li < DEPTH - 1) for (int u = bx; u < 16; u += G) { const int b = u >> 3, h = (u >> 1) & 3, qh = u & 1;
        attn_unit16(lds, Z, b * RB + qh * 128, b * RB, CTXL / 64, h, lam, 1.0f - lam_init, sg, Y); }
}

constexpr int NPHASES = 2 * 9 + 2 * 13 - 6;
__global__ void __launch_bounds__(NTHR, 2) fwd(Args a) {
    extern __shared__ __attribute__((aligned(16))) unsigned char lds_raw[];
    LAS unsigned char* lds = (LAS unsigned char*)lds_raw;
    volatile LAS unsigned* MISC = (volatile LAS unsigned*)(lds + MISC_OFF);
    const int tid = threadIdx.x, G = gridDim.x, bx = blockIdx.x;
    if (tid < 128) MISC[tid] = 0u;
    if (tid < 64) ((LAS unsigned*)(lds + PTAB_OFF))[tid] = ((const __attribute__((address_space(4))) unsigned*)__builtin_amdgcn_kernarg_segment_ptr())[tid];
    __syncthreads();
    const int lo = a.ph_lo, hi = a.ph_hi;
    unsigned* ctl = (unsigned*)(fresh_ptr(a.ws) + WS_CTL);
    XcdBarrier bar; bar.bar = ctl + CW_BAR; bar.x = 0; bar.st = MISC + 8;
    if (hi - lo > 1) bar = xcd_barrier_post(ctl + CW_BAR, MISC + 8);
    int ph = 0;
#define ON() (ph >= lo && ph < hi)
#define ENDPH() do { if (ON() && ph + 1 < hi) xcd_barrier(bar); ++ph; } while (0)
#define WSP(off) (fresh_ptr(a.ws) + (off))
#define XN ((bf16*)WSP(WS_XN))
#define Zb ((bf16*)WSP(WS_Z))
#define Yb ((bf16*)WSP(WS_Y))
#define HID ((bf16*)WSP(WS_HID))
#define win_t ((bf16*)WSP(WS_WIN))
#define wout_t ((bf16*)WSP(WS_WOUT))
#define wup_t ((bf16*)WSP(WS_WUP))
#define wdn_t ((bf16*)WSP(WS_WDN))
#define hctx ((float*)WSP(WS_HCTX))
#define WSB WSP(0)
#define modl ((const float*)WSP(WS_MOD) + (size_t)li * 3 * 6144)
    for (int li = 0; li < DEPTH; ++li) {
        const bool moe = (li & 1) != 0;
        const float* xlat = li == 0 ? AIN(0) : (const float*)fresh_ptr(a.out);
        if (li == 0) {
            if (PHEN(0) && ON()) phase_prep_a(a, li, lds, G, bx);
            ENDPH();
            if (PHEN(1) && ON()) phase_prep_b(a, li, lds, G, bx);
            ENDPH();
            if (PHEN(2) && ON()) phase_norm(a, li, 0, xlat, lds, G, bx);
            ENDPH();
        } else {
            if (ON()) { if (PHEN(0)) phase_prep_a(a, li, lds, G, bx); if (PHEN(1)) phase_prep_b(a, li, lds, G, bx); if (PHEN(2)) phase_norm(a, li, 0, xlat, lds, G, bx); }
            ENDPH();
        }
        for (int rep = 0; rep <= DUP_GEMM; ++rep) if (PHEN(3) && ON()) { pg8::Gemm g{XN, win_t, MROWS, INW, DM}; pg8::StaticOrder S; S.init(MROWS, INW, DM, G, bx);
            EpiIn E{Zb, (bf16*)(WSB + WS_ZT), (bf16*)(WSB + WS_ZTC), (const float*)(WSB + WS_ROPE), (const float*)(WSB + WS_ROPE) + 4096, AIN(22) + li * 128};
            pg8::gemm_phase<EpiIn, pg8::StaticOrder, true, true>(lds, g, S, E); }
        ENDPH();
        if (PHEN(4) && ON()) phase_mixers(a, li, lds, G, bx);
        ENDPH();
#if DUP_ADD
        if (PHEN(5) && ON()) { pg8::Gemm g{Yb, wout_t, MROWS, DM, DM}; SplitTailOrder S; S.init(DM, DM, G, bx);
            EpiRes E{xlat, a.out, hctx, modl + 2 * DM, DM / 64, (float*)(WSB + WS_SLAB), 0.f};
            pg8::gemm_phase<EpiRes, SplitTailOrder, true, true>(lds, g, S, E); }
#endif
        if (PHEN(5) && ON()) { pg8::Gemm g{Yb, wout_t, MROWS, DM, DM}; SplitTailOrder S; S.init(DM, DM, G, bx);
            EpiRes E{xlat, a.out, hctx, modl + 2 * DM, DM / 64, (float*)(WSB + WS_SLAB), 1.f};
            pg8::gemm_phase<EpiRes, SplitTailOrder, true, true>(lds, g, S, E); }
        ENDPH();
        if (!moe) {
            if (PHEN(6) && ON()) phase_norm(a, li, 3, a.out, lds, G, bx);
            ENDPH();
            for (int rep = 0; rep <= DUP_GEMM; ++rep) if (PHEN(7) && ON()) { pg8::Gemm g{XN, wup_t, MROWS, 2 * DFF, DM}; pg8::StaticOrder S; S.init(MROWS, 2 * DFF, DM, G, bx);
                EpiGlu E{HID, DFF, DFF / 128};
                pg8::gemm_phase<EpiGlu, pg8::StaticOrder, true, true>(lds, g, S, E); }
            ENDPH();
#if DUP_ADD
            if (PHEN(8) && ON()) { pg8::Gemm g{HID, wdn_t, MROWS, DM, DFF}; SplitTailOrder S; S.init(DM, DFF, G, bx);
                EpiRes E{a.out, a.out, hctx, modl + 5 * DM, DFF / 64, (float*)(WSB + WS_SLAB), 0.f};
                pg8::gemm_phase<EpiRes, SplitTailOrder, true, true>(lds, g, S, E); }
#endif
            if (PHEN(8) && ON()) { pg8::Gemm g{HID, wdn_t, MROWS, DM, DFF}; SplitTailOrder S; S.init(DM, DFF, G, bx);
                EpiRes E{a.out, a.out, hctx, modl + 5 * DM, DFF / 64, (float*)(WSB + WS_SLAB), 1.f};
                pg8::gemm_phase<EpiRes, SplitTailOrder, true, true>(lds, g, S, E); }
            ENDPH();
        } else {
            const LAS int* tab = (const LAS int*)(lds + TAB_OFF);
            if (PHEN(9) && ON()) phase_norm_router(a, li, a.out, lds, G, bx);
            ENDPH();
            if (PHEN(10) && ON()) phase_moe_gather(a, li, lds, G, bx);
            ENDPH();
            for (int rep = 0; rep <= DUP_GEMM; ++rep) if (PHEN(11) && ON()) { moe_tables(a, li >> 1, lds, G, bx);
                pg8::Gemm g{(const bf16*)(WSB + WS_AG), wup_t, 0, 0, DM}; MoeOrder S{G, bx, 2 * DFE / 256, 0, tab[16] * (2 * DFE / 256), tab, DM / 64};
                EpiGlu E{HID, DFE, DFE / 128};
                pg8::gemm_phase<EpiGlu, MoeOrder, true, true>(lds, g, S, E); }
            ENDPH();
            for (int k = 0; k < 2; ++k) {
#if DUP_ADD
                if (PHEN(12) && ON()) { moe_tables(a, li >> 1, lds, G, bx);
                    pg8::Gemm g{HID, wdn_t, 0, 0, DFE}; MoeDownOrder S; S.init(G, bx, k, tab);
                    EpiMoeDown E{a.out, hctx, modl + 5 * DM, (const int*)(WSB + WS_RTOK), (const float*)(WSB + WS_RGATE), tab, (float*)(WSB + WS_SLAB), 0.f};
                    pg8::gemm_phase<EpiMoeDown, MoeDownOrder, true, true>(lds, g, S, E); }
#endif
                if (PHEN(12) && ON()) { moe_tables(a, li >> 1, lds, G, bx);
                    pg8::Gemm g{HID, wdn_t, 0, 0, DFE}; MoeDownOrder S; S.init(G, bx, k, tab);
                    EpiMoeDown E{a.out, hctx, modl + 5 * DM, (const int*)(WSB + WS_RTOK), (const float*)(WSB + WS_RGATE), tab, (float*)(WSB + WS_SLAB), 1.f};
                    pg8::gemm_phase<EpiMoeDown, MoeDownOrder, true, true>(lds, g, S, E); }
                ENDPH();
            }
            for (int k = 0; k < 2; ++k) { if (ON()) phase_moe_fix(a, li, k, lds, G, bx); ENDPH(); }
        }
    }
#undef ON
#undef ENDPH
#undef WSP
#undef XN
#undef Zb
#undef Yb
#undef HID
#undef win_t
#undef wout_t
#undef wup_t
#undef wdn_t
#undef hctx
#undef WSB
#undef modl
}

extern "C" void kernel_launch(void* const* d_in, const int* in_sizes, int n_in, void* d_out, int out_size, void* d_ws, size_t ws_size, hipStream_t stream) {
    static int grid = 0;
    if (grid == 0) {
        if (n_in != 32 || in_sizes[0] != NB * SEQ * DM || out_size != NB * SEQ * DM || ws_size < WS_END) {
            fprintf(stderr, "kernel_launch: unexpected problem: n_in %d in0 %d out %d ws %zu (need %zu)\n", n_in, n_in > 0 ? in_sizes[0] : -1, out_size, ws_size, (size_t)WS_END); grid = -1; return; }
        int dev = 0, cus = 0, per_cu = 0;
        if (hipGetDevice(&dev) != hipSuccess || hipDeviceGetAttribute(&cus, hipDeviceAttributeMultiprocessorCount, dev) != hipSuccess) { grid = -1; return; }
        if (hipFuncSetAttribute((const void*)fwd, hipFuncAttributeMaxDynamicSharedMemorySize, LDS_BYTES) != hipSuccess) { fprintf(stderr, "kernel_launch: hipFuncSetAttribute failed\n"); grid = -1; return; }
        if (hipOccupancyMaxActiveBlocksPerMultiprocessor(&per_cu, (const void*)fwd, NTHR, LDS_BYTES) != hipSuccess || per_cu < 1) { fprintf(stderr, "kernel_launch: occupancy query says %d\n", per_cu); }
        (void)hipGetLastError();
        grid = cus;
    }
    if (grid < 0) return;
    (void)hipMemsetAsync((char*)d_ws + WS_CTL, 0, CTL_ZERO_BYTES, stream);
    Args a{};
    for (int i = 0; i < 32; ++i) a.in[i] = (const float*)d_in[i];
    a.out = (float*)d_out; a.ws = (unsigned char*)d_ws;
#if MK_ONE_LAUNCH
    a.ph_lo = 0; a.ph_hi = NPHASES;
    hipLaunchKernelGGL(fwd, dim3(grid), dim3(NTHR), LDS_BYTES, stream, a);
#else
    for (int p = 0; p < NPHASES; ++p) { a.ph_lo = p; a.ph_hi = p + 1; hipLaunchKernelGGL(fwd, dim3(grid), dim3(NTHR), LDS_BYTES, stream, a); }
#endif
}
```

```cpp
#include <hip/hip_runtime.h>
#include <cstdio>
#include <cstdint>

#ifndef MK_ONE_LAUNCH
#define MK_ONE_LAUNCH 1
#endif
#ifndef PH_MASK
#define PH_MASK 0xFFFF
#endif
#define PHEN(n) (((PH_MASK) >> (n)) & 1)
#define DUP_ATT 0
#define DUP_HY 0
#define DUP_POOL 0
#define DUP_PREP 0
#define DUP_PREPB 0
#define DUP_GEMM 0
#define DUP_ADD 0

#define GAS __attribute__((address_space(1)))
#define LAS __attribute__((address_space(3)))
typedef unsigned short bf16;
typedef unsigned v4u __attribute__((ext_vector_type(4)));
typedef unsigned v2u __attribute__((ext_vector_type(2)));
typedef float f32x4 __attribute__((ext_vector_type(4)));
typedef float f32x2 __attribute__((ext_vector_type(2)));
typedef float f32x16 __attribute__((ext_vector_type(16)));
typedef short bf16x8 __attribute__((ext_vector_type(8)));
typedef short s16x4 __attribute__((ext_vector_type(4)));
typedef short v4i16_t __attribute__((ext_vector_type(4)));

constexpr int DM = 1024, NB = 2, SEQ = 16384, DEPTH = 4, CTXL = 256;
constexpr int RB = CTXL + SEQ;
constexpr int MROWS = NB * RB;
constexpr int TPB = RB / 256;
constexpr int INW = 2560, Q_OFF = 1024, K_OFF = 1536, V_OFF = 2048;
constexpr int DFF = 2816, DFE = 3584, NEXP = 8;
constexpr int NWAVES = 8, NTHR = 512;
constexpr int SEGCAP = MROWS;
constexpr float C2 = 0.125f * 1.4426950408889634f;

constexpr size_t MiB = 1u << 20;
constexpr size_t WS_CTL = 0, CTL_ZERO_BYTES = 1 * MiB;
constexpr size_t WS_MODP = 1 * MiB;
constexpr size_t WS_MOD = 4 * MiB;
constexpr size_t WS_ROPE = 4 * MiB + 512 * 1024;
constexpr size_t WS_H2C = 4 * MiB + 640 * 1024;
constexpr size_t WS_KCTX = 5 * MiB;
constexpr size_t WS_HCTX = 6 * MiB;
constexpr size_t WS_H2 = 8 * MiB;
constexpr size_t WS_RTOK = 12 * MiB;
constexpr size_t WS_RGATE = 15 * MiB;
constexpr size_t WS_RREC = 18 * MiB;
constexpr size_t WS_RRECG = 18 * MiB + 256 * 1024;
constexpr size_t WS_CNTB = 18 * MiB + 512 * 1024;
constexpr size_t WS_H2B = 19 * MiB;
constexpr size_t WS_W = 32 * MiB;
constexpr size_t WS_WIN = WS_W, WS_WOUT = WS_W + 5 * MiB, WS_WUP = WS_W + 8 * MiB, WS_WDN = WS_W + 120 * MiB;
constexpr size_t WS_XN = 224 * MiB;
constexpr size_t WS_Z = 289 * MiB;
constexpr size_t WS_ZT = 452 * MiB;
constexpr size_t WS_ZTC = WS_ZT + 48 * MiB;
constexpr size_t WS_Y = 501 * MiB;
constexpr size_t WS_HF = 566 * MiB;
constexpr size_t WS_HID = 289 * MiB;
constexpr size_t WS_XB = 772 * MiB;
constexpr size_t WS_SLAB = 910 * MiB;
constexpr size_t WS_END = 974 * MiB;

constexpr int CW_TMO = 0, CW_BAR = 4096, CW_MOECNT = 8192;

constexpr int LDS_BYTES = 159744;
constexpr int MISC_OFF = 155648;
constexpr int TAB_OFF = MISC_OFF + 256;

__device__ __forceinline__ unsigned f2bf(float f) { unsigned u = __builtin_bit_cast(unsigned, f); return (u + 0x7fffu + ((u >> 16) & 1u)) >> 16; }
typedef float f32x2p __attribute__((ext_vector_type(2)));
typedef __bf16 bf16x2p __attribute__((ext_vector_type(2)));
__device__ __forceinline__ unsigned pk2(float lo, float hi) { f32x2p v = {lo, hi}; return __builtin_bit_cast(unsigned, __builtin_convertvector(v, bf16x2p)); }
__device__ __forceinline__ f32x4 bf4_f32(v2u w) { return (f32x4){__builtin_bit_cast(float, w.x << 16), __builtin_bit_cast(float, w.x & 0xffff0000u), __builtin_bit_cast(float, w.y << 16), __builtin_bit_cast(float, w.y & 0xffff0000u)}; }
__device__ __forceinline__ v2u f32_bf4(f32x4 v) { v2u w; w.x = pk2(v.x, v.y); w.y = pk2(v.z, v.w); return w; }
__device__ __forceinline__ float bf2f(bf16 b) { return __builtin_bit_cast(float, (unsigned)b << 16); }
template <int CTRL> __device__ __forceinline__ float dpp_f(float v) { return __builtin_bit_cast(float, __builtin_amdgcn_mov_dpp(__builtin_bit_cast(int, v), CTRL, 0xf, 0xf, true)); }
__device__ __forceinline__ float xor1_f(float v) { return dpp_f<0xB1>(v); }
__device__ __forceinline__ float xor2_f(float v) { return dpp_f<0x4E>(v); }
__device__ __forceinline__ float xor16_f(float v) { return __builtin_bit_cast(float, __builtin_amdgcn_ds_swizzle(__builtin_bit_cast(int, v), 0x401F)); }
__device__ __forceinline__ float xor32_f(float v) { auto rr = __builtin_amdgcn_permlane32_swap(__builtin_bit_cast(unsigned, v), __builtin_bit_cast(unsigned, v), false, false);
    return __builtin_bit_cast(float, (unsigned)rr[0]) == v ? __builtin_bit_cast(float, (unsigned)rr[1]) : __builtin_bit_cast(float, (unsigned)rr[0]); }
__device__ __forceinline__ float sum32_f(float v) { auto rr = __builtin_amdgcn_permlane32_swap(__builtin_bit_cast(unsigned, v), __builtin_bit_cast(unsigned, v), false, false);
    return __builtin_bit_cast(float, (unsigned)rr[0]) + __builtin_bit_cast(float, (unsigned)rr[1]); }
__device__ __forceinline__ float wave_sum(float v) {
    v += xor1_f(v); v += xor2_f(v); v += dpp_f<0x141>(v)  ; v += dpp_f<0x140>(v)  ; v += xor16_f(v);
    auto rr = __builtin_amdgcn_permlane32_swap(__builtin_bit_cast(unsigned, v), __builtin_bit_cast(unsigned, v), false, false);
    return __builtin_bit_cast(float, (unsigned)rr[0]) + __builtin_bit_cast(float, (unsigned)rr[1]);
}
__device__ __forceinline__ float sin_rev(float r) { return __builtin_amdgcn_sinf(__builtin_amdgcn_fractf(r)); }
__device__ __forceinline__ float cos_rev(float r) { return __builtin_amdgcn_cosf(__builtin_amdgcn_fractf(r)); }
__device__ __forceinline__ float sin_rad(float x) { return sin_rev(x * 0.15915494309189535f); }
__device__ __forceinline__ int fresh_tid() { int t = threadIdx.x; asm volatile("" : "+v"(t)); return t; }
template <class T> __device__ __forceinline__ T* fresh_ptr(T* p) { asm volatile("" : "+s"(p)); return p; }
#define LDS_WAIT() asm volatile("s_waitcnt lgkmcnt(0)" ::: "memory")
#define VM_WAIT() asm volatile("s_waitcnt vmcnt(0)" ::: "memory")

namespace pg8 {
typedef unsigned short bf16_t;
typedef unsigned u32x4 __attribute__((ext_vector_type(4)));
constexpr int BM = 256, BK = 64, HALF = 128, HTB = HALF * BK * 2, STAGE_BYTES = 8 * HTB, NXCD = 8, WGM = 8;
__host__ __device__ __forceinline__ int lds_byte(int r, int c) { const int st = (r >> 4) * 2 + (c >> 5), rr = r & 15, cc = c & 31, ob = rr * 64 + cc * 2; return st * 1024 + (ob ^ (((ob >> 9) & 1) << 5)); }
__host__ __device__ __forceinline__ void stage_rc(int b, int& R, int& C) { const int st = b / 1024, sb = b % 1024, swz = sb ^ (((sb >> 9) & 1) << 5); R = (st >> 1) * 16 + swz / 64; C = (st & 1) * 32 + (swz % 64) / 2; }
__host__ __device__ __forceinline__ int perm32(int rho) { const int n = rho >> 4, i = rho & 15; return 8 * (i >> 2) + 4 * n + (i & 3); }
struct Unit { int pm, pn, ko, nt, sl; };
struct Gemm { const bf16_t* A; const bf16_t* Bt; int M, N, K; };
struct StaticOrder {
    int nM, nN, nwg, G, c;
    int ntk;
    __host__ __device__ void init(int M, int N, int K, int G_, int c_) { nM = M / BM; nN = N / BM; nwg = nM * nN; G = G_; c = c_; ntk = K / BK; }
    __host__ __device__ __forceinline__ bool next(int i, Unit& u) const { return map((long)i * G + c, u); }
    __host__ __device__ __forceinline__ bool map(long L, Unit& u) const {
        if (L >= nwg) return false; u.ko = 0; u.nt = ntk; u.sl = -1;
        int wgid = (int)L; { const int q = nwg / NXCD, r = nwg % NXCD, xcd = wgid % NXCD, off = wgid / NXCD; wgid = (xcd < r ? xcd * (q + 1) : r * (q + 1) + (xcd - r) * q) + off; }
        const int nig = WGM * nN, gid = wgid / nig, fm = gid * WGM, gsz = (nM - fm) < WGM ? (nM - fm) : WGM;
        u.pm = fm + ((wgid % nig) % gsz); u.pn = (wgid % nig) / gsz; return true;
    }
    __device__ __forceinline__ void a_ready(const Unit&) const {}
    __device__ __forceinline__ void done(const Unit&) const {}
    __device__ __forceinline__ int arow(const Unit& u, int r) const { return u.pm * BM + r; }
};
__device__ __forceinline__ unsigned cvt_pk_bf16(float lo, float hi) { unsigned r; asm volatile("v_cvt_pk_bf16_f32 %0, %1, %2" : "=v"(r) : "v"(lo), "v"(hi)); return r; }

template <class Epi, class Sched, bool ALIGN_EPI = false, bool SP2 = false, bool GATHER = false>
__device__ __forceinline__ void gemm_phase(LAS unsigned char* lds, const Gemm g, const Sched& S, const Epi& E) {
    const int tid = fresh_tid(), wid = __builtin_amdgcn_readfirstlane(tid >> 6), lane = tid & 63, wr = wid >> 2, wc = wid & 3, fr = lane & 15, fq = lane >> 4;
    const int K = g.K;
    unsigned voffA[2], voffB[2];
#pragma unroll
    for (int i = 0; i < 2; ++i) { int R, C; stage_rc(tid * 16 + i * 8192, R, C); const int Rb = Epi::PERM ? ((R & ~31) + perm32(R & 31)) : R;
        voffA[i] = (unsigned)(R * K + C) * 2u; voffB[i] = (unsigned)(Rb * K + C) * 2u; }
    const size_t kstep = (size_t)(BK * 2);
    const size_t hstep = (size_t)HALF * K * 2;
    const size_t tstep = 2 * hstep;
    const unsigned ldsw = (unsigned)wid * 1024u;
    const int aoff = lds_byte(wr * 64 + fr, fq * 8), boff = lds_byte(wc * 32 + fr, fq * 8);
#define PG8_SA(b, h) (((b) * 2 + (h)) * HTB)
#define PG8_SB(b, h) ((4 + (b) * 2 + (h)) * HTB)
#define PG8_STAGE(bufoff, gbase, voff) do { _Pragma("unroll") for (int _i = 0; _i < 2; ++_i) \
        __builtin_amdgcn_global_load_lds((const unsigned*)((const char*)(gbase) + (voff)[_i]), (LAS unsigned*)(lds + (bufoff) + ldsw + _i * 8192), 16, 0, 0); } while (0)
#define PG8_STA(b, h, base, GO) do { if constexpr (GATHER) PG8_STAGE(PG8_SA(b, h), base, GO[h]); else PG8_STAGE(PG8_SA(b, h), (base) + (h) * hstep, voffA); } while (0)
#define PG8_LDA(dst, b, h) do { _Pragma("unroll") for (int m = 0; m < 4; ++m) _Pragma("unroll") for (int k = 0; k < 2; ++k) dst[m][k] = *(const LAS bf16x8*)(lds + PG8_SA(b, h) + aoff + m * 2048 + k * 1024); } while (0)
#define PG8_LDB(dst, b, h) do { _Pragma("unroll") for (int n = 0; n < 2; ++n) _Pragma("unroll") for (int k = 0; k < 2; ++k) dst[n][k] = *(const LAS bf16x8*)(lds + PG8_SB(b, h) + boff + n * 2048 + k * 1024); } while (0)
#define PG8_MMA(ai, bj, At, Bt) do { __builtin_amdgcn_s_setprio(1); _Pragma("unroll") for (int m = 0; m < 4; ++m) _Pragma("unroll") for (int n = 0; n < 2; ++n) _Pragma("unroll") for (int k = 0; k < 2; ++k) \
        acc[ai][bj][m][n] = __builtin_amdgcn_mfma_f32_16x16x32_bf16(Bt[n][k], At[m][k], acc[ai][bj][m][n], 0, 0, 0); __builtin_amdgcn_s_setprio(0); } while (0)
#define PG8_WAIT_V(n) asm volatile("s_waitcnt vmcnt(" #n ")" ::: "memory")
#define PG8_WAIT_L(n) asm volatile("s_waitcnt lgkmcnt(" #n ")" ::: "memory")
#define PG8_BAR __builtin_amdgcn_s_barrier()
#define PG8_SCHED __builtin_amdgcn_sched_barrier(0)
    Unit cur, nxt; int ui = 0;
    if (!S.next(0, cur)) return;
    f32x4 acc[2][2][4][2];
#pragma unroll
    for (int a = 0; a < 2; ++a)
#pragma unroll
        for (int b = 0; b < 2; ++b)
#pragma unroll
            for (int m = 0; m < 4; ++m)
#pragma unroll
                for (int n = 0; n < 2; ++n) acc[a][b][m][n] = (f32x4){0.f, 0.f, 0.f, 0.f};
    bf16x8 At[4][2], B0[2][2], B1[2][2];
    unsigned gc[2][2], gn[2][2], g2[2][2];
    auto set_goff = [&](const Unit& u, unsigned (&go)[2][2]) {
#pragma unroll
        for (int h = 0; h < 2; ++h)
#pragma unroll
            for (int i = 0; i < 2; ++i) { int R, C; stage_rc(tid * 16 + i * 8192, R, C); go[h][i] = (unsigned)(S.arow(u, 128 * h + R) * K + C) * 2u; } };
    if constexpr (GATHER) set_goff(cur, gc);
    const char* cA = (const char*)g.A + (GATHER ? (size_t)0 : (size_t)cur.pm * tstep) + (size_t)cur.ko * 2; const char* cB = (const char*)g.Bt + (size_t)cur.pn * tstep + (size_t)cur.ko * 2;
    S.a_ready(cur);
    if constexpr (SP2) {
        PG8_STAGE(PG8_SB(0, 0), cB, voffB); PG8_STAGE(PG8_SB(0, 1), cB + hstep, voffB); PG8_STA(0, 0, cA, gc); PG8_STA(0, 1, cA, gc);
        if (wr == 1) PG8_BAR;
        PG8_WAIT_V(2); PG8_BAR;
        PG8_STAGE(PG8_SB(1, 0), cB + kstep, voffB); PG8_STA(1, 0, cA + kstep, gc); PG8_STAGE(PG8_SB(1, 1), cB + hstep + kstep, voffB);
        PG8_WAIT_V(6); PG8_BAR;
    } else {
        PG8_STAGE(PG8_SB(0, 0), cB, voffB); PG8_STAGE(PG8_SA(0, 0), cA, voffA); PG8_STAGE(PG8_SB(0, 1), cB + hstep, voffB); PG8_STAGE(PG8_SA(0, 1), cA + hstep, voffA);
        if (wr == 1) PG8_BAR;
        PG8_WAIT_V(4); PG8_BAR;
        PG8_STAGE(PG8_SB(1, 0), cB + kstep, voffB); PG8_STAGE(PG8_SA(1, 0), cA + kstep, voffA); PG8_STAGE(PG8_SB(1, 1), cB + hstep + kstep, voffB);
        PG8_WAIT_V(6); PG8_BAR;
    }
    for (;;) {
        const bool has_next = S.next(ui + 1, nxt);
        if constexpr (GATHER) {
#pragma unroll
            for (int h = 0; h < 2; ++h) { gn[h][0] = gc[h][0]; gn[h][1] = gc[h][1]; } }
        const char* nA = has_next ? (const char*)g.A + (GATHER ? (size_t)0 : (size_t)nxt.pm * tstep) + (size_t)nxt.ko * 2 : cA; const char* nB = has_next ? (const char*)g.Bt + (size_t)nxt.pn * tstep + (size_t)nxt.ko * 2 : cB;
        const int nt = cur.nt;
        for (int t = 0; t < nt; t += 2) {
            const bool last = (t == nt - 2);
            const char* a1 = cA + (size_t)(t + 1) * kstep;
            const char* a2 = last ? nA : cA + (size_t)(t + 2) * kstep; const char* b2 = last ? nB : cB + (size_t)(t + 2) * kstep;
            const char* a3 = a2 + kstep; const char* b3 = b2 + kstep;
            if (last && has_next) S.a_ready(nxt);
            if constexpr (GATHER) { if (t == 4 && has_next) set_goff(nxt, gn); }
            if constexpr (GATHER) {
#pragma unroll
                for (int h = 0; h < 2; ++h) { g2[h][0] = last ? gn[h][0] : gc[h][0]; g2[h][1] = last ? gn[h][1] : gc[h][1]; } }
            if constexpr (SP2) {
            PG8_LDB(B0, 0, 0); PG8_LDB(B1, 0, 1); PG8_SCHED; PG8_LDA(At, 0, 0); PG8_STA(1, 1, a1, gc);
            PG8_WAIT_V(8); PG8_WAIT_L(0); PG8_BAR; PG8_MMA(0, 0, At, B0); PG8_MMA(0, 1, At, B1); PG8_BAR; PG8_SCHED;
            PG8_LDA(At, 0, 1); PG8_STAGE(PG8_SB(0, 0), b2, voffB); PG8_STAGE(PG8_SB(0, 1), b2 + hstep, voffB); PG8_STA(0, 0, a2, g2);
            PG8_WAIT_V(8); PG8_WAIT_L(0); PG8_BAR; PG8_MMA(1, 0, At, B0); PG8_MMA(1, 1, At, B1); PG8_BAR; PG8_SCHED;
            PG8_LDB(B0, 1, 0); PG8_LDB(B1, 1, 1); PG8_SCHED; PG8_LDA(At, 1, 0); PG8_STA(0, 1, a2, g2);
            PG8_WAIT_V(8); PG8_WAIT_L(0); PG8_BAR; PG8_MMA(0, 0, At, B0); PG8_MMA(0, 1, At, B1); PG8_BAR; PG8_SCHED;
            PG8_LDA(At, 1, 1); PG8_STAGE(PG8_SB(1, 0), b3, voffB); PG8_STAGE(PG8_SB(1, 1), b3 + hstep, voffB); PG8_STA(1, 0, a3, g2);
            PG8_WAIT_V(8); PG8_WAIT_L(0); PG8_BAR; PG8_MMA(1, 0, At, B0); PG8_MMA(1, 1, At, B1); PG8_BAR; PG8_SCHED;
            } else {
            PG8_LDB(B0, 0, 0); PG8_SCHED; PG8_LDA(At, 0, 0); PG8_STAGE(PG8_SA(1, 1), a1 + hstep, voffA);
            PG8_WAIT_L(8); PG8_BAR; PG8_WAIT_L(0); PG8_MMA(0, 0, At, B0); PG8_BAR; PG8_SCHED;
            PG8_LDB(B1, 0, 1); PG8_STAGE(PG8_SB(0, 0), b2, voffB);
            PG8_BAR; PG8_WAIT_L(0); PG8_MMA(0, 1, At, B1); PG8_BAR;
            PG8_LDA(At, 0, 1); PG8_STAGE(PG8_SA(0, 0), a2, voffA);
            PG8_BAR; PG8_WAIT_L(0); PG8_MMA(1, 0, At, B0); PG8_BAR; PG8_SCHED;
            PG8_STAGE(PG8_SB(0, 1), b2 + hstep, voffB);
            PG8_WAIT_V(6); PG8_BAR; PG8_MMA(1, 1, At, B1); PG8_BAR;
            PG8_LDB(B0, 1, 0); PG8_SCHED; PG8_LDA(At, 1, 0); PG8_STAGE(PG8_SA(0, 1), a2 + hstep, voffA);
            PG8_WAIT_L(8); PG8_BAR; PG8_WAIT_L(0); PG8_MMA(0, 0, At, B0); PG8_BAR; PG8_SCHED;
            PG8_LDB(B1, 1, 1); PG8_STAGE(PG8_SB(1, 0), b3, voffB);
            PG8_BAR; PG8_WAIT_L(0); PG8_MMA(0, 1, At, B1); PG8_BAR;
            PG8_LDA(At, 1, 1); PG8_STAGE(PG8_SA(1, 0), a3, voffA);
            PG8_BAR; PG8_WAIT_L(0); PG8_MMA(1, 0, At, B0); PG8_BAR; PG8_SCHED;
            PG8_STAGE(PG8_SB(1, 1), b3 + hstep, voffB);
            PG8_WAIT_V(6); PG8_BAR; PG8_MMA(1, 1, At, B1); PG8_BAR;
            }
        }
        if constexpr (ALIGN_EPI) { if (wr == 0) PG8_BAR; }
        E(acc, cur, wr, wc, fr, fq); S.done(cur);
        if (!has_next) break;
#pragma unroll
        for (int a = 0; a < 2; ++a)
#pragma unroll
            for (int b = 0; b < 2; ++b)
#pragma unroll
                for (int m = 0; m < 4; ++m)
#pragma unroll
                    for (int n = 0; n < 2; ++n) acc[a][b][m][n] = (f32x4){0.f, 0.f, 0.f, 0.f};
        cur = nxt; cA = nA; cB = nB; ++ui;
        if constexpr (GATHER) {
#pragma unroll
            for (int h = 0; h < 2; ++h) { gc[h][0] = gn[h][0]; gc[h][1] = gn[h][1]; } }
        if constexpr (ALIGN_EPI) { if (wr == 1) PG8_BAR; }
    }
    PG8_WAIT_V(0);
    if constexpr (!ALIGN_EPI) { if (wr == 0) PG8_BAR; }
    PG8_BAR;
#undef PG8_SA
#undef PG8_SB
#undef PG8_STAGE
#undef PG8_STA
#undef PG8_LDA
#undef PG8_LDB
#undef PG8_MMA
#undef PG8_WAIT_V
#undef PG8_WAIT_L
#undef PG8_BAR
#undef PG8_SCHED
}
}

#define XB_TMO      128
#define XB_XCNT(j)  (256  + 64 * (j))
#define XB_XSUB(j)  (1280 + 64 * (j))
#define XB_XGEN(j)  (2304 + 64 * (j))
#define XB_TOP      3328
#define XB_TOPGEN   3392
#define XCD_BAR_WORDS 3456
#define XB_SPIN_CAP (1u << 18)
__device__ __forceinline__ unsigned xb_ld(unsigned* p)              { return __hip_atomic_load(p, __ATOMIC_RELAXED, __HIP_MEMORY_SCOPE_AGENT); }
__device__ __forceinline__ unsigned xb_add(unsigned* p, unsigned v) { return __hip_atomic_fetch_add(p, v, __ATOMIC_RELAXED, __HIP_MEMORY_SCOPE_AGENT); }
__device__ __forceinline__ unsigned xb_xcc_id() { return (unsigned)__builtin_amdgcn_s_getreg((3 << 11) | 20) & 0xFu; }
#define XB_SPIN(cond, bar) do { unsigned _sp = 0; while (cond) { __builtin_amdgcn_s_sleep(1); \
    if ((++_sp & 255u) == 0u) { if (xb_ld(&(bar)[XB_TMO])) break; if (_sp > XB_SPIN_CAP) { atomicAdd(&(bar)[XB_TMO], 1u); break; } } } } while (0)
struct XcdBarrier { unsigned* bar; unsigned x; volatile LAS unsigned* st; };
__device__ __forceinline__ XcdBarrier xcd_barrier_post(unsigned* bar, volatile LAS unsigned* st) {
    XcdBarrier b; b.bar = bar; b.x = xb_xcc_id(); b.st = st;
    if (threadIdx.x == 0) (void)xb_add(&bar[XB_XCNT(b.x)], 1u);
    return b;
}
__device__ __forceinline__ void xcd_barrier_complete(unsigned* bar, unsigned x, unsigned& nloc, unsigned& nx) {
    const unsigned G = gridDim.x * gridDim.y * gridDim.z;
    unsigned sum, cnt, mine, sp = 0u;
    for (;;) {
        sum = 0u; cnt = 0u; mine = 0u;
#pragma unroll
        for (unsigned j = 0; j < 16; ++j) { const unsigned c = xb_ld(&bar[XB_XCNT(j)]); sum += c; cnt += (c > 0u) ? 1u : 0u; mine = (j == x) ? c : mine; }
        if (sum == G) break;
        __builtin_amdgcn_s_sleep(1);
        if ((++sp & 255u) == 0u) { if (xb_ld(&bar[XB_TMO])) break; if (sp > XB_SPIN_CAP) { atomicAdd(&bar[XB_TMO], 1u); break; } }
    }
    nloc = mine > 0u ? mine : 1u; nx = cnt > 0u ? cnt : 1u;
}
__device__ __forceinline__ void xcd_barrier(const XcdBarrier& b) {
    asm volatile("s_waitcnt vmcnt(0)" ::: "memory");
    __syncthreads();
    if (threadIdx.x == 0) {
        unsigned* bar = b.bar;
        __builtin_amdgcn_s_waitcnt(0);
        unsigned nloc = b.st[0], nx = b.st[1];
        if (nloc == 0u) { xcd_barrier_complete(bar, b.x, nloc, nx); b.st[0] = nloc; b.st[1] = nx; }
        const unsigned old = xb_add(&bar[XB_XSUB(b.x)], 1u);
        const unsigned gen = old / nloc;
        if (old + 1u == (gen + 1u) * nloc) {
            __builtin_amdgcn_fence(__ATOMIC_RELEASE, "agent");
            asm volatile("s_waitcnt vmcnt(0)" ::: "memory");
            const unsigned og = xb_add(&bar[XB_TOP], 1u);
            const unsigned tg = og / nx;
            if (og + 1u == (tg + 1u) * nx) xb_add(&bar[XB_TOPGEN], 1u);
            else XB_SPIN(xb_ld(&bar[XB_TOPGEN]) == tg, bar);
            __builtin_amdgcn_fence(__ATOMIC_ACQUIRE, "agent");
            xb_add(&bar[XB_XGEN(b.x)], 1u);
            asm volatile("s_waitcnt vmcnt(0)" ::: "memory");
        } else {
            XB_SPIN(xb_ld(&bar[XB_XGEN(b.x)]) == gen, bar);
            __builtin_amdgcn_fence(__ATOMIC_ACQUIRE, "agent");
            asm volatile("s_waitcnt vmcnt(0)" ::: "memory");
        }
    }
    __syncthreads();
}

__device__ __forceinline__ const float* xrow_in(int R, const float* xlat, const float* hctx) {
    const int b = R / RB, rr = R - b * RB;
    return rr < CTXL ? hctx + (size_t)(b * CTXL + rr) * DM : xlat + (size_t)(b * SEQ + rr - CTXL) * DM;
}
__device__ __forceinline__ float* xrow_out(int R, float* xlat, float* hctx) {
    const int b = R / RB, rr = R - b * RB;
    return rr < CTXL ? hctx + (size_t)(b * CTXL + rr) * DM : xlat + (size_t)(b * SEQ + rr - CTXL) * DM;
}
__device__ __forceinline__ int row_set(int R) { const int b = R / RB, rr = R - b * RB; return rr < CTXL ? 2 : b; }

__device__ __forceinline__ int qk_perm(int c) {
    const int bj = c >> 7, wc = (c >> 5) & 3, fq = (c >> 3) & 3, n = (c >> 2) & 1, j = c & 3;
    return 64 * wc + 32 * (fq >> 1) + 16 * bj + 8 * (fq & 1) + 4 * n + j;
}
struct EpiIn {
    static constexpr bool PERM = true;
    bf16* Z; bf16* ZT; bf16* ZTC; const float* ropec; const float* ropes; const float* qkg;
    __device__ __forceinline__ void operator()(const f32x4 (&acc)[2][2][4][2], const pg8::Unit& u, int wr, int wc, int fr, int fq) const {
        const int b = u.pm / TPB, jt = u.pm - b * TPB; const bool isctx = (jt == 0);
        if (u.pn == 0 || u.pn >= 8) {
#pragma unroll
            for (int ai = 0; ai < 2; ++ai)
#pragma unroll
                for (int m = 0; m < 4; ++m) { const int r = 128 * ai + 64 * wr + 16 * m + fr; bf16* rowp = Z + (size_t)(u.pm * 256 + r) * INW + u.pn * 256 + 32 * wc + 8 * fq;
#pragma unroll
                    for (int bj = 0; bj < 2; ++bj) { const f32x4 v0 = acc[ai][bj][m][0], v1 = acc[ai][bj][m][1];
                        v4u w; w.x = pg8::cvt_pk_bf16(v0[0], v0[1]); w.y = pg8::cvt_pk_bf16(v0[2], v0[3]); w.z = pg8::cvt_pk_bf16(v1[0], v1[1]); w.w = pg8::cvt_pk_bf16(v1[2], v1[3]);
                        *(v4u*)(rowp + bj * 128) = w; } }
        } else if (u.pn <= 3) {
            bf16* base = isctx ? ZTC + (size_t)b * 768 * CTXL : ZT + (size_t)b * 768 * SEQ + (size_t)(jt - 1) * 256;
            const size_t cstride = isctx ? CTXL : SEQ;
#pragma unroll
            for (int bj = 0; bj < 2; ++bj)
#pragma unroll
                for (int n = 0; n < 2; ++n)
#pragma unroll
                    for (int j = 0; j < 4; ++j) { const int ch = 256 * (u.pn - 1) + 128 * bj + 32 * wc + 8 * fq + 4 * n + j; bf16* cp = base + (size_t)ch * cstride;
#pragma unroll
                        for (int ai = 0; ai < 2; ++ai)
#pragma unroll
                            for (int m = 0; m < 4; ++m) { const int r = 128 * ai + 64 * wr + 16 * m + fr; cp[r] = (bf16)f2bf(acc[ai][bj][m][n][j]); } }
        } else {
            const int which = (u.pn >= 6) ? 1 : 0; const float osc = which ? 1.0f : C2;
            const int axis = fq >> 1, f0 = 8 * (fq & 1);
            float ga[2][4], gb[2][4];
#pragma unroll
            for (int n = 0; n < 2; ++n)
#pragma unroll
                for (int j = 0; j < 4; ++j) { ga[n][j] = qkg[which * 64 + 32 * axis + f0 + 4 * n + j]; gb[n][j] = qkg[which * 64 + 32 * axis + 16 + f0 + 4 * n + j]; }
#pragma unroll
            for (int ai = 0; ai < 2; ++ai)
#pragma unroll
                for (int m = 0; m < 4; ++m) {
                    const int r = 128 * ai + 64 * wr + 16 * m + fr;
                    float ss = 0.f;
#pragma unroll
                    for (int bj = 0; bj < 2; ++bj)
#pragma unroll
                        for (int n = 0; n < 2; ++n) { const f32x4 x = acc[ai][bj][m][n]; ss += (x[0] * x[0] + x[1] * x[1]) + (x[2] * x[2] + x[3] * x[3]); }
                    ss += xor16_f(ss); ss = sum32_f(ss);
                    const float rinv = __builtin_amdgcn_rsqf(ss * (1.0f / 64.0f) + 1e-6f);
                    f32x4 cv[2], sv[2];
                    if (!isctx) { const int t = (jt - 1) * 256 + r; const int pos = axis ? (t & 63) : (t >> 6);
                        cv[0] = *(const f32x4*)(ropec + pos * 16 + f0); cv[1] = *(const f32x4*)(ropec + pos * 16 + f0 + 4);
                        sv[0] = *(const f32x4*)(ropes + pos * 16 + f0); sv[1] = *(const f32x4*)(ropes + pos * 16 + f0 + 4); }
                    else { cv[0] = cv[1] = (f32x4){1.f, 1.f, 1.f, 1.f}; sv[0] = sv[1] = (f32x4){0.f, 0.f, 0.f, 0.f}; }
                    float oa[8], ob[8];
#pragma unroll
                    for (int n = 0; n < 2; ++n)
#pragma unroll
                        for (int j = 0; j < 4; ++j) { const float a = acc[ai][0][m][n][j] * rinv * ga[n][j], bb = acc[ai][1][m][n][j] * rinv * gb[n][j];
                            oa[4 * n + j] = (a * cv[n][j] - bb * sv[n][j]) * osc; ob[4 * n + j] = (bb * cv[n][j] + a * sv[n][j]) * osc; }
                    bf16* rowp = Z + (size_t)(u.pm * 256 + r) * INW + u.pn * 256 + 64 * wc + 32 * axis + f0;
                    v4u w; w.x = pg8::cvt_pk_bf16(oa[0], oa[1]); w.y = pg8::cvt_pk_bf16(oa[2], oa[3]); w.z = pg8::cvt_pk_bf16(oa[4], oa[5]); w.w = pg8::cvt_pk_bf16(oa[6], oa[7]);
                    *(v4u*)(rowp) = w;
                    w.x = pg8::cvt_pk_bf16(ob[0], ob[1]); w.y = pg8::cvt_pk_bf16(ob[2], ob[3]); w.z = pg8::cvt_pk_bf16(ob[4], ob[5]); w.w = pg8::cvt_pk_bf16(ob[6], ob[7]);
                    *(v4u*)(rowp + 16) = w;
                }
        }
    }
};
struct EpiRes {
    static constexpr bool PERM = false;
    bf16* xb; const float* gate; int ntk_full; float* slab; float gsc;
    __device__ __forceinline__ void operator()(const f32x4 (&acc)[2][2][4][2], const pg8::Unit& u, int wr, int wc, int fr, int fq) const {
        const int b = u.pm / TPB, jt = u.pm - b * TPB; const bool isctx = (jt == 0); const int set = isctx ? 2 : b;
        const int col0 = u.pn * 256 + wc * 32 + 4 * fq;
        f32x4 gv[2][2];
#pragma unroll
        for (int bj = 0; bj < 2; ++bj)
#pragma unroll
            for (int n = 0; n < 2; ++n) gv[bj][n] = *(const f32x4*)(gate + set * 6144 + col0 + bj * 128 + n * 16) * gsc;
        if (u.nt == ntk_full) {
            GAS char* xt = (GAS char*)(xb + (size_t)u.pm * 256 * DM);
            const unsigned lo = (unsigned)((64 * wr + fr) * DM + col0) * 2u;
#pragma unroll
            for (int ai = 0; ai < 2; ++ai) {
                v2u xi[4][2][2];
#pragma unroll
                for (int m = 0; m < 4; ++m)
#pragma unroll
                    for (int bj = 0; bj < 2; ++bj)
#pragma unroll
                        for (int n = 0; n < 2; ++n) xi[m][bj][n] = *(const GAS v2u*)(xt + lo + (unsigned)(128 * ai + 16 * m) * DM * 2u + (bj * 128 + n * 16) * 2);
#pragma unroll
                for (int m = 0; m < 4; ++m)
#pragma unroll
                    for (int bj = 0; bj < 2; ++bj)
#pragma unroll
                        for (int n = 0; n < 2; ++n) *(GAS v2u*)(xt + lo + (unsigned)(128 * ai + 16 * m) * DM * 2u + (bj * 128 + n * 16) * 2) = f32_bf4(bf4_f32(xi[m][bj][n]) + gv[bj][n] * acc[ai][bj][m][n]);
                asm volatile("" ::: "memory"); }
        } else {
            int fr_ = fr; asm volatile("" : "+v"(fr_));
            GAS float* sp = (GAS float*)(slab + (size_t)u.sl * 65536) + (unsigned)((64 * wr + fr_) * 256 + wc * 32 + 4 * fq);
#pragma unroll
            for (int ai = 0; ai < 2; ++ai)
#pragma unroll
                for (int m = 0; m < 4; ++m)
#pragma unroll
                    for (int bj = 0; bj < 2; ++bj)
#pragma unroll
                        for (int n = 0; n < 2; ++n) *(GAS f32x4*)(sp + (128 * ai + 16 * m) * 256 + bj * 128 + n * 16) = gv[bj][n] * acc[ai][bj][m][n];
        }
    }
};
__device__ __forceinline__ float silu_mul(float g, float u) { return g * u * __builtin_amdgcn_rcpf(1.0f + __builtin_amdgcn_exp2f(-1.4426950408889634f * g)); }
struct EpiGlu {
    static constexpr bool PERM = true;
    bf16* H; int ldh; int NT;
    __device__ __forceinline__ void operator()(const f32x4 (&acc)[2][2][4][2], const pg8::Unit& u, int wr, int wc, int fr, int fq) const {
        const int nt = u.pn % NT;
#pragma unroll
        for (int ai = 0; ai < 2; ++ai)
#pragma unroll
            for (int m = 0; m < 4; ++m) { const int r = 128 * ai + 64 * wr + 16 * m + fr; bf16* rowp = H + (size_t)(u.pm * 256 + r) * ldh + nt * 128 + 32 * wc + 8 * fq;
                float o[8];
#pragma unroll
                for (int n = 0; n < 2; ++n)
#pragma unroll
                    for (int j = 0; j < 4; ++j) o[4 * n + j] = silu_mul(acc[ai][0][m][n][j], acc[ai][1][m][n][j]);
                v4u w; w.x = pg8::cvt_pk_bf16(o[0], o[1]); w.y = pg8::cvt_pk_bf16(o[2], o[3]); w.z = pg8::cvt_pk_bf16(o[4], o[5]); w.w = pg8::cvt_pk_bf16(o[6], o[7]);
                *(v4u*)rowp = w; }
    }
};
__device__ __forceinline__ void k_quarter(int ntk, int kq, int& ko, int& nt) {
    const int pairs = ntk >> 1; int start = 0, len = 0;
#pragma unroll
    for (int q = 0; q < 4; ++q) { const int l = (pairs + 3 - q) >> 2; if (q < kq) start += l; if (q == kq) len = l; }
    ko = start * 128; nt = len * 2;
}
struct SplitTailOrder {
    pg8::StaticOrder S; int nN, nmain;
    __device__ __forceinline__ void init(int N, int K, int G, int c) { S.init(NB * SEQ, N, K, G, c); nN = N / 256; nmain = (NB * SEQ / 256) * nN; }
    __device__ __forceinline__ bool next(int i, pg8::Unit& u) const {
        const long L = (long)i * S.G + S.c;
        if (L < nmain) { S.map(L, u); u.pm += 1 + (u.pm >= SEQ / 256 ? 1 : 0); return true; }
        const int Lt = (int)(L - nmain); if (Lt >= 2 * nN * 4) return false;
        const int kq = Lt & 3, r = Lt >> 2; u.pn = r % nN; u.pm = (r / nN) * TPB; k_quarter(S.ntk, kq, u.ko, u.nt); u.sl = ((r / nN) * 4 + u.pn) * 4 + kq; return true;
    }
    __device__ __forceinline__ void a_ready(const pg8::Unit&) const {}
    __device__ __forceinline__ int arow(const pg8::Unit& u, int r) const { return u.pm * 256 + r; }
    __device__ __forceinline__ void done(const pg8::Unit&) const {}
};
struct MoeOrder {
    int G, c, NT, tlo, nunits; const LAS int* tab; int ntk; const int* rtok;
    __device__ __forceinline__ bool next(int i, pg8::Unit& u) const {
        const int L = i * G + c; if (L >= nunits) return false;
        const int tau = tlo + L / NT, nt = L - (L / NT) * NT;
        int s = 0;
#pragma unroll
        for (int q = 1; q < 16; ++q) s += (tab[q] <= tau) ? 1 : 0;
        u.pm = tau; u.pn = (s & 7) * NT + nt; u.ko = 0; u.nt = ntk; u.sl = -1; return true;
    }
    __device__ __forceinline__ void a_ready(const pg8::Unit&) const {}
    __device__ __forceinline__ int arow(const pg8::Unit& u, int r) const { const int tau = u.pm; int s = 0;
#pragma unroll
        for (int q = 1; q < 16; ++q) s += (tab[q] <= tau) ? 1 : 0;
        const int idx0 = (tau - tab[s]) * 256, cnt = tab[32 + s], idx = idx0 + r; return rtok[(size_t)s * SEGCAP + (idx < cnt ? idx : idx0)]; }
    __device__ __forceinline__ void done(const pg8::Unit&) const {}
};
struct MoeDownOrder {
    int G, c, k, nmain, ntailu; const LAS int* tab;
    __device__ __forceinline__ void init(int G_, int c_, int k_, const LAS int* tab_) { G = G_; c = c_; k = k_; tab = tab_; nmain = (tab[64 + 8 * k + 8] - tab[64 + 8 * k]) * 4; ntailu = tab[112 + k] * 16; }
    __device__ __forceinline__ bool next(int i, pg8::Unit& u) const {
        const int L = i * G + c;
        if (L < nmain) { const int mu = tab[64 + 8 * k] + (L >> 2); int s = 0;
#pragma unroll
            for (int q = 1; q < 16; ++q) s += (tab[64 + q] <= mu) ? 1 : 0;
            u.pm = tab[s] + (mu - tab[64 + s]); u.pn = (s & 7) * 4 + (L & 3); u.ko = 0; u.nt = DFE / 64; u.sl = -1; return true; }
        const int Lt = L - nmain; if (Lt >= ntailu) return false;
        const int s = tab[96 + 8 * k + (Lt >> 4)]; u.pm = tab[s + 1] - 1; u.pn = (s & 7) * 4 + ((Lt >> 2) & 3); k_quarter(DFE / 64, Lt & 3, u.ko, u.nt); u.sl = 8 * 16 * k + Lt; return true;
    }
    __device__ __forceinline__ void a_ready(const pg8::Unit&) const {}
    __device__ __forceinline__ int arow(const pg8::Unit& u, int r) const { return u.pm * 256 + r; }
    __device__ __forceinline__ void done(const pg8::Unit&) const {}
};
struct EpiMoeDown {
    static constexpr bool PERM = false;
    bf16* xb; const float* gate; const int* rtok; const float* rgate; const LAS int* tab; float* slab; float gsc;
    __device__ __forceinline__ void operator()(const f32x4 (&acc)[2][2][4][2], const pg8::Unit& u, int wr, int wc, int fr, int fq) const {
        const int tau = u.pm; int s = 0;
#pragma unroll
        for (int q = 1; q < 16; ++q) s += (tab[q] <= tau) ? 1 : 0;
        const int idx0 = (tau - tab[s]) * 256, cnt = tab[32 + s];
        const int col0 = (u.pn & 3) * 256 + wc * 32 + 4 * fq;
        const bool full = (u.nt == DFE / 64);
        if (full) {
            int Rr[8]; float gt[8]; bool ok[8];
#pragma unroll
            for (int q = 0; q < 8; ++q) { const int idx = idx0 + 128 * (q >> 2) + 64 * wr + 16 * (q & 3) + fr; ok[q] = idx < cnt; const int ic = ok[q] ? idx : idx0;
                Rr[q] = rtok[(size_t)s * SEGCAP + ic]; gt[q] = rgate[(size_t)s * SEGCAP + ic] * gsc; }
#pragma unroll
            for (int rp = 0; rp < 4; ++rp) {
                f32x4 gv[2][2][2]; v2u xi[2][2][2]; bf16* xp[2];
#pragma unroll
                for (int j = 0; j < 2; ++j) { const int q = 2 * rp + j; xp[j] = xb + (size_t)Rr[q] * DM + col0; const float* gp = gate + row_set(Rr[q]) * 6144 + col0;
#pragma unroll
                    for (int bj = 0; bj < 2; ++bj)
#pragma unroll
                        for (int n = 0; n < 2; ++n) { gv[j][bj][n] = *(const f32x4*)(gp + bj * 128 + n * 16); xi[j][bj][n] = *(const v2u*)(xp[j] + bj * 128 + n * 16); } }
#pragma unroll
                for (int j = 0; j < 2; ++j) { const int q = 2 * rp + j;
                    if (ok[q]) {
#pragma unroll
                        for (int bj = 0; bj < 2; ++bj)
#pragma unroll
                            for (int n = 0; n < 2; ++n) *(v2u*)(xp[j] + bj * 128 + n * 16) = f32_bf4(bf4_f32(xi[j][bj][n]) + gv[j][bj][n] * gt[q] * acc[q >> 2][bj][q & 3][n]); } }
            }
        } else {
#pragma unroll
        for (int ai = 0; ai < 2; ++ai)
#pragma unroll
            for (int m = 0; m < 4; ++m) { const int idx = idx0 + 128 * ai + 64 * wr + 16 * m + fr;
                if (idx < cnt) { const int R = rtok[(size_t)s * SEGCAP + idx]; const float gt = rgate[(size_t)s * SEGCAP + idx] * gsc;
                    const float* gp = gate + row_set(R) * 6144 + col0;
#pragma unroll
                    for (int bj = 0; bj < 2; ++bj)
#pragma unroll
                        for (int n = 0; n < 2; ++n) { const f32x4 gv = *(const f32x4*)(gp + bj * 128 + n * 16); const f32x4 v = gv * gt * acc[ai][bj][m][n];
                            int fr_ = fr; asm volatile("" : "+v"(fr_));
                            *(GAS f32x4*)((GAS char*)(slab + (size_t)u.sl * 65536) + (unsigned)(((128 * ai + 64 * wr + 16 * m + fr_) * 256 + wc * 32 + 4 * fq + bj * 128 + n * 16) * 4)) = v; } } }
        }
    }
};

__device__ __forceinline__ void transpose_item(const float* colp  , int ldw, int K, bf16* WT, int kb, int n0, int lane) {
    const int hh = lane >> 5, m = lane & 31, k0 = 64 * kb + 32 * hh;
    f32x4 v[32];
#pragma unroll
    for (int i = 0; i < 32; ++i) v[i] = *(const f32x4*)(colp + (size_t)(k0 + i) * ldw);
    bf16* dp = WT + (size_t)(n0 + 4 * m) * K + k0;
#pragma unroll
    for (int jj = 0; jj < 4; ++jj)
#pragma unroll
        for (int h8 = 0; h8 < 4; ++h8) { v4u o; o.x = pk2(v[8 * h8][jj], v[8 * h8 + 1][jj]); o.y = pk2(v[8 * h8 + 2][jj], v[8 * h8 + 3][jj]); o.z = pk2(v[8 * h8 + 4][jj], v[8 * h8 + 5][jj]); o.w = pk2(v[8 * h8 + 6][jj], v[8 * h8 + 7][jj]);
            *(v4u*)(dp + (size_t)jj * K + 8 * h8) = o; }
}
__device__ __forceinline__ int src_in_col(int nd) { const int t = nd >> 8, c = nd & 255; return (t >= 4 && t <= 7) ? (t * 256 + qk_perm(c)) : nd; }

struct Args { const float* in[32]; float* out; unsigned char* ws; int ph_lo, ph_hi; };
constexpr int PTAB_OFF = MISC_OFF + 1024;
__device__ __forceinline__ const float* inptr(LAS unsigned char* lds, int k) {
    const LAS unsigned* p = (const LAS unsigned*)(lds + PTAB_OFF) + 2 * k;
    const unsigned lo = (unsigned)__builtin_amdgcn_readfirstlane((int)p[0]), hi = (unsigned)__builtin_amdgcn_readfirstlane((int)p[1]);
    return (const float*)(const GAS float*)(((unsigned long long)hi << 32) | lo);
}
#define AIN(k) inptr(lds, (k))

__device__ __forceinline__ float block_sum(float v, LAS float* red, int wave, int lane) {
    v = wave_sum(v);
    if (lane == 0) red[wave] = v;
    __syncthreads();
    float s = 0.f;
#pragma unroll
    for (int w = 0; w < NWAVES; ++w) s += red[w];
    __syncthreads();
    return s;
}

__device__ __forceinline__ void phase_prep_a(const Args& a, int li, LAS unsigned char* lds, int G, int bx) {
    const int tid = fresh_tid(), lane = tid & 63, wave = __builtin_amdgcn_readfirstlane(tid >> 6);
    const int gw = bx * NWAVES + wave, NGW = G * NWAVES;
    unsigned char* ws = fresh_ptr(a.ws);
    const bool moe = (li & 1) != 0; const int lj = li >> 1;
    {
        bf16* win_t = (bf16*)(ws + WS_WIN); bf16* wout_t = (bf16*)(ws + WS_WOUT); bf16* wup_t = (bf16*)(ws + WS_WUP); bf16* wdn_t = (bf16*)(ws + WS_WDN);
        const float* w_in = AIN(8) + (size_t)li * DM * INW; const float* w_out = AIN(9) + (size_t)li * DM * DM;
        constexpr int I_IN = 16 * 20, I_OUT = 16 * 8, I_UPD = 16 * 44, I_DND = 44 * 8, I_UPE = 16 * 56, I_DNE = 56 * 8;
        const int NIT = moe ? (I_IN + I_OUT + NEXP * (I_UPE + I_DNE)) : (I_IN + I_OUT + I_UPD + I_DND);
        const int m4 = 4 * (lane & 31);
        for (int it = gw; it < NIT; it += NGW) {
            int r = it;
            if (r < I_IN) { const int nb = r % 20; transpose_item(w_in + src_in_col(128 * nb + m4), INW, DM, win_t, r / 20, 128 * nb, lane); continue; } r -= I_IN;
            if (r < I_OUT) { const int nb = r % 8; transpose_item(w_out + 128 * nb + m4, DM, DM, wout_t, r / 8, 128 * nb, lane); continue; } r -= I_OUT;
            if (!moe) {
                if (r < I_UPD) { const int nb = r % 44; const float* W = (nb & 1) ? AIN(26) : AIN(25);
                    transpose_item(W + (size_t)lj * DM * DFF + (nb >> 1) * 128 + m4, DFF, DM, wup_t, r / 44, 128 * nb, lane); continue; } r -= I_UPD;
                { const int nb = r % 8; transpose_item(AIN(27) + (size_t)lj * DFF * DM + 128 * nb + m4, DM, DFF, wdn_t, r / 8, 128 * nb, lane); }
            } else {
                if (r < NEXP * I_UPE) { const int e = r / I_UPE, r2 = r % I_UPE, nb = r2 % 56; const size_t wo = (size_t)(lj * NEXP + e) * DM * DFE;
                    const float* W = (nb & 1) ? AIN(30) : AIN(29);
                    transpose_item(W + wo + (nb >> 1) * 128 + m4, DFE, DM, wup_t + (size_t)e * 2 * DFE * DM, r2 / 56, 128 * nb, lane); continue; } r -= NEXP * I_UPE;
                const int e = r / I_DNE, r2 = r % I_DNE, nb = r2 % 8;
                transpose_item(AIN(31) + (size_t)(lj * NEXP + e) * DFE * DM + 128 * nb + m4, DM, DFE, wdn_t + (size_t)e * DM * DFE, r2 / 8, 128 * nb, lane);
            }
        }
    }
    if (li == 0) for (int l = 0; l < DEPTH; ++l) {
        const float* w1 = AIN(14) + l * 33 * 64; const float* w2 = AIN(17) + l * 64 * 64;
        const float bb1 = AIN(15)[l * 64 + lane], ff1 = AIN(16)[l * 64 + lane], bb2 = AIN(18)[l * 64 + lane], ff2 = AIN(19)[l * 64 + lane];
        float w1c[33], w2c[64];
#pragma unroll
        for (int q = 0; q < 33; ++q) w1c[q] = w1[q * 64 + lane];
#pragma unroll
        for (int q = 0; q < 64; ++q) w2c[q] = w2[q * 64 + lane];
        bf16* H2B = (bf16*)(ws + WS_H2B) + (size_t)l * (SEQ + CTXL) * 64;
        for (int tt = gw; tt < SEQ + CTXL; tt += NGW) {
            const int L = tt < SEQ ? SEQ : CTXL, t = tt < SEQ ? tt : tt - SEQ;
            float feat = 0.f;
            if (lane == 0) feat = (float)t / (float)(L - 1);
            else if (lane <= 32) { const int jb = (lane - 1) & 15; const float rev = (float)((jb * t) & (L - 1)) / (float)L + 1e-4f * (1.0f - (float)jb * (1.0f / 15.0f)) * (float)t / (float)L;
                feat = lane <= 16 ? __builtin_amdgcn_cosf(__builtin_amdgcn_fractf(rev)) : -__builtin_amdgcn_sinf(__builtin_amdgcn_fractf(rev)); }
            float z1 = 0.f;
#pragma unroll
            for (int q = 0; q < 33; ++q) z1 += __builtin_bit_cast(float, __builtin_amdgcn_readlane(__builtin_bit_cast(int, feat), q)) * w1c[q];
            const float h1 = sin_rad(ff1 * (z1 + bb1));
            float z2 = 0.f;
#pragma unroll
            for (int q = 0; q < 64; ++q) z2 += __builtin_bit_cast(float, __builtin_amdgcn_readlane(__builtin_bit_cast(int, h1), q)) * w2c[q];
            H2B[(size_t)tt * 64 + lane] = (bf16)f2bf(sin_rad(ff2 * (z2 + bb2)));
        }
    }
    if (li == 0) {
        __syncthreads();
        LAS float* sv = (LAS float*)lds;
        for (int idx = tid; idx < 3 * DM; idx += NTHR) { const int s = idx >> 10, k = idx & 1023; const float v = s < 2 ? AIN(1)[s * DM + k] : AIN(3)[k];
            sv[idx] = v * __builtin_amdgcn_rcpf(1.0f + __builtin_amdgcn_exp2f(-1.4426950408889634f * v)); }
        __syncthreads();
        float* MODP = (float*)(ws + WS_MODP);
        for (int it = bx; it < 4 * 8 * 12; it += G) {
            const int l = it / 96, q = (it / 12) & 7, jc = it % 12, j = jc * 512 + tid;
            const float* wp = AIN(4) + ((size_t)l * DM + q * 128) * 6144 + j;
            float a0 = 0.f, a1 = 0.f, a2 = 0.f;
#pragma unroll 8
            for (int k = 0; k < 128; ++k) { const float w = wp[(size_t)k * 6144]; a0 += sv[q * 128 + k] * w; a1 += sv[DM + q * 128 + k] * w; a2 += sv[2 * DM + q * 128 + k] * w; }
            float* dp = MODP + (size_t)((q * 4 + l) * 3) * 6144 + j;
            dp[0] = a0; dp[6144] = a1; dp[2 * 6144] = a2;
        }
        const int gid = bx * NTHR + tid;
        if (gid < 4096) { const int pos = gid >> 4, f = gid & 15; const float inv = __builtin_amdgcn_exp2f(-(float)f * 0.83048202372184059f);
            const float rev = (float)pos * inv * 0.15915494309189535f; float* RT = (float*)(ws + WS_ROPE);
            RT[gid] = __builtin_amdgcn_cosf(__builtin_amdgcn_fractf(rev)); RT[4096 + gid] = __builtin_amdgcn_sinf(__builtin_amdgcn_fractf(rev)); }
        const f32x4* cs = (const f32x4*)AIN(2); f32x4* cd = (f32x4*)(ws + WS_HCTX);
        for (int idx = gid; idx < NB * CTXL * DM / 4; idx += G * NTHR) cd[idx] = cs[idx];
        __syncthreads();
    }
}

__device__ __forceinline__ int fidx(int i) { return i + (i >> 7); }
__device__ __forceinline__ void fft4_index(int b, int q, int& i, int& j) {
    if (q >= 64) { j = b & (q - 1); i = ((b & ~(q - 1)) << 2) + j; }
    else { const int rr = b & 127, qq = b >> 7; j = qq & (q - 1); i = rr * 128 + ((qq & ~(q - 1)) << 2) + j; }
}
__device__ __forceinline__ f32x2 cmulf(f32x2 a, f32x2 w) { return (f32x2){a.x * w.x - a.y * w.y, a.x * w.y + a.y * w.x}; }
__device__ __forceinline__ void fft_fwd(LAS f32x2* X, int tid) {
    for (int p = 0; p < 7; ++p) {
        const int h = 8192 >> (2 * p), q = h >> 1; const float inv2h = 0.5f / (float)h;
#pragma unroll 2
        for (int r = 0; r < 8; ++r) { int i, j; fft4_index(tid + NTHR * r, q, i, j);
            const float ang = (float)j * inv2h; const f32x2 w1 = {__builtin_amdgcn_cosf(ang), -__builtin_amdgcn_sinf(ang)}; const f32x2 w2 = cmulf(w1, w1);
            const int i0 = fidx(i), i1 = fidx(i + q), i2 = fidx(i + 2 * q), i3 = fidx(i + 3 * q);
            const f32x2 x0 = X[i0], x1 = X[i1], x2 = X[i2], x3 = X[i3];
            const f32x2 a0 = x0 + x2, a1 = x1 + x3, d02 = cmulf(x0 - x2, w1), t13 = cmulf(x1 - x3, w1); const f32x2 d13 = {t13.y, -t13.x};
            X[i0] = a0 + a1; X[i1] = cmulf(a0 - a1, w2); X[i2] = d02 + d13; X[i3] = cmulf(d02 - d13, w2); }
        __syncthreads();
    }
}
__device__ __forceinline__ void fft_inv(LAS f32x2* X, int tid) {
    for (int p = 6; p >= 0; --p) {
        const int h = 8192 >> (2 * p), q = h >> 1; const float inv2h = 0.5f / (float)h;
#pragma unroll 2
        for (int r = 0; r < 8; ++r) { int i, j; fft4_index(tid + NTHR * r, q, i, j);
            const float ang = (float)j * inv2h; const f32x2 w1 = {__builtin_amdgcn_cosf(ang), __builtin_amdgcn_sinf(ang)}; const f32x2 w2 = cmulf(w1, w1);
            const int i0 = fidx(i), i1 = fidx(i + q), i2 = fidx(i + 2 * q), i3 = fidx(i + 3 * q);
            const f32x2 b0 = X[i0], b1 = X[i1], b2 = X[i2], b3 = X[i3];
            const f32x2 t1 = cmulf(b1, w2), t3 = cmulf(b3, w2); const f32x2 a0 = b0 + t1, a1 = b0 - t1, a2 = b2 + t3, a3 = b2 - t3;
            const f32x2 u2 = cmulf(a2, w1), v3 = cmulf(a3, w1); const f32x2 u3 = {-v3.y, v3.x};
            X[i0] = a0 + u2; X[i2] = a0 - u2; X[i1] = a1 + u3; X[i3] = a1 - u3; }
        __syncthreads();
    }
}
__device__ __forceinline__ int brev14(int k) { return (int)(__builtin_bitreverse32((unsigned)k) >> 18); }
constexpr int FFT_AUX = 133120;

__device__ __forceinline__ void phase_prep_b(const Args& a, int li, LAS unsigned char* lds, int G, int bx) {
    const int tid = fresh_tid(), lane = tid & 63, wave = __builtin_amdgcn_readfirstlane(tid >> 6);
    unsigned char* ws = fresh_ptr(a.ws);
    if (li == 0) {
        const float* MODP = (const float*)(ws + WS_MODP); float* MOD = (float*)(ws + WS_MOD);
        for (int idx = bx * NTHR + tid; idx < 4 * 3 * 6144; idx += G * NTHR) { const int l = idx / 18432, j = idx % 6144; float s = AIN(5)[l * 6144 + j];
#pragma unroll
            for (int q = 0; q < 8; ++q) s += MODP[(size_t)q * 73728 + idx];
            MOD[idx] = s; }
    }
    LAS f32x2* X = (LAS f32x2*)lds; LAS float* Xf = (LAS float*)lds;
    LAS float* w3c = (LAS float*)(lds + FFT_AUX); LAS float* red = w3c + 128; LAS float* kc = (LAS float*)(lds + FFT_AUX + 1024);
    const bf16* H2 = (const bf16*)(ws + WS_H2B) + (size_t)li * (SEQ + CTXL) * 64; const bf16* H2C = H2 + (size_t)SEQ * 64;
    const float* w3 = AIN(20) + (size_t)li * 64 * 512;
    const float min_decay = 3.0701134573253945f, max_decay = 15.350567286626973f;
    for (int c0 = bx; c0 < 256; c0 += G) { const int c = G == 256 ? (((c0 & 7) << 5) | (c0 >> 3)) : c0;
        if (tid < 128) w3c[tid] = w3[(tid & 63) * 512 + (tid >> 6) * 256 + c];
        __syncthreads();
        const float delta = min_decay + (float)c * ((max_decay - min_decay) / 255.0f);
        float asum = 0.f;
#pragma unroll 2
        for (int r = 0; r < 32; ++r) { const int t = tid + NTHR * r; const v4u* hr = (const v4u*)(H2 + (size_t)t * 64);
            float df = 0.f, db = 0.f;
#pragma unroll
            for (int q = 0; q < 8; ++q) { const v4u hw = hr[q];
#pragma unroll
                for (int e = 0; e < 4; ++e) { const float h0 = __builtin_bit_cast(float, hw[e] << 16), h1 = __builtin_bit_cast(float, hw[e] & 0xffff0000u);
                    df += h0 * w3c[8 * q + 2 * e] + h1 * w3c[8 * q + 2 * e + 1]; db += h0 * w3c[64 + 8 * q + 2 * e] + h1 * w3c[64 + 8 * q + 2 * e + 1]; } }
            const float dec = __builtin_amdgcn_exp2f(-1.4426950408889634f * delta * ((float)t * (1.0f / 16383.0f)));
            df *= dec; db *= dec;
            Xf[2 * fidx(t >> 1) + (t & 1)] = df; asum += __builtin_fabsf(df);
            if (t >= 1) { const int n = 32768 - t; Xf[2 * fidx(n >> 1) + (n & 1)] = db; asum += __builtin_fabsf(db); } }
        if (tid == 0) Xf[2 * fidx(8192)] = 0.f;
        const float S1 = block_sum(asum, red, wave, lane);
        fft_fwd(X, tid);
        const float scale = 1.0f / (S1 * 16384.0f);
        f32x4* HF = (f32x4*)(ws + WS_HF) + (size_t)c * 8193;
        for (int k = tid; k <= 8192; k += NTHR) {
            const f32x2 A = X[fidx(brev14(k))], B = X[fidx(brev14((16384 - k) & 16383))]; f32x4 o;
            if (k == 0) o = (f32x4){A.x + A.y, 0.f, A.x - A.y, 0.f};
            else { const float Ex = 0.5f * (A.x + B.x), Ey = 0.5f * (A.y - B.y), Ox = 0.5f * (A.y + B.y), Oy = -0.5f * (A.x - B.x);
                const float ang = (float)k * (1.0f / 32768.0f), wc = __builtin_amdgcn_cosf(ang), wsn = -__builtin_amdgcn_sinf(ang);
                const float px = Ox * wc - Oy * wsn, py = Ox * wsn + Oy * wc;
                o = (f32x4){Ex + px, Ey + py, Ex - px, -(Ey - py)}; }
            HF[k] = o * scale; }
        __syncthreads();
        float as2 = 0.f;
        if (tid < CTXL) { const int t = tid; const v4u* hr = (const v4u*)(H2C + (size_t)t * 64); float df = 0.f, db = 0.f;
#pragma unroll
            for (int q = 0; q < 8; ++q) { const v4u hw = hr[q];
#pragma unroll
                for (int e = 0; e < 4; ++e) { const float h0 = __builtin_bit_cast(float, hw[e] << 16), h1 = __builtin_bit_cast(float, hw[e] & 0xffff0000u);
                    df += h0 * w3c[8 * q + 2 * e] + h1 * w3c[8 * q + 2 * e + 1]; db += h0 * w3c[64 + 8 * q + 2 * e] + h1 * w3c[64 + 8 * q + 2 * e + 1]; } }
            const float dec = __builtin_amdgcn_exp2f(-1.4426950408889634f * delta * ((float)t * (1.0f / 255.0f)));
            df *= dec; db *= dec; kc[t] = df; as2 += __builtin_fabsf(df);
            if (t >= 1) { kc[512 - t] = db; as2 += __builtin_fabsf(db); } else kc[256] = 0.f; }
        const float S2 = block_sum(as2, red, wave, lane);
        ((float*)(ws + WS_KCTX))[(size_t)c * 512 + tid] = kc[tid] / S2;
        __syncthreads();
    }
}

__device__ __forceinline__ void norm_load(const float* xr, int lane, f32x4 (&v)[4]) {
    const f32x4* xp = (const f32x4*)xr + lane;
#pragma unroll
    for (int j = 0; j < 4; ++j) v[j] = xp[64 * j];
}
__device__ __forceinline__ void norm_load_b(const bf16* xr, int lane, f32x4 (&v)[4]) {
    const v2u* xp = (const v2u*)xr + lane;
#pragma unroll
    for (int j = 0; j < 4; ++j) v[j] = bf4_f32(xp[64 * j]);
}
__device__ __forceinline__ void norm_finish(f32x4 (&v)[4], bf16* xbrow, const float* modl, int set, int which, const f32x4 (&g)[4], int lane, bf16* dst, f32x4 (&o)[4], const float* pend = nullptr) {
    float ss = 0.f;
#pragma unroll
    for (int j = 0; j < 4; ++j) {
        if (pend) { const f32x4* pp = (const f32x4*)(pend + (size_t)j * 4 * 65536) + lane; v[j] = (((v[j] + pp[0]) + pp[16384]) + pp[2 * 16384]) + pp[3 * 16384]; ((v2u*)xbrow)[lane + 64 * j] = f32_bf4(v[j]); }
        ss += (v[j].x * v[j].x + v[j].y * v[j].y) + (v[j].z * v[j].z + v[j].w * v[j].w); }
    const float rinv = __builtin_amdgcn_rsqf(wave_sum(ss) * (1.0f / DM) + 1e-6f);
    const f32x4* sh = (const f32x4*)(modl + set * 6144 + which * DM) + lane; const f32x4* sc = (const f32x4*)(modl + set * 6144 + (which + 1) * DM) + lane;
    v2u* dp = (v2u*)dst + lane;
#pragma unroll
    for (int j = 0; j < 4; ++j) { const f32x4 y = v[j] * rinv * g[j]; o[j] = y * (sc[64 * j] + 1.0f) + sh[64 * j];
        v2u w; w.x = pk2(o[j].x, o[j].y); w.y = pk2(o[j].z, o[j].w); dp[64 * j] = w; }
}
__device__ __forceinline__ const float* ctx_pending(const Args& a, int R) {
    const int b = R / RB, rr = R - b * RB; return rr < CTXL ? (const float*)(fresh_ptr(a.ws) + WS_SLAB) + (size_t)b * 16 * 65536 + rr * 256 : nullptr; }
__device__ __forceinline__ void norm_finish_lds(f32x4 (&v)[4], bf16* xbrow, bool store_x, const LAS f32x4* mt, int set, const f32x4 (&g)[4], int lane, bf16* dst, const float* pend) {
    float ss = 0.f;
#pragma unroll
    for (int j = 0; j < 4; ++j) {
        if (pend) { const f32x4* pp = (const f32x4*)(pend + (size_t)j * 4 * 65536) + lane; v[j] = (((v[j] + pp[0]) + pp[16384]) + pp[2 * 16384]) + pp[3 * 16384]; }
        if (pend || store_x) ((v2u*)xbrow)[lane + 64 * j] = f32_bf4(v[j]);
        ss += (v[j].x * v[j].x + v[j].y * v[j].y) + (v[j].z * v[j].z + v[j].w * v[j].w); }
    const float rinv = __builtin_amdgcn_rsqf(wave_sum(ss) * (1.0f / DM) + 1e-6f);
    const LAS f32x4* sh = mt + set * 512 + lane; const LAS f32x4* sc = sh + 256;
    v2u* dp = (v2u*)dst + lane;
#pragma unroll
    for (int j = 0; j < 4; ++j) { const f32x4 y = v[j] * rinv * g[j]; const f32x4 o = y * (sc[64 * j] + 1.0f) + sh[64 * j];
        v2u w; w.x = pk2(o.x, o.y); w.y = pk2(o.z, o.w); dp[64 * j] = w; }
}
__device__ __forceinline__ void phase_norm(const Args& a, int li, int which  , bool f32in  , LAS unsigned char* lds, int G, int bx) {
    const int tid = fresh_tid(), lane = tid & 63, wave = __builtin_amdgcn_readfirstlane(tid >> 6);
    const int gw = bx * NWAVES + wave, NGW = G * NWAVES;
    unsigned char* ws = fresh_ptr(a.ws); const float* modl = (const float*)(ws + WS_MOD) + (size_t)li * 3 * 6144; const float* hctx = (const float*)(ws + WS_HCTX);
    const float* gsrc = (which == 0 ? AIN(6) : AIN(7)) + li * DM; bf16* XN = (bf16*)(ws + WS_XN); bf16* XB = (bf16*)(ws + WS_XB); const float* xlat = AIN(0);
    LAS f32x4* mt = (LAS f32x4*)lds;
    __syncthreads();
    for (int idx = tid; idx < 3 * 512; idx += NTHR) { const int set = idx >> 9, rem = idx & 511; mt[idx] = ((const f32x4*)(modl + set * 6144 + which * DM))[rem]; }
    f32x4 g[4];
#pragma unroll
    for (int j = 0; j < 4; ++j) g[j] = ((const f32x4*)gsrc)[lane + 64 * j];
    __syncthreads();
    const bool pending = (which == 3) || (li & 1);
    constexpr int NR = 9;
    for (int R = gw; R < MROWS; R += NR * NGW) {
        f32x4 v[NR][4]; int Rq[NR];
#pragma unroll
        for (int q = 0; q < NR; ++q) { Rq[q] = R + q * NGW; const int Rc = Rq[q] < MROWS ? Rq[q] : R;
            if (f32in) norm_load(xrow_in(Rc, xlat, hctx), lane, v[q]); else norm_load_b(XB + (size_t)Rc * DM, lane, v[q]); }
#pragma unroll
        for (int q = 0; q < NR; ++q) if (Rq[q] < MROWS) norm_finish_lds(v[q], XB + (size_t)Rq[q] * DM, f32in, mt, row_set(Rq[q]), g, lane, XN + (size_t)Rq[q] * DM, pending ? ctx_pending(a, Rq[q]) : nullptr); }
    __syncthreads();
}
__device__ __forceinline__ void phase_norm_router(const Args& a, int li, LAS unsigned char* lds, int G, int bx) {
    const int tid = fresh_tid(), lane = tid & 63, wave = __builtin_amdgcn_readfirstlane(tid >> 6);
    unsigned char* ws = fresh_ptr(a.ws); const float* modl = (const float*)(ws + WS_MOD) + (size_t)li * 3 * 6144; bf16* XB = (bf16*)(ws + WS_XB);
    const float* gsrc = AIN(7) + li * DM; bf16* XN = (bf16*)(ws + WS_XN); const int lj = li >> 1;
    const float* rw = AIN(28) + (size_t)lj * DM * NEXP;
    LAS float* rwT = (LAS float*)lds;
    LAS int* re = (LAS int*)(lds + 32768);
    LAS float* rg = (LAS float*)(lds + 32768 + 2048);
    LAS int* lcnt = (LAS int*)(lds + 32768 + 4096);
    for (int idx = tid; idx < DM * NEXP; idx += NTHR) rwT[(idx & 7) * DM + (idx >> 3)] = rw[idx];
    if (tid < 32) lcnt[tid] = 0;
    __syncthreads();
    const int RPB = (MROWS + G - 1) / G, R0 = bx * RPB; int nrows = MROWS - R0; nrows = nrows > RPB ? RPB : nrows; nrows = nrows < 0 ? 0 : nrows;
    f32x4 g[4];
#pragma unroll
    for (int j = 0; j < 4; ++j) g[j] = ((const f32x4*)gsrc)[lane + 64 * j];
    f32x4 vnext[4];
    if (wave < nrows) norm_load_b(XB + (size_t)(R0 + wave) * DM, lane, vnext);
    for (int i = wave; i < nrows; i += NWAVES) { const int R = R0 + i; f32x4 o[4], v[4];
#pragma unroll
        for (int j = 0; j < 4; ++j) v[j] = vnext[j];
        if (i + NWAVES < nrows) norm_load_b(XB + (size_t)(R + NWAVES) * DM, lane, vnext);
        norm_finish(v, XB + (size_t)R * DM, modl, row_set(R), 3, g, lane, XN + (size_t)R * DM, o, ctx_pending(a, R));
        float lg[8];
#pragma unroll
        for (int e = 0; e < 8; ++e) { float s = 0.f;
#pragma unroll
            for (int j = 0; j < 4; ++j) { const f32x4 w = *(const LAS f32x4*)(rwT + e * DM + 4 * lane + 256 * j); s += (o[j].x * w.x + o[j].y * w.y) + (o[j].z * w.z + o[j].w * w.w); }
            lg[e] = wave_sum(s); }
        int e0 = 0; float v0 = lg[0];
#pragma unroll
        for (int e = 1; e < 8; ++e) if (lg[e] > v0) { v0 = lg[e]; e0 = e; }
        int e1 = -1; float v1 = -3.0e38f;
#pragma unroll
        for (int e = 0; e < 8; ++e) if (e != e0 && lg[e] > v1) { v1 = lg[e]; e1 = e; }
        if (lane == 0) { re[i] = e0 | (e1 << 8); rg[i] = 1.0f / (1.0f + __expf(v1 - v0)); }
    }
    __syncthreads();
    if (tid < nrows) { const int w = re[tid], e0 = w & 255, e1 = w >> 8; int r0 = 0, r1 = 0;
        for (int j = 0; j < tid; ++j) { const int wj = re[j]; r0 += ((wj & 255) == e0) ? 1 : 0; r1 += ((wj >> 8) == e1) ? 1 : 0; }
        ((int*)(ws + WS_RREC))[R0 + tid] = e0 | (e1 << 4) | (r0 << 8) | (r1 << 20); ((float*)(ws + WS_RRECG))[R0 + tid] = rg[tid]; }
    if (tid < 16) { int c = 0; for (int j = 0; j < nrows; ++j) { const int wj = re[j]; c += ((tid < 8 ? (wj & 255) : (wj >> 8)) == (tid & 7)) ? 1 : 0; }
        ((int*)(ws + WS_CNTB))[bx * 16 + tid] = c; }
    __syncthreads();
}
__device__ __forceinline__ void moe_tables(const Args& a, int lj, LAS unsigned char* lds, int G, int bx) {
    LAS int* tab = (LAS int*)(lds + TAB_OFF); const int tid = fresh_tid(); const int* cntb = (const int*)(fresh_ptr(a.ws) + WS_CNTB);
    if (tid < 16) { tab[32 + tid] = 0; tab[116 + tid] = 0; }
    __syncthreads();
    { const int sg = tid & 15; int c = 0, below = 0;
        for (int b = tid >> 4; b < G; b += NTHR / 16) { const int v = cntb[b * 16 + sg]; c += v; below += b < bx ? v : 0; }
        atomicAdd((int*)(tab + 32 + sg), c); atomicAdd((int*)(tab + 116 + sg), below); }
    __syncthreads();
    if (tid == 0) { int tb = 0, tm = 0, n0 = 0, n1 = 0;
        for (int s = 0; s < 16; ++s) { const int c = tab[32 + s]; const int nt = (c + 255) >> 8;
            tab[s] = tb; tab[64 + s] = tm; tb += nt; tm += nt > 0 ? nt - 1 : 0;
            if (nt > 0) { if (s < 8) tab[96 + n0++] = s; else tab[104 + n1++] = s; } }
        tab[16] = tb; tab[80] = tm; tab[112] = n0; tab[113] = n1; }
    __syncthreads();
    (void)lj;
}
__device__ __forceinline__ void phase_moe_gather(const Args& a, int li, LAS unsigned char* lds, int G, int bx) {
    const int tid = fresh_tid(), lane = tid & 63, wave = __builtin_amdgcn_readfirstlane(tid >> 6);
    moe_tables(a, li >> 1, lds, G, bx);
    const LAS int* tab = (const LAS int*)(lds + TAB_OFF);
    unsigned char* ws = fresh_ptr(a.ws);
    int* rtok = (int*)(ws + WS_RTOK); float* rgate = (float*)(ws + WS_RGATE); const int* rec = (const int*)(ws + WS_RREC); const float* recg = (const float*)(ws + WS_RRECG);
    const int RPB = (MROWS + G - 1) / G, R0 = bx * RPB; int nrows = MROWS - R0; nrows = nrows > RPB ? RPB : nrows; nrows = nrows < 0 ? 0 : nrows;
    for (int it0 = wave; it0 < 2 * nrows; it0 += 4 * NWAVES) {
        int Rr[4], sg[4], ix[4]; float gg[4]; bool ok[4];
#pragma unroll
        for (int u = 0; u < 4; ++u) { const int it = it0 + u * NWAVES; ok[u] = it < 2 * nrows; const int itc = ok[u] ? it : it0; const int k = itc & 1; Rr[u] = R0 + (itc >> 1);
            const int w = rec[Rr[u]]; const float g0 = recg[Rr[u]];
            const int e = k ? ((w >> 4) & 15) : (w & 15), rk = k ? (w >> 20) : ((w >> 8) & 4095); sg[u] = k * 8 + e; ix[u] = tab[116 + sg[u]] + rk; gg[u] = k ? 1.0f - g0 : g0; }
#pragma unroll
        for (int u = 0; u < 4; ++u) if (ok[u]) {
            if (lane == 0) { rtok[(size_t)sg[u] * SEGCAP + ix[u]] = Rr[u]; rgate[(size_t)sg[u] * SEGCAP + ix[u]] = gg[u]; } }
    }
}
__device__ __forceinline__ void phase_moe_fix(const Args& a, int li, int k, LAS unsigned char* lds, int G, int bx) {
    const int tid = fresh_tid(), lane = tid & 63, wave = __builtin_amdgcn_readfirstlane(tid >> 6);
    const int gw = bx * NWAVES + wave, NGW = G * NWAVES;
    moe_tables(a, li >> 1, lds, G, bx);
    const LAS int* tab = (const LAS int*)(lds + TAB_OFF);
    const int nt = tab[112 + k]; const int* rtok = (const int*)(fresh_ptr(a.ws) + WS_RTOK); const float* slab = (const float*)(fresh_ptr(a.ws) + WS_SLAB);
    bf16* XB = (bf16*)(fresh_ptr(a.ws) + WS_XB);
    for (int it = gw; it < nt * 256; it += NGW) { const int jl = it >> 8, r = it & 255, s = tab[96 + 8 * k + jl];
        const int idx = (tab[s + 1] - 1 - tab[s]) * 256 + r; if (idx >= tab[32 + s]) continue;
        const int R = rtok[(size_t)s * SEGCAP + idx]; v2u* xp = (v2u*)(XB + (size_t)R * DM) + lane;
        const f32x4* sp = (const f32x4*)(slab + (size_t)((k * 8 + jl) * 16) * 65536 + r * 256) + lane;
#pragma unroll
        for (int j = 0; j < 4; ++j) { const f32x4* pp = sp + (size_t)j * 4 * 16384; xp[64 * j] = f32_bf4((((bf4_f32(xp[64 * j]) + pp[0]) + pp[16384]) + pp[2 * 16384]) + pp[3 * 16384]); } }
}
__device__ __forceinline__ void phase_final(const Args& a, int G, int bx) {
    const int tid = fresh_tid(); const bf16* XB = (const bf16*)(fresh_ptr(a.ws) + WS_XB); float* out = fresh_ptr(a.out);
    for (size_t i = (size_t)bx * NTHR + tid; i < (size_t)NB * SEQ * DM / 8; i += (size_t)G * NTHR) {
        const size_t e = i * 8, row = e / DM, c = e - row * DM, b = row / SEQ, t = row - b * SEQ;
        const v4u w = *(const v4u*)(XB + ((size_t)b * RB + CTXL + t) * DM + c);
        f32x4* dp = (f32x4*)(out + e);
        dp[0] = (f32x4){__builtin_bit_cast(float, w.x << 16), __builtin_bit_cast(float, w.x & 0xffff0000u), __builtin_bit_cast(float, w.y << 16), __builtin_bit_cast(float, w.y & 0xffff0000u)};
        dp[1] = (f32x4){__builtin_bit_cast(float, w.z << 16), __builtin_bit_cast(float, w.z & 0xffff0000u), __builtin_bit_cast(float, w.w << 16), __builtin_bit_cast(float, w.w & 0xffff0000u)}; }
}

constexpr int PL_ZT = 0, PL_DT = 40960, PL_LIN = 74752;
__device__ __forceinline__ void pool_load_lin(const Args& a, int li, LAS unsigned char* lds) {
    LAS bf16* linT = (LAS bf16*)(lds + PL_LIN); const float* src = AIN(10) + (size_t)li * 4 * 64 * 64;
    for (int idx = fresh_tid(); idx < 4 * 4096; idx += NTHR) { const int g = idx >> 12, c = (idx >> 6) & 63, e = idx & 63; linT[(g * 64 + e) * 72 + c] = (bf16)f2bf(src[idx]); }
    __syncthreads();
}
__device__ __forceinline__ void pool_unit(const Args& a, int li, int p, LAS unsigned char* lds) {
    const int tid = fresh_tid(), lane = tid & 63, r32 = lane & 31, hi = lane >> 5, wave = __builtin_amdgcn_readfirstlane(tid >> 6);
    const bf16* Z = (const bf16*)(fresh_ptr(a.ws) + WS_Z); bf16* Y = (bf16*)(fresh_ptr(a.ws) + WS_Y);
    const int b = p >> 8, t0 = (p & 255) * 64, rowbase = b * RB + CTXL;
    LAS bf16* zt = (LAS bf16*)(lds + PL_ZT); LAS bf16* dt = (LAS bf16*)(lds + PL_DT); const LAS bf16* linT = (const LAS bf16*)(lds + PL_LIN);
    for (int idx = tid; idx < 80 * 32; idx += NTHR) { const int row = idx >> 5, ch8 = idx & 31, t = t0 - 8 + row; v4u w = {0u, 0u, 0u, 0u};
        if (t >= 0 && t < SEQ) w = *(const v4u*)(Z + (size_t)(rowbase + t) * INW + ch8 * 8);
        *(LAS v4u*)(zt + row * 256 + ch8 * 8) = w; }
    __syncthreads();
    { const int ch = tid & 255, th = tid >> 8, hw = 1 << (ch >> 6), tb = t0 + 32 * th; const LAS bf16* zc = zt + ch;
        float s = 0.f;
        for (int q = -hw; q < hw; ++q) s += bf2f(zc[(32 * th + 8 + q) * 256]);
#pragma unroll 4
        for (int tt = 0; tt < 32; ++tt) { const int t = tb + tt, rel = 32 * th + tt + 8; int lo = t - hw; lo = lo < 0 ? 0 : lo; int hq = t + hw; hq = hq > SEQ ? SEQ : hq;
            dt[(32 * th + tt) * 264 + ch] = (bf16)f2bf(s * __builtin_amdgcn_rcpf((float)(hq - lo)) - bf2f(zc[rel * 256]));
            s += bf2f(zc[(rel + hw) * 256]) - bf2f(zc[(rel - hw) * 256]); } }
    __syncthreads();
    { const int g = wave >> 1, th = wave & 1;
        bf16x8 bfr[4], afr[2][4];
#pragma unroll
        for (int ks = 0; ks < 4; ++ks) { bfr[ks] = *(const LAS bf16x8*)(dt + (32 * th + r32) * 264 + g * 64 + 16 * ks + 8 * hi);
#pragma unroll
            for (int mt = 0; mt < 2; ++mt) afr[mt][ks] = *(const LAS bf16x8*)(linT + (g * 64 + 32 * mt + r32) * 72 + 16 * ks + 8 * hi); }
        f32x16 acc[2];
#pragma unroll
        for (int mt = 0; mt < 2; ++mt) {
#pragma unroll
            for (int r = 0; r < 16; ++r) acc[mt][r] = 0.f;
#pragma unroll
            for (int ks = 0; ks < 4; ++ks) acc[mt] = __builtin_amdgcn_mfma_f32_32x32x16_bf16(afr[mt][ks], bfr[ks], acc[mt], 0, 0, 0); }
        const float* ps = AIN(11) + li * 256 + g * 64;
        bf16* yp = Y + (size_t)(rowbase + t0 + 32 * th + r32) * DM + g * 64;
#pragma unroll
        for (int mt = 0; mt < 2; ++mt)
#pragma unroll
            for (int rq = 0; rq < 4; ++rq) { const int e0 = 32 * mt + 8 * rq + 4 * hi; const f32x4 sc = *(const f32x4*)(ps + e0);
                v2u w; w.x = pk2(acc[mt][4 * rq] * sc.x, acc[mt][4 * rq + 1] * sc.y); w.y = pk2(acc[mt][4 * rq + 2] * sc.z, acc[mt][4 * rq + 3] * sc.w);
                *(v2u*)(yp + e0) = w; }
    }
    __syncthreads();
}
__device__ __forceinline__ void pool_ctx_pair(const Args& a, int li, int cp, LAS unsigned char* lds) {
    const int tid = fresh_tid();
    const bf16* Z = (const bf16*)(fresh_ptr(a.ws) + WS_Z); bf16* Y = (bf16*)(fresh_ptr(a.ws) + WS_Y);
    LAS float* dm = (LAS float*)(lds + PL_ZT);
    const int ct = 2 * cp + (tid >> 8), b = ct >> 8, t = ct & 255, ch = tid & 255, hw = 1 << (ch >> 6), rowbase = b * RB;
    int lo = t - hw; lo = lo < 0 ? 0 : lo; int hq = t + hw; hq = hq > CTXL ? CTXL : hq; float s = 0.f;
    for (int q = lo; q < hq; ++q) s += bf2f(Z[(size_t)(rowbase + q) * INW + ch]);
    dm[tid] = s / (float)(hq - lo) - bf2f(Z[(size_t)(rowbase + t) * INW + ch]);
    __syncthreads();
    { const int g = ch >> 6, eo = ch & 63; const float* lin = AIN(10) + (size_t)li * 4 * 64 * 64 + g * 4096 + eo; const LAS float* dr = dm + (tid >> 8) * 256 + g * 64; float acc = 0.f;
#pragma unroll 8
        for (int c = 0; c < 64; ++c) acc += dr[c] * lin[c * 64];
        Y[(size_t)(rowbase + t) * DM + ch] = (bf16)f2bf(acc * AIN(11)[li * 256 + ch]); }
    __syncthreads();
}

__device__ __forceinline__ void sconv2(const bf16* zr, int t0, int L, float w0, float w1, float w2, float sb, float& y0, float& y1) {
    const unsigned pr = *(const unsigned*)(zr + t0); const float z0 = __builtin_bit_cast(float, pr << 16), z1 = __builtin_bit_cast(float, pr & 0xffff0000u);
    const float zm = t0 > 0 ? bf2f(zr[t0 - 1]) : 0.f, zp = (t0 + 2 < L) ? bf2f(zr[t0 + 2]) : 0.f;
    y0 = sb + zm * w0 + z0 * w1 + z1 * w2; y1 = sb + z0 * w0 + z1 * w1 + zp * w2;
}
__device__ __forceinline__ void sconv8(const bf16* zr, int t0, int L, float w0, float w1, float w2, float sb, float (&y)[8]) {
    const v4u w = *(const v4u*)(zr + t0); float z[10];
    z[0] = t0 > 0 ? bf2f(zr[t0 - 1]) : 0.f; z[9] = (t0 + 8 < L) ? bf2f(zr[t0 + 8]) : 0.f;
#pragma unroll
    for (int e = 0; e < 4; ++e) { z[1 + 2 * e] = __builtin_bit_cast(float, w[e] << 16); z[2 + 2 * e] = __builtin_bit_cast(float, w[e] & 0xffff0000u); }
#pragma unroll
    for (int e = 0; e < 8; ++e) y[e] = sb + z[e] * w0 + z[e + 1] * w1 + z[e + 2] * w2;
}
__device__ __forceinline__ void hyena_unit(const Args& a, int li, int c, LAS unsigned char* lds) {
    const int tid = fresh_tid();
    unsigned char* ws = fresh_ptr(a.ws); const bf16* ZT = (const bf16*)(ws + WS_ZT); const bf16* ZTC = (const bf16*)(ws + WS_ZTC); bf16* Y = (bf16*)(ws + WS_Y);
    const float* sw = AIN(12) + (size_t)li * 3 * 768; const float* sbp = AIN(13) + (size_t)li * 768; const float hb = AIN(21)[li * 256 + c];
    const float a0 = sw[c], a1 = sw[768 + c], a2 = sw[1536 + c], ab = sbp[c];
    const float b0 = sw[256 + c], b1 = sw[768 + 256 + c], b2 = sw[1536 + 256 + c], bb = sbp[256 + c];
    const float c0 = sw[512 + c], c1 = sw[768 + 512 + c], c2 = sw[1536 + 512 + c], cb = sbp[512 + c];
    LAS f32x2* X = (LAS f32x2*)lds;
    const f32x4* HF = (const f32x4*)(ws + WS_HF) + (size_t)c * 8193;
    for (int b = 0; b < NB; ++b) {
        const bf16* px0 = ZT + (size_t)(b * 768 + c) * SEQ; const bf16* px1 = ZT + (size_t)(b * 768 + 256 + c) * SEQ; const bf16* pv = ZT + (size_t)(b * 768 + 512 + c) * SEQ;
        float u[4][8];
#pragma unroll
        for (int r = 0; r < 4; ++r) { const int m = tid + NTHR * r; float vv[8], gg[8];
            sconv8(pv, 8 * m, SEQ, c0, c1, c2, cb, vv); sconv8(px1, 8 * m, SEQ, b0, b1, b2, bb, gg);
#pragma unroll
            for (int e = 0; e < 8; ++e) u[r][e] = vv[e] * gg[e];
            const int i0 = fidx(4 * m), i1 = fidx(4 * m + 8192);
#pragma unroll
            for (int q = 0; q < 4; ++q) { X[i0 + q] = (f32x2){u[r][2 * q], u[r][2 * q + 1]}; X[i1 + q] = (f32x2){0.f, 0.f}; } }
        __syncthreads();
        fft_fwd(X, tid);
        for (int k0 = tid; k0 <= 8192; k0 += 4 * NTHR) {
            f32x4 Hq[4];
#pragma unroll
            for (int q = 0; q < 4; ++q) Hq[q] = HF[k0 + q * NTHR <= 8192 ? k0 + q * NTHR : k0];
#pragma unroll
            for (int q = 0; q < 4; ++q) { const int k = k0 + q * NTHR; if (k > 8192) break;
            const int pa = fidx(brev14(k)), pb = fidx(brev14((16384 - k) & 16383));
            const f32x2 A = X[pa], B = X[pb]; const f32x4 H = Hq[q];
            if (k == 0) { const float Y0 = (A.x + A.y) * H.x, YN = (A.x - A.y) * H.z; X[pa] = (f32x2){0.5f * (Y0 + YN), 0.5f * (Y0 - YN)}; }
            else { const float Ex = 0.5f * (A.x + B.x), Ey = 0.5f * (A.y - B.y), Ox = 0.5f * (A.y + B.y), Oy = -0.5f * (A.x - B.x);
                const float ang = (float)k * (1.0f / 32768.0f), wc = __builtin_amdgcn_cosf(ang), wsn = -__builtin_amdgcn_sinf(ang);
                const float px = Ox * wc - Oy * wsn, py = Ox * wsn + Oy * wc;
                const float Xkx = Ex + px, Xky = Ey + py, Xnx = Ex - px, Xny = -(Ey - py);
                const float Ykx = Xkx * H.x - Xky * H.y, Yky = Xkx * H.y + Xky * H.x, Ynx = Xnx * H.z - Xny * H.w, Yny = Xnx * H.w + Xny * H.z;
                const float Epx = 0.5f * (Ykx + Ynx), Epy = 0.5f * (Yky - Yny), Dx = Ykx - Ynx, Dy = Yky + Yny;
                const float Opx = 0.5f * (Dx * wc + Dy * wsn), Opy = 0.5f * (Dy * wc - Dx * wsn);
                X[pa] = (f32x2){Epx - Opy, Epy + Opx};
                if (k != 8192) X[pb] = (f32x2){Epx + Opy, -Epy + Opx}; } } }
        __syncthreads();
        fft_inv(X, tid);
#pragma unroll
        for (int r = 0; r < 4; ++r) { const int m = tid + NTHR * r; float xx[8];
            sconv8(px0, 8 * m, SEQ, a0, a1, a2, ab, xx);
            const int i0 = fidx(4 * m); const f32x2 y0 = X[i0], y1 = X[i0 + 1], y2 = X[i0 + 2], y3 = X[i0 + 3];
            const float yv[8] = {y0.x, y0.y, y1.x, y1.y, y2.x, y2.y, y3.x, y3.y};
            bf16* yp = Y + (size_t)(b * RB + CTXL + 8 * m) * DM + 256 + c;
#pragma unroll
            for (int e = 0; e < 8; ++e) yp[(size_t)e * DM] = (bf16)f2bf((yv[e] + u[r][e] * hb) * xx[e]); }
        __syncthreads();
    }
    {
        LAS float* kc = (LAS float*)lds; LAS float* uc = kc + 512;
        kc[tid] = ((const float*)(ws + WS_KCTX))[(size_t)c * 512 + tid];
        const int b = tid >> 8, t = tid & 255, te = t & ~1;
        const bf16* px0 = ZTC + (size_t)(b * 768 + c) * CTXL; const bf16* px1 = ZTC + (size_t)(b * 768 + 256 + c) * CTXL; const bf16* pv = ZTC + (size_t)(b * 768 + 512 + c) * CTXL;
        float v0, v1, g0, g1, x00, x01;
        sconv2(pv, te, CTXL, c0, c1, c2, cb, v0, v1); sconv2(px1, te, CTXL, b0, b1, b2, bb, g0, g1); sconv2(px0, te, CTXL, a0, a1, a2, ab, x00, x01);
        const float u = (t & 1) ? v1 * g1 : v0 * g0, x0v = (t & 1) ? x01 : x00;
        uc[tid] = u;
        __syncthreads();
        float y = 0.f;
#pragma unroll 8
        for (int s = 0; s < CTXL; ++s) y += kc[(t - s) & 511] * uc[b * 256 + s];
        Y[(size_t)(b * RB + t) * DM + 256 + c] = (bf16)f2bf((y + u * hb) * x0v);
        __syncthreads();
    }
}

__device__ __forceinline__ void glds16(const void* gsrc, unsigned lds_dst) { unsigned keep;
    asm volatile("s_mov_b32 %0, m0\n\ts_mov_b32 m0, %2\n\ts_nop 0\n\tglobal_load_lds_dwordx4 %1, off\n\ts_mov_b32 m0, %0" : "=&s"(keep) : "v"(gsrc), "s"(lds_dst) : "memory"); }
__device__ __forceinline__ s16x4 vtr(const LAS unsigned char* p) { return __builtin_bit_cast(s16x4, __builtin_amdgcn_ds_read_tr16_b64_v4i16((LAS v4i16_t*)p)); }
typedef __bf16 bf16x2n __attribute__((ext_vector_type(2)));
__device__ __forceinline__ unsigned cvtpk_s(float lo, float hi) { f32x2 v = {lo, hi}; bf16x2n b = __builtin_convertvector(v, bf16x2n); return __builtin_bit_cast(unsigned, b); }
__device__ __forceinline__ int crow(int r, int hi) { return (r & 3) + 8 * (r >> 2) + 4 * hi; }
#define ATT_WAIT_BAR(N) asm volatile("s_waitcnt vmcnt(" #N ") lgkmcnt(0)\n\ts_barrier" ::: "memory")
constexpr int ATT_WS = 98304;
__device__ __forceinline__ void attn_unit(LAS unsigned char* lds, const bf16* Z, int qrow0, int krow0, int NT, int h, float negb, float lam, float oscale, const float* sg, bf16* Y) {
    const int tid = fresh_tid(), lane = tid & 63, r32 = lane & 31, hi = lane >> 5; const int wid = __builtin_amdgcn_readfirstlane(tid >> 6); const int mp = wid >> 2, wq = wid & 3;
    const unsigned lds0 = (unsigned)(uintptr_t)lds;
    const int dr = lane >> 4, dsl = lane & 15;
    const bf16* ks0 = Z + (size_t)(krow0 + 4 * wid + dr) * INW + K_OFF + h * 128 + (dsl ^ ((4 * wid + dr) & 15)) * 8;
    const bf16* vs0 = Z + (size_t)(krow0 + 4 * wid + dr) * INW + V_OFF + h * 128 + (dsl ^ (dr << 2)) * 8;
#define DMA_K(t) do { const size_t off_ = (size_t)(t) * 64 * INW; const unsigned sb_ = lds0 + (unsigned)((t) % 3) * 16384u + wid * 1024; \
        glds16(ks0 + off_, (unsigned)__builtin_amdgcn_readfirstlane(sb_)); glds16(ks0 + off_ + (size_t)32 * INW, (unsigned)__builtin_amdgcn_readfirstlane(sb_ + 8192)); } while (0)
#define DMA_V(t) do { const size_t off_ = (size_t)(t) * 64 * INW; const unsigned sb_ = lds0 + 49152u + (unsigned)((t) & 1) * 16384u + wid * 1024; \
        glds16(vs0 + off_, (unsigned)__builtin_amdgcn_readfirstlane(sb_)); glds16(vs0 + off_ + (size_t)32 * INW, (unsigned)__builtin_amdgcn_readfirstlane(sb_ + 8192)); } while (0)
    int kof[4], vof[4];
    { const int g1 = (lane >> 4) & 1, q = (lane & 15) >> 2, p = lane & 3;
#pragma unroll
        for (int d0 = 0; d0 < 4; ++d0) { kof[d0] = r32 * 256 + (((mp * 8 + 2 * d0 + hi) ^ (r32 & 15)) << 4);
            vof[d0] = 49152 + (4 * hi + q) * 256 + (((4 * d0 + 2 * g1 + (p >> 1)) ^ (q << 2)) << 4) + (p & 1) * 8; } }
    bf16x8 qr[4];
    { const bf16* qp = Z + (size_t)(qrow0 + wq * 32 + r32) * INW + Q_OFF + h * 128 + mp * 64 + hi * 8;
#pragma unroll
        for (int d0 = 0; d0 < 4; ++d0) qr[d0] = *(const bf16x8*)(qp + d0 * 16); }
    DMA_K(0); DMA_K(1);
    if (mp) __builtin_amdgcn_s_setprio(1);
    f32x16 o[4];
#pragma unroll
    for (int d0 = 0; d0 < 4; ++d0)
#pragma unroll
        for (int r = 0; r < 16; ++r) o[d0][r] = 0.f;
    const f32x16 zero16 = {0.f, 0.f, 0.f, 0.f, 0.f, 0.f, 0.f, 0.f, 0.f, 0.f, 0.f, 0.f, 0.f, 0.f, 0.f, 0.f};
    float l_reg = 0.f;
    v4u pw[4];
    (void)negb;
#define ATT_QK(P0, P1, t) do { const LAS unsigned char* kp_ = lds + ((t) % 3) * 16384; \
        { bf16x8 kf_[4]; _Pragma("unroll") for (int d0 = 0; d0 < 4; ++d0) kf_[d0] = *(const LAS bf16x8*)(kp_ + kof[d0]); \
          P0 = __builtin_amdgcn_mfma_f32_32x32x16_bf16(kf_[0], qr[0], zero16, 0, 0, 0); \
          _Pragma("unroll") for (int d0 = 1; d0 < 4; ++d0) P0 = __builtin_amdgcn_mfma_f32_32x32x16_bf16(kf_[d0], qr[d0], P0, 0, 0, 0); } \
        { bf16x8 kf_[4]; _Pragma("unroll") for (int d0 = 0; d0 < 4; ++d0) kf_[d0] = *(const LAS bf16x8*)(kp_ + kof[d0] + 8192); \
          P1 = __builtin_amdgcn_mfma_f32_32x32x16_bf16(kf_[0], qr[0], zero16, 0, 0, 0); \
          _Pragma("unroll") for (int d0 = 1; d0 < 4; ++d0) P1 = __builtin_amdgcn_mfma_f32_32x32x16_bf16(kf_[d0], qr[d0], P1, 0, 0, 0); } } while (0)
#define ATT_EXP(P0, P1) do { float sa_ = 0.f, sb_ = 0.f; \
        _Pragma("unroll") for (int r = 0; r < 16; ++r) { P0[r] = __builtin_amdgcn_exp2f(P0[r]); P1[r] = __builtin_amdgcn_exp2f(P1[r]); sa_ += P0[r]; sb_ += P1[r]; } \
        l_reg += sa_ + sb_; } while (0)
#define ATT_PACK(P0, P1) do { \
        _Pragma("unroll") for (int q = 0; q < 4; ++q) { pw[0][q] = cvtpk_s(P0[2 * q], P0[2 * q + 1]); pw[1][q] = cvtpk_s(P0[8 + 2 * q], P0[8 + 2 * q + 1]); \
            pw[2][q] = cvtpk_s(P1[2 * q], P1[2 * q + 1]); pw[3][q] = cvtpk_s(P1[8 + 2 * q], P1[8 + 2 * q + 1]); } } while (0)
#define VTR(dst, addr, off) dst = vtr((const LAS unsigned char*)(addr) + (off))
#define ATT_VLOAD(V, t, d0) do { const unsigned va_ = lds0 + (unsigned)((t) & 1) * 16384u + (unsigned)vof[d0]; \
        VTR(V[0], va_, 0); VTR(V[1], va_, 2048); VTR(V[2], va_, 4096); VTR(V[3], va_, 6144); VTR(V[4], va_, 8192); VTR(V[5], va_, 10240); VTR(V[6], va_, 12288); VTR(V[7], va_, 14336); } while (0)
#define ATT_LGKM(n) asm volatile("s_waitcnt lgkmcnt(" #n ")" ::: "memory")
#define VFR(V, ks) (bf16x8){V[2 * (ks)][0], V[2 * (ks)][1], V[2 * (ks)][2], V[2 * (ks)][3], V[2 * (ks) + 1][0], V[2 * (ks) + 1][1], V[2 * (ks) + 1][2], V[2 * (ks) + 1][3]}
#define ATT_PVX(V, d0, P, B) do { \
        _Pragma("unroll") for (int ks = 0; ks < 4; ++ks) { o[d0] = __builtin_amdgcn_mfma_f32_32x32x16_bf16(__builtin_bit_cast(bf16x8, pw[ks]), VFR(V, ks), o[d0], 0, 0, 0); \
            P[B + 2 * ks] = __builtin_amdgcn_exp2f(P[B + 2 * ks]); P[B + 2 * ks + 1] = __builtin_amdgcn_exp2f(P[B + 2 * ks + 1]); sa_ += P[B + 2 * ks]; sb_ += P[B + 2 * ks + 1]; } \
        _Pragma("unroll") for (int ks = 0; ks < 4; ++ks) { __builtin_amdgcn_sched_group_barrier(0x008, 1, 0); __builtin_amdgcn_sched_group_barrier(0x400, 2, 0); __builtin_amdgcn_sched_group_barrier(0x002, 2, 0); } \
        __builtin_amdgcn_sched_barrier(0); } while (0)
#define ATT_PVONLY(V, d0) do { _Pragma("unroll") for (int ks = 0; ks < 4; ++ks) o[d0] = __builtin_amdgcn_mfma_f32_32x32x16_bf16(__builtin_bit_cast(bf16x8, pw[ks]), VFR(V, ks), o[d0], 0, 0, 0); __builtin_amdgcn_sched_barrier(0); } while (0)
#define ATT_TOP(t) do { if ((t) + 1 < NT) ATT_WAIT_BAR(2); else ATT_WAIT_BAR(0); DMA_V(t); if ((t) + 2 < NT) DMA_K((t) + 2); } while (0)
    { f32x16 p0, p1;
        ATT_TOP(0); ATT_QK(p0, p1, 0); ATT_EXP(p0, p1); ATT_PACK(p0, p1); }
    s16x4 va[8], vb[8];
    for (int t = 1; t < NT; ++t) {
        f32x16 p0, p1; float sa_ = 0.f, sb_ = 0.f;
        ATT_TOP(t);
        ATT_VLOAD(va, t - 1, 0); __builtin_amdgcn_sched_barrier(0);
        ATT_QK(p0, p1, t); __builtin_amdgcn_sched_barrier(0);
        ATT_VLOAD(vb, t - 1, 1); ATT_LGKM(8); __builtin_amdgcn_sched_barrier(0);
        ATT_PVX(va, 0, p0, 0);
        ATT_VLOAD(va, t - 1, 2); ATT_LGKM(8); __builtin_amdgcn_sched_barrier(0);
        ATT_PVX(vb, 1, p0, 8);
        ATT_VLOAD(vb, t - 1, 3); ATT_LGKM(8); __builtin_amdgcn_sched_barrier(0);
        ATT_PVX(va, 2, p1, 0);
        ATT_LGKM(0); __builtin_amdgcn_sched_barrier(0);
        ATT_PVX(vb, 3, p1, 8);
        l_reg += sa_ + sb_;
        ATT_PACK(p0, p1); }
    ATT_WAIT_BAR(0);
    ATT_VLOAD(va, NT - 1, 0); ATT_VLOAD(vb, NT - 1, 1); ATT_LGKM(8); ATT_PVONLY(va, 0);
    ATT_VLOAD(va, NT - 1, 2); ATT_LGKM(8); ATT_PVONLY(vb, 1);
    ATT_VLOAD(vb, NT - 1, 3); ATT_LGKM(8); ATT_PVONLY(va, 2);
    ATT_LGKM(0); ATT_PVONLY(vb, 3);
#undef ATT_EXP
#undef VTR
#undef ATT_VLOAD
#undef ATT_LGKM
#undef VFR
#undef ATT_PVX
#undef ATT_PVONLY
#undef ATT_PACK
#undef ATT_TOP
#undef ATT_QK
#undef ATT_PV
#undef DMA_K
#undef DMA_V
    __builtin_amdgcn_s_setprio(0);
    { auto rr = __builtin_amdgcn_permlane32_swap(__float_as_uint(l_reg), __float_as_uint(l_reg), false, false); l_reg = __uint_as_float(rr[0]) + __uint_as_float(rr[1]); }
    LAS float* wsf = (LAS float*)(lds + ATT_WS) + wid * 64;
    if (hi == 0) wsf[r32] = l_reg;
    LDS_WAIT();
    float rl[16];
#pragma unroll
    for (int r = 0; r < 16; ++r) rl[r] = __builtin_amdgcn_rcpf(wsf[crow(r, hi)]) * (mp ? lam : 1.0f);
    ATT_WAIT_BAR(0);
    LAS float* stg = (LAS float*)lds + wq * (32 * 132);
    if (mp == 1) {
#pragma unroll
        for (int d0 = 0; d0 < 4; ++d0)
#pragma unroll
            for (int r = 0; r < 16; ++r) stg[crow(r, hi) * 132 + d0 * 32 + r32] = o[d0][r] * rl[r];
    }
    ATT_WAIT_BAR(0);
    if (mp == 0) {
#pragma unroll
        for (int d0 = 0; d0 < 4; ++d0)
#pragma unroll
            for (int r = 0; r < 16; ++r) { const int ix = crow(r, hi) * 132 + d0 * 32 + r32; stg[ix] = o[d0][r] * rl[r] - stg[ix]; }
        LDS_WAIT();
        const int q = lane >> 1, half = lane & 1; const LAS float* rp = stg + q * 132 + half * 64;
        f32x4 v[16]; float ss = 0.f;
#pragma unroll
        for (int i = 0; i < 16; ++i) { v[i] = *(const LAS f32x4*)(rp + 4 * i); ss += (v[i].x * v[i].x + v[i].y * v[i].y) + (v[i].z * v[i].z + v[i].w * v[i].w); }
        ss += xor1_f(ss);
        const float rinv = __builtin_amdgcn_rsqf(ss * (1.0f / 128.0f) + 1e-6f) * oscale;
        bf16* yp = Y + (size_t)(qrow0 + wq * 32 + q) * DM + 512 + h * 128 + half * 64;
        const f32x4* sgp = (const f32x4*)(sg + half * 64);
#pragma unroll
        for (int i = 0; i < 8; ++i) { const f32x4 a0 = v[2 * i] * sgp[2 * i] * rinv, a1 = v[2 * i + 1] * sgp[2 * i + 1] * rinv;
            v4u w; w.x = pk2(a0.x, a0.y); w.y = pk2(a0.z, a0.w); w.z = pk2(a1.x, a1.y); w.w = pk2(a1.z, a1.w); *(v4u*)(yp + 8 * i) = w; }
    }
    ATT_WAIT_BAR(0);
}

__device__ __forceinline__ void attn_unit16(LAS unsigned char* lds, const bf16* Z, int qrow0, int krow0, int NT, int h, float lam, float oscale, const float* sg, bf16* Y) {
    const int tid = fresh_tid(), lane = tid & 63, r16 = lane & 15, g = lane >> 4; const int wid = __builtin_amdgcn_readfirstlane(tid >> 6); const int mp = wid >> 2, wq = wid & 3;
    const unsigned lds0 = (unsigned)(uintptr_t)lds;
    const int dr = lane >> 4, dsl = lane & 15;
    const bf16* ks0 = Z + (size_t)(krow0 + 4 * wid + dr) * INW + K_OFF + h * 128 + (dsl ^ ((4 * wid + dr) & 15)) * 8;
    const bf16* vs0 = Z + (size_t)(krow0 + 4 * wid + dr) * INW + V_OFF + h * 128 + (dsl ^ (dr << 2) ^ ((wid & 1) << 1)) * 8;
#define DMA_K(t) do { const size_t off_ = (size_t)(t) * 64 * INW; const unsigned sb_ = lds0 + (unsigned)((t) % 3) * 16384u + wid * 1024; \
        glds16(ks0 + off_, (unsigned)__builtin_amdgcn_readfirstlane(sb_)); glds16(ks0 + off_ + (size_t)32 * INW, (unsigned)__builtin_amdgcn_readfirstlane(sb_ + 8192)); } while (0)
#define DMA_V(t) do { const size_t off_ = (size_t)(t) * 64 * INW; const unsigned sb_ = lds0 + 49152u + (unsigned)((t) & 1) * 16384u + wid * 1024; \
        glds16(vs0 + off_, (unsigned)__builtin_amdgcn_readfirstlane(sb_)); glds16(vs0 + off_ + (size_t)32 * INW, (unsigned)__builtin_amdgcn_readfirstlane(sb_ + 8192)); } while (0)
    int kof[2];
    kof[0] = r16 * 256 + (((mp * 8 + g) ^ r16) << 4); kof[1] = r16 * 256 + (((mp * 8 + 4 + g) ^ r16) << 4);
    const int q4 = r16 >> 2, pq = r16 & 3;
    const int vrow = 49152 + (4 * g + q4) * 256 + (pq & 1) * 8, vx = (q4 << 2) ^ ((g & 1) << 1) ^ (pq >> 1);
    bf16x8 qf[2][2];
    { const bf16* qp = Z + (size_t)(qrow0 + wq * 32 + r16) * INW + Q_OFF + h * 128 + mp * 64 + g * 8;
#pragma unroll
        for (int qb = 0; qb < 2; ++qb)
#pragma unroll
            for (int ks = 0; ks < 2; ++ks) qf[qb][ks] = *(const bf16x8*)(qp + (size_t)qb * 16 * INW + ks * 32); }
    DMA_K(0); DMA_K(1);
    if (mp) __builtin_amdgcn_s_setprio(1);
    f32x4 o[2][8];
#pragma unroll
    for (int qb = 0; qb < 2; ++qb)
#pragma unroll
        for (int db = 0; db < 8; ++db) o[qb][db] = (f32x4){0.f, 0.f, 0.f, 0.f};
    const f32x4 zero4 = {0.f, 0.f, 0.f, 0.f};
    float l0 = 0.f, l1 = 0.f;
    v4u pw[2][2];
    f32x4 S[4][2];
#define ATT_QK(t) do { const LAS unsigned char* kp_ = lds + ((t) % 3) * 16384; \
        _Pragma("unroll") for (int kh = 0; kh < 2; ++kh) { bf16x8 kf_[2][2]; \
            _Pragma("unroll") for (int kb = 0; kb < 2; ++kb) _Pragma("unroll") for (int ks = 0; ks < 2; ++ks) kf_[kb][ks] = *(const LAS bf16x8*)(kp_ + kof[ks] + (2 * kh + kb) * 4096); \
            _Pragma("unroll") for (int kb = 0; kb < 2; ++kb) _Pragma("unroll") for (int qb = 0; qb < 2; ++qb) { \
                S[2 * kh + kb][qb] = __builtin_amdgcn_mfma_f32_16x16x32_bf16(kf_[kb][0], qf[qb][0], zero4, 0, 0, 0); \
                S[2 * kh + kb][qb] = __builtin_amdgcn_mfma_f32_16x16x32_bf16(kf_[kb][1], qf[qb][1], S[2 * kh + kb][qb], 0, 0, 0); } } } while (0)
#define ATT_EXPB(kb) do { _Pragma("unroll") for (int r = 0; r < 4; ++r) { S[kb][0][r] = __builtin_amdgcn_exp2f(S[kb][0][r]); S[kb][1][r] = __builtin_amdgcn_exp2f(S[kb][1][r]); sa_ += S[kb][0][r]; sb_ += S[kb][1][r]; } } while (0)
#define ATT_PACK() do { _Pragma("unroll") for (int qb = 0; qb < 2; ++qb) _Pragma("unroll") for (int s_ = 0; s_ < 2; ++s_) { \
        pw[qb][s_][0] = cvtpk_s(S[2 * s_][qb][0], S[2 * s_][qb][1]); pw[qb][s_][1] = cvtpk_s(S[2 * s_][qb][2], S[2 * s_][qb][3]); \
        pw[qb][s_][2] = cvtpk_s(S[2 * s_ + 1][qb][0], S[2 * s_ + 1][qb][1]); pw[qb][s_][3] = cvtpk_s(S[2 * s_ + 1][qb][2], S[2 * s_ + 1][qb][3]); } } while (0)
#define ATT_VLOAD(V, t, dg) do { const LAS unsigned char* vp_ = lds + ((t) & 1) * 16384 + vrow; \
        _Pragma("unroll") for (int dbl = 0; dbl < 2; ++dbl) { const int va_ = ((2 * (2 * (dg) + dbl)) ^ vx) << 4; \
            _Pragma("unroll") for (int s_ = 0; s_ < 2; ++s_) { V[(dbl * 2 + s_) * 2] = vtr(vp_ + va_ + s_ * 8192); V[(dbl * 2 + s_) * 2 + 1] = vtr(vp_ + va_ + s_ * 8192 + 4096); } } } while (0)
#define VFR(V, i) (bf16x8){V[2 * (i)][0], V[2 * (i)][1], V[2 * (i)][2], V[2 * (i)][3], V[2 * (i) + 1][0], V[2 * (i) + 1][1], V[2 * (i) + 1][2], V[2 * (i) + 1][3]}
#define ATT_PVG(V, dg) do { _Pragma("unroll") for (int dbl = 0; dbl < 2; ++dbl) _Pragma("unroll") for (int qb = 0; qb < 2; ++qb) _Pragma("unroll") for (int s_ = 0; s_ < 2; ++s_) \
            o[qb][2 * (dg) + dbl] = __builtin_amdgcn_mfma_f32_16x16x32_bf16(__builtin_bit_cast(bf16x8, pw[qb][s_]), VFR(V, dbl * 2 + s_), o[qb][2 * (dg) + dbl], 0, 0, 0); } while (0)
#define ATT_PVX(V, dg) do { ATT_PVG(V, dg); ATT_EXPB(dg); \
        _Pragma("unroll") for (int i_ = 0; i_ < 4; ++i_) { __builtin_amdgcn_sched_group_barrier(0x008, 2, 0); __builtin_amdgcn_sched_group_barrier(0x400, 2, 0); __builtin_amdgcn_sched_group_barrier(0x002, 2, 0); } \
        __builtin_amdgcn_sched_barrier(0); } while (0)
#define ATT_TOP(t) do { if ((t) + 1 < NT) ATT_WAIT_BAR(2); else ATT_WAIT_BAR(0); DMA_V(t); if ((t) + 2 < NT) DMA_K((t) + 2); } while (0)
#define ATT_LGKM(n) asm volatile("s_waitcnt lgkmcnt(" #n ")" ::: "memory")
    { float sa_ = 0.f, sb_ = 0.f; ATT_TOP(0); ATT_QK(0); ATT_EXPB(0); ATT_EXPB(1); ATT_EXPB(2); ATT_EXPB(3); l0 += sa_; l1 += sb_; ATT_PACK(); }
    s16x4 va[8], vb[8];
    for (int t = 1; t < NT; ++t) {
        float sa_ = 0.f, sb_ = 0.f;
        ATT_TOP(t);
        ATT_VLOAD(va, t - 1, 0); __builtin_amdgcn_sched_barrier(0);
        ATT_QK(t); __builtin_amdgcn_sched_barrier(0);
        ATT_VLOAD(vb, t - 1, 1); ATT_LGKM(8); __builtin_amdgcn_sched_barrier(0);
        ATT_PVX(va, 0);
        ATT_VLOAD(va, t - 1, 2); ATT_LGKM(8); __builtin_amdgcn_sched_barrier(0);
        ATT_PVX(vb, 1);
        ATT_VLOAD(vb, t - 1, 3); ATT_LGKM(8); __builtin_amdgcn_sched_barrier(0);
        ATT_PVX(va, 2);
        ATT_LGKM(0); __builtin_amdgcn_sched_barrier(0);
        ATT_PVX(vb, 3);
        l0 += sa_; l1 += sb_;
        ATT_PACK(); }
    ATT_WAIT_BAR(0);
    ATT_VLOAD(va, NT - 1, 0); ATT_VLOAD(vb, NT - 1, 1); ATT_LGKM(8); ATT_PVG(va, 0); __builtin_amdgcn_sched_barrier(0);
    ATT_VLOAD(va, NT - 1, 2); ATT_LGKM(8); ATT_PVG(vb, 1); __builtin_amdgcn_sched_barrier(0);
    ATT_VLOAD(vb, NT - 1, 3); ATT_LGKM(8); ATT_PVG(va, 2); __builtin_amdgcn_sched_barrier(0);
    ATT_LGKM(0); ATT_PVG(vb, 3);
#undef DMA_K
#undef DMA_V
#undef ATT_QK
#undef ATT_EXPB
#undef ATT_PACK
#undef ATT_VLOAD
#undef VFR
#undef ATT_PVG
#undef ATT_PVX
#undef ATT_TOP
#undef ATT_LGKM
    __builtin_amdgcn_s_setprio(0);
    l0 += xor16_f(l0); l0 = sum32_f(l0); l1 += xor16_f(l1); l1 = sum32_f(l1);
    LAS float* wsf = (LAS float*)(lds + ATT_WS) + wid * 64;
    if (g == 0) { wsf[r16] = l0; wsf[16 + r16] = l1; }
    LDS_WAIT();
    float rl[2][4];
#pragma unroll
    for (int qb = 0; qb < 2; ++qb)
#pragma unroll
        for (int r = 0; r < 4; ++r) rl[qb][r] = __builtin_amdgcn_rcpf(wsf[16 * qb + 4 * g + r]) * (mp ? lam : 1.0f);
    ATT_WAIT_BAR(0);
    LAS float* stg = (LAS float*)lds + wq * (32 * 132);
    if (mp == 1) {
#pragma unroll
        for (int qb = 0; qb < 2; ++qb)
#pragma unroll
            for (int db = 0; db < 8; ++db)
#pragma unroll
                for (int r = 0; r < 4; ++r) stg[(16 * qb + 4 * g + r) * 132 + 16 * db + r16] = o[qb][db][r] * rl[qb][r];
    }
    ATT_WAIT_BAR(0);
    if (mp == 0) {
#pragma unroll
        for (int qb = 0; qb < 2; ++qb)
#pragma unroll
            for (int db = 0; db < 8; ++db)
#pragma unroll
                for (int r = 0; r < 4; ++r) { const int ix = (16 * qb + 4 * g + r) * 132 + 16 * db + r16; stg[ix] = o[qb][db][r] * rl[qb][r] - stg[ix]; }
        LDS_WAIT();
        const int q = lane >> 1, half = lane & 1; const LAS float* rp = stg + q * 132 + half * 64;
        f32x4 v[16]; float ss = 0.f;
#pragma unroll
        for (int i = 0; i < 16; ++i) { v[i] = *(const LAS f32x4*)(rp + 4 * i); ss += (v[i].x * v[i].x + v[i].y * v[i].y) + (v[i].z * v[i].z + v[i].w * v[i].w); }
        ss += xor1_f(ss);
        const float rinv = __builtin_amdgcn_rsqf(ss * (1.0f / 128.0f) + 1e-6f) * oscale;
        bf16* yp = Y + (size_t)(qrow0 + wq * 32 + q) * DM + 512 + h * 128 + half * 64;
        const f32x4* sgp = (const f32x4*)(sg + half * 64);
#pragma unroll
        for (int i = 0; i < 8; ++i) { const f32x4 a0 = v[2 * i] * sgp[2 * i] * rinv, a1 = v[2 * i + 1] * sgp[2 * i + 1] * rinv;
            v4u w; w.x = pk2(a0.x, a0.y); w.y = pk2(a0.z, a0.w); w.z = pk2(a1.x, a1.y); w.w = pk2(a1.z, a1.w); *(v4u*)(yp + 8 * i) = w; }
    }
    ATT_WAIT_BAR(0);
}

__device__ __forceinline__ void phase_mixers(const Args& a, int li, LAS unsigned char* lds, int G, int bx) {
    unsigned char* ws = fresh_ptr(a.ws);
    for (int rep = 0; rep <= DUP_HY; ++rep) if (PHEN(13)) for (int c = bx; c < 256; c += G) hyena_unit(a, li, G == 256 ? (((c & 7) << 5) | (c >> 3)) : c, lds);
    for (int rep = 0; rep <= DUP_POOL; ++rep) if (PHEN(14)) { pool_load_lin(a, li, lds);
    for (int p = bx; p < 512; p += G) pool_unit(a, li, p, lds);
    for (int cp = bx; cp < 256; cp += G) pool_ctx_pair(a, li, cp, lds); }
    if (!PHEN(15)) return;
    const float* qkg = AIN(22) + li * 128; const float* dl = AIN(23) + li * 256; const float* sg = AIN(24) + li * 128;
    float mq = 0.f, mk = 0.f, d1 = 0.f, d2 = 0.f;
    for (int q = 0; q < 64; ++q) { mq = __builtin_fmaxf(mq, __builtin_fabsf(qkg[q])); mk = __builtin_fmaxf(mk, __builtin_fabsf(qkg[64 + q])); d1 += dl[q] * dl[64 + q]; d2 += dl[128 + q] * dl[192 + q]; }
    const float lam_init = 0.8f - 0.6f * __expf(-0.3f * (float)li);
    const float lam = __expf(d1) - __expf(d2) + lam_init;
    const float negb = -(64.0f * mq * mk * C2);
    const bf16* Z = (const bf16*)(ws + WS_Z); bf16* Y = (bf16*)(ws + WS_Y);
    for (int rep = 0; rep <= DUP_ATT; ++rep)
    for (int i = 0; i * G + bx < 1024; ++i) {
        int bh, qb;
        if (G == 256) { const int vcu = (bx & 7) * 32 + (bx >> 3); bh = vcu >> 5; qb = (vcu & 31) + 32 * i; } else { const int u = i * G + bx; bh = u >> 7; qb = u & 127; }
        const int b = bh >> 2, h = bh & 3;
        attn_unit16(lds, Z, b * RB + CTXL + qb * 128, b * RB, RB / 64, h, lam, 1.0f - lam_init, sg, Y);
    }
    if (li < DEPTH - 1) for (int u = bx; u < 16; u += G) { const int b = u >> 3, h = (u >> 1) & 3, qh = u & 1;
        attn_unit16(lds, Z, b * RB + qh * 128, b * RB, CTXL / 64, h, lam, 1.0f - lam_init, sg, Y); }
}

constexpr int NPHASES = 2 * 9 + 2 * 13 - 6 + 1;
__global__ void __launch_bounds__(NTHR, 2) fwd(Args a) {
    extern __shared__ __attribute__((aligned(16))) unsigned char lds_raw[];
    LAS unsigned char* lds = (LAS unsigned char*)lds_raw;
    volatile LAS unsigned* MISC = (volatile LAS unsigned*)(lds + MISC_OFF);
    const int tid = threadIdx.x, G = gridDim.x, bx = blockIdx.x;
    if (tid < 128) MISC[tid] = 0u;
    if (tid < 64) ((LAS unsigned*)(lds + PTAB_OFF))[tid] = ((const __attribute__((address_space(4))) unsigned*)__builtin_amdgcn_kernarg_segment_ptr())[tid];
    __syncthreads();
    const int lo = a.ph_lo, hi = a.ph_hi;
    unsigned* ctl = (unsigned*)(fresh_ptr(a.ws) + WS_CTL);
    XcdBarrier bar; bar.bar = ctl + CW_BAR; bar.x = 0; bar.st = MISC + 8;
    if (hi - lo > 1) bar = xcd_barrier_post(ctl + CW_BAR, MISC + 8);
    int ph = 0;
#define ON() (ph >= lo && ph < hi)
#define ENDPH() do { if (ON() && ph + 1 < hi) xcd_barrier(bar); ++ph; } while (0)
#define WSP(off) (fresh_ptr(a.ws) + (off))
#define XN ((bf16*)WSP(WS_XN))
#define Zb ((bf16*)WSP(WS_Z))
#define Yb ((bf16*)WSP(WS_Y))
#define HID ((bf16*)WSP(WS_HID))
#define win_t ((bf16*)WSP(WS_WIN))
#define wout_t ((bf16*)WSP(WS_WOUT))
#define wup_t ((bf16*)WSP(WS_WUP))
#define wdn_t ((bf16*)WSP(WS_WDN))
#define XBp ((bf16*)WSP(WS_XB))
#define WSB WSP(0)
#define modl ((const float*)WSP(WS_MOD) + (size_t)li * 3 * 6144)
    for (int li = 0; li < DEPTH; ++li) {
        const bool moe = (li & 1) != 0;
        if (li == 0) {
            if (PHEN(0) && ON()) phase_prep_a(a, li, lds, G, bx);
            ENDPH();
            if (PHEN(1) && ON()) phase_prep_b(a, li, lds, G, bx);
            ENDPH();
            if (PHEN(2) && ON()) phase_norm(a, li, 0, true, lds, G, bx);
            ENDPH();
        } else {
            if (ON()) { if (PHEN(0)) phase_prep_a(a, li, lds, G, bx); if (PHEN(1)) phase_prep_b(a, li, lds, G, bx); if (PHEN(2)) phase_norm(a, li, 0, false, lds, G, bx); }
            ENDPH();
        }
        for (int rep = 0; rep <= DUP_GEMM; ++rep) if (PHEN(3) && ON()) { pg8::Gemm g{XN, win_t, MROWS, INW, DM}; pg8::StaticOrder S; S.init(MROWS, INW, DM, G, bx);
            EpiIn E{Zb, (bf16*)(WSB + WS_ZT), (bf16*)(WSB + WS_ZTC), (const float*)(WSB + WS_ROPE), (const float*)(WSB + WS_ROPE) + 4096, AIN(22) + li * 128};
            pg8::gemm_phase<EpiIn, pg8::StaticOrder, true, true>(lds, g, S, E); }
        ENDPH();
        if (PHEN(4) && ON()) phase_mixers(a, li, lds, G, bx);
        ENDPH();
        if (PHEN(5) && ON()) { pg8::Gemm g{Yb, wout_t, MROWS, DM, DM}; SplitTailOrder S; S.init(DM, DM, G, bx);
            EpiRes E{XBp, modl + 2 * DM, DM / 64, (float*)(WSB + WS_SLAB), 1.f};
            pg8::gemm_phase<EpiRes, SplitTailOrder, true, true>(lds, g, S, E); }
        ENDPH();
        if (!moe) {
            if (PHEN(6) && ON()) phase_norm(a, li, 3, false, lds, G, bx);
            ENDPH();
            for (int rep = 0; rep <= DUP_GEMM; ++rep) if (PHEN(7) && ON()) { pg8::Gemm g{XN, wup_t, MROWS, 2 * DFF, DM}; pg8::StaticOrder S; S.init(MROWS, 2 * DFF, DM, G, bx);
                EpiGlu E{HID, DFF, DFF / 128};
                pg8::gemm_phase<EpiGlu, pg8::StaticOrder, true, true>(lds, g, S, E); }
            ENDPH();
            if (PHEN(8) && ON()) { pg8::Gemm g{HID, wdn_t, MROWS, DM, DFF}; SplitTailOrder S; S.init(DM, DFF, G, bx);
                EpiRes E{XBp, modl + 5 * DM, DFF / 64, (float*)(WSB + WS_SLAB), 1.f};
                pg8::gemm_phase<EpiRes, SplitTailOrder, true, true>(lds, g, S, E); }
            ENDPH();
        } else {
            const LAS int* tab = (const LAS int*)(lds + TAB_OFF);
            if (PHEN(9) && ON()) phase_norm_router(a, li, lds, G, bx);
            ENDPH();
            if (PHEN(10) && ON()) phase_moe_gather(a, li, lds, G, bx);
            ENDPH();
            for (int rep = 0; rep <= DUP_GEMM; ++rep) if (PHEN(11) && ON()) { moe_tables(a, li >> 1, lds, G, bx);
                pg8::Gemm g{XN, wup_t, 0, 0, DM}; MoeOrder S{G, bx, 2 * DFE / 256, 0, tab[16] * (2 * DFE / 256), tab, DM / 64, (const int*)(WSB + WS_RTOK)};
                EpiGlu E{HID, DFE, DFE / 128};
                pg8::gemm_phase<EpiGlu, MoeOrder, true, true, true>(lds, g, S, E); }
            ENDPH();
            for (int k = 0; k < 2; ++k) {
                if (PHEN(12) && ON()) { moe_tables(a, li >> 1, lds, G, bx);
                    pg8::Gemm g{HID, wdn_t, 0, 0, DFE}; MoeDownOrder S; S.init(G, bx, k, tab);
                    EpiMoeDown E{XBp, modl + 5 * DM, (const int*)(WSB + WS_RTOK), (const float*)(WSB + WS_RGATE), tab, (float*)(WSB + WS_SLAB), 1.f};
                    pg8::gemm_phase<EpiMoeDown, MoeDownOrder, true, true>(lds, g, S, E); }
                ENDPH();
            }
            for (int k = 0; k < 2; ++k) { if (ON()) phase_moe_fix(a, li, k, lds, G, bx); ENDPH(); }
        }
    }
    if (ON()) phase_final(a, G, bx);
    ++ph;
#undef ON
#undef ENDPH
#undef WSP
#undef XN
#undef Zb
#undef Yb
#undef HID
#undef win_t
#undef wout_t
#undef wup_t
#undef wdn_t
#undef XBp
#undef WSB
#undef modl
}

extern "C" void kernel_launch(void* const* d_in, const int* in_sizes, int n_in, void* d_out, int out_size, void* d_ws, size_t ws_size, hipStream_t stream) {
    static int grid = 0;
    if (grid == 0) {
        if (n_in != 32 || in_sizes[0] != NB * SEQ * DM || out_size != NB * SEQ * DM || ws_size < WS_END) {
            fprintf(stderr, "kernel_launch: unexpected problem: n_in %d in0 %d out %d ws %zu (need %zu)\n", n_in, n_in > 0 ? in_sizes[0] : -1, out_size, ws_size, (size_t)WS_END); grid = -1; return; }
        int dev = 0, cus = 0, per_cu = 0;
        if (hipGetDevice(&dev) != hipSuccess || hipDeviceGetAttribute(&cus, hipDeviceAttributeMultiprocessorCount, dev) != hipSuccess) { grid = -1; return; }
        if (hipFuncSetAttribute((const void*)fwd, hipFuncAttributeMaxDynamicSharedMemorySize, LDS_BYTES) != hipSuccess) { fprintf(stderr, "kernel_launch: hipFuncSetAttribute failed\n"); grid = -1; return; }
        if (hipOccupancyMaxActiveBlocksPerMultiprocessor(&per_cu, (const void*)fwd, NTHR, LDS_BYTES) != hipSuccess || per_cu < 1) { fprintf(stderr, "kernel_launch: occupancy query says %d\n", per_cu); }
        (void)hipGetLastError();
        grid = cus;
    }
    if (grid < 0) return;
    (void)hipMemsetAsync((char*)d_ws + WS_CTL, 0, CTL_ZERO_BYTES, stream);
    Args a{};
    for (int i = 0; i < 32; ++i) a.in[i] = (const float*)d_in[i];
    a.out = (float*)d_out; a.ws = (unsigned char*)d_ws;
#if MK_ONE_LAUNCH
    a.ph_lo = 0; a.ph_hi = NPHASES;
    hipLaunchKernelGGL(fwd, dim3(grid), dim3(NTHR), LDS_BYTES, stream, a);
#else
    for (int p = 0; p < NPHASES; ++p) { a.ph_lo = p; a.ph_hi = p + 1; hipLaunchKernelGGL(fwd, dim3(grid), dim3(NTHR), LDS_BYTES, stream, a); }
#endif
}
```

```cpp
#include <hip/hip_runtime.h>
#include <cstdio>
#include <cstdint>

#ifndef MK_ONE_LAUNCH
#define MK_ONE_LAUNCH 1
#endif
#ifndef PH_MASK
#define PH_MASK 0xFFFF
#endif
#define PHEN(n) (((PH_MASK) >> (n)) & 1)
#define DUP_ATT 0
#define DUP_HY 0
#define DUP_POOL 0
#define DUP_PREP 0
#define DUP_PREPB 0
#define DUP_GEMM 0
#define DUP_ADD 0

#define GAS __attribute__((address_space(1)))
#define LAS __attribute__((address_space(3)))
typedef unsigned short bf16;
typedef unsigned v4u __attribute__((ext_vector_type(4)));
typedef unsigned v2u __attribute__((ext_vector_type(2)));
typedef float f32x4 __attribute__((ext_vector_type(4)));
typedef float f32x2 __attribute__((ext_vector_type(2)));
typedef float f32x16 __attribute__((ext_vector_type(16)));
typedef short bf16x8 __attribute__((ext_vector_type(8)));
typedef short s16x4 __attribute__((ext_vector_type(4)));
typedef short v4i16_t __attribute__((ext_vector_type(4)));

constexpr int DM = 1024, NB = 2, SEQ = 16384, DEPTH = 4, CTXL = 256;
constexpr int RB = CTXL + SEQ;
constexpr int MROWS = NB * RB;
constexpr int TPB = RB / 256;
constexpr int INW = 2560, Q_OFF = 1024, K_OFF = 1536, V_OFF = 2048;
constexpr int DFF = 2816, DFE = 3584, NEXP = 8;
constexpr int NWAVES = 8, NTHR = 512;
constexpr int SEGCAP = MROWS;
constexpr float C2 = 0.125f * 1.4426950408889634f;

constexpr size_t MiB = 1u << 20;
constexpr size_t WS_CTL = 0, CTL_ZERO_BYTES = 1 * MiB;
constexpr size_t WS_MODP = 1 * MiB;
constexpr size_t WS_MOD = 4 * MiB;
constexpr size_t WS_ROPE = 4 * MiB + 512 * 1024;
constexpr size_t WS_H2C = 4 * MiB + 640 * 1024;
constexpr size_t WS_KCTX = 5 * MiB;
constexpr size_t WS_HCTX = 6 * MiB;
constexpr size_t WS_H2 = 8 * MiB;
constexpr size_t WS_RTOK = 12 * MiB;
constexpr size_t WS_RGATE = 15 * MiB;
constexpr size_t WS_RREC = 18 * MiB;
constexpr size_t WS_RRECG = 18 * MiB + 256 * 1024;
constexpr size_t WS_CNTB = 18 * MiB + 512 * 1024;
constexpr size_t WS_H2B = 19 * MiB;
constexpr size_t WS_W = 32 * MiB;
constexpr size_t WS_WIN = WS_W, WS_WOUT = WS_W + 5 * MiB, WS_WUP = WS_W + 8 * MiB, WS_WDN = WS_W + 120 * MiB;
constexpr size_t WS_XN = 224 * MiB;
constexpr size_t WS_Z = 289 * MiB;
constexpr size_t WS_ZT = 452 * MiB;
constexpr size_t WS_ZTC = WS_ZT + 48 * MiB;
constexpr size_t WS_Y = 501 * MiB;
constexpr size_t WS_HF = 566 * MiB;
constexpr size_t WS_HID = 289 * MiB;
constexpr size_t WS_AG = 772 * MiB;
constexpr size_t WS_SLAB = 910 * MiB;
constexpr size_t WS_END = 974 * MiB;

constexpr int CW_TMO = 0, CW_BAR = 4096, CW_MOECNT = 8192;

constexpr int LDS_BYTES = 159744;
constexpr int MISC_OFF = 155648;
constexpr int TAB_OFF = MISC_OFF + 256;

__device__ __forceinline__ unsigned f2bf(float f) { unsigned u = __builtin_bit_cast(unsigned, f); return (u + 0x7fffu + ((u >> 16) & 1u)) >> 16; }
__device__ __forceinline__ unsigned pk2(float lo, float hi) { return f2bf(lo) | (f2bf(hi) << 16); }
__device__ __forceinline__ float bf2f(bf16 b) { return __builtin_bit_cast(float, (unsigned)b << 16); }
template <int CTRL> __device__ __forceinline__ float dpp_f(float v) { return __builtin_bit_cast(float, __builtin_amdgcn_mov_dpp(__builtin_bit_cast(int, v), CTRL, 0xf, 0xf, true)); }
__device__ __forceinline__ float xor1_f(float v) { return dpp_f<0xB1>(v); }
__device__ __forceinline__ float xor2_f(float v) { return dpp_f<0x4E>(v); }
__device__ __forceinline__ float xor16_f(float v) { return __builtin_bit_cast(float, __builtin_amdgcn_ds_swizzle(__builtin_bit_cast(int, v), 0x401F)); }
__device__ __forceinline__ float xor32_f(float v) { auto rr = __builtin_amdgcn_permlane32_swap(__builtin_bit_cast(unsigned, v), __builtin_bit_cast(unsigned, v), false, false);
    return __builtin_bit_cast(float, (unsigned)rr[0]) == v ? __builtin_bit_cast(float, (unsigned)rr[1]) : __builtin_bit_cast(float, (unsigned)rr[0]); }
__device__ __forceinline__ float sum32_f(float v) { auto rr = __builtin_amdgcn_permlane32_swap(__builtin_bit_cast(unsigned, v), __builtin_bit_cast(unsigned, v), false, false);
    return __builtin_bit_cast(float, (unsigned)rr[0]) + __builtin_bit_cast(float, (unsigned)rr[1]); }
__device__ __forceinline__ float wave_sum(float v) {
    v += xor1_f(v); v += xor2_f(v); v += dpp_f<0x141>(v)  ; v += dpp_f<0x140>(v)  ; v += xor16_f(v);
    auto rr = __builtin_amdgcn_permlane32_swap(__builtin_bit_cast(unsigned, v), __builtin_bit_cast(unsigned, v), false, false);
    return __builtin_bit_cast(float, (unsigned)rr[0]) + __builtin_bit_cast(float, (unsigned)rr[1]);
}
__device__ __forceinline__ float sin_rev(float r) { return __builtin_amdgcn_sinf(__builtin_amdgcn_fractf(r)); }
__device__ __forceinline__ float cos_rev(float r) { return __builtin_amdgcn_cosf(__builtin_amdgcn_fractf(r)); }
__device__ __forceinline__ float sin_rad(float x) { return sin_rev(x * 0.15915494309189535f); }
__device__ __forceinline__ int fresh_tid() { int t = threadIdx.x; asm volatile("" : "+v"(t)); return t; }
template <class T> __device__ __forceinline__ T* fresh_ptr(T* p) { asm volatile("" : "+s"(p)); return p; }
#define LDS_WAIT() asm volatile("s_waitcnt lgkmcnt(0)" ::: "memory")
#define VM_WAIT() asm volatile("s_waitcnt vmcnt(0)" ::: "memory")

namespace pg8 {
typedef unsigned short bf16_t;
typedef unsigned u32x4 __attribute__((ext_vector_type(4)));
constexpr int BM = 256, BK = 64, HALF = 128, HTB = HALF * BK * 2, STAGE_BYTES = 8 * HTB, NXCD = 8, WGM = 8;
__host__ __device__ __forceinline__ int lds_byte(int r, int c) { const int st = (r >> 4) * 2 + (c >> 5), rr = r & 15, cc = c & 31, ob = rr * 64 + cc * 2; return st * 1024 + (ob ^ (((ob >> 9) & 1) << 5)); }
__host__ __device__ __forceinline__ void stage_rc(int b, int& R, int& C) { const int st = b / 1024, sb = b % 1024, swz = sb ^ (((sb >> 9) & 1) << 5); R = (st >> 1) * 16 + swz / 64; C = (st & 1) * 32 + (swz % 64) / 2; }
__host__ __device__ __forceinline__ int perm32(int rho) { const int n = rho >> 4, i = rho & 15; return 8 * (i >> 2) + 4 * n + (i & 3); }
struct Unit { int pm, pn, ko, nt, sl; };
struct Gemm { const bf16_t* A; const bf16_t* Bt; int M, N, K; };
struct StaticOrder {
    int nM, nN, nwg, G, c;
    int ntk;
    __host__ __device__ void init(int M, int N, int K, int G_, int c_) { nM = M / BM; nN = N / BM; nwg = nM * nN; G = G_; c = c_; ntk = K / BK; }
    __host__ __device__ __forceinline__ bool next(int i, Unit& u) const { return map((long)i * G + c, u); }
    __host__ __device__ __forceinline__ bool map(long L, Unit& u) const {
        if (L >= nwg) return false; u.ko = 0; u.nt = ntk; u.sl = -1;
        int wgid = (int)L; { const int q = nwg / NXCD, r = nwg % NXCD, xcd = wgid % NXCD, off = wgid / NXCD; wgid = (xcd < r ? xcd * (q + 1) : r * (q + 1) + (xcd - r) * q) + off; }
        const int nig = WGM * nN, gid = wgid / nig, fm = gid * WGM, gsz = (nM - fm) < WGM ? (nM - fm) : WGM;
        u.pm = fm + ((wgid % nig) % gsz); u.pn = (wgid % nig) / gsz; return true;
    }
    __device__ __forceinline__ void a_ready(const Unit&) const {}
    __device__ __forceinline__ void done(const Unit&) const {}
};
__device__ __forceinline__ unsigned cvt_pk_bf16(float lo, float hi) { unsigned r; asm volatile("v_cvt_pk_bf16_f32 %0, %1, %2" : "=v"(r) : "v"(lo), "v"(hi)); return r; }

template <class Epi, class Sched, bool ALIGN_EPI = false, bool SP2 = false>
__device__ __forceinline__ void gemm_phase(LAS unsigned char* lds, const Gemm g, const Sched& S, const Epi& E) {
    const int tid = fresh_tid(), wid = __builtin_amdgcn_readfirstlane(tid >> 6), lane = tid & 63, wr = wid >> 2, wc = wid & 3, fr = lane & 15, fq = lane >> 4;
    const int K = g.K;
    unsigned voffA[2], voffB[2];
#pragma unroll
    for (int i = 0; i < 2; ++i) { int R, C; stage_rc(tid * 16 + i * 8192, R, C); const int Rb = Epi::PERM ? ((R & ~31) + perm32(R & 31)) : R;
        voffA[i] = (unsigned)(R * K + C) * 2u; voffB[i] = (unsigned)(Rb * K + C) * 2u; }
    const size_t kstep = (size_t)(BK * 2);
    const size_t hstep = (size_t)HALF * K * 2;
    const size_t tstep = 2 * hstep;
    const unsigned ldsw = (unsigned)wid * 1024u;
    const int aoff = lds_byte(wr * 64 + fr, fq * 8), boff = lds_byte(wc * 32 + fr, fq * 8);
#define PG8_SA(b, h) (((b) * 2 + (h)) * HTB)
#define PG8_SB(b, h) ((4 + (b) * 2 + (h)) * HTB)
#define PG8_STAGE(bufoff, gbase, voff) do { _Pragma("unroll") for (int _i = 0; _i < 2; ++_i) \
        __builtin_amdgcn_global_load_lds((const unsigned*)((const char*)(gbase) + (voff)[_i]), (LAS unsigned*)(lds + (bufoff) + ldsw + _i * 8192), 16, 0, 0); } while (0)
#define PG8_LDA(dst, b, h) do { _Pragma("unroll") for (int m = 0; m < 4; ++m) _Pragma("unroll") for (int k = 0; k < 2; ++k) dst[m][k] = *(const LAS bf16x8*)(lds + PG8_SA(b, h) + aoff + m * 2048 + k * 1024); } while (0)
#define PG8_LDB(dst, b, h) do { _Pragma("unroll") for (int n = 0; n < 2; ++n) _Pragma("unroll") for (int k = 0; k < 2; ++k) dst[n][k] = *(const LAS bf16x8*)(lds + PG8_SB(b, h) + boff + n * 2048 + k * 1024); } while (0)
#define PG8_MMA(ai, bj, At, Bt) do { __builtin_amdgcn_s_setprio(1); _Pragma("unroll") for (int m = 0; m < 4; ++m) _Pragma("unroll") for (int n = 0; n < 2; ++n) _Pragma("unroll") for (int k = 0; k < 2; ++k) \
        acc[ai][bj][m][n] = __builtin_amdgcn_mfma_f32_16x16x32_bf16(Bt[n][k], At[m][k], acc[ai][bj][m][n], 0, 0, 0); __builtin_amdgcn_s_setprio(0); } while (0)
#define PG8_WAIT_V(n) asm volatile("s_waitcnt vmcnt(" #n ")" ::: "memory")
#define PG8_WAIT_L(n) asm volatile("s_waitcnt lgkmcnt(" #n ")" ::: "memory")
#define PG8_BAR __builtin_amdgcn_s_barrier()
#define PG8_SCHED __builtin_amdgcn_sched_barrier(0)
    Unit cur, nxt; int ui = 0;
    if (!S.next(0, cur)) return;
    f32x4 acc[2][2][4][2];
#pragma unroll
    for (int a = 0; a < 2; ++a)
#pragma unroll
        for (int b = 0; b < 2; ++b)
#pragma unroll
            for (int m = 0; m < 4; ++m)
#pragma unroll
                for (int n = 0; n < 2; ++n) acc[a][b][m][n] = (f32x4){0.f, 0.f, 0.f, 0.f};
    bf16x8 At[4][2], B0[2][2], B1[2][2];
    const char* cA = (const char*)g.A + (size_t)cur.pm * tstep + (size_t)cur.ko * 2; const char* cB = (const char*)g.Bt + (size_t)cur.pn * tstep + (size_t)cur.ko * 2;
    S.a_ready(cur);
    if constexpr (SP2) {
        PG8_STAGE(PG8_SB(0, 0), cB, voffB); PG8_STAGE(PG8_SB(0, 1), cB + hstep, voffB); PG8_STAGE(PG8_SA(0, 0), cA, voffA); PG8_STAGE(PG8_SA(0, 1), cA + hstep, voffA);
        if (wr == 1) PG8_BAR;
        PG8_WAIT_V(2); PG8_BAR;
        PG8_STAGE(PG8_SB(1, 0), cB + kstep, voffB); PG8_STAGE(PG8_SA(1, 0), cA + kstep, voffA); PG8_STAGE(PG8_SB(1, 1), cB + hstep + kstep, voffB);
        PG8_WAIT_V(6); PG8_BAR;
    } else {
        PG8_STAGE(PG8_SB(0, 0), cB, voffB); PG8_STAGE(PG8_SA(0, 0), cA, voffA); PG8_STAGE(PG8_SB(0, 1), cB + hstep, voffB); PG8_STAGE(PG8_SA(0, 1), cA + hstep, voffA);
        if (wr == 1) PG8_BAR;
        PG8_WAIT_V(4); PG8_BAR;
        PG8_STAGE(PG8_SB(1, 0), cB + kstep, voffB); PG8_STAGE(PG8_SA(1, 0), cA + kstep, voffA); PG8_STAGE(PG8_SB(1, 1), cB + hstep + kstep, voffB);
        PG8_WAIT_V(6); PG8_BAR;
    }
    for (;;) {
        const bool has_next = S.next(ui + 1, nxt);
        const char* nA = has_next ? (const char*)g.A + (size_t)nxt.pm * tstep + (size_t)nxt.ko * 2 : cA; const char* nB = has_next ? (const char*)g.Bt + (size_t)nxt.pn * tstep + (size_t)nxt.ko * 2 : cB;
        const int nt = cur.nt;
        for (int t = 0; t < nt; t += 2) {
            const bool last = (t == nt - 2);
            const char* a1 = cA + (size_t)(t + 1) * kstep;
            const char* a2 = last ? nA : cA + (size_t)(t + 2) * kstep; const char* b2 = last ? nB : cB + (size_t)(t + 2) * kstep;
            const char* a3 = a2 + kstep; const char* b3 = b2 + kstep;
            if (last && has_next) S.a_ready(nxt);
            if constexpr (SP2) {
            PG8_LDB(B0, 0, 0); PG8_LDB(B1, 0, 1); PG8_SCHED; PG8_LDA(At, 0, 0); PG8_STAGE(PG8_SA(1, 1), a1 + hstep, voffA);
            PG8_WAIT_V(8); PG8_WAIT_L(0); PG8_BAR; PG8_MMA(0, 0, At, B0); PG8_MMA(0, 1, At, B1); PG8_BAR; PG8_SCHED;
            PG8_LDA(At, 0, 1); PG8_STAGE(PG8_SB(0, 0), b2, voffB); PG8_STAGE(PG8_SB(0, 1), b2 + hstep, voffB); PG8_STAGE(PG8_SA(0, 0), a2, voffA);
            PG8_WAIT_V(8); PG8_WAIT_L(0); PG8_BAR; PG8_MMA(1, 0, At, B0); PG8_MMA(1, 1, At, B1); PG8_BAR; PG8_SCHED;
            PG8_LDB(B0, 1, 0); PG8_LDB(B1, 1, 1); PG8_SCHED; PG8_LDA(At, 1, 0); PG8_STAGE(PG8_SA(0, 1), a2 + hstep, voffA);
            PG8_WAIT_V(8); PG8_WAIT_L(0); PG8_BAR; PG8_MMA(0, 0, At, B0); PG8_MMA(0, 1, At, B1); PG8_BAR; PG8_SCHED;
            PG8_LDA(At, 1, 1); PG8_STAGE(PG8_SB(1, 0), b3, voffB); PG8_STAGE(PG8_SB(1, 1), b3 + hstep, voffB); PG8_STAGE(PG8_SA(1, 0), a3, voffA);
            PG8_WAIT_V(8); PG8_WAIT_L(0); PG8_BAR; PG8_MMA(1, 0, At, B0); PG8_MMA(1, 1, At, B1); PG8_BAR; PG8_SCHED;
            } else {
            PG8_LDB(B0, 0, 0); PG8_SCHED; PG8_LDA(At, 0, 0); PG8_STAGE(PG8_SA(1, 1), a1 + hstep, voffA);
            PG8_WAIT_L(8); PG8_BAR; PG8_WAIT_L(0); PG8_MMA(0, 0, At, B0); PG8_BAR; PG8_SCHED;
            PG8_LDB(B1, 0, 1); PG8_STAGE(PG8_SB(0, 0), b2, voffB);
            PG8_BAR; PG8_WAIT_L(0); PG8_MMA(0, 1, At, B1); PG8_BAR;
            PG8_LDA(At, 0, 1); PG8_STAGE(PG8_SA(0, 0), a2, voffA);
            PG8_BAR; PG8_WAIT_L(0); PG8_MMA(1, 0, At, B0); PG8_BAR; PG8_SCHED;
            PG8_STAGE(PG8_SB(0, 1), b2 + hstep, voffB);
            PG8_WAIT_V(6); PG8_BAR; PG8_MMA(1, 1, At, B1); PG8_BAR;
            PG8_LDB(B0, 1, 0); PG8_SCHED; PG8_LDA(At, 1, 0); PG8_STAGE(PG8_SA(0, 1), a2 + hstep, voffA);
            PG8_WAIT_L(8); PG8_BAR; PG8_WAIT_L(0); PG8_MMA(0, 0, At, B0); PG8_BAR; PG8_SCHED;
            PG8_LDB(B1, 1, 1); PG8_STAGE(PG8_SB(1, 0), b3, voffB);
            PG8_BAR; PG8_WAIT_L(0); PG8_MMA(0, 1, At, B1); PG8_BAR;
            PG8_LDA(At, 1, 1); PG8_STAGE(PG8_SA(1, 0), a3, voffA);
            PG8_BAR; PG8_WAIT_L(0); PG8_MMA(1, 0, At, B0); PG8_BAR; PG8_SCHED;
            PG8_STAGE(PG8_SB(1, 1), b3 + hstep, voffB);
            PG8_WAIT_V(6); PG8_BAR; PG8_MMA(1, 1, At, B1); PG8_BAR;
            }
        }
        if constexpr (ALIGN_EPI) { if (wr == 0) PG8_BAR; }
        E(acc, cur, wr, wc, fr, fq); S.done(cur);
        if (!has_next) break;
#pragma unroll
        for (int a = 0; a < 2; ++a)
#pragma unroll
            for (int b = 0; b < 2; ++b)
#pragma unroll
                for (int m = 0; m < 4; ++m)
#pragma unroll
                    for (int n = 0; n < 2; ++n) acc[a][b][m][n] = (f32x4){0.f, 0.f, 0.f, 0.f};
        cur = nxt; cA = nA; cB = nB; ++ui;
        if constexpr (ALIGN_EPI) { if (wr == 1) PG8_BAR; }
    }
    PG8_WAIT_V(0);
    if constexpr (!ALIGN_EPI) { if (wr == 0) PG8_BAR; }
    PG8_BAR;
#undef PG8_SA
#undef PG8_SB
#undef PG8_STAGE
#undef PG8_LDA
#undef PG8_LDB
#undef PG8_MMA
#undef PG8_WAIT_V
#undef PG8_WAIT_L
#undef PG8_BAR
#undef PG8_SCHED
}
}

#define XB_TMO      128
#define XB_XCNT(j)  (256  + 64 * (j))
#define XB_XSUB(j)  (1280 + 64 * (j))
#define XB_XGEN(j)  (2304 + 64 * (j))
#define XB_TOP      3328
#define XB_TOPGEN   3392
#define XCD_BAR_WORDS 3456
#define XB_SPIN_CAP (1u << 18)
__device__ __forceinline__ unsigned xb_ld(unsigned* p)              { return __hip_atomic_load(p, __ATOMIC_RELAXED, __HIP_MEMORY_SCOPE_AGENT); }
__device__ __forceinline__ unsigned xb_add(unsigned* p, unsigned v) { return __hip_atomic_fetch_add(p, v, __ATOMIC_RELAXED, __HIP_MEMORY_SCOPE_AGENT); }
__device__ __forceinline__ unsigned xb_xcc_id() { return (unsigned)__builtin_amdgcn_s_getreg((3 << 11) | 20) & 0xFu; }
#define XB_SPIN(cond, bar) do { unsigned _sp = 0; while (cond) { __builtin_amdgcn_s_sleep(1); \
    if ((++_sp & 255u) == 0u) { if (xb_ld(&(bar)[XB_TMO])) break; if (_sp > XB_SPIN_CAP) { atomicAdd(&(bar)[XB_TMO], 1u); break; } } } } while (0)
struct XcdBarrier { unsigned* bar; unsigned x; volatile LAS unsigned* st; };
__device__ __forceinline__ XcdBarrier xcd_barrier_post(unsigned* bar, volatile LAS unsigned* st) {
    XcdBarrier b; b.bar = bar; b.x = xb_xcc_id(); b.st = st;
    if (threadIdx.x == 0) (void)xb_add(&bar[XB_XCNT(b.x)], 1u);
    return b;
}
__device__ __forceinline__ void xcd_barrier_complete(unsigned* bar, unsigned x, unsigned& nloc, unsigned& nx) {
    const unsigned G = gridDim.x * gridDim.y * gridDim.z;
    unsigned sum, cnt, mine, sp = 0u;
    for (;;) {
        sum = 0u; cnt = 0u; mine = 0u;
#pragma unroll
        for (unsigned j = 0; j < 16; ++j) { const unsigned c = xb_ld(&bar[XB_XCNT(j)]); sum += c; cnt += (c > 0u) ? 1u : 0u; mine = (j == x) ? c : mine; }
        if (sum == G) break;
        __builtin_amdgcn_s_sleep(1);
        if ((++sp & 255u) == 0u) { if (xb_ld(&bar[XB_TMO])) break; if (sp > XB_SPIN_CAP) { atomicAdd(&bar[XB_TMO], 1u); break; } }
    }
    nloc = mine > 0u ? mine : 1u; nx = cnt > 0u ? cnt : 1u;
}
__device__ __forceinline__ void xcd_barrier(const XcdBarrier& b) {
    asm volatile("s_waitcnt vmcnt(0)" ::: "memory");
    __syncthreads();
    if (threadIdx.x == 0) {
        unsigned* bar = b.bar;
        __builtin_amdgcn_s_waitcnt(0);
        unsigned nloc = b.st[0], nx = b.st[1];
        if (nloc == 0u) { xcd_barrier_complete(bar, b.x, nloc, nx); b.st[0] = nloc; b.st[1] = nx; }
        const unsigned old = xb_add(&bar[XB_XSUB(b.x)], 1u);
        const unsigned gen = old / nloc;
        if (old + 1u == (gen + 1u) * nloc) {
            __builtin_amdgcn_fence(__ATOMIC_RELEASE, "agent");
            asm volatile("s_waitcnt vmcnt(0)" ::: "memory");
            const unsigned og = xb_add(&bar[XB_TOP], 1u);
            const unsigned tg = og / nx;
            if (og + 1u == (tg + 1u) * nx) xb_add(&bar[XB_TOPGEN], 1u);
            else XB_SPIN(xb_ld(&bar[XB_TOPGEN]) == tg, bar);
            __builtin_amdgcn_fence(__ATOMIC_ACQUIRE, "agent");
            xb_add(&bar[XB_XGEN(b.x)], 1u);
            asm volatile("s_waitcnt vmcnt(0)" ::: "memory");
        } else {
            XB_SPIN(xb_ld(&bar[XB_XGEN(b.x)]) == gen, bar);
            __builtin_amdgcn_fence(__ATOMIC_ACQUIRE, "agent");
            asm volatile("s_waitcnt vmcnt(0)" ::: "memory");
        }
    }
    __syncthreads();
}

__device__ __forceinline__ const float* xrow_in(int R, const float* xlat, const float* hctx) {
    const int b = R / RB, rr = R - b * RB;
    return rr < CTXL ? hctx + (size_t)(b * CTXL + rr) * DM : xlat + (size_t)(b * SEQ + rr - CTXL) * DM;
}
__device__ __forceinline__ float* xrow_out(int R, float* xlat, float* hctx) {
    const int b = R / RB, rr = R - b * RB;
    return rr < CTXL ? hctx + (size_t)(b * CTXL + rr) * DM : xlat + (size_t)(b * SEQ + rr - CTXL) * DM;
}
__device__ __forceinline__ int row_set(int R) { const int b = R / RB, rr = R - b * RB; return rr < CTXL ? 2 : b; }

__device__ __forceinline__ int qk_perm(int c) {
    const int bj = c >> 7, wc = (c >> 5) & 3, fq = (c >> 3) & 3, n = (c >> 2) & 1, j = c & 3;
    return 64 * wc + 32 * (fq >> 1) + 16 * bj + 8 * (fq & 1) + 4 * n + j;
}
struct EpiIn {
    static constexpr bool PERM = true;
    bf16* Z; bf16* ZT; bf16* ZTC; const float* ropec; const float* ropes; const float* qkg;
    __device__ __forceinline__ void operator()(const f32x4 (&acc)[2][2][4][2], const pg8::Unit& u, int wr, int wc, int fr, int fq) const {
        const int b = u.pm / TPB, jt = u.pm - b * TPB; const bool isctx = (jt == 0);
        if (u.pn == 0 || u.pn >= 8) {
#pragma unroll
            for (int ai = 0; ai < 2; ++ai)
#pragma unroll
                for (int m = 0; m < 4; ++m) { const int r = 128 * ai + 64 * wr + 16 * m + fr; bf16* rowp = Z + (size_t)(u.pm * 256 + r) * INW + u.pn * 256 + 32 * wc + 8 * fq;
#pragma unroll
                    for (int bj = 0; bj < 2; ++bj) { const f32x4 v0 = acc[ai][bj][m][0], v1 = acc[ai][bj][m][1];
                        v4u w; w.x = pg8::cvt_pk_bf16(v0[0], v0[1]); w.y = pg8::cvt_pk_bf16(v0[2], v0[3]); w.z = pg8::cvt_pk_bf16(v1[0], v1[1]); w.w = pg8::cvt_pk_bf16(v1[2], v1[3]);
                        *(v4u*)(rowp + bj * 128) = w; } }
        } else if (u.pn <= 3) {
            bf16* base = isctx ? ZTC + (size_t)b * 768 * CTXL : ZT + (size_t)b * 768 * SEQ + (size_t)(jt - 1) * 256;
            const size_t cstride = isctx ? CTXL : SEQ;
#pragma unroll
            for (int bj = 0; bj < 2; ++bj)
#pragma unroll
                for (int n = 0; n < 2; ++n)
#pragma unroll
                    for (int j = 0; j < 4; ++j) { const int ch = 256 * (u.pn - 1) + 128 * bj + 32 * wc + 8 * fq + 4 * n + j; bf16* cp = base + (size_t)ch * cstride;
#pragma unroll
                        for (int ai = 0; ai < 2; ++ai)
#pragma unroll
                            for (int m = 0; m < 4; ++m) { const int r = 128 * ai + 64 * wr + 16 * m + fr; cp[r] = (bf16)f2bf(acc[ai][bj][m][n][j]); } }
        } else {
            const int which = (u.pn >= 6) ? 1 : 0; const float osc = which ? 1.0f : C2;
            const int axis = fq >> 1, f0 = 8 * (fq & 1);
            float ga[2][4], gb[2][4];
#pragma unroll
            for (int n = 0; n < 2; ++n)
#pragma unroll
                for (int j = 0; j < 4; ++j) { ga[n][j] = qkg[which * 64 + 32 * axis + f0 + 4 * n + j]; gb[n][j] = qkg[which * 64 + 32 * axis + 16 + f0 + 4 * n + j]; }
#pragma unroll
            for (int ai = 0; ai < 2; ++ai)
#pragma unroll
                for (int m = 0; m < 4; ++m) {
                    const int r = 128 * ai + 64 * wr + 16 * m + fr;
                    float ss = 0.f;
#pragma unroll
                    for (int bj = 0; bj < 2; ++bj)
#pragma unroll
                        for (int n = 0; n < 2; ++n) { const f32x4 x = acc[ai][bj][m][n]; ss += (x[0] * x[0] + x[1] * x[1]) + (x[2] * x[2] + x[3] * x[3]); }
                    ss += xor16_f(ss); ss = sum32_f(ss);
                    const float rinv = __builtin_amdgcn_rsqf(ss * (1.0f / 64.0f) + 1e-6f);
                    f32x4 cv[2], sv[2];
                    if (!isctx) { const int t = (jt - 1) * 256 + r; const int pos = axis ? (t & 63) : (t >> 6);
                        cv[0] = *(const f32x4*)(ropec + pos * 16 + f0); cv[1] = *(const f32x4*)(ropec + pos * 16 + f0 + 4);
                        sv[0] = *(const f32x4*)(ropes + pos * 16 + f0); sv[1] = *(const f32x4*)(ropes + pos * 16 + f0 + 4); }
                    else { cv[0] = cv[1] = (f32x4){1.f, 1.f, 1.f, 1.f}; sv[0] = sv[1] = (f32x4){0.f, 0.f, 0.f, 0.f}; }
                    float oa[8], ob[8];
#pragma unroll
                    for (int n = 0; n < 2; ++n)
#pragma unroll
                        for (int j = 0; j < 4; ++j) { const float a = acc[ai][0][m][n][j] * rinv * ga[n][j], bb = acc[ai][1][m][n][j] * rinv * gb[n][j];
                            oa[4 * n + j] = (a * cv[n][j] - bb * sv[n][j]) * osc; ob[4 * n + j] = (bb * cv[n][j] + a * sv[n][j]) * osc; }
                    bf16* rowp = Z + (size_t)(u.pm * 256 + r) * INW + u.pn * 256 + 64 * wc + 32 * axis + f0;
                    v4u w; w.x = pg8::cvt_pk_bf16(oa[0], oa[1]); w.y = pg8::cvt_pk_bf16(oa[2], oa[3]); w.z = pg8::cvt_pk_bf16(oa[4], oa[5]); w.w = pg8::cvt_pk_bf16(oa[6], oa[7]);
                    *(v4u*)(rowp) = w;
                    w.x = pg8::cvt_pk_bf16(ob[0], ob[1]); w.y = pg8::cvt_pk_bf16(ob[2], ob[3]); w.z = pg8::cvt_pk_bf16(ob[4], ob[5]); w.w = pg8::cvt_pk_bf16(ob[6], ob[7]);
                    *(v4u*)(rowp + 16) = w;
                }
        }
    }
};
struct EpiRes {
    static constexpr bool PERM = false;
    const float* xin; float* xout; float* hctx; const float* gate; int ntk_full; float* slab; float gsc;
    __device__ __forceinline__ void operator()(const f32x4 (&acc)[2][2][4][2], const pg8::Unit& u, int wr, int wc, int fr, int fq) const {
        const int b = u.pm / TPB, jt = u.pm - b * TPB; const bool isctx = (jt == 0); const int set = isctx ? 2 : b;
        const int col0 = u.pn * 256 + wc * 32 + 4 * fq;
        f32x4 gv[2][2];
#pragma unroll
        for (int bj = 0; bj < 2; ++bj)
#pragma unroll
            for (int n = 0; n < 2; ++n) gv[bj][n] = *(const f32x4*)(gate + set * 6144 + col0 + bj * 128 + n * 16) * gsc;
        const unsigned long long coff = (unsigned long long)(b * CTXL) * DM * 4, loff = (unsigned long long)(b * SEQ + (jt - 1) * 256) * DM * 4;
        const unsigned long long ia = isctx ? (unsigned long long)hctx + coff : (unsigned long long)xin + loff, oa = isctx ? (unsigned long long)hctx + coff : (unsigned long long)xout + loff;
        const GAS char* ib = (const GAS char*)ia; GAS char* ob = (GAS char*)oa;
        const unsigned lo = (unsigned)((64 * wr + fr) * DM + col0) * 4u;
        if (u.nt == ntk_full) {
#pragma unroll
            for (int ai = 0; ai < 2; ++ai)
#pragma unroll
                for (int m = 0; m < 4; ++m) { const unsigned off = lo + (unsigned)(128 * ai + 16 * m) * DM * 4u;
#pragma unroll
                    for (int bj = 0; bj < 2; ++bj)
#pragma unroll
                        for (int n = 0; n < 2; ++n) { const f32x4 xi = *(const GAS f32x4*)(ib + off + (bj * 128 + n * 16) * 4); *(GAS f32x4*)(ob + off + (bj * 128 + n * 16) * 4) = xi + gv[bj][n] * acc[ai][bj][m][n]; }
                    if (m == 3) asm volatile("" ::: "memory"); }
        } else {
            int fr_ = fr; asm volatile("" : "+v"(fr_));
            GAS float* sp = (GAS float*)(slab + (size_t)u.sl * 65536) + (unsigned)((64 * wr + fr_) * 256 + wc * 32 + 4 * fq);
#pragma unroll
            for (int ai = 0; ai < 2; ++ai)
#pragma unroll
                for (int m = 0; m < 4; ++m)
#pragma unroll
                    for (int bj = 0; bj < 2; ++bj)
#pragma unroll
                        for (int n = 0; n < 2; ++n) *(GAS f32x4*)(sp + (128 * ai + 16 * m) * 256 + bj * 128 + n * 16) = gv[bj][n] * acc[ai][bj][m][n];
        }
    }
};
__device__ __forceinline__ float silu_mul(float g, float u) { return g * u * __builtin_amdgcn_rcpf(1.0f + __builtin_amdgcn_exp2f(-1.4426950408889634f * g)); }
struct EpiGlu {
    static constexpr bool PERM = true;
    bf16* H; int ldh; int NT;
    __device__ __forceinline__ void operator()(const f32x4 (&acc)[2][2][4][2], const pg8::Unit& u, int wr, int wc, int fr, int fq) const {
        const int nt = u.pn % NT;
#pragma unroll
        for (int ai = 0; ai < 2; ++ai)
#pragma unroll
            for (int m = 0; m < 4; ++m) { const int r = 128 * ai + 64 * wr + 16 * m + fr; bf16* rowp = H + (size_t)(u.pm * 256 + r) * ldh + nt * 128 + 32 * wc + 8 * fq;
                float o[8];
#pragma unroll
                for (int n = 0; n < 2; ++n)
#pragma unroll
                    for (int j = 0; j < 4; ++j) o[4 * n + j] = silu_mul(acc[ai][0][m][n][j], acc[ai][1][m][n][j]);
                v4u w; w.x = pg8::cvt_pk_bf16(o[0], o[1]); w.y = pg8::cvt_pk_bf16(o[2], o[3]); w.z = pg8::cvt_pk_bf16(o[4], o[5]); w.w = pg8::cvt_pk_bf16(o[6], o[7]);
                *(v4u*)rowp = w; }
    }
};
__device__ __forceinline__ void k_quarter(int ntk, int kq, int& ko, int& nt) {
    const int pairs = ntk >> 1; int start = 0, len = 0;
#pragma unroll
    for (int q = 0; q < 4; ++q) { const int l = (pairs + 3 - q) >> 2; if (q < kq) start += l; if (q == kq) len = l; }
    ko = start * 128; nt = len * 2;
}
struct SplitTailOrder {
    pg8::StaticOrder S; int nN, nmain;
    __device__ __forceinline__ void init(int N, int K, int G, int c) { S.init(NB * SEQ, N, K, G, c); nN = N / 256; nmain = (NB * SEQ / 256) * nN; }
    __device__ __forceinline__ bool next(int i, pg8::Unit& u) const {
        const long L = (long)i * S.G + S.c;
        if (L < nmain) { S.map(L, u); u.pm += 1 + (u.pm >= SEQ / 256 ? 1 : 0); return true; }
        const int Lt = (int)(L - nmain); if (Lt >= 2 * nN * 4) return false;
        const int kq = Lt & 3, r = Lt >> 2; u.pn = r % nN; u.pm = (r / nN) * TPB; k_quarter(S.ntk, kq, u.ko, u.nt); u.sl = ((r / nN) * 4 + u.pn) * 4 + kq; return true;
    }
    __device__ __forceinline__ void a_ready(const pg8::Unit&) const {}
    __device__ __forceinline__ void done(const pg8::Unit&) const {}
};
struct MoeOrder {
    int G, c, NT, tlo, nunits; const LAS int* tab; int ntk;
    __device__ __forceinline__ bool next(int i, pg8::Unit& u) const {
        const int L = i * G + c; if (L >= nunits) return false;
        const int tau = tlo + L / NT, nt = L - (L / NT) * NT;
        int s = 0;
#pragma unroll
        for (int q = 1; q < 16; ++q) s += (tab[q] <= tau) ? 1 : 0;
        u.pm = tau; u.pn = (s & 7) * NT + nt; u.ko = 0; u.nt = ntk; u.sl = -1; return true;
    }
    __device__ __forceinline__ void a_ready(const pg8::Unit&) const {}
    __device__ __forceinline__ void done(const pg8::Unit&) const {}
};
struct MoeDownOrder {
    int G, c, k, nmain, ntailu; const LAS int* tab;
    __device__ __forceinline__ void init(int G_, int c_, int k_, const LAS int* tab_) { G = G_; c = c_; k = k_; tab = tab_; nmain = (tab[64 + 8 * k + 8] - tab[64 + 8 * k]) * 4; ntailu = tab[112 + k] * 16; }
    __device__ __forceinline__ bool next(int i, pg8::Unit& u) const {
        const int L = i * G + c;
        if (L < nmain) { const int mu = tab[64 + 8 * k] + (L >> 2); int s = 0;
#pragma unroll
            for (int q = 1; q < 16; ++q) s += (tab[64 + q] <= mu) ? 1 : 0;
            u.pm = tab[s] + (mu - tab[64 + s]); u.pn = (s & 7) * 4 + (L & 3); u.ko = 0; u.nt = DFE / 64; u.sl = -1; return true; }
        const int Lt = L - nmain; if (Lt >= ntailu) return false;
        const int s = tab[96 + 8 * k + (Lt >> 4)]; u.pm = tab[s + 1] - 1; u.pn = (s & 7) * 4 + ((Lt >> 2) & 3); k_quarter(DFE / 64, Lt & 3, u.ko, u.nt); u.sl = 8 * 16 * k + Lt; return true;
    }
    __device__ __forceinline__ void a_ready(const pg8::Unit&) const {}
    __device__ __forceinline__ void done(const pg8::Unit&) const {}
};
struct EpiMoeDown {
    static constexpr bool PERM = false;
    float* xlat; float* hctx; const float* gate; const int* rtok; const float* rgate; const LAS int* tab; float* slab; float gsc;
    __device__ __forceinline__ void operator()(const f32x4 (&acc)[2][2][4][2], const pg8::Unit& u, int wr, int wc, int fr, int fq) const {
        const int tau = u.pm; int s = 0;
#pragma unroll
        for (int q = 1; q < 16; ++q) s += (tab[q] <= tau) ? 1 : 0;
        const int idx0 = (tau - tab[s]) * 256, cnt = tab[32 + s];
        const int col0 = (u.pn & 3) * 256 + wc * 32 + 4 * fq;
        const bool full = (u.nt == DFE / 64);
        if (full) {
            int Rr[8]; float gt[8]; bool ok[8];
#pragma unroll
            for (int q = 0; q < 8; ++q) { const int idx = idx0 + 128 * (q >> 2) + 64 * wr + 16 * (q & 3) + fr; ok[q] = idx < cnt; const int ic = ok[q] ? idx : idx0;
                Rr[q] = rtok[(size_t)s * SEGCAP + ic]; gt[q] = rgate[(size_t)s * SEGCAP + ic] * gsc; }
#pragma unroll
            for (int rp = 0; rp < 4; ++rp) {
                f32x4 gv[2][2][2], xi[2][2][2]; float* xp[2];
#pragma unroll
                for (int j = 0; j < 2; ++j) { const int q = 2 * rp + j; xp[j] = xrow_out(Rr[q], xlat, hctx) + col0; const float* gp = gate + row_set(Rr[q]) * 6144 + col0;
#pragma unroll
                    for (int bj = 0; bj < 2; ++bj)
#pragma unroll
                        for (int n = 0; n < 2; ++n) { gv[j][bj][n] = *(const f32x4*)(gp + bj * 128 + n * 16); xi[j][bj][n] = *(const f32x4*)(xp[j] + bj * 128 + n * 16); } }
#pragma unroll
                for (int j = 0; j < 2; ++j) { const int q = 2 * rp + j;
                    if (ok[q]) {
#pragma unroll
                        for (int bj = 0; bj < 2; ++bj)
#pragma unroll
                            for (int n = 0; n < 2; ++n) *(f32x4*)(xp[j] + bj * 128 + n * 16) = xi[j][bj][n] + gv[j][bj][n] * gt[q] * acc[q >> 2][bj][q & 3][n]; } }
            }
        } else {
#pragma unroll
        for (int ai = 0; ai < 2; ++ai)
#pragma unroll
            for (int m = 0; m < 4; ++m) { const int idx = idx0 + 128 * ai + 64 * wr + 16 * m + fr;
                if (idx < cnt) { const int R = rtok[(size_t)s * SEGCAP + idx]; const float gt = rgate[(size_t)s * SEGCAP + idx] * gsc;
                    const float* gp = gate + row_set(R) * 6144 + col0;
#pragma unroll
                    for (int bj = 0; bj < 2; ++bj)
#pragma unroll
                        for (int n = 0; n < 2; ++n) { const f32x4 gv = *(const f32x4*)(gp + bj * 128 + n * 16); const f32x4 v = gv * gt * acc[ai][bj][m][n];
                            int fr_ = fr; asm volatile("" : "+v"(fr_));
                            *(GAS f32x4*)((GAS char*)(slab + (size_t)u.sl * 65536) + (unsigned)(((128 * ai + 64 * wr + 16 * m + fr_) * 256 + wc * 32 + 4 * fq + bj * 128 + n * 16) * 4)) = v; } } }
        }
    }
};

__device__ __forceinline__ void transpose_item(const float* colp  , int ldw, int K, bf16* WT, int kb, int n0, int lane) {
    const int hh = lane >> 5, m = lane & 31, k0 = 64 * kb + 32 * hh;
    f32x4 v[32];
#pragma unroll
    for (int i = 0; i < 32; ++i) v[i] = *(const f32x4*)(colp + (size_t)(k0 + i) * ldw);
    bf16* dp = WT + (size_t)(n0 + 4 * m) * K + k0;
#pragma unroll
    for (int jj = 0; jj < 4; ++jj)
#pragma unroll
        for (int h8 = 0; h8 < 4; ++h8) { v4u o; o.x = pk2(v[8 * h8][jj], v[8 * h8 + 1][jj]); o.y = pk2(v[8 * h8 + 2][jj], v[8 * h8 + 3][jj]); o.z = pk2(v[8 * h8 + 4][jj], v[8 * h8 + 5][jj]); o.w = pk2(v[8 * h8 + 6][jj], v[8 * h8 + 7][jj]);
            *(v4u*)(dp + (size_t)jj * K + 8 * h8) = o; }
}
__device__ __forceinline__ int src_in_col(int nd) { const int t = nd >> 8, c = nd & 255; return (t >= 4 && t <= 7) ? (t * 256 + qk_perm(c)) : nd; }

struct Args { const float* in[32]; float* out; unsigned char* ws; int ph_lo, ph_hi; };
constexpr int PTAB_OFF = MISC_OFF + 1024;
__device__ __forceinline__ const float* inptr(LAS unsigned char* lds, int k) {
    const LAS unsigned* p = (const LAS unsigned*)(lds + PTAB_OFF) + 2 * k;
    const unsigned lo = (unsigned)__builtin_amdgcn_readfirstlane((int)p[0]), hi = (unsigned)__builtin_amdgcn_readfirstlane((int)p[1]);
    return (const float*)(const GAS float*)(((unsigned long long)hi << 32) | lo);
}
#define AIN(k) inptr(lds, (k))

__device__ __forceinline__ float block_sum(float v, LAS float* red, int wave, int lane) {
    v = wave_sum(v);
    if (lane == 0) red[wave] = v;
    __syncthreads();
    float s = 0.f;
#pragma unroll
    for (int w = 0; w < NWAVES; ++w) s += red[w];
    __syncthreads();
    return s;
}

__device__ __forceinline__ void phase_prep_a(const Args& a, int li, LAS unsigned char* lds, int G, int bx) {
    const int tid = fresh_tid(), lane = tid & 63, wave = __builtin_amdgcn_readfirstlane(tid >> 6);
    const int gw = bx * NWAVES + wave, NGW = G * NWAVES;
    unsigned char* ws = fresh_ptr(a.ws);
    const bool moe = (li & 1) != 0; const int lj = li >> 1;
    {
        bf16* win_t = (bf16*)(ws + WS_WIN); bf16* wout_t = (bf16*)(ws + WS_WOUT); bf16* wup_t = (bf16*)(ws + WS_WUP); bf16* wdn_t = (bf16*)(ws + WS_WDN);
        const float* w_in = AIN(8) + (size_t)li * DM * INW; const float* w_out = AIN(9) + (size_t)li * DM * DM;
        constexpr int I_IN = 16 * 20, I_OUT = 16 * 8, I_UPD = 16 * 44, I_DND = 44 * 8, I_UPE = 16 * 56, I_DNE = 56 * 8;
        const int NIT = moe ? (I_IN + I_OUT + NEXP * (I_UPE + I_DNE)) : (I_IN + I_OUT + I_UPD + I_DND);
        const int m4 = 4 * (lane & 31);
        for (int it = gw; it < NIT; it += NGW) {
            int r = it;
            if (r < I_IN) { const int nb = r % 20; transpose_item(w_in + src_in_col(128 * nb + m4), INW, DM, win_t, r / 20, 128 * nb, lane); continue; } r -= I_IN;
            if (r < I_OUT) { const int nb = r % 8; transpose_item(w_out + 128 * nb + m4, DM, DM, wout_t, r / 8, 128 * nb, lane); continue; } r -= I_OUT;
            if (!moe) {
                if (r < I_UPD) { const int nb = r % 44; const float* W = (nb & 1) ? AIN(26) : AIN(25);
                    transpose_item(W + (size_t)lj * DM * DFF + (nb >> 1) * 128 + m4, DFF, DM, wup_t, r / 44, 128 * nb, lane); continue; } r -= I_UPD;
                { const int nb = r % 8; transpose_item(AIN(27) + (size_t)lj * DFF * DM + 128 * nb + m4, DM, DFF, wdn_t, r / 8, 128 * nb, lane); }
            } else {
                if (r < NEXP * I_UPE) { const int e = r / I_UPE, r2 = r % I_UPE, nb = r2 % 56; const size_t wo = (size_t)(lj * NEXP + e) * DM * DFE;
                    const float* W = (nb & 1) ? AIN(30) : AIN(29);
                    transpose_item(W + wo + (nb >> 1) * 128 + m4, DFE, DM, wup_t + (size_t)e * 2 * DFE * DM, r2 / 56, 128 * nb, lane); continue; } r -= NEXP * I_UPE;
                const int e = r / I_DNE, r2 = r % I_DNE, nb = r2 % 8;
                transpose_item(AIN(31) + (size_t)(lj * NEXP + e) * DFE * DM + 128 * nb + m4, DM, DFE, wdn_t + (size_t)e * DM * DFE, r2 / 8, 128 * nb, lane);
            }
        }
    }
    if (li == 0) for (int l = 0; l < DEPTH; ++l) {
        const float* w1 = AIN(14) + l * 33 * 64; const float* w2 = AIN(17) + l * 64 * 64;
        const float bb1 = AIN(15)[l * 64 + lane], ff1 = AIN(16)[l * 64 + lane], bb2 = AIN(18)[l * 64 + lane], ff2 = AIN(19)[l * 64 + lane];
        float w1c[33], w2c[64];
#pragma unroll
        for (int q = 0; q < 33; ++q) w1c[q] = w1[q * 64 + lane];
#pragma unroll
        for (int q = 0; q < 64; ++q) w2c[q] = w2[q * 64 + lane];
        bf16* H2B = (bf16*)(ws + WS_H2B) + (size_t)l * (SEQ + CTXL) * 64;
        for (int tt = gw; tt < SEQ + CTXL; tt += NGW) {
            const int L = tt < SEQ ? SEQ : CTXL, t = tt < SEQ ? tt : tt - SEQ;
            float feat = 0.f;
            if (lane == 0) feat = (float)t / (float)(L - 1);
            else if (lane <= 32) { const int jb = (lane - 1) & 15; const float rev = (float)((jb * t) & (L - 1)) / (float)L + 1e-4f * (1.0f - (float)jb * (1.0f / 15.0f)) * (float)t / (float)L;
                feat = lane <= 16 ? __builtin_amdgcn_cosf(__builtin_amdgcn_fractf(rev)) : -__builtin_amdgcn_sinf(__builtin_amdgcn_fractf(rev)); }
            float z1 = 0.f;
#pragma unroll
            for (int q = 0; q < 33; ++q) z1 += __builtin_bit_cast(float, __builtin_amdgcn_readlane(__builtin_bit_cast(int, feat), q)) * w1c[q];
            const float h1 = sin_rad(ff1 * (z1 + bb1));
            float z2 = 0.f;
#pragma unroll
            for (int q = 0; q < 64; ++q) z2 += __builtin_bit_cast(float, __builtin_amdgcn_readlane(__builtin_bit_cast(int, h1), q)) * w2c[q];
            H2B[(size_t)tt * 64 + lane] = (bf16)f2bf(sin_rad(ff2 * (z2 + bb2)));
        }
    }
    if (li == 0) {
        __syncthreads();
        LAS float* sv = (LAS float*)lds;
        for (int idx = tid; idx < 3 * DM; idx += NTHR) { const int s = idx >> 10, k = idx & 1023; const float v = s < 2 ? AIN(1)[s * DM + k] : AIN(3)[k];
            sv[idx] = v * __builtin_amdgcn_rcpf(1.0f + __builtin_amdgcn_exp2f(-1.4426950408889634f * v)); }
        __syncthreads();
        float* MODP = (float*)(ws + WS_MODP);
        for (int it = bx; it < 4 * 8 * 12; it += G) {
            const int l = it / 96, q = (it / 12) & 7, jc = it % 12, j = jc * 512 + tid;
            const float* wp = AIN(4) + ((size_t)l * DM + q * 128) * 6144 + j;
            float a0 = 0.f, a1 = 0.f, a2 = 0.f;
#pragma unroll 8
            for (int k = 0; k < 128; ++k) { const float w = wp[(size_t)k * 6144]; a0 += sv[q * 128 + k] * w; a1 += sv[DM + q * 128 + k] * w; a2 += sv[2 * DM + q * 128 + k] * w; }
            float* dp = MODP + (size_t)((q * 4 + l) * 3) * 6144 + j;
            dp[0] = a0; dp[6144] = a1; dp[2 * 6144] = a2;
        }
        const int gid = bx * NTHR + tid;
        if (gid < 4096) { const int pos = gid >> 4, f = gid & 15; const float inv = __builtin_amdgcn_exp2f(-(float)f * 0.83048202372184059f);
            const float rev = (float)pos * inv * 0.15915494309189535f; float* RT = (float*)(ws + WS_ROPE);
            RT[gid] = __builtin_amdgcn_cosf(__builtin_amdgcn_fractf(rev)); RT[4096 + gid] = __builtin_amdgcn_sinf(__builtin_amdgcn_fractf(rev)); }
        const f32x4* cs = (const f32x4*)AIN(2); f32x4* cd = (f32x4*)(ws + WS_HCTX);
        for (int idx = gid; idx < NB * CTXL * DM / 4; idx += G * NTHR) cd[idx] = cs[idx];
        __syncthreads();
    }
}

__device__ __forceinline__ int fidx(int i) { return i + (i >> 7); }
__device__ __forceinline__ void fft4_index(int b, int q, int& i, int& j) {
    if (q >= 64) { j = b & (q - 1); i = ((b & ~(q - 1)) << 2) + j; }
    else { const int rr = b & 127, qq = b >> 7; j = qq & (q - 1); i = rr * 128 + ((qq & ~(q - 1)) << 2) + j; }
}
__device__ __forceinline__ f32x2 cmulf(f32x2 a, f32x2 w) { return (f32x2){a.x * w.x - a.y * w.y, a.x * w.y + a.y * w.x}; }
__device__ __forceinline__ void fft_fwd(LAS f32x2* X, int tid) {
    for (int p = 0; p < 7; ++p) {
        const int h = 8192 >> (2 * p), q = h >> 1; const float inv2h = 0.5f / (float)h;
#pragma unroll 2
        for (int r = 0; r < 8; ++r) { int i, j; fft4_index(tid + NTHR * r, q, i, j);
            const float ang = (float)j * inv2h; const f32x2 w1 = {__builtin_amdgcn_cosf(ang), -__builtin_amdgcn_sinf(ang)}; const f32x2 w2 = cmulf(w1, w1);
            const int i0 = fidx(i), i1 = fidx(i + q), i2 = fidx(i + 2 * q), i3 = fidx(i + 3 * q);
            const f32x2 x0 = X[i0], x1 = X[i1], x2 = X[i2], x3 = X[i3];
            const f32x2 a0 = x0 + x2, a1 = x1 + x3, d02 = cmulf(x0 - x2, w1), t13 = cmulf(x1 - x3, w1); const f32x2 d13 = {t13.y, -t13.x};
            X[i0] = a0 + a1; X[i1] = cmulf(a0 - a1, w2); X[i2] = d02 + d13; X[i3] = cmulf(d02 - d13, w2); }
        __syncthreads();
    }
}
__device__ __forceinline__ void fft_inv(LAS f32x2* X, int tid) {
    for (int p = 6; p >= 0; --p) {
        const int h = 8192 >> (2 * p), q = h >> 1; const float inv2h = 0.5f / (float)h;
#pragma unroll 2
        for (int r = 0; r < 8; ++r) { int i, j; fft4_index(tid + NTHR * r, q, i, j);
            const float ang = (float)j * inv2h; const f32x2 w1 = {__builtin_amdgcn_cosf(ang), __builtin_amdgcn_sinf(ang)}; const f32x2 w2 = cmulf(w1, w1);
            const int i0 = fidx(i), i1 = fidx(i + q), i2 = fidx(i + 2 * q), i3 = fidx(i + 3 * q);
            const f32x2 b0 = X[i0], b1 = X[i1], b2 = X[i2], b3 = X[i3];
            const f32x2 t1 = cmulf(b1, w2), t3 = cmulf(b3, w2); const f32x2 a0 = b0 + t1, a1 = b0 - t1, a2 = b2 + t3, a3 = b2 - t3;
            const f32x2 u2 = cmulf(a2, w1), v3 = cmulf(a3, w1); const f32x2 u3 = {-v3.y, v3.x};
            X[i0] = a0 + u2; X[i2] = a0 - u2; X[i1] = a1 + u3; X[i3] = a1 - u3; }
        __syncthreads();
    }
}
__device__ __forceinline__ int brev14(int k) { return (int)(__builtin_bitreverse32((unsigned)k) >> 18); }
__device__ __forceinline__ void pair_slots(int r, int& j, int& jp, int& k, bool& ev) {
    if (r == 0) { j = 0; jp = 0; k = 0; ev = true; return; }
    if (r == 8192) { j = 1; jp = 1; k = 8192; ev = true; return; }
    const int hb = 31 - __builtin_clz((unsigned)r), base = 2 << hb; j = base + (r - (1 << hb)); jp = 3 * base - 1 - j; ev = (j & 1) == 0; k = brev14(ev ? j : jp);
}
constexpr int FFT_AUX = 133120;

__device__ __forceinline__ void phase_prep_b(const Args& a, int li, LAS unsigned char* lds, int G, int bx) {
    const int tid = fresh_tid(), lane = tid & 63, wave = __builtin_amdgcn_readfirstlane(tid >> 6);
    unsigned char* ws = fresh_ptr(a.ws);
    if (li == 0) {
        const float* MODP = (const float*)(ws + WS_MODP); float* MOD = (float*)(ws + WS_MOD);
        for (int idx = bx * NTHR + tid; idx < 4 * 3 * 6144; idx += G * NTHR) { const int l = idx / 18432, j = idx % 6144; float s = AIN(5)[l * 6144 + j];
#pragma unroll
            for (int q = 0; q < 8; ++q) s += MODP[(size_t)q * 73728 + idx];
            MOD[idx] = s; }
    }
    LAS f32x2* X = (LAS f32x2*)lds; LAS float* Xf = (LAS float*)lds;
    LAS float* w3c = (LAS float*)(lds + FFT_AUX); LAS float* red = w3c + 128; LAS float* kc = (LAS float*)(lds + FFT_AUX + 1024);
    const bf16* H2 = (const bf16*)(ws + WS_H2B) + (size_t)li * (SEQ + CTXL) * 64; const bf16* H2C = H2 + (size_t)SEQ * 64;
    const float* w3 = AIN(20) + (size_t)li * 64 * 512;
    const float min_decay = 3.0701134573253945f, max_decay = 15.350567286626973f;
    const bool coop = (G == 256);
    const int xg = bx & 7, mi = bx >> 3;
    float* FT = (float*)(ws + WS_Z) + (size_t)xg * 64 * SEQ;
    if (coop) {
        const int r16 = lane & 15, g4 = lane >> 4, t0 = 512 * mi + 64 * wave;
        bf16x8 wf[4][2], hf[4][2];
#pragma unroll
        for (int blk = 0; blk < 4; ++blk)
#pragma unroll
            for (int ks = 0; ks < 2; ++ks) hf[blk][ks] = *(const bf16x8*)(H2 + (size_t)(t0 + 16 * blk + r16) * 64 + 8 * g4 + 32 * ks);
#pragma unroll
        for (int tau = 0; tau < 4; ++tau)
#pragma unroll
            for (int ks = 0; ks < 2; ++ks) { v4u w; const int o = 16 * tau + r16, col = (o & 1) * 256 + 32 * xg + (o >> 1);
#pragma unroll
                for (int j2 = 0; j2 < 4; ++j2) { const int kk = 32 * ks + 8 * g4 + 2 * j2; w[j2] = pk2(w3[kk * 512 + col], w3[(kk + 1) * 512 + col]); }
                wf[tau][ks] = __builtin_bit_cast(bf16x8, w); }
#pragma unroll
        for (int tau = 0; tau < 4; ++tau)
#pragma unroll
            for (int blk = 0; blk < 4; ++blk) { f32x4 acc = {0.f, 0.f, 0.f, 0.f};
#pragma unroll
                for (int ks = 0; ks < 2; ++ks) acc = __builtin_amdgcn_mfma_f32_16x16x32_bf16(hf[blk][ks], wf[tau][ks], acc, 0, 0, 0);
                *(f32x4*)(FT + (size_t)(16 * tau + r16) * SEQ + t0 + 16 * blk + 4 * g4) = acc; }
        asm volatile("s_waitcnt vmcnt(0)" ::: "memory");
        __syncthreads();
        if (tid == 0) { unsigned* cnt = (unsigned*)(ws + WS_CTL) + CW_MOECNT + li * 8 + xg;
            __builtin_amdgcn_fence(__ATOMIC_RELEASE, "agent"); (void)xb_add(cnt, 1u);
            unsigned sp = 0; while (xb_ld(cnt) < 32u) { __builtin_amdgcn_s_sleep(1); if (++sp > (1u << 22)) break; }
            __builtin_amdgcn_fence(__ATOMIC_ACQUIRE, "agent"); }
        __syncthreads();
    }
    for (int c0 = bx; c0 < 256; c0 += G) { const int c = G == 256 ? (((c0 & 7) << 5) | (c0 >> 3)) : c0;
        if (tid < 128) w3c[tid] = w3[(tid & 63) * 512 + (tid >> 6) * 256 + c];
        __syncthreads();
        const float delta = min_decay + (float)c * ((max_decay - min_decay) / 255.0f);
        float asum = 0.f;
        if (coop) {
            const float* ff = FT + (size_t)(2 * mi) * SEQ; const float* fb = ff + SEQ;
#pragma unroll 8
            for (int r = 0; r < 32; ++r) { const int t = tid + NTHR * r;
                float df = ff[t], db = fb[t];
                const float dec = __builtin_amdgcn_exp2f(-1.4426950408889634f * delta * ((float)t * (1.0f / 16383.0f)));
                df *= dec; db *= dec;
                Xf[2 * fidx(t >> 1) + (t & 1)] = df; asum += __builtin_fabsf(df);
                if (t >= 1) { const int n = 32768 - t; Xf[2 * fidx(n >> 1) + (n & 1)] = db; asum += __builtin_fabsf(db); } }
        } else
        {
            const int r16 = lane & 15, g4 = lane >> 4;
            bf16x8 af[4][2];
#pragma unroll
            for (int i = 0; i < 4; ++i)
#pragma unroll
                for (int ks = 0; ks < 2; ++ks) { v4u w;
#pragma unroll
                    for (int j2 = 0; j2 < 4; ++j2) { const int kk = 32 * ks + 8 * g4 + 2 * j2;
                        const float lo = r16 == 4 * i ? w3c[kk] : (r16 == 4 * i + 1 ? w3c[64 + kk] : 0.f), hi = r16 == 4 * i ? w3c[kk + 1] : (r16 == 4 * i + 1 ? w3c[64 + kk + 1] : 0.f);
                        w[j2] = pk2(lo, hi); }
                    af[i][ks] = __builtin_bit_cast(bf16x8, w); }
#pragma unroll 2
            for (int r = 0; r < 32; ++r) { const int t = tid + NTHR * r, t0 = t - lane;
                f32x4 acc = {0.f, 0.f, 0.f, 0.f};
#pragma unroll
                for (int i = 0; i < 4; ++i)
#pragma unroll
                    for (int ks = 0; ks < 2; ++ks) { const bf16x8 hb8 = *(const bf16x8*)(H2 + (size_t)(t0 + 16 * i + r16) * 64 + 8 * g4 + 32 * ks);
                        acc = __builtin_amdgcn_mfma_f32_16x16x32_bf16(af[i][ks], hb8, acc, 0, 0, 0); }
                float df = acc[0], db = acc[1];
                const float dec = __builtin_amdgcn_exp2f(-1.4426950408889634f * delta * ((float)t * (1.0f / 16383.0f)));
                df *= dec; db *= dec;
                Xf[2 * fidx(t >> 1) + (t & 1)] = df; asum += __builtin_fabsf(df);
                if (t >= 1) { const int n = 32768 - t; Xf[2 * fidx(n >> 1) + (n & 1)] = db; asum += __builtin_fabsf(db); } }
        }
        if (tid == 0) Xf[2 * fidx(8192)] = 0.f;
        const float S1 = block_sum(asum, red, wave, lane);
        fft_fwd(X, tid);
        const float scale = 1.0f / (S1 * 16384.0f);
        f32x4* HF = (f32x4*)(ws + WS_HF) + (size_t)c * 8193;
        for (int r = tid; r <= 8192; r += NTHR) {
            int j, jp, k; bool ev; pair_slots(r, j, jp, k, ev);
            const f32x2 P = X[fidx(j)], Q = X[fidx(jp)]; const f32x2 A = ev ? P : Q, B = ev ? Q : P; f32x4 o;
            if (k == 0) o = (f32x4){A.x + A.y, 0.f, A.x - A.y, 0.f};
            else { const float Ex = 0.5f * (A.x + B.x), Ey = 0.5f * (A.y - B.y), Ox = 0.5f * (A.y + B.y), Oy = -0.5f * (A.x - B.x);
                const float ang = (float)k * (1.0f / 32768.0f), wc = __builtin_amdgcn_cosf(ang), wsn = -__builtin_amdgcn_sinf(ang);
                const float px = Ox * wc - Oy * wsn, py = Ox * wsn + Oy * wc;
                o = (f32x4){Ex + px, Ey + py, Ex - px, -(Ey - py)}; }
            HF[r] = o * scale; }
        __syncthreads();
        float as2 = 0.f;
        if (tid < CTXL) { const int t = tid; const v4u* hr = (const v4u*)(H2C + (size_t)t * 64); float df = 0.f, db = 0.f;
#pragma unroll
            for (int q = 0; q < 8; ++q) { const v4u hw = hr[q];
#pragma unroll
                for (int e = 0; e < 4; ++e) { const float h0 = __builtin_bit_cast(float, hw[e] << 16), h1 = __builtin_bit_cast(float, hw[e] & 0xffff0000u);
                    df += h0 * w3c[8 * q + 2 * e] + h1 * w3c[8 * q + 2 * e + 1]; db += h0 * w3c[64 + 8 * q + 2 * e] + h1 * w3c[64 + 8 * q + 2 * e + 1]; } }
            const float dec = __builtin_amdgcn_exp2f(-1.4426950408889634f * delta * ((float)t * (1.0f / 255.0f)));
            df *= dec; db *= dec; kc[t] = df; as2 += __builtin_fabsf(df);
            if (t >= 1) { kc[512 - t] = db; as2 += __builtin_fabsf(db); } else kc[256] = 0.f; }
        const float S2 = block_sum(as2, red, wave, lane);
        ((float*)(ws + WS_KCTX))[(size_t)c * 512 + tid] = kc[tid] / S2;
        __syncthreads();
    }
}

__device__ __forceinline__ void norm_load(const float* xr, int lane, f32x4 (&v)[4]) {
    const f32x4* xp = (const f32x4*)xr + lane;
#pragma unroll
    for (int j = 0; j < 4; ++j) v[j] = xp[64 * j];
}
__device__ __forceinline__ void norm_finish(f32x4 (&v)[4], const float* xr, const float* modl, int set, int which, const f32x4 (&g)[4], int lane, bf16* dst, f32x4 (&o)[4], const float* pend = nullptr) {
    float ss = 0.f;
#pragma unroll
    for (int j = 0; j < 4; ++j) {
        if (pend) { const f32x4* pp = (const f32x4*)(pend + (size_t)j * 4 * 65536) + lane; v[j] = (((v[j] + pp[0]) + pp[16384]) + pp[2 * 16384]) + pp[3 * 16384]; ((f32x4*)xr)[lane + 64 * j] = v[j]; }
        ss += (v[j].x * v[j].x + v[j].y * v[j].y) + (v[j].z * v[j].z + v[j].w * v[j].w); }
    const float rinv = __builtin_amdgcn_rsqf(wave_sum(ss) * (1.0f / DM) + 1e-6f);
    const f32x4* sh = (const f32x4*)(modl + set * 6144 + which * DM) + lane; const f32x4* sc = (const f32x4*)(modl + set * 6144 + (which + 1) * DM) + lane;
    v2u* dp = (v2u*)dst + lane;
#pragma unroll
    for (int j = 0; j < 4; ++j) { const f32x4 y = v[j] * rinv * g[j]; o[j] = y * (sc[64 * j] + 1.0f) + sh[64 * j];
        v2u w; w.x = pk2(o[j].x, o[j].y); w.y = pk2(o[j].z, o[j].w); dp[64 * j] = w; }
}
__device__ __forceinline__ const float* ctx_pending(const Args& a, int R) {
    const int b = R / RB, rr = R - b * RB; return rr < CTXL ? (const float*)(fresh_ptr(a.ws) + WS_SLAB) + (size_t)b * 16 * 65536 + rr * 256 : nullptr; }
__device__ __forceinline__ void norm_finish_lds(f32x4 (&v)[4], const float* xr, const LAS f32x4* mt, int set, const f32x4 (&g)[4], int lane, bf16* dst, const float* pend) {
    float ss = 0.f;
#pragma unroll
    for (int j = 0; j < 4; ++j) {
        if (pend) { const f32x4* pp = (const f32x4*)(pend + (size_t)j * 4 * 65536) + lane; v[j] = (((v[j] + pp[0]) + pp[16384]) + pp[2 * 16384]) + pp[3 * 16384]; ((f32x4*)xr)[lane + 64 * j] = v[j]; }
        ss += (v[j].x * v[j].x + v[j].y * v[j].y) + (v[j].z * v[j].z + v[j].w * v[j].w); }
    const float rinv = __builtin_amdgcn_rsqf(wave_sum(ss) * (1.0f / DM) + 1e-6f);
    const LAS f32x4* sh = mt + set * 512 + lane; const LAS f32x4* sc = sh + 256;
    v2u* dp = (v2u*)dst + lane;
#pragma unroll
    for (int j = 0; j < 4; ++j) { const f32x4 y = v[j] * rinv * g[j]; const f32x4 o = y * (sc[64 * j] + 1.0f) + sh[64 * j];
        v2u w; w.x = pk2(o.x, o.y); w.y = pk2(o.z, o.w); dp[64 * j] = w; }
}
__device__ __forceinline__ void phase_norm(const Args& a, int li, int which  , const float* xlat, LAS unsigned char* lds, int G, int bx) {
    const int tid = fresh_tid(), lane = tid & 63, wave = __builtin_amdgcn_readfirstlane(tid >> 6);
    const int gw = bx * NWAVES + wave, NGW = G * NWAVES;
    unsigned char* ws = fresh_ptr(a.ws); const float* modl = (const float*)(ws + WS_MOD) + (size_t)li * 3 * 6144; const float* hctx = (const float*)(ws + WS_HCTX);
    const float* gsrc = (which == 0 ? AIN(6) : AIN(7)) + li * DM; bf16* XN = (bf16*)(ws + WS_XN);
    LAS f32x4* mt = (LAS f32x4*)lds;
    __syncthreads();
    for (int idx = tid; idx < 3 * 512; idx += NTHR) { const int set = idx >> 9, rem = idx & 511; mt[idx] = ((const f32x4*)(modl + set * 6144 + which * DM))[rem]; }
    f32x4 g[4];
#pragma unroll
    for (int j = 0; j < 4; ++j) g[j] = ((const f32x4*)gsrc)[lane + 64 * j];
    __syncthreads();
    const bool pending = (which == 3) || (li & 1);
    constexpr int NR = 9;
    for (int R = gw; R < MROWS; R += NR * NGW) {
        f32x4 v[NR][4]; const float* xr[NR]; int Rq[NR];
#pragma unroll
        for (int q = 0; q < NR; ++q) { Rq[q] = R + q * NGW; xr[q] = xrow_in(Rq[q] < MROWS ? Rq[q] : R, xlat, hctx); norm_load(xr[q], lane, v[q]); }
#pragma unroll
        for (int q = 0; q < NR; ++q) if (Rq[q] < MROWS) norm_finish_lds(v[q], xr[q], mt, row_set(Rq[q]), g, lane, XN + (size_t)Rq[q] * DM, pending ? ctx_pending(a, Rq[q]) : nullptr); }
    __syncthreads();
}
__device__ __forceinline__ void phase_norm_router(const Args& a, int li, const float* xlat, LAS unsigned char* lds, int G, int bx) {
    const int tid = fresh_tid(), lane = tid & 63, wave = __builtin_amdgcn_readfirstlane(tid >> 6);
    unsigned char* ws = fresh_ptr(a.ws); const float* modl = (const float*)(ws + WS_MOD) + (size_t)li * 3 * 6144; const float* hctx = (const float*)(ws + WS_HCTX);
    const float* gsrc = AIN(7) + li * DM; bf16* XN = (bf16*)(ws + WS_XN); const int lj = li >> 1;
    const float* rw = AIN(28) + (size_t)lj * DM * NEXP;
    LAS float* rwT = (LAS float*)lds;
    LAS int* re = (LAS int*)(lds + 32768);
    LAS float* rg = (LAS float*)(lds + 32768 + 2048);
    LAS int* lcnt = (LAS int*)(lds + 32768 + 4096);
    for (int idx = tid; idx < DM * NEXP; idx += NTHR) rwT[(idx & 7) * DM + (idx >> 3)] = rw[idx];
    if (tid < 32) lcnt[tid] = 0;
    __syncthreads();
    const int RPB = (MROWS + G - 1) / G, R0 = bx * RPB; int nrows = MROWS - R0; nrows = nrows > RPB ? RPB : nrows; nrows = nrows < 0 ? 0 : nrows;
    f32x4 g[4];
#pragma unroll
    for (int j = 0; j < 4; ++j) g[j] = ((const f32x4*)gsrc)[lane + 64 * j];
    f32x4 vnext[4];
    if (wave < nrows) norm_load(xrow_in(R0 + wave, xlat, hctx), lane, vnext);
    for (int i = wave; i < nrows; i += NWAVES) { const int R = R0 + i; f32x4 o[4], v[4];
#pragma unroll
        for (int j = 0; j < 4; ++j) v[j] = vnext[j];
        if (i + NWAVES < nrows) norm_load(xrow_in(R + NWAVES, xlat, hctx), lane, vnext);
        norm_finish(v, xrow_in(R, xlat, hctx), modl, row_set(R), 3, g, lane, XN + (size_t)R * DM, o, ctx_pending(a, R));
        float lg[8];
#pragma unroll
        for (int e = 0; e < 8; ++e) { float s = 0.f;
#pragma unroll
            for (int j = 0; j < 4; ++j) { const f32x4 w = *(const LAS f32x4*)(rwT + e * DM + 4 * lane + 256 * j); s += (o[j].x * w.x + o[j].y * w.y) + (o[j].z * w.z + o[j].w * w.w); }
            lg[e] = wave_sum(s); }
        int e0 = 0; float v0 = lg[0];
#pragma unroll
        for (int e = 1; e < 8; ++e) if (lg[e] > v0) { v0 = lg[e]; e0 = e; }
        int e1 = -1; float v1 = -3.0e38f;
#pragma unroll
        for (int e = 0; e < 8; ++e) if (e != e0 && lg[e] > v1) { v1 = lg[e]; e1 = e; }
        if (lane == 0) { re[i] = e0 | (e1 << 8); rg[i] = 1.0f / (1.0f + __expf(v1 - v0)); }
    }
    __syncthreads();
    if (tid < nrows) { const int w = re[tid], e0 = w & 255, e1 = w >> 8; int r0 = 0, r1 = 0;
        for (int j = 0; j < tid; ++j) { const int wj = re[j]; r0 += ((wj & 255) == e0) ? 1 : 0; r1 += ((wj >> 8) == e1) ? 1 : 0; }
        ((int*)(ws + WS_RREC))[R0 + tid] = e0 | (e1 << 4) | (r0 << 8) | (r1 << 20); ((float*)(ws + WS_RRECG))[R0 + tid] = rg[tid]; }
    if (tid < 16) { int c = 0; for (int j = 0; j < nrows; ++j) { const int wj = re[j]; c += ((tid < 8 ? (wj & 255) : (wj >> 8)) == (tid & 7)) ? 1 : 0; }
        ((int*)(ws + WS_CNTB))[bx * 16 + tid] = c; }
    __syncthreads();
}
__device__ __forceinline__ void moe_tables(const Args& a, int lj, LAS unsigned char* lds, int G, int bx) {
    LAS int* tab = (LAS int*)(lds + TAB_OFF); const int tid = fresh_tid(); const int* cntb = (const int*)(fresh_ptr(a.ws) + WS_CNTB);
    if (tid < 16) { tab[32 + tid] = 0; tab[116 + tid] = 0; }
    __syncthreads();
    { const int sg = tid & 15; int c = 0, below = 0;
        for (int b = tid >> 4; b < G; b += NTHR / 16) { const int v = cntb[b * 16 + sg]; c += v; below += b < bx ? v : 0; }
        atomicAdd((int*)(tab + 32 + sg), c); atomicAdd((int*)(tab + 116 + sg), below); }
    __syncthreads();
    if (tid == 0) { int tb = 0, tm = 0, n0 = 0, n1 = 0;
        for (int s = 0; s < 16; ++s) { const int c = tab[32 + s]; const int nt = (c + 255) >> 8;
            tab[s] = tb; tab[64 + s] = tm; tb += nt; tm += nt > 0 ? nt - 1 : 0;
            if (nt > 0) { if (s < 8) tab[96 + n0++] = s; else tab[104 + n1++] = s; } }
        tab[16] = tb; tab[80] = tm; tab[112] = n0; tab[113] = n1; }
    __syncthreads();
    (void)lj;
}
__device__ __forceinline__ void phase_moe_gather(const Args& a, int li, LAS unsigned char* lds, int G, int bx) {
    const int tid = fresh_tid(), lane = tid & 63, wave = __builtin_amdgcn_readfirstlane(tid >> 6);
    moe_tables(a, li >> 1, lds, G, bx);
    const LAS int* tab = (const LAS int*)(lds + TAB_OFF);
    unsigned char* ws = fresh_ptr(a.ws);
    int* rtok = (int*)(ws + WS_RTOK); float* rgate = (float*)(ws + WS_RGATE); const int* rec = (const int*)(ws + WS_RREC); const float* recg = (const float*)(ws + WS_RRECG);
    const bf16* XN = (const bf16*)(ws + WS_XN); bf16* AG = (bf16*)(ws + WS_AG);
    const int RPB = (MROWS + G - 1) / G, R0 = bx * RPB; int nrows = MROWS - R0; nrows = nrows > RPB ? RPB : nrows; nrows = nrows < 0 ? 0 : nrows;
    for (int it0 = wave; it0 < 2 * nrows; it0 += 4 * NWAVES) {
        int Rr[4], sg[4], ix[4]; float gg[4]; bool ok[4]; v4u x0[4], x1[4];
#pragma unroll
        for (int u = 0; u < 4; ++u) { const int it = it0 + u * NWAVES; ok[u] = it < 2 * nrows; const int itc = ok[u] ? it : it0; const int k = itc & 1; Rr[u] = R0 + (itc >> 1);
            const int w = rec[Rr[u]]; const float g0 = recg[Rr[u]];
            const int e = k ? ((w >> 4) & 15) : (w & 15), rk = k ? (w >> 20) : ((w >> 8) & 4095); sg[u] = k * 8 + e; ix[u] = tab[116 + sg[u]] + rk; gg[u] = k ? 1.0f - g0 : g0; }
#pragma unroll
        for (int u = 0; u < 4; ++u) { const v4u* sp = (const v4u*)(XN + (size_t)Rr[u] * DM) + lane; x0[u] = sp[0]; x1[u] = sp[64]; }
#pragma unroll
        for (int u = 0; u < 4; ++u) if (ok[u]) {
            if (lane == 0) { rtok[(size_t)sg[u] * SEGCAP + ix[u]] = Rr[u]; rgate[(size_t)sg[u] * SEGCAP + ix[u]] = gg[u]; }
            v4u* dp = (v4u*)(AG + ((size_t)tab[sg[u]] * 256 + ix[u]) * DM) + lane; dp[0] = x0[u]; dp[64] = x1[u]; }
    }
}
__device__ __forceinline__ void phase_moe_fix(const Args& a, int li, int k, LAS unsigned char* lds, int G, int bx) {
    const int tid = fresh_tid(), lane = tid & 63, wave = __builtin_amdgcn_readfirstlane(tid >> 6);
    const int gw = bx * NWAVES + wave, NGW = G * NWAVES;
    moe_tables(a, li >> 1, lds, G, bx);
    const LAS int* tab = (const LAS int*)(lds + TAB_OFF);
    const int nt = tab[112 + k]; const int* rtok = (const int*)(fresh_ptr(a.ws) + WS_RTOK); const float* slab = (const float*)(fresh_ptr(a.ws) + WS_SLAB);
    float* hctx = (float*)(fresh_ptr(a.ws) + WS_HCTX);
    for (int it = gw; it < nt * 256; it += NGW) { const int jl = it >> 8, r = it & 255, s = tab[96 + 8 * k + jl];
        const int idx = (tab[s + 1] - 1 - tab[s]) * 256 + r; if (idx >= tab[32 + s]) continue;
        const int R = rtok[(size_t)s * SEGCAP + idx]; f32x4* xp = (f32x4*)xrow_out(R, a.out, hctx) + lane;
        const f32x4* sp = (const f32x4*)(slab + (size_t)((k * 8 + jl) * 16) * 65536 + r * 256) + lane;
#pragma unroll
        for (int j = 0; j < 4; ++j) { const f32x4* pp = sp + (size_t)j * 4 * 16384; xp[64 * j] = (((xp[64 * j] + pp[0]) + pp[16384]) + pp[2 * 16384]) + pp[3 * 16384]; } }
}

constexpr int PL_ZT = 0, PL_DT = 40960, PL_LIN = 74752;
__device__ __forceinline__ void pool_load_lin(const Args& a, int li, LAS unsigned char* lds) {
    LAS bf16* linT = (LAS bf16*)(lds + PL_LIN); const float* src = AIN(10) + (size_t)li * 4 * 64 * 64;
    for (int idx = fresh_tid(); idx < 4 * 4096; idx += NTHR) { const int g = idx >> 12, c = (idx >> 6) & 63, e = idx & 63; linT[(g * 64 + e) * 72 + c] = (bf16)f2bf(src[idx]); }
    __syncthreads();
}
__device__ __forceinline__ void pool_unit(const Args& a, int li, int p, LAS unsigned char* lds) {
    const int tid = fresh_tid(), lane = tid & 63, r32 = lane & 31, hi = lane >> 5, wave = __builtin_amdgcn_readfirstlane(tid >> 6);
    const bf16* Z = (const bf16*)(fresh_ptr(a.ws) + WS_Z); bf16* Y = (bf16*)(fresh_ptr(a.ws) + WS_Y);
    const int b = p >> 8, t0 = (p & 255) * 64, rowbase = b * RB + CTXL;
    LAS bf16* zt = (LAS bf16*)(lds + PL_ZT); LAS bf16* dt = (LAS bf16*)(lds + PL_DT); const LAS bf16* linT = (const LAS bf16*)(lds + PL_LIN);
    for (int idx = tid; idx < 80 * 32; idx += NTHR) { const int row = idx >> 5, ch8 = idx & 31, t = t0 - 8 + row; v4u w = {0u, 0u, 0u, 0u};
        if (t >= 0 && t < SEQ) w = *(const v4u*)(Z + (size_t)(rowbase + t) * INW + ch8 * 8);
        *(LAS v4u*)(zt + row * 256 + ch8 * 8) = w; }
    __syncthreads();
    { const int ch = tid & 255, th = tid >> 8, hw = 1 << (ch >> 6), tb = t0 + 32 * th; const LAS bf16* zc = zt + ch;
        float s = 0.f;
        for (int q = -hw; q < hw; ++q) s += bf2f(zc[(32 * th + 8 + q) * 256]);
#pragma unroll 4
        for (int tt = 0; tt < 32; ++tt) { const int t = tb + tt, rel = 32 * th + tt + 8; int lo = t - hw; lo = lo < 0 ? 0 : lo; int hq = t + hw; hq = hq > SEQ ? SEQ : hq;
            dt[(32 * th + tt) * 264 + ch] = (bf16)f2bf(s * __builtin_amdgcn_rcpf((float)(hq - lo)) - bf2f(zc[rel * 256]));
            s += bf2f(zc[(rel + hw) * 256]) - bf2f(zc[(rel - hw) * 256]); } }
    __syncthreads();
    { const int g = wave >> 1, th = wave & 1;
        bf16x8 bfr[4], afr[2][4];
#pragma unroll
        for (int ks = 0; ks < 4; ++ks) { bfr[ks] = *(const LAS bf16x8*)(dt + (32 * th + r32) * 264 + g * 64 + 16 * ks + 8 * hi);
#pragma unroll
            for (int mt = 0; mt < 2; ++mt) afr[mt][ks] = *(const LAS bf16x8*)(linT + (g * 64 + 32 * mt + r32) * 72 + 16 * ks + 8 * hi); }
        f32x16 acc[2];
#pragma unroll
        for (int mt = 0; mt < 2; ++mt) {
#pragma unroll
            for (int r = 0; r < 16; ++r) acc[mt][r] = 0.f;
#pragma unroll
            for (int ks = 0; ks < 4; ++ks) acc[mt] = __builtin_amdgcn_mfma_f32_32x32x16_bf16(afr[mt][ks], bfr[ks], acc[mt], 0, 0, 0); }
        const float* ps = AIN(11) + li * 256 + g * 64;
        bf16* yp = Y + (size_t)(rowbase + t0 + 32 * th + r32) * DM + g * 64;
#pragma unroll
        for (int mt = 0; mt < 2; ++mt)
#pragma unroll
            for (int rq = 0; rq < 4; ++rq) { const int e0 = 32 * mt + 8 * rq + 4 * hi; const f32x4 sc = *(const f32x4*)(ps + e0);
                v2u w; w.x = pk2(acc[mt][4 * rq] * sc.x, acc[mt][4 * rq + 1] * sc.y); w.y = pk2(acc[mt][4 * rq + 2] * sc.z, acc[mt][4 * rq + 3] * sc.w);
                *(v2u*)(yp + e0) = w; }
    }
    __syncthreads();
}
__device__ __forceinline__ void pool_ctx_pair(const Args& a, int li, int cp, LAS unsigned char* lds) {
    const int tid = fresh_tid();
    const bf16* Z = (const bf16*)(fresh_ptr(a.ws) + WS_Z); bf16* Y = (bf16*)(fresh_ptr(a.ws) + WS_Y);
    LAS float* dm = (LAS float*)(lds + PL_ZT);
    const int ct = 2 * cp + (tid >> 8), b = ct >> 8, t = ct & 255, ch = tid & 255, hw = 1 << (ch >> 6), rowbase = b * RB;
    int lo = t - hw; lo = lo < 0 ? 0 : lo; int hq = t + hw; hq = hq > CTXL ? CTXL : hq; float s = 0.f;
    for (int q = lo; q < hq; ++q) s += bf2f(Z[(size_t)(rowbase + q) * INW + ch]);
    dm[tid] = s / (float)(hq - lo) - bf2f(Z[(size_t)(rowbase + t) * INW + ch]);
    __syncthreads();
    { const int g = ch >> 6, eo = ch & 63; const float* lin = AIN(10) + (size_t)li * 4 * 64 * 64 + g * 4096 + eo; const LAS float* dr = dm + (tid >> 8) * 256 + g * 64; float acc = 0.f;
#pragma unroll 8
        for (int c = 0; c < 64; ++c) acc += dr[c] * lin[c * 64];
        Y[(size_t)(rowbase + t) * DM + ch] = (bf16)f2bf(acc * AIN(11)[li * 256 + ch]); }
    __syncthreads();
}

__device__ __forceinline__ void sconv2(const bf16* zr, int t0, int L, float w0, float w1, float w2, float sb, float& y0, float& y1) {
    const unsigned pr = *(const unsigned*)(zr + t0); const float z0 = __builtin_bit_cast(float, pr << 16), z1 = __builtin_bit_cast(float, pr & 0xffff0000u);
    const float zm = t0 > 0 ? bf2f(zr[t0 - 1]) : 0.f, zp = (t0 + 2 < L) ? bf2f(zr[t0 + 2]) : 0.f;
    y0 = sb + zm * w0 + z0 * w1 + z1 * w2; y1 = sb + z0 * w0 + z1 * w1 + zp * w2;
}
__device__ __forceinline__ void sconv8(const bf16* zr, int t0, int L, float w0, float w1, float w2, float sb, float (&y)[8]) {
    const v4u w = *(const v4u*)(zr + t0); float z[10];
    z[0] = t0 > 0 ? bf2f(zr[t0 - 1]) : 0.f; z[9] = (t0 + 8 < L) ? bf2f(zr[t0 + 8]) : 0.f;
#pragma unroll
    for (int e = 0; e < 4; ++e) { z[1 + 2 * e] = __builtin_bit_cast(float, w[e] << 16); z[2 + 2 * e] = __builtin_bit_cast(float, w[e] & 0xffff0000u); }
#pragma unroll
    for (int e = 0; e < 8; ++e) y[e] = sb + z[e] * w0 + z[e + 1] * w1 + z[e + 2] * w2;
}
__device__ __forceinline__ void hyena_unit(const Args& a, int li, int cp, int b, LAS unsigned char* lds) {
    const int tid = fresh_tid();
    unsigned char* ws = fresh_ptr(a.ws); const bf16* ZT = (const bf16*)(ws + WS_ZT); const bf16* ZTC = (const bf16*)(ws + WS_ZTC); bf16* Y = (bf16*)(ws + WS_Y);
    const float* sw = AIN(12) + (size_t)li * 3 * 768; const float* sbp = AIN(13) + (size_t)li * 768;
    LAS f32x2* X = (LAS f32x2*)lds;
    float o0[4][8];
    for (int ch = 0; ch < 2; ++ch) {
        const int c = 2 * cp + ch; const float hb = AIN(21)[li * 256 + c];
        const float a0 = sw[c], a1 = sw[768 + c], a2 = sw[1536 + c], ab = sbp[c];
        const float b0 = sw[256 + c], b1 = sw[768 + 256 + c], b2 = sw[1536 + 256 + c], bb = sbp[256 + c];
        const float c0 = sw[512 + c], c1 = sw[768 + 512 + c], c2 = sw[1536 + 512 + c], cb = sbp[512 + c];
        const f32x4* HF = (const f32x4*)(ws + WS_HF) + (size_t)c * 8193;
        const bf16* px0 = ZT + (size_t)(b * 768 + c) * SEQ; const bf16* px1 = ZT + (size_t)(b * 768 + 256 + c) * SEQ; const bf16* pv = ZT + (size_t)(b * 768 + 512 + c) * SEQ;
        float u[4][8];
#pragma unroll
        for (int r = 0; r < 4; ++r) { const int m = tid + NTHR * r; float vv[8], gg[8];
            sconv8(pv, 8 * m, SEQ, c0, c1, c2, cb, vv); sconv8(px1, 8 * m, SEQ, b0, b1, b2, bb, gg);
#pragma unroll
            for (int e = 0; e < 8; ++e) u[r][e] = vv[e] * gg[e];
            const int i0 = fidx(4 * m), i1 = fidx(4 * m + 8192);
#pragma unroll
            for (int q = 0; q < 4; ++q) { X[i0 + q] = (f32x2){u[r][2 * q], u[r][2 * q + 1]}; X[i1 + q] = (f32x2){0.f, 0.f}; } }
        __syncthreads();
        fft_fwd(X, tid);
        for (int k0 = tid; k0 <= 8192; k0 += 4 * NTHR) {
            f32x4 Hq[4];
#pragma unroll
            for (int q = 0; q < 4; ++q) Hq[q] = HF[k0 + q * NTHR <= 8192 ? k0 + q * NTHR : k0];
#pragma unroll
            for (int q = 0; q < 4; ++q) { const int r = k0 + q * NTHR; if (r > 8192) break;
            int j, jp, k; bool ev; pair_slots(r, j, jp, k, ev);
            const int sj = fidx(j), sp = fidx(jp);
            const f32x2 P = X[sj], Q = X[sp]; const f32x2 A = ev ? P : Q, B = ev ? Q : P; const f32x4 H = Hq[q];
            if (k == 0) { const float Y0 = (A.x + A.y) * H.x, YN = (A.x - A.y) * H.z; X[sj] = (f32x2){0.5f * (Y0 + YN), 0.5f * (Y0 - YN)}; }
            else { const float Ex = 0.5f * (A.x + B.x), Ey = 0.5f * (A.y - B.y), Ox = 0.5f * (A.y + B.y), Oy = -0.5f * (A.x - B.x);
                const float ang = (float)k * (1.0f / 32768.0f), wc = __builtin_amdgcn_cosf(ang), wsn = -__builtin_amdgcn_sinf(ang);
                const float px = Ox * wc - Oy * wsn, py = Ox * wsn + Oy * wc;
                const float Xkx = Ex + px, Xky = Ey + py, Xnx = Ex - px, Xny = -(Ey - py);
                const float Ykx = Xkx * H.x - Xky * H.y, Yky = Xkx * H.y + Xky * H.x, Ynx = Xnx * H.z - Xny * H.w, Yny = Xnx * H.w + Xny * H.z;
                const float Epx = 0.5f * (Ykx + Ynx), Epy = 0.5f * (Yky - Yny), Dx = Ykx - Ynx, Dy = Yky + Yny;
                const float Opx = 0.5f * (Dx * wc + Dy * wsn), Opy = 0.5f * (Dy * wc - Dx * wsn);
                const f32x2 na = {Epx - Opy, Epy + Opx}, nb = {Epx + Opy, -Epy + Opx};
                X[sj] = ev ? na : nb;
                if (k != 8192) X[sp] = ev ? nb : na; } } }
        __syncthreads();
        fft_inv(X, tid);
#pragma unroll
        for (int r = 0; r < 4; ++r) { const int m = tid + NTHR * r; float xx[8];
            sconv8(px0, 8 * m, SEQ, a0, a1, a2, ab, xx);
            const int i0 = fidx(4 * m); const f32x2 y0 = X[i0], y1 = X[i0 + 1], y2 = X[i0 + 2], y3 = X[i0 + 3];
            const float yv[8] = {y0.x, y0.y, y1.x, y1.y, y2.x, y2.y, y3.x, y3.y};
            bf16* yp = Y + (size_t)(b * RB + CTXL + 8 * m) * DM + 256 + 2 * cp;
            if (ch == 0) {
#pragma unroll
                for (int e = 0; e < 8; ++e) o0[r][e] = (yv[e] + u[r][e] * hb) * xx[e]; }
            else {
#pragma unroll
                for (int e = 0; e < 8; ++e) *(unsigned*)(yp + (size_t)e * DM) = pk2(o0[r][e], (yv[e] + u[r][e] * hb) * xx[e]); } }
        __syncthreads();
    }
    {
        LAS float* kc = (LAS float*)lds; LAS float* uc = kc + 1024;
        const int ch = tid >> 8, c = 2 * cp + ch, t = tid & 255, te = t & ~1;
        kc[tid] = ((const float*)(ws + WS_KCTX))[(size_t)(2 * cp) * 512 + tid]; kc[512 + tid] = ((const float*)(ws + WS_KCTX))[(size_t)(2 * cp + 1) * 512 + tid];
        const float hb = AIN(21)[li * 256 + c];
        const float a0 = sw[c], a1 = sw[768 + c], a2 = sw[1536 + c], ab = sbp[c];
        const float b0 = sw[256 + c], b1 = sw[768 + 256 + c], b2 = sw[1536 + 256 + c], bb = sbp[256 + c];
        const float c0 = sw[512 + c], c1 = sw[768 + 512 + c], c2 = sw[1536 + 512 + c], cb = sbp[512 + c];
        const bf16* px0 = ZTC + (size_t)(b * 768 + c) * CTXL; const bf16* px1 = ZTC + (size_t)(b * 768 + 256 + c) * CTXL; const bf16* pv = ZTC + (size_t)(b * 768 + 512 + c) * CTXL;
        float v0, v1, g0, g1, x00, x01;
        sconv2(pv, te, CTXL, c0, c1, c2, cb, v0, v1); sconv2(px1, te, CTXL, b0, b1, b2, bb, g0, g1); sconv2(px0, te, CTXL, a0, a1, a2, ab, x00, x01);
        const float u = (t & 1) ? v1 * g1 : v0 * g0, x0v = (t & 1) ? x01 : x00;
        uc[tid] = u;
        __syncthreads();
        float y = 0.f;
#pragma unroll 8
        for (int s2 = 0; s2 < CTXL; ++s2) y += kc[ch * 512 + ((t - s2) & 511)] * uc[ch * 256 + s2];
        Y[(size_t)(b * RB + t) * DM + 256 + c] = (bf16)f2bf((y + u * hb) * x0v);
        __syncthreads();
    }
}

__device__ __forceinline__ void glds16(const void* gsrc, unsigned lds_dst) { unsigned keep;
    asm volatile("s_mov_b32 %0, m0\n\ts_mov_b32 m0, %2\n\ts_nop 0\n\tglobal_load_lds_dwordx4 %1, off\n\ts_mov_b32 m0, %0" : "=&s"(keep) : "v"(gsrc), "s"(lds_dst) : "memory"); }
__device__ __forceinline__ s16x4 vtr(const LAS unsigned char* p) { return __builtin_bit_cast(s16x4, __builtin_amdgcn_ds_read_tr16_b64_v4i16((LAS v4i16_t*)p)); }
typedef __bf16 bf16x2n __attribute__((ext_vector_type(2)));
__device__ __forceinline__ unsigned cvtpk_s(float lo, float hi) { f32x2 v = {lo, hi}; bf16x2n b = __builtin_convertvector(v, bf16x2n); return __builtin_bit_cast(unsigned, b); }
__device__ __forceinline__ int crow(int r, int hi) { return (r & 3) + 8 * (r >> 2) + 4 * hi; }
#define ATT_WAIT_BAR(N) asm volatile("s_waitcnt vmcnt(" #N ") lgkmcnt(0)\n\ts_barrier" ::: "memory")
constexpr int ATT_WS = 98304;
__device__ __forceinline__ void attn_unit(LAS unsigned char* lds, const bf16* Z, int qrow0, int krow0, int NT, int h, float negb, float lam, float oscale, const float* sg, bf16* Y) {
    const int tid = fresh_tid(), lane = tid & 63, r32 = lane & 31, hi = lane >> 5; const int wid = __builtin_amdgcn_readfirstlane(tid >> 6); const int mp = wid >> 2, wq = wid & 3;
    const unsigned lds0 = (unsigned)(uintptr_t)lds;
    const int dr = lane >> 4, dsl = lane & 15;
    const bf16* ks0 = Z + (size_t)(krow0 + 4 * wid + dr) * INW + K_OFF + h * 128 + (dsl ^ ((4 * wid + dr) & 15)) * 8;
    const bf16* vs0 = Z + (size_t)(krow0 + 4 * wid + dr) * INW + V_OFF + h * 128 + (dsl ^ (dr << 2)) * 8;
#define DMA_K(t) do { const size_t off_ = (size_t)(t) * 64 * INW; const unsigned sb_ = lds0 + (unsigned)((t) % 3) * 16384u + wid * 1024; \
        glds16(ks0 + off_, (unsigned)__builtin_amdgcn_readfirstlane(sb_)); glds16(ks0 + off_ + (size_t)32 * INW, (unsigned)__builtin_amdgcn_readfirstlane(sb_ + 8192)); } while (0)
#define DMA_V(t) do { const size_t off_ = (size_t)(t) * 64 * INW; const unsigned sb_ = lds0 + 49152u + (unsigned)((t) & 1) * 16384u + wid * 1024; \
        glds16(vs0 + off_, (unsigned)__builtin_amdgcn_readfirstlane(sb_)); glds16(vs0 + off_ + (size_t)32 * INW, (unsigned)__builtin_amdgcn_readfirstlane(sb_ + 8192)); } while (0)
    int kof[4], vof[4];
    { const int g1 = (lane >> 4) & 1, q = (lane & 15) >> 2, p = lane & 3;
#pragma unroll
        for (int d0 = 0; d0 < 4; ++d0) { kof[d0] = r32 * 256 + (((mp * 8 + 2 * d0 + hi) ^ (r32 & 15)) << 4);
            vof[d0] = 49152 + (4 * hi + q) * 256 + (((4 * d0 + 2 * g1 + (p >> 1)) ^ (q << 2)) << 4) + (p & 1) * 8; } }
    bf16x8 qr[4];
    { const bf16* qp = Z + (size_t)(qrow0 + wq * 32 + r32) * INW + Q_OFF + h * 128 + mp * 64 + hi * 8;
#pragma unroll
        for (int d0 = 0; d0 < 4; ++d0) qr[d0] = *(const bf16x8*)(qp + d0 * 16); }
    DMA_K(0); DMA_K(1);
    if (mp) __builtin_amdgcn_s_setprio(1);
    f32x16 o[4];
#pragma unroll
    for (int d0 = 0; d0 < 4; ++d0)
#pragma unroll
        for (int r = 0; r < 16; ++r) o[d0][r] = 0.f;
    const f32x16 zero16 = {0.f, 0.f, 0.f, 0.f, 0.f, 0.f, 0.f, 0.f, 0.f, 0.f, 0.f, 0.f, 0.f, 0.f, 0.f, 0.f};
    float l_reg = 0.f;
    v4u pw[4];
    (void)negb;
#define ATT_QK(P0, P1, t) do { const LAS unsigned char* kp_ = lds + ((t) % 3) * 16384; \
        { bf16x8 kf_[4]; _Pragma("unroll") for (int d0 = 0; d0 < 4; ++d0) kf_[d0] = *(const LAS bf16x8*)(kp_ + kof[d0]); \
          P0 = __builtin_amdgcn_mfma_f32_32x32x16_bf16(kf_[0], qr[0], zero16, 0, 0, 0); \
          _Pragma("unroll") for (int d0 = 1; d0 < 4; ++d0) P0 = __builtin_amdgcn_mfma_f32_32x32x16_bf16(kf_[d0], qr[d0], P0, 0, 0, 0); } \
        { bf16x8 kf_[4]; _Pragma("unroll") for (int d0 = 0; d0 < 4; ++d0) kf_[d0] = *(const LAS bf16x8*)(kp_ + kof[d0] + 8192); \
          P1 = __builtin_amdgcn_mfma_f32_32x32x16_bf16(kf_[0], qr[0], zero16, 0, 0, 0); \
          _Pragma("unroll") for (int d0 = 1; d0 < 4; ++d0) P1 = __builtin_amdgcn_mfma_f32_32x32x16_bf16(kf_[d0], qr[d0], P1, 0, 0, 0); } } while (0)
#define ATT_EXP(P0, P1) do { float sa_ = 0.f, sb_ = 0.f; \
        _Pragma("unroll") for (int r = 0; r < 16; ++r) { P0[r] = __builtin_amdgcn_exp2f(P0[r]); P1[r] = __builtin_amdgcn_exp2f(P1[r]); sa_ += P0[r]; sb_ += P1[r]; } \
        l_reg += sa_ + sb_; } while (0)
#define ATT_PACK(P0, P1) do { \
        _Pragma("unroll") for (int q = 0; q < 4; ++q) { pw[0][q] = cvtpk_s(P0[2 * q], P0[2 * q + 1]); pw[1][q] = cvtpk_s(P0[8 + 2 * q], P0[8 + 2 * q + 1]); \
            pw[2][q] = cvtpk_s(P1[2 * q], P1[2 * q + 1]); pw[3][q] = cvtpk_s(P1[8 + 2 * q], P1[8 + 2 * q + 1]); } } while (0)
#define VTR(dst, addr, off) dst = vtr((const LAS unsigned char*)(addr) + (off))
#define ATT_VLOAD(V, t, d0) do { const unsigned va_ = lds0 + (unsigned)((t) & 1) * 16384u + (unsigned)vof[d0]; \
        VTR(V[0], va_, 0); VTR(V[1], va_, 2048); VTR(V[2], va_, 4096); VTR(V[3], va_, 6144); VTR(V[4], va_, 8192); VTR(V[5], va_, 10240); VTR(V[6], va_, 12288); VTR(V[7], va_, 14336); } while (0)
#define ATT_LGKM(n) asm volatile("s_waitcnt lgkmcnt(" #n ")" ::: "memory")
#define VFR(V, ks) (bf16x8){V[2 * (ks)][0], V[2 * (ks)][1], V[2 * (ks)][2], V[2 * (ks)][3], V[2 * (ks) + 1][0], V[2 * (ks) + 1][1], V[2 * (ks) + 1][2], V[2 * (ks) + 1][3]}
#define ATT_PVX(V, d0, P, B) do { \
        _Pragma("unroll") for (int ks = 0; ks < 4; ++ks) { o[d0] = __builtin_amdgcn_mfma_f32_32x32x16_bf16(__builtin_bit_cast(bf16x8, pw[ks]), VFR(V, ks), o[d0], 0, 0, 0); \
            P[B + 2 * ks] = __builtin_amdgcn_exp2f(P[B + 2 * ks]); P[B + 2 * ks + 1] = __builtin_amdgcn_exp2f(P[B + 2 * ks + 1]); sa_ += P[B + 2 * ks]; sb_ += P[B + 2 * ks + 1]; } \
        _Pragma("unroll") for (int ks = 0; ks < 4; ++ks) { __builtin_amdgcn_sched_group_barrier(0x008, 1, 0); __builtin_amdgcn_sched_group_barrier(0x400, 2, 0); __builtin_amdgcn_sched_group_barrier(0x002, 2, 0); } \
        __builtin_amdgcn_sched_barrier(0); } while (0)
#define ATT_PVONLY(V, d0) do { _Pragma("unroll") for (int ks = 0; ks < 4; ++ks) o[d0] = __builtin_amdgcn_mfma_f32_32x32x16_bf16(__builtin_bit_cast(bf16x8, pw[ks]), VFR(V, ks), o[d0], 0, 0, 0); __builtin_amdgcn_sched_barrier(0); } while (0)
#define ATT_TOP(t) do { if ((t) + 1 < NT) ATT_WAIT_BAR(2); else ATT_WAIT_BAR(0); DMA_V(t); if ((t) + 2 < NT) DMA_K((t) + 2); } while (0)
    { f32x16 p0, p1;
        ATT_TOP(0); ATT_QK(p0, p1, 0); ATT_EXP(p0, p1); ATT_PACK(p0, p1); }
    s16x4 va[8], vb[8];
    for (int t = 1; t < NT; ++t) {
        f32x16 p0, p1; float sa_ = 0.f, sb_ = 0.f;
        ATT_TOP(t);
        ATT_VLOAD(va, t - 1, 0); __builtin_amdgcn_sched_barrier(0);
        ATT_QK(p0, p1, t); __builtin_amdgcn_sched_barrier(0);
        ATT_VLOAD(vb, t - 1, 1); ATT_LGKM(8); __builtin_amdgcn_sched_barrier(0);
        ATT_PVX(va, 0, p0, 0);
        ATT_VLOAD(va, t - 1, 2); ATT_LGKM(8); __builtin_amdgcn_sched_barrier(0);
        ATT_PVX(vb, 1, p0, 8);
        ATT_VLOAD(vb, t - 1, 3); ATT_LGKM(8); __builtin_amdgcn_sched_barrier(0);
        ATT_PVX(va, 2, p1, 0);
        ATT_LGKM(0); __builtin_amdgcn_sched_barrier(0);
        ATT_PVX(vb, 3, p1, 8);
        l_reg += sa_ + sb_;
        ATT_PACK(p0, p1); }
    ATT_WAIT_BAR(0);
    ATT_VLOAD(va, NT - 1, 0); ATT_VLOAD(vb, NT - 1, 1); ATT_LGKM(8); ATT_PVONLY(va, 0);
    ATT_VLOAD(va, NT - 1, 2); ATT_LGKM(8); ATT_PVONLY(vb, 1);
    ATT_VLOAD(vb, NT - 1, 3); ATT_LGKM(8); ATT_PVONLY(va, 2);
    ATT_LGKM(0); ATT_PVONLY(vb, 3);
#undef ATT_EXP
#undef VTR
#undef ATT_VLOAD
#undef ATT_LGKM
#undef VFR
#undef ATT_PVX
#undef ATT_PVONLY
#undef ATT_PACK
#undef ATT_TOP
#undef ATT_QK
#undef ATT_PV
#undef DMA_K
#undef DMA_V
    __builtin_amdgcn_s_setprio(0);
    { auto rr = __builtin_amdgcn_permlane32_swap(__float_as_uint(l_reg), __float_as_uint(l_reg), false, false); l_reg = __uint_as_float(rr[0]) + __uint_as_float(rr[1]); }
    LAS float* wsf = (LAS float*)(lds + ATT_WS) + wid * 64;
    if (hi == 0) wsf[r32] = l_reg;
    LDS_WAIT();
    float rl[16];
#pragma unroll
    for (int r = 0; r < 16; ++r) rl[r] = __builtin_amdgcn_rcpf(wsf[crow(r, hi)]) * (mp ? lam : 1.0f);
    ATT_WAIT_BAR(0);
    LAS float* stg = (LAS float*)lds + wq * (32 * 132);
    if (mp == 1) {
#pragma unroll
        for (int d0 = 0; d0 < 4; ++d0)
#pragma unroll
            for (int r = 0; r < 16; ++r) stg[crow(r, hi) * 132 + d0 * 32 + r32] = o[d0][r] * rl[r];
    }
    ATT_WAIT_BAR(0);
    if (mp == 0) {
#pragma unroll
        for (int d0 = 0; d0 < 4; ++d0)
#pragma unroll
            for (int r = 0; r < 16; ++r) { const int ix = crow(r, hi) * 132 + d0 * 32 + r32; stg[ix] = o[d0][r] * rl[r] - stg[ix]; }
        LDS_WAIT();
        const int q = lane >> 1, half = lane & 1; const LAS float* rp = stg + q * 132 + half * 64;
        f32x4 v[16]; float ss = 0.f;
#pragma unroll
        for (int i = 0; i < 16; ++i) { v[i] = *(const LAS f32x4*)(rp + 4 * i); ss += (v[i].x * v[i].x + v[i].y * v[i].y) + (v[i].z * v[i].z + v[i].w * v[i].w); }
        ss += xor1_f(ss);
        const float rinv = __builtin_amdgcn_rsqf(ss * (1.0f / 128.0f) + 1e-6f) * oscale;
        bf16* yp = Y + (size_t)(qrow0 + wq * 32 + q) * DM + 512 + h * 128 + half * 64;
        const f32x4* sgp = (const f32x4*)(sg + half * 64);
#pragma unroll
        for (int i = 0; i < 8; ++i) { const f32x4 a0 = v[2 * i] * sgp[2 * i] * rinv, a1 = v[2 * i + 1] * sgp[2 * i + 1] * rinv;
            v4u w; w.x = pk2(a0.x, a0.y); w.y = pk2(a0.z, a0.w); w.z = pk2(a1.x, a1.y); w.w = pk2(a1.z, a1.w); *(v4u*)(yp + 8 * i) = w; }
    }
    ATT_WAIT_BAR(0);
}

__device__ __forceinline__ void attn_unit16(LAS unsigned char* lds, const bf16* Z, int qrow0, int krow0, int NT, int h, float lam, float oscale, const float* sg, bf16* Y) {
    const int tid = fresh_tid(), lane = tid & 63, r16 = lane & 15, g = lane >> 4; const int wid = __builtin_amdgcn_readfirstlane(tid >> 6); const int mp = wid >> 2, wq = wid & 3;
    const unsigned lds0 = (unsigned)(uintptr_t)lds;
    const int dr = lane >> 4, dsl = lane & 15;
    const bf16* ks0 = Z + (size_t)(krow0 + 4 * wid + dr) * INW + K_OFF + h * 128 + (dsl ^ ((4 * wid + dr) & 15)) * 8;
    const bf16* vs0 = Z + (size_t)(krow0 + 4 * wid + dr) * INW + V_OFF + h * 128 + (dsl ^ (dr << 2) ^ ((wid & 1) << 1)) * 8;
#define DMA_K(t) do { const size_t off_ = (size_t)(t) * 64 * INW; const unsigned sb_ = lds0 + (unsigned)((t) % 3) * 16384u + wid * 1024; \
        glds16(ks0 + off_, (unsigned)__builtin_amdgcn_readfirstlane(sb_)); glds16(ks0 + off_ + (size_t)32 * INW, (unsigned)__builtin_amdgcn_readfirstlane(sb_ + 8192)); } while (0)
#define DMA_V(t) do { const size_t off_ = (size_t)(t) * 64 * INW; const unsigned sb_ = lds0 + 49152u + (unsigned)((t) & 1) * 16384u + wid * 1024; \
        glds16(vs0 + off_, (unsigned)__builtin_amdgcn_readfirstlane(sb_)); glds16(vs0 + off_ + (size_t)32 * INW, (unsigned)__builtin_amdgcn_readfirstlane(sb_ + 8192)); } while (0)
    int kof[2];
    kof[0] = r16 * 256 + (((mp * 8 + g) ^ r16) << 4); kof[1] = r16 * 256 + (((mp * 8 + 4 + g) ^ r16) << 4);
    const int q4 = r16 >> 2, pq = r16 & 3;
    const int vrow = 49152 + (4 * g + q4) * 256 + (pq & 1) * 8, vx = (q4 << 2) ^ ((g & 1) << 1) ^ (pq >> 1);
    bf16x8 qf[2][2];
    { const bf16* qp = Z + (size_t)(qrow0 + wq * 32 + r16) * INW + Q_OFF + h * 128 + mp * 64 + g * 8;
#pragma unroll
        for (int qb = 0; qb < 2; ++qb)
#pragma unroll
            for (int ks = 0; ks < 2; ++ks) qf[qb][ks] = *(const bf16x8*)(qp + (size_t)qb * 16 * INW + ks * 32); }
    DMA_K(0); DMA_K(1);
    if (mp) __builtin_amdgcn_s_setprio(1);
    f32x4 o[2][8];
#pragma unroll
    for (int qb = 0; qb < 2; ++qb)
#pragma unroll
        for (int db = 0; db < 8; ++db) o[qb][db] = (f32x4){0.f, 0.f, 0.f, 0.f};
    const f32x4 zero4 = {0.f, 0.f, 0.f, 0.f};
    float l0 = 0.f, l1 = 0.f;
    v4u pw[2][2];
    f32x4 S[4][2];
#define ATT_QK(t) do { const LAS unsigned char* kp_ = lds + ((t) % 3) * 16384; \
        _Pragma("unroll") for (int kh = 0; kh < 2; ++kh) { bf16x8 kf_[2][2]; \
            _Pragma("unroll") for (int kb = 0; kb < 2; ++kb) _Pragma("unroll") for (int ks = 0; ks < 2; ++ks) kf_[kb][ks] = *(const LAS bf16x8*)(kp_ + kof[ks] + (2 * kh + kb) * 4096); \
            _Pragma("unroll") for (int kb = 0; kb < 2; ++kb) _Pragma("unroll") for (int qb = 0; qb < 2; ++qb) { \
                S[2 * kh + kb][qb] = __builtin_amdgcn_mfma_f32_16x16x32_bf16(kf_[kb][0], qf[qb][0], zero4, 0, 0, 0); \
                S[2 * kh + kb][qb] = __builtin_amdgcn_mfma_f32_16x16x32_bf16(kf_[kb][1], qf[qb][1], S[2 * kh + kb][qb], 0, 0, 0); } } } while (0)
#define ATT_EXPB(kb) do { _Pragma("unroll") for (int r = 0; r < 4; ++r) { S[kb][0][r] = __builtin_amdgcn_exp2f(S[kb][0][r]); S[kb][1][r] = __builtin_amdgcn_exp2f(S[kb][1][r]); sa_ += S[kb][0][r]; sb_ += S[kb][1][r]; } } while (0)
#define ATT_PACK() do { _Pragma("unroll") for (int qb = 0; qb < 2; ++qb) _Pragma("unroll") for (int s_ = 0; s_ < 2; ++s_) { \
        pw[qb][s_][0] = cvtpk_s(S[2 * s_][qb][0], S[2 * s_][qb][1]); pw[qb][s_][1] = cvtpk_s(S[2 * s_][qb][2], S[2 * s_][qb][3]); \
        pw[qb][s_][2] = cvtpk_s(S[2 * s_ + 1][qb][0], S[2 * s_ + 1][qb][1]); pw[qb][s_][3] = cvtpk_s(S[2 * s_ + 1][qb][2], S[2 * s_ + 1][qb][3]); } } while (0)
#define ATT_VLOAD(V, t, dg) do { const LAS unsigned char* vp_ = lds + ((t) & 1) * 16384 + vrow; \
        _Pragma("unroll") for (int dbl = 0; dbl < 2; ++dbl) { const int va_ = ((2 * (2 * (dg) + dbl)) ^ vx) << 4; \
            _Pragma("unroll") for (int s_ = 0; s_ < 2; ++s_) { V[(dbl * 2 + s_) * 2] = vtr(vp_ + va_ + s_ * 8192); V[(dbl * 2 + s_) * 2 + 1] = vtr(vp_ + va_ + s_ * 8192 + 4096); } } } while (0)
#define VFR(V, i) (bf16x8){V[2 * (i)][0], V[2 * (i)][1], V[2 * (i)][2], V[2 * (i)][3], V[2 * (i) + 1][0], V[2 * (i) + 1][1], V[2 * (i) + 1][2], V[2 * (i) + 1][3]}
#define ATT_PVG(V, dg) do { _Pragma("unroll") for (int dbl = 0; dbl < 2; ++dbl) _Pragma("unroll") for (int qb = 0; qb < 2; ++qb) _Pragma("unroll") for (int s_ = 0; s_ < 2; ++s_) \
            o[qb][2 * (dg) + dbl] = __builtin_amdgcn_mfma_f32_16x16x32_bf16(__builtin_bit_cast(bf16x8, pw[qb][s_]), VFR(V, dbl * 2 + s_), o[qb][2 * (dg) + dbl], 0, 0, 0); } while (0)
#define ATT_PVX(V, dg) do { ATT_PVG(V, dg); ATT_EXPB(dg); \
        _Pragma("unroll") for (int i_ = 0; i_ < 4; ++i_) { __builtin_amdgcn_sched_group_barrier(0x008, 2, 0); __builtin_amdgcn_sched_group_barrier(0x400, 2, 0); __builtin_amdgcn_sched_group_barrier(0x002, 2, 0); } \
        __builtin_amdgcn_sched_barrier(0); } while (0)
#define ATT_TOP(t) do { if ((t) + 1 < NT) ATT_WAIT_BAR(2); else ATT_WAIT_BAR(0); DMA_V(t); if ((t) + 2 < NT) DMA_K((t) + 2); } while (0)
#define ATT_LGKM(n) asm volatile("s_waitcnt lgkmcnt(" #n ")" ::: "memory")
    { float sa_ = 0.f, sb_ = 0.f; ATT_TOP(0); ATT_QK(0); ATT_EXPB(0); ATT_EXPB(1); ATT_EXPB(2); ATT_EXPB(3); l0 += sa_; l1 += sb_; ATT_PACK(); }
    s16x4 va[8], vb[8];
    for (int t = 1; t < NT; ++t) {
        float sa_ = 0.f, sb_ = 0.f;
        ATT_TOP(t);
        ATT_VLOAD(va, t - 1, 0); __builtin_amdgcn_sched_barrier(0);
        ATT_QK(t); __builtin_amdgcn_sched_barrier(0);
        ATT_VLOAD(vb, t - 1, 1); ATT_LGKM(8); __builtin_amdgcn_sched_barrier(0);
        ATT_PVX(va, 0);
        ATT_VLOAD(va, t - 1, 2); ATT_LGKM(8); __builtin_amdgcn_sched_barrier(0);
        ATT_PVX(vb, 1);
        ATT_VLOAD(vb, t - 1, 3); ATT_LGKM(8); __builtin_amdgcn_sched_barrier(0);
        ATT_PVX(va, 2);
        ATT_LGKM(0); __builtin_amdgcn_sched_barrier(0);
        ATT_PVX(vb, 3);
        l0 += sa_; l1 += sb_;
        ATT_PACK(); }
    ATT_WAIT_BAR(0);
    ATT_VLOAD(va, NT - 1, 0); ATT_VLOAD(vb, NT - 1, 1); ATT_LGKM(8); ATT_PVG(va, 0); __builtin_amdgcn_sched_barrier(0);
    ATT_VLOAD(va, NT - 1, 2); ATT_LGKM(8); ATT_PVG(vb, 1); __builtin_amdgcn_sched_barrier(0);
    ATT_VLOAD(vb, NT - 1, 3); ATT_LGKM(8); ATT_PVG(va, 2); __builtin_amdgcn_sched_barrier(0);
    ATT_LGKM(0); ATT_PVG(vb, 3);
#undef DMA_K
#undef DMA_V
#undef ATT_QK
#undef ATT_EXPB
#undef ATT_PACK
#undef ATT_VLOAD
#undef VFR
#undef ATT_PVG
#undef ATT_PVX
#undef ATT_TOP
#undef ATT_LGKM
    __builtin_amdgcn_s_setprio(0);
    l0 += xor16_f(l0); l0 = sum32_f(l0); l1 += xor16_f(l1); l1 = sum32_f(l1);
    LAS float* wsf = (LAS float*)(lds + ATT_WS) + wid * 64;
    if (g == 0) { wsf[r16] = l0; wsf[16 + r16] = l1; }
    LDS_WAIT();
    float rl[2][4];
#pragma unroll
    for (int qb = 0; qb < 2; ++qb)
#pragma unroll
        for (int r = 0; r < 4; ++r) rl[qb][r] = __builtin_amdgcn_rcpf(wsf[16 * qb + 4 * g + r]) * (mp ? lam : 1.0f);
    ATT_WAIT_BAR(0);
    LAS float* stg = (LAS float*)lds + wq * (32 * 132);
    if (mp == 1) {
#pragma unroll
        for (int qb = 0; qb < 2; ++qb)
#pragma unroll
            for (int db = 0; db < 8; ++db)
#pragma unroll
                for (int r = 0; r < 4; ++r) stg[(16 * qb + 4 * g + r) * 132 + 16 * db + r16] = o[qb][db][r] * rl[qb][r];
    }
    ATT_WAIT_BAR(0);
    if (mp == 0) {
#pragma unroll
        for (int qb = 0; qb < 2; ++qb)
#pragma unroll
            for (int db = 0; db < 8; ++db)
#pragma unroll
                for (int r = 0; r < 4; ++r) { const int ix = (16 * qb + 4 * g + r) * 132 + 16 * db + r16; stg[ix] = o[qb][db][r] * rl[qb][r] - stg[ix]; }
        LDS_WAIT();
        const int q = lane >> 1, half = lane & 1; const LAS float* rp = stg + q * 132 + half * 64;
        f32x4 v[16]; float ss = 0.f;
#pragma unroll
        for (int i = 0; i < 16; ++i) { v[i] = *(const LAS f32x4*)(rp + 4 * i); ss += (v[i].x * v[i].x + v[i].y * v[i].y) + (v[i].z * v[i].z + v[i].w * v[i].w); }
        ss += xor1_f(ss);
        const float rinv = __builtin_amdgcn_rsqf(ss * (1.0f / 128.0f) + 1e-6f) * oscale;
        bf16* yp = Y + (size_t)(qrow0 + wq * 32 + q) * DM + 512 + h * 128 + half * 64;
        const f32x4* sgp = (const f32x4*)(sg + half * 64);
#pragma unroll
        for (int i = 0; i < 8; ++i) { const f32x4 a0 = v[2 * i] * sgp[2 * i] * rinv, a1 = v[2 * i + 1] * sgp[2 * i + 1] * rinv;
            v4u w; w.x = pk2(a0.x, a0.y); w.y = pk2(a0.z, a0.w); w.z = pk2(a1.x, a1.y); w.w = pk2(a1.z, a1.w); *(v4u*)(yp + 8 * i) = w; }
    }
    ATT_WAIT_BAR(0);
}

__device__ __forceinline__ void phase_mixers(const Args& a, int li, LAS unsigned char* lds, int G, int bx) {
    unsigned char* ws = fresh_ptr(a.ws);
    for (int rep = 0; rep <= DUP_HY; ++rep) if (PHEN(13)) for (int c = bx; c < 256; c += G) { const int v = G == 256 ? (((c & 7) << 5) | (c >> 3)) : c; hyena_unit(a, li, v >> 1, v & 1, lds); }
    for (int rep = 0; rep <= DUP_POOL; ++rep) if (PHEN(14)) { pool_load_lin(a, li, lds);
    for (int p = bx; p < 512; p += G) pool_unit(a, li, p, lds);
    for (int cp = bx; cp < 256; cp += G) pool_ctx_pair(a, li, cp, lds); }
    if (!PHEN(15)) return;
    const float* qkg = AIN(22) + li * 128; const float* dl = AIN(23) + li * 256; const float* sg = AIN(24) + li * 128;
    float mq = 0.f, mk = 0.f, d1 = 0.f, d2 = 0.f;
    for (int q = 0; q < 64; ++q) { mq = __builtin_fmaxf(mq, __builtin_fabsf(qkg[q])); mk = __builtin_fmaxf(mk, __builtin_fabsf(qkg[64 + q])); d1 += dl[q] * dl[64 + q]; d2 += dl[128 + q] * dl[192 + q]; }
    const float lam_init = 0.8f - 0.6f * __expf(-0.3f * (float)li);
    const float lam = __expf(d1) - __expf(d2) + lam_init;
    const float negb = -(64.0f * mq * mk * C2);
    const bf16* Z = (const bf16*)(ws + WS_Z); bf16* Y = (bf16*)(ws + WS_Y);
    for (int rep = 0; rep <= DUP_ATT; ++rep)
    for (int i = 0; i * G + bx < 1024; ++i) {
        int bh, qb;
        if (G == 256) { const int vcu = (bx & 7) * 32 + (bx >> 3); bh = vcu >> 5; qb = (vcu & 31) + 32 * i; } else { const int u = i * G + bx; bh = u >> 7; qb = u & 127; }
        const int b = bh >> 2, h = bh & 3;
        attn_unit16(lds, Z, b * RB + CTXL + qb * 128, b * RB, RB / 64, h, lam, 1.0f - lam_init, sg, Y);
    }
    if (li < DEPTH - 1) for (int u = bx; u < 16; u += G) { const int b = u >> 3, h = (u >> 1) & 3, qh = u & 1;
        attn_unit16(lds, Z, b * RB + qh * 128, b * RB, CTXL / 64, h, lam, 1.0f - lam_init, sg, Y); }
}

constexpr int NPHASES = 2 * 9 + 2 * 13 - 6;
__global__ void __launch_bounds__(NTHR, 2) fwd(Args a) {
    extern __shared__ __attribute__((aligned(16))) unsigned char lds_raw[];
    LAS unsigned char* lds = (LAS unsigned char*)lds_raw;
    volatile LAS unsigned* MISC = (volatile LAS unsigned*)(lds + MISC_OFF);
    const int tid = threadIdx.x, G = gridDim.x, bx = blockIdx.x;
    if (tid < 128) MISC[tid] = 0u;
    if (tid < 64) ((LAS unsigned*)(lds + PTAB_OFF))[tid] = ((const __attribute__((address_space(4))) unsigned*)__builtin_amdgcn_kernarg_segment_ptr())[tid];
    __syncthreads();
    const int lo = a.ph_lo, hi = a.ph_hi;
    unsigned* ctl = (unsigned*)(fresh_ptr(a.ws) + WS_CTL);
    XcdBarrier bar; bar.bar = ctl + CW_BAR; bar.x = 0; bar.st = MISC + 8;
    if (hi - lo > 1) bar = xcd_barrier_post(ctl + CW_BAR, MISC + 8);
    int ph = 0;
#define ON() (ph >= lo && ph < hi)
#define ENDPH() do { if (ON() && ph + 1 < hi) xcd_barrier(bar); ++ph; } while (0)
#define WSP(off) (fresh_ptr(a.ws) + (off))
#define XN ((bf16*)WSP(WS_XN))
#define Zb ((bf16*)WSP(WS_Z))
#define Yb ((bf16*)WSP(WS_Y))
#define HID ((bf16*)WSP(WS_HID))
#define win_t ((bf16*)WSP(WS_WIN))
#define wout_t ((bf16*)WSP(WS_WOUT))
#define wup_t ((bf16*)WSP(WS_WUP))
#define wdn_t ((bf16*)WSP(WS_WDN))
#define hctx ((float*)WSP(WS_HCTX))
#define WSB WSP(0)
#define modl ((const float*)WSP(WS_MOD) + (size_t)li * 3 * 6144)
    for (int li = 0; li < DEPTH; ++li) {
        const bool moe = (li & 1) != 0;
        const float* xlat = li == 0 ? AIN(0) : (const float*)fresh_ptr(a.out);
        if (li == 0) {
            if (PHEN(0) && ON()) phase_prep_a(a, li, lds, G, bx);
            ENDPH();
            if (PHEN(1) && ON()) phase_prep_b(a, li, lds, G, bx);
            ENDPH();
            if (PHEN(2) && ON()) phase_norm(a, li, 0, xlat, lds, G, bx);
            ENDPH();
        } else {
            if (ON()) { if (PHEN(0)) phase_prep_a(a, li, lds, G, bx); if (PHEN(1)) phase_prep_b(a, li, lds, G, bx); if (PHEN(2)) phase_norm(a, li, 0, xlat, lds, G, bx); }
            ENDPH();
        }
        for (int rep = 0; rep <= DUP_GEMM; ++rep) if (PHEN(3) && ON()) { pg8::Gemm g{XN, win_t, MROWS, INW, DM}; pg8::StaticOrder S; S.init(MROWS, INW, DM, G, bx);
            EpiIn E{Zb, (bf16*)(WSB + WS_ZT), (bf16*)(WSB + WS_ZTC), (const float*)(WSB + WS_ROPE), (const float*)(WSB + WS_ROPE) + 4096, AIN(22) + li * 128};
            pg8::gemm_phase<EpiIn, pg8::StaticOrder, true, true>(lds, g, S, E); }
        ENDPH();
        if (PHEN(4) && ON()) phase_mixers(a, li, lds, G, bx);
        ENDPH();
#if DUP_ADD
        if (PHEN(5) && ON()) { pg8::Gemm g{Yb, wout_t, MROWS, DM, DM}; SplitTailOrder S; S.init(DM, DM, G, bx);
            EpiRes E{xlat, a.out, hctx, modl + 2 * DM, DM / 64, (float*)(WSB + WS_SLAB), 0.f};
            pg8::gemm_phase<EpiRes, SplitTailOrder, true, true>(lds, g, S, E); }
#endif
        if (PHEN(5) && ON()) { pg8::Gemm g{Yb, wout_t, MROWS, DM, DM}; SplitTailOrder S; S.init(DM, DM, G, bx);
            EpiRes E{xlat, a.out, hctx, modl + 2 * DM, DM / 64, (float*)(WSB + WS_SLAB), 1.f};
            pg8::gemm_phase<EpiRes, SplitTailOrder, true, true>(lds, g, S, E); }
        ENDPH();
        if (!moe) {
            if (PHEN(6) && ON()) phase_norm(a, li, 3, a.out, lds, G, bx);
            ENDPH();
            for (int rep = 0; rep <= DUP_GEMM; ++rep) if (PHEN(7) && ON()) { pg8::Gemm g{XN, wup_t, MROWS, 2 * DFF, DM}; pg8::StaticOrder S; S.init(MROWS, 2 * DFF, DM, G, bx);
                EpiGlu E{HID, DFF, DFF / 128};
                pg8::gemm_phase<EpiGlu, pg8::StaticOrder, true, true>(lds, g, S, E); }
            ENDPH();
#if DUP_ADD
            if (PHEN(8) && ON()) { pg8::Gemm g{HID, wdn_t, MROWS, DM, DFF}; SplitTailOrder S; S.init(DM, DFF, G, bx);
                EpiRes E{a.out, a.out, hctx, modl + 5 * DM, DFF / 64, (float*)(WSB + WS_SLAB), 0.f};
                pg8::gemm_phase<EpiRes, SplitTailOrder, true, true>(lds, g, S, E); }
#endif
            if (PHEN(8) && ON()) { pg8::Gemm g{HID, wdn_t, MROWS, DM, DFF}; SplitTailOrder S; S.init(DM, DFF, G, bx);
                EpiRes E{a.out, a.out, hctx, modl + 5 * DM, DFF / 64, (float*)(WSB + WS_SLAB), 1.f};
                pg8::gemm_phase<EpiRes, SplitTailOrder, true, true>(lds, g, S, E); }
            ENDPH();
        } else {
            const LAS int* tab = (const LAS int*)(lds + TAB_OFF);
            if (PHEN(9) && ON()) phase_norm_router(a, li, a.out, lds, G, bx);
            ENDPH();
            if (PHEN(10) && ON()) phase_moe_gather(a, li, lds, G, bx);
            ENDPH();
            for (int rep = 0; rep <= DUP_GEMM; ++rep) if (PHEN(11) && ON()) { moe_tables(a, li >> 1, lds, G, bx);
                pg8::Gemm g{(const bf16*)(WSB + WS_AG), wup_t, 0, 0, DM}; MoeOrder S{G, bx, 2 * DFE / 256, 0, tab[16] * (2 * DFE / 256), tab, DM / 64};
                EpiGlu E{HID, DFE, DFE / 128};
                pg8::gemm_phase<EpiGlu, MoeOrder, true, true>(lds, g, S, E); }
            ENDPH();
            for (int k = 0; k < 2; ++k) {
#if DUP_ADD
                if (PHEN(12) && ON()) { moe_tables(a, li >> 1, lds, G, bx);
                    pg8::Gemm g{HID, wdn_t, 0, 0, DFE}; MoeDownOrder S; S.init(G, bx, k, tab);
                    EpiMoeDown E{a.out, hctx, modl + 5 * DM, (const int*)(WSB + WS_RTOK), (const float*)(WSB + WS_RGATE), tab, (float*)(WSB + WS_SLAB), 0.f};
                    pg8::gemm_phase<EpiMoeDown, MoeDownOrder, true, true>(lds, g, S, E); }
#endif
                if (PHEN(12) && ON()) { moe_tables(a, li >> 1, lds, G, bx);
                    pg8::Gemm g{HID, wdn_t, 0, 0, DFE}; MoeDownOrder S; S.init(G, bx, k, tab);
                    EpiMoeDown E{a.out, hctx, modl + 5 * DM, (const int*)(WSB + WS_RTOK), (const float*)(WSB + WS_RGATE), tab, (float*)(WSB + WS_SLAB), 1.f};
                    pg8::gemm_phase<EpiMoeDown, MoeDownOrder, true, true>(lds, g, S, E); }
                ENDPH();
            }
            for (int k = 0; k < 2; ++k) { if (ON()) phase_moe_fix(a, li, k, lds, G, bx); ENDPH(); }
        }
    }
#undef ON
#undef ENDPH
#undef WSP
#undef XN
#undef Zb
#undef Yb
#undef HID
#undef win_t
#undef wout_t
#undef wup_t
#undef wdn_t
#undef hctx
#undef WSB
#undef modl
}

extern "C" void kernel_launch(void* const* d_in, const int* in_sizes, int n_in, void* d_out, int out_size, void* d_ws, size_t ws_size, hipStream_t stream) {
    static int grid = 0;
    if (grid == 0) {
        if (n_in != 32 || in_sizes[0] != NB * SEQ * DM || out_size != NB * SEQ * DM || ws_size < WS_END) {
            fprintf(stderr, "kernel_launch: unexpected problem: n_in %d in0 %d out %d ws %zu (need %zu)\n", n_in, n_in > 0 ? in_sizes[0] : -1, out_size, ws_size, (size_t)WS_END); grid = -1; return; }
        int dev = 0, cus = 0, per_cu = 0;
        if (hipGetDevice(&dev) != hipSuccess || hipDeviceGetAttribute(&cus, hipDeviceAttributeMultiprocessorCount, dev) != hipSuccess) { grid = -1; return; }
        if (hipFuncSetAttribute((const void*)fwd, hipFuncAttributeMaxDynamicSharedMemorySize, LDS_BYTES) != hipSuccess) { fprintf(stderr, "kernel_launch: hipFuncSetAttribute failed\n"); grid = -1; return; }
        if (hipOccupancyMaxActiveBlocksPerMultiprocessor(&per_cu, (const void*)fwd, NTHR, LDS_BYTES) != hipSuccess || per_cu < 1) { fprintf(stderr, "kernel_launch: occupancy query says %d\n", per_cu); }
        (void)hipGetLastError();
        grid = cus;
    }
    if (grid < 0) return;
    (void)hipMemsetAsync((char*)d_ws + WS_CTL, 0, CTL_ZERO_BYTES, stream);
    Args a{};
    for (int i = 0; i < 32; ++i) a.in[i] = (const float*)d_in[i];
    a.out = (float*)d_out; a.ws = (unsigned char*)d_ws;
#if MK_ONE_LAUNCH
    a.ph_lo = 0; a.ph_hi = NPHASES;
    hipLaunchKernelGGL(fwd, dim3(grid), dim3(NTHR), LDS_BYTES, stream, a);
#else
    for (int p = 0; p < NPHASES; ++p) { a.ph_lo = p; a.ph_hi = p + 1; hipLaunchKernelGGL(fwd, dim3(grid), dim3(NTHR), LDS_BYTES, stream, a); }
#endif
}
```

```cpp
#include <hip/hip_runtime.h>
#include <cstdio>
#include <cstdint>

#ifndef MK_ONE_LAUNCH
#define MK_ONE_LAUNCH 1
#endif
#ifndef PH_MASK
#define PH_MASK 0xFFFF
#endif
#define PHEN(n) (((PH_MASK) >> (n)) & 1)
#define DUP_ATT 0
#define DUP_HY 0
#define DUP_POOL 0
#define DUP_PREP 0
#define DUP_PREPB 0
#define DUP_GEMM 0
#define DUP_ADD 0

#define GAS __attribute__((address_space(1)))
#define LAS __attribute__((address_space(3)))
typedef unsigned short bf16;
typedef unsigned v4u __attribute__((ext_vector_type(4)));
typedef unsigned v2u __attribute__((ext_vector_type(2)));
typedef float f32x4 __attribute__((ext_vector_type(4)));
typedef float f32x2 __attribute__((ext_vector_type(2)));
typedef float f32x16 __attribute__((ext_vector_type(16)));
typedef short bf16x8 __attribute__((ext_vector_type(8)));
typedef short s16x4 __attribute__((ext_vector_type(4)));
typedef short v4i16_t __attribute__((ext_vector_type(4)));

constexpr int DM = 1024, NB = 2, SEQ = 16384, DEPTH = 4, CTXL = 256;
constexpr int RB = CTXL + SEQ;
constexpr int MROWS = NB * RB;
constexpr int TPB = RB / 256;
constexpr int INW = 2560, Q_OFF = 1024, K_OFF = 1536, V_OFF = 2048;
constexpr int DFF = 2816, DFE = 3584, NEXP = 8;
constexpr int NWAVES = 8, NTHR = 512;
constexpr int SEGCAP = MROWS;
constexpr float C2 = 0.125f * 1.4426950408889634f;

constexpr size_t MiB = 1u << 20;
constexpr size_t WS_CTL = 0, CTL_ZERO_BYTES = 1 * MiB;
constexpr size_t WS_MODP = 1 * MiB;
constexpr size_t WS_MOD = 4 * MiB;
constexpr size_t WS_ROPE = 4 * MiB + 512 * 1024;
constexpr size_t WS_H2C = 4 * MiB + 640 * 1024;
constexpr size_t WS_KCTX = 5 * MiB;
constexpr size_t WS_HCTX = 6 * MiB;
constexpr size_t WS_H2 = 8 * MiB;
constexpr size_t WS_RTOK = 12 * MiB;
constexpr size_t WS_RGATE = 15 * MiB;
constexpr size_t WS_RREC = 18 * MiB;
constexpr size_t WS_RRECG = 18 * MiB + 256 * 1024;
constexpr size_t WS_CNTB = 18 * MiB + 512 * 1024;
constexpr size_t WS_H2B = 19 * MiB;
constexpr size_t WS_W = 32 * MiB;
constexpr size_t WS_WIN = WS_W, WS_WOUT = WS_W + 5 * MiB, WS_WUP = WS_W + 8 * MiB, WS_WDN = WS_W + 120 * MiB;
constexpr size_t WS_XN = 224 * MiB;
constexpr size_t WS_Z = 289 * MiB;
constexpr size_t WS_ZT = 452 * MiB;
constexpr size_t WS_ZTC = WS_ZT + 48 * MiB;
constexpr size_t WS_Y = 501 * MiB;
constexpr size_t WS_HF = 566 * MiB;
constexpr size_t WS_HID = 289 * MiB;
constexpr size_t WS_AG = 772 * MiB;
constexpr size_t WS_SLAB = 910 * MiB;
constexpr size_t WS_END = 974 * MiB;

constexpr int CW_TMO = 0, CW_BAR = 4096, CW_MOECNT = 8192;

constexpr int LDS_BYTES = 159744;
constexpr int MISC_OFF = 155648;
constexpr int TAB_OFF = MISC_OFF + 256;

__device__ __forceinline__ unsigned f2bf(float f) { unsigned u = __builtin_bit_cast(unsigned, f); return (u + 0x7fffu + ((u >> 16) & 1u)) >> 16; }
__device__ __forceinline__ unsigned pk2(float lo, float hi) { return f2bf(lo) | (f2bf(hi) << 16); }
__device__ __forceinline__ float bf2f(bf16 b) { return __builtin_bit_cast(float, (unsigned)b << 16); }
template <int CTRL> __device__ __forceinline__ float dpp_f(float v) { return __builtin_bit_cast(float, __builtin_amdgcn_mov_dpp(__builtin_bit_cast(int, v), CTRL, 0xf, 0xf, true)); }
__device__ __forceinline__ float xor1_f(float v) { return dpp_f<0xB1>(v); }
__device__ __forceinline__ float xor2_f(float v) { return dpp_f<0x4E>(v); }
__device__ __forceinline__ float xor16_f(float v) { return __builtin_bit_cast(float, __builtin_amdgcn_ds_swizzle(__builtin_bit_cast(int, v), 0x401F)); }
__device__ __forceinline__ float xor32_f(float v) { auto rr = __builtin_amdgcn_permlane32_swap(__builtin_bit_cast(unsigned, v), __builtin_bit_cast(unsigned, v), false, false);
    return __builtin_bit_cast(float, (unsigned)rr[0]) == v ? __builtin_bit_cast(float, (unsigned)rr[1]) : __builtin_bit_cast(float, (unsigned)rr[0]); }
__device__ __forceinline__ float sum32_f(float v) { auto rr = __builtin_amdgcn_permlane32_swap(__builtin_bit_cast(unsigned, v), __builtin_bit_cast(unsigned, v), false, false);
    return __builtin_bit_cast(float, (unsigned)rr[0]) + __builtin_bit_cast(float, (unsigned)rr[1]); }
__device__ __forceinline__ float wave_sum(float v) {
    v += xor1_f(v); v += xor2_f(v); v += dpp_f<0x141>(v)  ; v += dpp_f<0x140>(v)  ; v += xor16_f(v);
    auto rr = __builtin_amdgcn_permlane32_swap(__builtin_bit_cast(unsigned, v), __builtin_bit_cast(unsigned, v), false, false);
    return __builtin_bit_cast(float, (unsigned)rr[0]) + __builtin_bit_cast(float, (unsigned)rr[1]);
}
__device__ __forceinline__ float sin_rev(float r) { return __builtin_amdgcn_sinf(__builtin_amdgcn_fractf(r)); }
__device__ __forceinline__ float cos_rev(float r) { return __builtin_amdgcn_cosf(__builtin_amdgcn_fractf(r)); }
__device__ __forceinline__ float sin_rad(float x) { return sin_rev(x * 0.15915494309189535f); }
__device__ __forceinline__ int fresh_tid() { int t = threadIdx.x; asm volatile("" : "+v"(t)); return t; }
template <class T> __device__ __forceinline__ T* fresh_ptr(T* p) { asm volatile("" : "+s"(p)); return (T*)(GAS T*)(unsigned long long)p; }
#define LDS_WAIT() asm volatile("s_waitcnt lgkmcnt(0)" ::: "memory")
#define VM_WAIT() asm volatile("s_waitcnt vmcnt(0)" ::: "memory")

namespace pg8 {
typedef unsigned short bf16_t;
typedef unsigned u32x4 __attribute__((ext_vector_type(4)));
constexpr int BM = 256, BK = 64, HALF = 128, HTB = HALF * BK * 2, STAGE_BYTES = 8 * HTB, NXCD = 8, WGM = 8;
__host__ __device__ __forceinline__ int lds_byte(int r, int c) { const int st = (r >> 4) * 2 + (c >> 5), rr = r & 15, cc = c & 31, ob = rr * 64 + cc * 2; return st * 1024 + (ob ^ (((ob >> 9) & 1) << 5)); }
__host__ __device__ __forceinline__ void stage_rc(int b, int& R, int& C) { const int st = b / 1024, sb = b % 1024, swz = sb ^ (((sb >> 9) & 1) << 5); R = (st >> 1) * 16 + swz / 64; C = (st & 1) * 32 + (swz % 64) / 2; }
__host__ __device__ __forceinline__ int perm32(int rho) { const int n = rho >> 4, i = rho & 15; return 8 * (i >> 2) + 4 * n + (i & 3); }
struct Unit { int pm, pn, ko, nt, sl; };
struct Gemm { const bf16_t* A; const bf16_t* Bt; int M, N, K; };
struct StaticOrder {
    int nM, nN, nwg, G, c;
    int ntk;
    __host__ __device__ void init(int M, int N, int K, int G_, int c_) { nM = M / BM; nN = N / BM; nwg = nM * nN; G = G_; c = c_; ntk = K / BK; }
    __host__ __device__ __forceinline__ bool next(int i, Unit& u) const { return map((long)i * G + c, u); }
    __host__ __device__ __forceinline__ bool map(long L, Unit& u) const {
        if (L >= nwg) return false; u.ko = 0; u.nt = ntk; u.sl = -1;
        int wgid = (int)L; { const int q = nwg / NXCD, r = nwg % NXCD, xcd = wgid % NXCD, off = wgid / NXCD; wgid = (xcd < r ? xcd * (q + 1) : r * (q + 1) + (xcd - r) * q) + off; }
        const int nig = WGM * nN, gid = wgid / nig, fm = gid * WGM, gsz = (nM - fm) < WGM ? (nM - fm) : WGM;
        u.pm = fm + ((wgid % nig) % gsz); u.pn = (wgid % nig) / gsz; return true;
    }
    __device__ __forceinline__ void a_ready(const Unit&) const {}
    __device__ __forceinline__ void done(const Unit&) const {}
};
__device__ __forceinline__ unsigned cvt_pk_bf16(float lo, float hi) { unsigned r; asm volatile("v_cvt_pk_bf16_f32 %0, %1, %2" : "=v"(r) : "v"(lo), "v"(hi)); return r; }

template <class Epi, class Sched, bool ALIGN_EPI = false, bool SP2 = false>
__device__ __forceinline__ void gemm_phase(LAS unsigned char* lds, const Gemm g, const Sched& S, const Epi& E) {
    const int tid = fresh_tid(), wid = __builtin_amdgcn_readfirstlane(tid >> 6), lane = tid & 63, wr = wid >> 2, wc = wid & 3, fr = lane & 15, fq = lane >> 4;
    const int K = g.K;
    unsigned voffA[2], voffB[2];
#pragma unroll
    for (int i = 0; i < 2; ++i) { int R, C; stage_rc(tid * 16 + i * 8192, R, C); const int Rb = Epi::PERM ? ((R & ~31) + perm32(R & 31)) : R;
        voffA[i] = (unsigned)(R * K + C) * 2u; voffB[i] = (unsigned)(Rb * K + C) * 2u; }
    const size_t kstep = (size_t)(BK * 2);
    const size_t hstep = (size_t)HALF * K * 2;
    const size_t tstep = 2 * hstep;
    const unsigned ldsw = (unsigned)wid * 1024u;
    const int aoff = lds_byte(wr * 64 + fr, fq * 8), boff = lds_byte(wc * 32 + fr, fq * 8);
#define PG8_SA(b, h) (((b) * 2 + (h)) * HTB)
#define PG8_SB(b, h) ((4 + (b) * 2 + (h)) * HTB)
#define PG8_STAGE(bufoff, gbase, voff) do { _Pragma("unroll") for (int _i = 0; _i < 2; ++_i) \
        __builtin_amdgcn_global_load_lds((const unsigned*)((const char*)(gbase) + (voff)[_i]), (LAS unsigned*)(lds + (bufoff) + ldsw + _i * 8192), 16, 0, 0); } while (0)
#define PG8_LDA(dst, b, h) do { _Pragma("unroll") for (int m = 0; m < 4; ++m) _Pragma("unroll") for (int k = 0; k < 2; ++k) dst[m][k] = *(const LAS bf16x8*)(lds + PG8_SA(b, h) + aoff + m * 2048 + k * 1024); } while (0)
#define PG8_LDB(dst, b, h) do { _Pragma("unroll") for (int n = 0; n < 2; ++n) _Pragma("unroll") for (int k = 0; k < 2; ++k) dst[n][k] = *(const LAS bf16x8*)(lds + PG8_SB(b, h) + boff + n * 2048 + k * 1024); } while (0)
#define PG8_MMA(ai, bj, At, Bt) do { __builtin_amdgcn_s_setprio(1); _Pragma("unroll") for (int m = 0; m < 4; ++m) _Pragma("unroll") for (int n = 0; n < 2; ++n) _Pragma("unroll") for (int k = 0; k < 2; ++k) \
        acc[ai][bj][m][n] = __builtin_amdgcn_mfma_f32_16x16x32_bf16(Bt[n][k], At[m][k], acc[ai][bj][m][n], 0, 0, 0); __builtin_amdgcn_s_setprio(0); } while (0)
#define PG8_WAIT_V(n) asm volatile("s_waitcnt vmcnt(" #n ")" ::: "memory")
#define PG8_WAIT_L(n) asm volatile("s_waitcnt lgkmcnt(" #n ")" ::: "memory")
#define PG8_BAR __builtin_amdgcn_s_barrier()
#define PG8_SCHED __builtin_amdgcn_sched_barrier(0)
    Unit cur, nxt; int ui = 0;
    if (!S.next(0, cur)) return;
    f32x4 acc[2][2][4][2];
#pragma unroll
    for (int a = 0; a < 2; ++a)
#pragma unroll
        for (int b = 0; b < 2; ++b)
#pragma unroll
            for (int m = 0; m < 4; ++m)
#pragma unroll
                for (int n = 0; n < 2; ++n) acc[a][b][m][n] = (f32x4){0.f, 0.f, 0.f, 0.f};
    bf16x8 At[4][2], B0[2][2], B1[2][2];
    const char* cA = (const char*)g.A + (size_t)cur.pm * tstep + (size_t)cur.ko * 2; const char* cB = (const char*)g.Bt + (size_t)cur.pn * tstep + (size_t)cur.ko * 2;
    S.a_ready(cur);
    if constexpr (SP2) {
        PG8_STAGE(PG8_SB(0, 0), cB, voffB); PG8_STAGE(PG8_SB(0, 1), cB + hstep, voffB); PG8_STAGE(PG8_SA(0, 0), cA, voffA); PG8_STAGE(PG8_SA(0, 1), cA + hstep, voffA);
        if (wr == 1) PG8_BAR;
        PG8_WAIT_V(2); PG8_BAR;
        PG8_STAGE(PG8_SB(1, 0), cB + kstep, voffB); PG8_STAGE(PG8_SA(1, 0), cA + kstep, voffA); PG8_STAGE(PG8_SB(1, 1), cB + hstep + kstep, voffB);
        PG8_WAIT_V(6); PG8_BAR;
    } else {
        PG8_STAGE(PG8_SB(0, 0), cB, voffB); PG8_STAGE(PG8_SA(0, 0), cA, voffA); PG8_STAGE(PG8_SB(0, 1), cB + hstep, voffB); PG8_STAGE(PG8_SA(0, 1), cA + hstep, voffA);
        if (wr == 1) PG8_BAR;
        PG8_WAIT_V(4); PG8_BAR;
        PG8_STAGE(PG8_SB(1, 0), cB + kstep, voffB); PG8_STAGE(PG8_SA(1, 0), cA + kstep, voffA); PG8_STAGE(PG8_SB(1, 1), cB + hstep + kstep, voffB);
        PG8_WAIT_V(6); PG8_BAR;
    }
    for (;;) {
        const bool has_next = S.next(ui + 1, nxt);
        const char* nA = has_next ? (const char*)g.A + (size_t)nxt.pm * tstep + (size_t)nxt.ko * 2 : cA; const char* nB = has_next ? (const char*)g.Bt + (size_t)nxt.pn * tstep + (size_t)nxt.ko * 2 : cB;
        const int nt = cur.nt;
        for (int t = 0; t < nt; t += 2) {
            const bool last = (t == nt - 2);
            const char* a1 = cA + (size_t)(t + 1) * kstep;
            const char* a2 = last ? nA : cA + (size_t)(t + 2) * kstep; const char* b2 = last ? nB : cB + (size_t)(t + 2) * kstep;
            const char* a3 = a2 + kstep; const char* b3 = b2 + kstep;
            if (last && has_next) S.a_ready(nxt);
            if constexpr (SP2) {
            PG8_LDB(B0, 0, 0); PG8_LDB(B1, 0, 1); PG8_SCHED; PG8_LDA(At, 0, 0); PG8_STAGE(PG8_SA(1, 1), a1 + hstep, voffA);
            PG8_WAIT_V(8); PG8_WAIT_L(0); PG8_BAR; PG8_MMA(0, 0, At, B0); PG8_MMA(0, 1, At, B1); PG8_BAR; PG8_SCHED;
            PG8_LDA(At, 0, 1); PG8_STAGE(PG8_SB(0, 0), b2, voffB); PG8_STAGE(PG8_SB(0, 1), b2 + hstep, voffB); PG8_STAGE(PG8_SA(0, 0), a2, voffA);
            PG8_WAIT_V(8); PG8_WAIT_L(0); PG8_BAR; PG8_MMA(1, 0, At, B0); PG8_MMA(1, 1, At, B1); PG8_BAR; PG8_SCHED;
            PG8_LDB(B0, 1, 0); PG8_LDB(B1, 1, 1); PG8_SCHED; PG8_LDA(At, 1, 0); PG8_STAGE(PG8_SA(0, 1), a2 + hstep, voffA);
            PG8_WAIT_V(8); PG8_WAIT_L(0); PG8_BAR; PG8_MMA(0, 0, At, B0); PG8_MMA(0, 1, At, B1); PG8_BAR; PG8_SCHED;
            PG8_LDA(At, 1, 1); PG8_STAGE(PG8_SB(1, 0), b3, voffB); PG8_STAGE(PG8_SB(1, 1), b3 + hstep, voffB); PG8_STAGE(PG8_SA(1, 0), a3, voffA);
            PG8_WAIT_V(8); PG8_WAIT_L(0); PG8_BAR; PG8_MMA(1, 0, At, B0); PG8_MMA(1, 1, At, B1); PG8_BAR; PG8_SCHED;
            } else {
            PG8_LDB(B0, 0, 0); PG8_SCHED; PG8_LDA(At, 0, 0); PG8_STAGE(PG8_SA(1, 1), a1 + hstep, voffA);
            PG8_WAIT_L(8); PG8_BAR; PG8_WAIT_L(0); PG8_MMA(0, 0, At, B0); PG8_BAR; PG8_SCHED;
            PG8_LDB(B1, 0, 1); PG8_STAGE(PG8_SB(0, 0), b2, voffB);
            PG8_BAR; PG8_WAIT_L(0); PG8_MMA(0, 1, At, B1); PG8_BAR;
            PG8_LDA(At, 0, 1); PG8_STAGE(PG8_SA(0, 0), a2, voffA);
            PG8_BAR; PG8_WAIT_L(0); PG8_MMA(1, 0, At, B0); PG8_BAR; PG8_SCHED;
            PG8_STAGE(PG8_SB(0, 1), b2 + hstep, voffB);
            PG8_WAIT_V(6); PG8_BAR; PG8_MMA(1, 1, At, B1); PG8_BAR;
            PG8_LDB(B0, 1, 0); PG8_SCHED; PG8_LDA(At, 1, 0); PG8_STAGE(PG8_SA(0, 1), a2 + hstep, voffA);
            PG8_WAIT_L(8); PG8_BAR; PG8_WAIT_L(0); PG8_MMA(0, 0, At, B0); PG8_BAR; PG8_SCHED;
            PG8_LDB(B1, 1, 1); PG8_STAGE(PG8_SB(1, 0), b3, voffB);
            PG8_BAR; PG8_WAIT_L(0); PG8_MMA(0, 1, At, B1); PG8_BAR;
            PG8_LDA(At, 1, 1); PG8_STAGE(PG8_SA(1, 0), a3, voffA);
            PG8_BAR; PG8_WAIT_L(0); PG8_MMA(1, 0, At, B0); PG8_BAR; PG8_SCHED;
            PG8_STAGE(PG8_SB(1, 1), b3 + hstep, voffB);
            PG8_WAIT_V(6); PG8_BAR; PG8_MMA(1, 1, At, B1); PG8_BAR;
            }
        }
        if constexpr (ALIGN_EPI) { if (wr == 0) PG8_BAR; }
        E(acc, cur, wr, wc, fr, fq); S.done(cur);
        if (!has_next) break;
#pragma unroll
        for (int a = 0; a < 2; ++a)
#pragma unroll
            for (int b = 0; b < 2; ++b)
#pragma unroll
                for (int m = 0; m < 4; ++m)
#pragma unroll
                    for (int n = 0; n < 2; ++n) acc[a][b][m][n] = (f32x4){0.f, 0.f, 0.f, 0.f};
        cur = nxt; cA = nA; cB = nB; ++ui;
        if constexpr (ALIGN_EPI) { if (wr == 1) PG8_BAR; }
    }
    PG8_WAIT_V(0);
    if constexpr (!ALIGN_EPI) { if (wr == 0) PG8_BAR; }
    PG8_BAR;
#undef PG8_SA
#undef PG8_SB
#undef PG8_STAGE
#undef PG8_LDA
#undef PG8_LDB
#undef PG8_MMA
#undef PG8_WAIT_V
#undef PG8_WAIT_L
#undef PG8_BAR
#undef PG8_SCHED
}
}

#define XB_TMO      128
#define XB_XCNT(j)  (256  + 64 * (j))
#define XB_XSUB(j)  (1280 + 64 * (j))
#define XB_XGEN(j)  (2304 + 64 * (j))
#define XB_TOP      3328
#define XB_TOPGEN   3392
#define XCD_BAR_WORDS 3456
#define XB_SPIN_CAP (1u << 18)
__device__ __forceinline__ unsigned xb_ld(unsigned* p)              { return __hip_atomic_load(p, __ATOMIC_RELAXED, __HIP_MEMORY_SCOPE_AGENT); }
__device__ __forceinline__ unsigned xb_add(unsigned* p, unsigned v) { return __hip_atomic_fetch_add(p, v, __ATOMIC_RELAXED, __HIP_MEMORY_SCOPE_AGENT); }
__device__ __forceinline__ unsigned xb_xcc_id() { return (unsigned)__builtin_amdgcn_s_getreg((3 << 11) | 20) & 0xFu; }
#define XB_SPIN(cond, bar) do { unsigned _sp = 0; while (cond) { __builtin_amdgcn_s_sleep(1); \
    if ((++_sp & 255u) == 0u) { if (xb_ld(&(bar)[XB_TMO])) break; if (_sp > XB_SPIN_CAP) { atomicAdd(&(bar)[XB_TMO], 1u); break; } } } } while (0)
struct XcdBarrier { unsigned* bar; unsigned x; volatile LAS unsigned* st; };
__device__ __forceinline__ XcdBarrier xcd_barrier_post(unsigned* bar, volatile LAS unsigned* st) {
    XcdBarrier b; b.bar = bar; b.x = xb_xcc_id(); b.st = st;
    if (threadIdx.x == 0) (void)xb_add(&bar[XB_XCNT(b.x)], 1u);
    return b;
}
__device__ __forceinline__ void xcd_barrier_complete(unsigned* bar, unsigned x, unsigned& nloc, unsigned& nx) {
    const unsigned G = gridDim.x * gridDim.y * gridDim.z;
    unsigned sum, cnt, mine, sp = 0u;
    for (;;) {
        sum = 0u; cnt = 0u; mine = 0u;
#pragma unroll
        for (unsigned j = 0; j < 16; ++j) { const unsigned c = xb_ld(&bar[XB_XCNT(j)]); sum += c; cnt += (c > 0u) ? 1u : 0u; mine = (j == x) ? c : mine; }
        if (sum == G) break;
        __builtin_amdgcn_s_sleep(1);
        if ((++sp & 255u) == 0u) { if (xb_ld(&bar[XB_TMO])) break; if (sp > XB_SPIN_CAP) { atomicAdd(&bar[XB_TMO], 1u); break; } }
    }
    nloc = mine > 0u ? mine : 1u; nx = cnt > 0u ? cnt : 1u;
}
__device__ __forceinline__ void xcd_barrier(const XcdBarrier& b) {
    asm volatile("s_waitcnt vmcnt(0)" ::: "memory");
    __syncthreads();
    if (threadIdx.x == 0) {
        unsigned* bar = b.bar;
        __builtin_amdgcn_s_waitcnt(0);
        unsigned nloc = b.st[0], nx = b.st[1];
        if (nloc == 0u) { xcd_barrier_complete(bar, b.x, nloc, nx); b.st[0] = nloc; b.st[1] = nx; }
        const unsigned old = xb_add(&bar[XB_XSUB(b.x)], 1u);
        const unsigned gen = old / nloc;
        if (old + 1u == (gen + 1u) * nloc) {
            __builtin_amdgcn_fence(__ATOMIC_RELEASE, "agent");
            asm volatile("s_waitcnt vmcnt(0)" ::: "memory");
            const unsigned og = xb_add(&bar[XB_TOP], 1u);
            const unsigned tg = og / nx;
            if (og + 1u == (tg + 1u) * nx) xb_add(&bar[XB_TOPGEN], 1u);
            else XB_SPIN(xb_ld(&bar[XB_TOPGEN]) == tg, bar);
            __builtin_amdgcn_fence(__ATOMIC_ACQUIRE, "agent");
            xb_add(&bar[XB_XGEN(b.x)], 1u);
            asm volatile("s_waitcnt vmcnt(0)" ::: "memory");
        } else {
            XB_SPIN(xb_ld(&bar[XB_XGEN(b.x)]) == gen, bar);
            __builtin_amdgcn_fence(__ATOMIC_ACQUIRE, "agent");
            asm volatile("s_waitcnt vmcnt(0)" ::: "memory");
        }
    }
    __syncthreads();
}

__device__ __forceinline__ const float* xrow_in(int R, const float* xlat, const float* hctx) {
    const int b = R / RB, rr = R - b * RB;
    return rr < CTXL ? hctx + (size_t)(b * CTXL + rr) * DM : xlat + (size_t)(b * SEQ + rr - CTXL) * DM;
}
__device__ __forceinline__ float* xrow_out(int R, float* xlat, float* hctx) {
    const int b = R / RB, rr = R - b * RB;
    return rr < CTXL ? hctx + (size_t)(b * CTXL + rr) * DM : xlat + (size_t)(b * SEQ + rr - CTXL) * DM;
}
__device__ __forceinline__ int row_set(int R) { const int b = R / RB, rr = R - b * RB; return rr < CTXL ? 2 : b; }

__device__ __forceinline__ int qk_perm(int c) {
    const int bj = c >> 7, wc = (c >> 5) & 3, fq = (c >> 3) & 3, n = (c >> 2) & 1, j = c & 3;
    return 64 * wc + 32 * (fq >> 1) + 16 * bj + 8 * (fq & 1) + 4 * n + j;
}
struct EpiIn {
    static constexpr bool PERM = true;
    bf16* Z; bf16* ZT; bf16* ZTC; const float* ropec; const float* ropes; const float* qkg;
    __device__ __forceinline__ void operator()(const f32x4 (&acc)[2][2][4][2], const pg8::Unit& u, int wr, int wc, int fr, int fq) const {
        const int b = u.pm / TPB, jt = u.pm - b * TPB; const bool isctx = (jt == 0);
        if (u.pn == 0 || u.pn >= 8) {
#pragma unroll
            for (int ai = 0; ai < 2; ++ai)
#pragma unroll
                for (int m = 0; m < 4; ++m) { const int r = 128 * ai + 64 * wr + 16 * m + fr; bf16* rowp = Z + (size_t)(u.pm * 256 + r) * INW + u.pn * 256 + 32 * wc + 8 * fq;
#pragma unroll
                    for (int bj = 0; bj < 2; ++bj) { const f32x4 v0 = acc[ai][bj][m][0], v1 = acc[ai][bj][m][1];
                        v4u w; w.x = pg8::cvt_pk_bf16(v0[0], v0[1]); w.y = pg8::cvt_pk_bf16(v0[2], v0[3]); w.z = pg8::cvt_pk_bf16(v1[0], v1[1]); w.w = pg8::cvt_pk_bf16(v1[2], v1[3]);
                        *(v4u*)(rowp + bj * 128) = w; } }
        } else if (u.pn <= 3) {
            bf16* base = isctx ? ZTC + (size_t)b * 768 * CTXL : ZT + (size_t)b * 768 * SEQ + (size_t)(jt - 1) * 256;
            const size_t cstride = isctx ? CTXL : SEQ;
#pragma unroll
            for (int bj = 0; bj < 2; ++bj)
#pragma unroll
                for (int n = 0; n < 2; ++n)
#pragma unroll
                    for (int j = 0; j < 4; ++j) { const int ch = 256 * (u.pn - 1) + 128 * bj + 32 * wc + 8 * fq + 4 * n + j; bf16* cp = base + (size_t)ch * cstride;
#pragma unroll
                        for (int ai = 0; ai < 2; ++ai)
#pragma unroll
                            for (int m = 0; m < 4; ++m) { const int r = 128 * ai + 64 * wr + 16 * m + fr; cp[r] = (bf16)f2bf(acc[ai][bj][m][n][j]); } }
        } else {
            const int which = (u.pn >= 6) ? 1 : 0; const float osc = which ? 1.0f : C2;
            const int axis = fq >> 1, f0 = 8 * (fq & 1);
            float ga[2][4], gb[2][4];
#pragma unroll
            for (int n = 0; n < 2; ++n)
#pragma unroll
                for (int j = 0; j < 4; ++j) { ga[n][j] = qkg[which * 64 + 32 * axis + f0 + 4 * n + j]; gb[n][j] = qkg[which * 64 + 32 * axis + 16 + f0 + 4 * n + j]; }
#pragma unroll
            for (int ai = 0; ai < 2; ++ai)
#pragma unroll
                for (int m = 0; m < 4; ++m) {
                    const int r = 128 * ai + 64 * wr + 16 * m + fr;
                    float ss = 0.f;
#pragma unroll
                    for (int bj = 0; bj < 2; ++bj)
#pragma unroll
                        for (int n = 0; n < 2; ++n) { const f32x4 x = acc[ai][bj][m][n]; ss += (x[0] * x[0] + x[1] * x[1]) + (x[2] * x[2] + x[3] * x[3]); }
                    ss += xor16_f(ss); ss = sum32_f(ss);
                    const float rinv = __builtin_amdgcn_rsqf(ss * (1.0f / 64.0f) + 1e-6f);
                    f32x4 cv[2], sv[2];
                    if (!isctx) { const int t = (jt - 1) * 256 + r; const int pos = axis ? (t & 63) : (t >> 6);
                        cv[0] = *(const f32x4*)(ropec + pos * 16 + f0); cv[1] = *(const f32x4*)(ropec + pos * 16 + f0 + 4);
                        sv[0] = *(const f32x4*)(ropes + pos * 16 + f0); sv[1] = *(const f32x4*)(ropes + pos * 16 + f0 + 4); }
                    else { cv[0] = cv[1] = (f32x4){1.f, 1.f, 1.f, 1.f}; sv[0] = sv[1] = (f32x4){0.f, 0.f, 0.f, 0.f}; }
                    float oa[8], ob[8];
#pragma unroll
                    for (int n = 0; n < 2; ++n)
#pragma unroll
                        for (int j = 0; j < 4; ++j) { const float a = acc[ai][0][m][n][j] * rinv * ga[n][j], bb = acc[ai][1][m][n][j] * rinv * gb[n][j];
                            oa[4 * n + j] = (a * cv[n][j] - bb * sv[n][j]) * osc; ob[4 * n + j] = (bb * cv[n][j] + a * sv[n][j]) * osc; }
                    bf16* rowp = Z + (size_t)(u.pm * 256 + r) * INW + u.pn * 256 + 64 * wc + 32 * axis + f0;
                    v4u w; w.x = pg8::cvt_pk_bf16(oa[0], oa[1]); w.y = pg8::cvt_pk_bf16(oa[2], oa[3]); w.z = pg8::cvt_pk_bf16(oa[4], oa[5]); w.w = pg8::cvt_pk_bf16(oa[6], oa[7]);
                    *(v4u*)(rowp) = w;
                    w.x = pg8::cvt_pk_bf16(ob[0], ob[1]); w.y = pg8::cvt_pk_bf16(ob[2], ob[3]); w.z = pg8::cvt_pk_bf16(ob[4], ob[5]); w.w = pg8::cvt_pk_bf16(ob[6], ob[7]);
                    *(v4u*)(rowp + 16) = w;
                }
        }
    }
};
struct EpiRes {
    static constexpr bool PERM = false;
    const float* xin; float* xout; float* hctx; const float* gate; int ntk_full; float* slab; float gsc;
    __device__ __forceinline__ void operator()(const f32x4 (&acc)[2][2][4][2], const pg8::Unit& u, int wr, int wc, int fr, int fq) const {
        const int b = u.pm / TPB, jt = u.pm - b * TPB; const bool isctx = (jt == 0); const int set = isctx ? 2 : b;
        const int col0 = u.pn * 256 + wc * 32 + 4 * fq;
        f32x4 gv[2][2];
#pragma unroll
        for (int bj = 0; bj < 2; ++bj)
#pragma unroll
            for (int n = 0; n < 2; ++n) gv[bj][n] = *(const f32x4*)(gate + set * 6144 + col0 + bj * 128 + n * 16) * gsc;
        const unsigned long long coff = (unsigned long long)(b * CTXL) * DM * 4, loff = (unsigned long long)(b * SEQ + (jt - 1) * 256) * DM * 4;
        const unsigned long long ia = isctx ? (unsigned long long)hctx + coff : (unsigned long long)xin + loff, oa = isctx ? (unsigned long long)hctx + coff : (unsigned long long)xout + loff;
        const GAS char* ib = (const GAS char*)ia; GAS char* ob = (GAS char*)oa;
        const unsigned lo = (unsigned)((64 * wr + fr) * DM + col0) * 4u;
        if (u.nt == ntk_full) {
#pragma unroll
            for (int ai = 0; ai < 2; ++ai)
#pragma unroll
                for (int m = 0; m < 4; ++m) { const unsigned off = lo + (unsigned)(128 * ai + 16 * m) * DM * 4u;
#pragma unroll
                    for (int bj = 0; bj < 2; ++bj)
#pragma unroll
                        for (int n = 0; n < 2; ++n) { const f32x4 xi = *(const GAS f32x4*)(ib + off + (bj * 128 + n * 16) * 4); *(GAS f32x4*)(ob + off + (bj * 128 + n * 16) * 4) = xi + gv[bj][n] * acc[ai][bj][m][n]; }
                    if (m == 3) asm volatile("" ::: "memory"); }
        } else {
            int fr_ = fr; asm volatile("" : "+v"(fr_));
            GAS float* sp = (GAS float*)(slab + (size_t)u.sl * 65536) + (unsigned)((64 * wr + fr_) * 256 + wc * 32 + 4 * fq);
#pragma unroll
            for (int ai = 0; ai < 2; ++ai)
#pragma unroll
                for (int m = 0; m < 4; ++m)
#pragma unroll
                    for (int bj = 0; bj < 2; ++bj)
#pragma unroll
                        for (int n = 0; n < 2; ++n) *(GAS f32x4*)(sp + (128 * ai + 16 * m) * 256 + bj * 128 + n * 16) = gv[bj][n] * acc[ai][bj][m][n];
        }
    }
};
__device__ __forceinline__ float silu_mul(float g, float u) { return g * u * __builtin_amdgcn_rcpf(1.0f + __builtin_amdgcn_exp2f(-1.4426950408889634f * g)); }
struct EpiGlu {
    static constexpr bool PERM = true;
    bf16* H; int ldh; int NT;
    __device__ __forceinline__ void operator()(const f32x4 (&acc)[2][2][4][2], const pg8::Unit& u, int wr, int wc, int fr, int fq) const {
        const int nt = u.pn % NT;
#pragma unroll
        for (int ai = 0; ai < 2; ++ai)
#pragma unroll
            for (int m = 0; m < 4; ++m) { const int r = 128 * ai + 64 * wr + 16 * m + fr; bf16* rowp = H + (size_t)(u.pm * 256 + r) * ldh + nt * 128 + 32 * wc + 8 * fq;
                float o[8];
#pragma unroll
                for (int n = 0; n < 2; ++n)
#pragma unroll
                    for (int j = 0; j < 4; ++j) o[4 * n + j] = silu_mul(acc[ai][0][m][n][j], acc[ai][1][m][n][j]);
                v4u w; w.x = pg8::cvt_pk_bf16(o[0], o[1]); w.y = pg8::cvt_pk_bf16(o[2], o[3]); w.z = pg8::cvt_pk_bf16(o[4], o[5]); w.w = pg8::cvt_pk_bf16(o[6], o[7]);
                *(v4u*)rowp = w; }
    }
};
__device__ __forceinline__ void k_quarter(int ntk, int kq, int& ko, int& nt) {
    const int pairs = ntk >> 1; int start = 0, len = 0;
#pragma unroll
    for (int q = 0; q < 4; ++q) { const int l = (pairs + 3 - q) >> 2; if (q < kq) start += l; if (q == kq) len = l; }
    ko = start * 128; nt = len * 2;
}
struct SplitTailOrder {
    pg8::StaticOrder S; int nN, nmain;
    __device__ __forceinline__ void init(int N, int K, int G, int c) { S.init(NB * SEQ, N, K, G, c); nN = N / 256; nmain = (NB * SEQ / 256) * nN; }
    __device__ __forceinline__ bool next(int i, pg8::Unit& u) const {
        const long L = (long)i * S.G + S.c;
        if (L < nmain) { S.map(L, u); u.pm += 1 + (u.pm >= SEQ / 256 ? 1 : 0); return true; }
        const int Lt = (int)(L - nmain); if (Lt >= 2 * nN * 4) return false;
        const int kq = Lt & 3, r = Lt >> 2; u.pn = r % nN; u.pm = (r / nN) * TPB; k_quarter(S.ntk, kq, u.ko, u.nt); u.sl = ((r / nN) * 4 + u.pn) * 4 + kq; return true;
    }
    __device__ __forceinline__ void a_ready(const pg8::Unit&) const {}
    __device__ __forceinline__ void done(const pg8::Unit&) const {}
};
struct MoeOrder {
    int G, c, NT, tlo, nunits; const LAS int* tab; int ntk;
    __device__ __forceinline__ bool next(int i, pg8::Unit& u) const {
        const int L = i * G + c; if (L >= nunits) return false;
        const int tau = tlo + L / NT, nt = L - (L / NT) * NT;
        int s = 0;
#pragma unroll
        for (int q = 1; q < 16; ++q) s += (tab[q] <= tau) ? 1 : 0;
        u.pm = tau; u.pn = (s & 7) * NT + nt; u.ko = 0; u.nt = ntk; u.sl = -1; return true;
    }
    __device__ __forceinline__ void a_ready(const pg8::Unit&) const {}
    __device__ __forceinline__ void done(const pg8::Unit&) const {}
};
struct MoeDownOrder {
    int G, c, k, nmain, ntailu; const LAS int* tab;
    __device__ __forceinline__ void init(int G_, int c_, int k_, const LAS int* tab_) { G = G_; c = c_; k = k_; tab = tab_; nmain = (tab[64 + 8 * k + 8] - tab[64 + 8 * k]) * 4; ntailu = tab[112 + k] * 16; }
    __device__ __forceinline__ bool next(int i, pg8::Unit& u) const {
        const int L = i * G + c;
        if (L < nmain) { const int mu = tab[64 + 8 * k] + (L >> 2); int s = 0;
#pragma unroll
            for (int q = 1; q < 16; ++q) s += (tab[64 + q] <= mu) ? 1 : 0;
            u.pm = tab[s] + (mu - tab[64 + s]); u.pn = (s & 7) * 4 + (L & 3); u.ko = 0; u.nt = DFE / 64; u.sl = -1; return true; }
        const int Lt = L - nmain; if (Lt >= ntailu) return false;
        const int s = tab[96 + 8 * k + (Lt >> 4)]; u.pm = tab[s + 1] - 1; u.pn = (s & 7) * 4 + ((Lt >> 2) & 3); k_quarter(DFE / 64, Lt & 3, u.ko, u.nt); u.sl = 8 * 16 * k + Lt; return true;
    }
    __device__ __forceinline__ void a_ready(const pg8::Unit&) const {}
    __device__ __forceinline__ void done(const pg8::Unit&) const {}
};
struct EpiMoeDown {
    static constexpr bool PERM = false;
    float* xlat; float* hctx; const float* gate; const int* rtok; const float* rgate; const LAS int* tab; float* slab; float gsc;
    __device__ __forceinline__ void operator()(const f32x4 (&acc)[2][2][4][2], const pg8::Unit& u, int wr, int wc, int fr, int fq) const {
        const int tau = u.pm; int s = 0;
#pragma unroll
        for (int q = 1; q < 16; ++q) s += (tab[q] <= tau) ? 1 : 0;
        const int idx0 = (tau - tab[s]) * 256, cnt = tab[32 + s];
        const int col0 = (u.pn & 3) * 256 + wc * 32 + 4 * fq;
        const bool full = (u.nt == DFE / 64);
        if (full) {
            int Rr[8]; float gt[8]; bool ok[8];
#pragma unroll
            for (int q = 0; q < 8; ++q) { const int idx = idx0 + 128 * (q >> 2) + 64 * wr + 16 * (q & 3) + fr; ok[q] = idx < cnt; const int ic = ok[q] ? idx : idx0;
                Rr[q] = rtok[(size_t)s * SEGCAP + ic]; gt[q] = rgate[(size_t)s * SEGCAP + ic] * gsc; }
#pragma unroll
            for (int rp = 0; rp < 4; ++rp) {
                f32x4 gv[2][2][2], xi[2][2][2]; float* xp[2];
#pragma unroll
                for (int j = 0; j < 2; ++j) { const int q = 2 * rp + j; xp[j] = xrow_out(Rr[q], xlat, hctx) + col0; const float* gp = gate + row_set(Rr[q]) * 6144 + col0;
#pragma unroll
                    for (int bj = 0; bj < 2; ++bj)
#pragma unroll
                        for (int n = 0; n < 2; ++n) { gv[j][bj][n] = *(const f32x4*)(gp + bj * 128 + n * 16); xi[j][bj][n] = *(const f32x4*)(xp[j] + bj * 128 + n * 16); } }
#pragma unroll
                for (int j = 0; j < 2; ++j) { const int q = 2 * rp + j;
                    if (ok[q]) {
#pragma unroll
                        for (int bj = 0; bj < 2; ++bj)
#pragma unroll
                            for (int n = 0; n < 2; ++n) *(f32x4*)(xp[j] + bj * 128 + n * 16) = xi[j][bj][n] + gv[j][bj][n] * gt[q] * acc[q >> 2][bj][q & 3][n]; } }
            }
        } else {
#pragma unroll
        for (int ai = 0; ai < 2; ++ai)
#pragma unroll
            for (int m = 0; m < 4; ++m) { const int idx = idx0 + 128 * ai + 64 * wr + 16 * m + fr;
                if (idx < cnt) { const int R = rtok[(size_t)s * SEGCAP + idx]; const float gt = rgate[(size_t)s * SEGCAP + idx] * gsc;
                    const float* gp = gate + row_set(R) * 6144 + col0;
#pragma unroll
                    for (int bj = 0; bj < 2; ++bj)
#pragma unroll
                        for (int n = 0; n < 2; ++n) { const f32x4 gv = *(const f32x4*)(gp + bj * 128 + n * 16); const f32x4 v = gv * gt * acc[ai][bj][m][n];
                            int fr_ = fr; asm volatile("" : "+v"(fr_));
                            *(GAS f32x4*)((GAS char*)(slab + (size_t)u.sl * 65536) + (unsigned)(((128 * ai + 64 * wr + 16 * m + fr_) * 256 + wc * 32 + 4 * fq + bj * 128 + n * 16) * 4)) = v; } } }
        }
    }
};

__device__ __forceinline__ void transpose_item(const float* colp  , int ldw, int K, bf16* WT, int kb, int n0, int lane) {
    const int hh = lane >> 5, m = lane & 31, k0 = 64 * kb + 32 * hh;
    f32x4 v[32];
#pragma unroll
    for (int i = 0; i < 32; ++i) v[i] = *(const f32x4*)(colp + (size_t)(k0 + i) * ldw);
    bf16* dp = WT + (size_t)(n0 + 4 * m) * K + k0;
#pragma unroll
    for (int jj = 0; jj < 4; ++jj)
#pragma unroll
        for (int h8 = 0; h8 < 4; ++h8) { v4u o; o.x = pk2(v[8 * h8][jj], v[8 * h8 + 1][jj]); o.y = pk2(v[8 * h8 + 2][jj], v[8 * h8 + 3][jj]); o.z = pk2(v[8 * h8 + 4][jj], v[8 * h8 + 5][jj]); o.w = pk2(v[8 * h8 + 6][jj], v[8 * h8 + 7][jj]);
            *(v4u*)(dp + (size_t)jj * K + 8 * h8) = o; }
}
__device__ __forceinline__ int src_in_col(int nd) { const int t = nd >> 8, c = nd & 255; return (t >= 4 && t <= 7) ? (t * 256 + qk_perm(c)) : nd; }

struct Args { const float* in[32]; float* out; unsigned char* ws; int ph_lo, ph_hi; };
constexpr int PTAB_OFF = MISC_OFF + 1024;
__device__ __forceinline__ const float* inptr(LAS unsigned char* lds, int k) {
    const LAS unsigned* p = (const LAS unsigned*)(lds + PTAB_OFF) + 2 * k;
    const unsigned lo = (unsigned)__builtin_amdgcn_readfirstlane((int)p[0]), hi = (unsigned)__builtin_amdgcn_readfirstlane((int)p[1]);
    return (const float*)(const GAS float*)(((unsigned long long)hi << 32) | lo);
}
#define AIN(k) inptr(lds, (k))

__device__ __forceinline__ float block_sum(float v, LAS float* red, int wave, int lane) {
    v = wave_sum(v);
    if (lane == 0) red[wave] = v;
    __syncthreads();
    float s = 0.f;
#pragma unroll
    for (int w = 0; w < NWAVES; ++w) s += red[w];
    __syncthreads();
    return s;
}

__device__ __forceinline__ void phase_prep_a(const Args& a, int li, LAS unsigned char* lds, int G, int bx) {
    const int tid = fresh_tid(), lane = tid & 63, wave = __builtin_amdgcn_readfirstlane(tid >> 6);
    const int gw = bx * NWAVES + wave, NGW = G * NWAVES;
    unsigned char* ws = fresh_ptr(a.ws);
    const bool moe = (li & 1) != 0; const int lj = li >> 1;
    {
        bf16* win_t = (bf16*)(ws + WS_WIN); bf16* wout_t = (bf16*)(ws + WS_WOUT); bf16* wup_t = (bf16*)(ws + WS_WUP); bf16* wdn_t = (bf16*)(ws + WS_WDN);
        const float* w_in = AIN(8) + (size_t)li * DM * INW; const float* w_out = AIN(9) + (size_t)li * DM * DM;
        constexpr int I_IN = 16 * 20, I_OUT = 16 * 8, I_UPD = 16 * 44, I_DND = 44 * 8, I_UPE = 16 * 56, I_DNE = 56 * 8;
        const int NIT = moe ? (I_IN + I_OUT + NEXP * (I_UPE + I_DNE)) : (I_IN + I_OUT + I_UPD + I_DND);
        const int m4 = 4 * (lane & 31);
        for (int it = gw; it < NIT; it += NGW) {
            int r = it;
            if (r < I_IN) { const int nb = r % 20; transpose_item(w_in + src_in_col(128 * nb + m4), INW, DM, win_t, r / 20, 128 * nb, lane); continue; } r -= I_IN;
            if (r < I_OUT) { const int nb = r % 8; transpose_item(w_out + 128 * nb + m4, DM, DM, wout_t, r / 8, 128 * nb, lane); continue; } r -= I_OUT;
            if (!moe) {
                if (r < I_UPD) { const int nb = r % 44; const float* W = (nb & 1) ? AIN(26) : AIN(25);
                    transpose_item(W + (size_t)lj * DM * DFF + (nb >> 1) * 128 + m4, DFF, DM, wup_t, r / 44, 128 * nb, lane); continue; } r -= I_UPD;
                { const int nb = r % 8; transpose_item(AIN(27) + (size_t)lj * DFF * DM + 128 * nb + m4, DM, DFF, wdn_t, r / 8, 128 * nb, lane); }
            } else {
                if (r < NEXP * I_UPE) { const int e = r / I_UPE, r2 = r % I_UPE, nb = r2 % 56; const size_t wo = (size_t)(lj * NEXP + e) * DM * DFE;
                    const float* W = (nb & 1) ? AIN(30) : AIN(29);
                    transpose_item(W + wo + (nb >> 1) * 128 + m4, DFE, DM, wup_t + (size_t)e * 2 * DFE * DM, r2 / 56, 128 * nb, lane); continue; } r -= NEXP * I_UPE;
                const int e = r / I_DNE, r2 = r % I_DNE, nb = r2 % 8;
                transpose_item(AIN(31) + (size_t)(lj * NEXP + e) * DFE * DM + 128 * nb + m4, DM, DFE, wdn_t + (size_t)e * DM * DFE, r2 / 8, 128 * nb, lane);
            }
        }
    }
    if (li == 0) for (int l = 0; l < DEPTH; ++l) {
        const float* w1 = AIN(14) + l * 33 * 64; const float* w2 = AIN(17) + l * 64 * 64;
        const float bb1 = AIN(15)[l * 64 + lane], ff1 = AIN(16)[l * 64 + lane], bb2 = AIN(18)[l * 64 + lane], ff2 = AIN(19)[l * 64 + lane];
        float w1c[33], w2c[64];
#pragma unroll
        for (int q = 0; q < 33; ++q) w1c[q] = w1[q * 64 + lane];
#pragma unroll
        for (int q = 0; q < 64; ++q) w2c[q] = w2[q * 64 + lane];
        bf16* H2B = (bf16*)(ws + WS_H2B) + (size_t)l * (SEQ + CTXL) * 64;
        for (int tt = gw; tt < SEQ + CTXL; tt += NGW) {
            const int L = tt < SEQ ? SEQ : CTXL, t = tt < SEQ ? tt : tt - SEQ;
            float feat = 0.f;
            if (lane == 0) feat = (float)t / (float)(L - 1);
            else if (lane <= 32) { const int jb = (lane - 1) & 15; const float rev = (float)((jb * t) & (L - 1)) / (float)L + 1e-4f * (1.0f - (float)jb * (1.0f / 15.0f)) * (float)t / (float)L;
                feat = lane <= 16 ? __builtin_amdgcn_cosf(__builtin_amdgcn_fractf(rev)) : -__builtin_amdgcn_sinf(__builtin_amdgcn_fractf(rev)); }
            float z1 = 0.f;
#pragma unroll
            for (int q = 0; q < 33; ++q) z1 += __builtin_bit_cast(float, __builtin_amdgcn_readlane(__builtin_bit_cast(int, feat), q)) * w1c[q];
            const float h1 = sin_rad(ff1 * (z1 + bb1));
            float z2 = 0.f;
#pragma unroll
            for (int q = 0; q < 64; ++q) z2 += __builtin_bit_cast(float, __builtin_amdgcn_readlane(__builtin_bit_cast(int, h1), q)) * w2c[q];
            H2B[(size_t)tt * 64 + lane] = (bf16)f2bf(sin_rad(ff2 * (z2 + bb2)));
        }
    }
    if (li == 0) {
        __syncthreads();
        LAS float* sv = (LAS float*)lds;
        for (int idx = tid; idx < 3 * DM; idx += NTHR) { const int s = idx >> 10, k = idx & 1023; const float v = s < 2 ? AIN(1)[s * DM + k] : AIN(3)[k];
            sv[idx] = v * __builtin_amdgcn_rcpf(1.0f + __builtin_amdgcn_exp2f(-1.4426950408889634f * v)); }
        __syncthreads();
        float* MODP = (float*)(ws + WS_MODP);
        for (int it = bx; it < 4 * 8 * 12; it += G) {
            const int l = it / 96, q = (it / 12) & 7, jc = it % 12, j = jc * 512 + tid;
            const float* wp = AIN(4) + ((size_t)l * DM + q * 128) * 6144 + j;
            float a0 = 0.f, a1 = 0.f, a2 = 0.f;
#pragma unroll 8
            for (int k = 0; k < 128; ++k) { const float w = wp[(size_t)k * 6144]; a0 += sv[q * 128 + k] * w; a1 += sv[DM + q * 128 + k] * w; a2 += sv[2 * DM + q * 128 + k] * w; }
            float* dp = MODP + (size_t)((q * 4 + l) * 3) * 6144 + j;
            dp[0] = a0; dp[6144] = a1; dp[2 * 6144] = a2;
        }
        const int gid = bx * NTHR + tid;
        if (gid < 4096) { const int pos = gid >> 4, f = gid & 15; const float inv = __builtin_amdgcn_exp2f(-(float)f * 0.83048202372184059f);
            const float rev = (float)pos * inv * 0.15915494309189535f; float* RT = (float*)(ws + WS_ROPE);
            RT[gid] = __builtin_amdgcn_cosf(__builtin_amdgcn_fractf(rev)); RT[4096 + gid] = __builtin_amdgcn_sinf(__builtin_amdgcn_fractf(rev)); }
        const f32x4* cs = (const f32x4*)AIN(2); f32x4* cd = (f32x4*)(ws + WS_HCTX);
        for (int idx = gid; idx < NB * CTXL * DM / 4; idx += G * NTHR) cd[idx] = cs[idx];
        __syncthreads();
    }
}

__device__ __forceinline__ int fidx(int i) { return i + (i >> 7); }
__device__ __forceinline__ void fft4_index(int b, int q, int& i, int& j) {
    if (q >= 64) { j = b & (q - 1); i = ((b & ~(q - 1)) << 2) + j; }
    else { const int rr = b & 127, qq = b >> 7; j = qq & (q - 1); i = rr * 128 + ((qq & ~(q - 1)) << 2) + j; }
}
__device__ __forceinline__ f32x2 cmulf(f32x2 a, f32x2 w) { return (f32x2){a.x * w.x - a.y * w.y, a.x * w.y + a.y * w.x}; }
__device__ __forceinline__ void fft_fwd(LAS f32x2* X, int tid) {
    for (int p = 0; p < 7; ++p) {
        const int h = 8192 >> (2 * p), q = h >> 1; const float inv2h = 0.5f / (float)h;
#pragma unroll 2
        for (int r = 0; r < 8; ++r) { int i, j; fft4_index(tid + NTHR * r, q, i, j);
            const float ang = (float)j * inv2h; const f32x2 w1 = {__builtin_amdgcn_cosf(ang), -__builtin_amdgcn_sinf(ang)}; const f32x2 w2 = cmulf(w1, w1);
            const int i0 = fidx(i), i1 = fidx(i + q), i2 = fidx(i + 2 * q), i3 = fidx(i + 3 * q);
            const f32x2 x0 = X[i0], x1 = X[i1], x2 = X[i2], x3 = X[i3];
            const f32x2 a0 = x0 + x2, a1 = x1 + x3, d02 = cmulf(x0 - x2, w1), t13 = cmulf(x1 - x3, w1); const f32x2 d13 = {t13.y, -t13.x};
            X[i0] = a0 + a1; X[i1] = cmulf(a0 - a1, w2); X[i2] = d02 + d13; X[i3] = cmulf(d02 - d13, w2); }
        __syncthreads();
    }
}
__device__ __forceinline__ void fft_inv(LAS f32x2* X, int tid) {
    for (int p = 6; p >= 0; --p) {
        const int h = 8192 >> (2 * p), q = h >> 1; const float inv2h = 0.5f / (float)h;
#pragma unroll 2
        for (int r = 0; r < 8; ++r) { int i, j; fft4_index(tid + NTHR * r, q, i, j);
            const float ang = (float)j * inv2h; const f32x2 w1 = {__builtin_amdgcn_cosf(ang), __builtin_amdgcn_sinf(ang)}; const f32x2 w2 = cmulf(w1, w1);
            const int i0 = fidx(i), i1 = fidx(i + q), i2 = fidx(i + 2 * q), i3 = fidx(i + 3 * q);
            const f32x2 b0 = X[i0], b1 = X[i1], b2 = X[i2], b3 = X[i3];
            const f32x2 t1 = cmulf(b1, w2), t3 = cmulf(b3, w2); const f32x2 a0 = b0 + t1, a1 = b0 - t1, a2 = b2 + t3, a3 = b2 - t3;
            const f32x2 u2 = cmulf(a2, w1), v3 = cmulf(a3, w1); const f32x2 u3 = {-v3.y, v3.x};
            X[i0] = a0 + u2; X[i2] = a0 - u2; X[i1] = a1 + u3; X[i3] = a1 - u3; }
        __syncthreads();
    }
}
__device__ __forceinline__ int brev14(int k) { return (int)(__builtin_bitreverse32((unsigned)k) >> 18); }
__device__ __forceinline__ void pair_slots(int r, int& j, int& jp, int& k, bool& ev) {
    if (r == 0) { j = 0; jp = 0; k = 0; ev = true; return; }
    if (r == 8192) { j = 1; jp = 1; k = 8192; ev = true; return; }
    const int hb = 31 - __builtin_clz((unsigned)r), base = 2 << hb; j = base + (r - (1 << hb)); jp = 3 * base - 1 - j; ev = (j & 1) == 0; k = brev14(ev ? j : jp);
}
constexpr int FFT_AUX = 133120;

__device__ __forceinline__ void phase_prep_b(const Args& a, int li, LAS unsigned char* lds, int G, int bx) {
    const int tid = fresh_tid(), lane = tid & 63, wave = __builtin_amdgcn_readfirstlane(tid >> 6);
    unsigned char* ws = fresh_ptr(a.ws);
    if (li == 0) {
        const float* MODP = (const float*)(ws + WS_MODP); float* MOD = (float*)(ws + WS_MOD);
        for (int idx = bx * NTHR + tid; idx < 4 * 3 * 6144; idx += G * NTHR) { const int l = idx / 18432, j = idx % 6144; float s = AIN(5)[l * 6144 + j];
#pragma unroll
            for (int q = 0; q < 8; ++q) s += MODP[(size_t)q * 73728 + idx];
            MOD[idx] = s; }
    }
    LAS f32x2* X = (LAS f32x2*)lds; LAS float* Xf = (LAS float*)lds;
    LAS float* w3c = (LAS float*)(lds + FFT_AUX); LAS float* red = w3c + 128; LAS float* kc = (LAS float*)(lds + FFT_AUX + 1024);
    const bf16* H2 = (const bf16*)(ws + WS_H2B) + (size_t)li * (SEQ + CTXL) * 64; const bf16* H2C = H2 + (size_t)SEQ * 64;
    const float* w3 = AIN(20) + (size_t)li * 64 * 512;
    const float min_decay = 3.0701134573253945f, max_decay = 15.350567286626973f;
    const bool coop = (G == 256);
    const int xg = bx & 7, mi = bx >> 3;
    float* FT = (float*)(ws + WS_Z) + (size_t)xg * 64 * SEQ;
    if (coop) {
        const int r16 = lane & 15, g4 = lane >> 4, t0 = 512 * mi + 64 * wave;
        bf16x8 wf[4][2], hf[4][2];
#pragma unroll
        for (int blk = 0; blk < 4; ++blk)
#pragma unroll
            for (int ks = 0; ks < 2; ++ks) hf[blk][ks] = *(const bf16x8*)(H2 + (size_t)(t0 + 16 * blk + r16) * 64 + 8 * g4 + 32 * ks);
#pragma unroll
        for (int tau = 0; tau < 4; ++tau)
#pragma unroll
            for (int ks = 0; ks < 2; ++ks) { v4u w; const int o = 16 * tau + r16, col = (o & 1) * 256 + 32 * xg + (o >> 1);
#pragma unroll
                for (int j2 = 0; j2 < 4; ++j2) { const int kk = 32 * ks + 8 * g4 + 2 * j2; w[j2] = pk2(w3[kk * 512 + col], w3[(kk + 1) * 512 + col]); }
                wf[tau][ks] = __builtin_bit_cast(bf16x8, w); }
#pragma unroll
        for (int tau = 0; tau < 4; ++tau)
#pragma unroll
            for (int blk = 0; blk < 4; ++blk) { f32x4 acc = {0.f, 0.f, 0.f, 0.f};
#pragma unroll
                for (int ks = 0; ks < 2; ++ks) acc = __builtin_amdgcn_mfma_f32_16x16x32_bf16(hf[blk][ks], wf[tau][ks], acc, 0, 0, 0);
                *(f32x4*)(FT + (size_t)(16 * tau + r16) * SEQ + t0 + 16 * blk + 4 * g4) = acc; }
        asm volatile("s_waitcnt vmcnt(0)" ::: "memory");
        __syncthreads();
        if (tid == 0) { unsigned* cnt = (unsigned*)(ws + WS_CTL) + CW_MOECNT + li * 8 + xg;
            __builtin_amdgcn_fence(__ATOMIC_RELEASE, "agent"); (void)xb_add(cnt, 1u);
            unsigned sp = 0; while (xb_ld(cnt) < 32u) { __builtin_amdgcn_s_sleep(1); if (++sp > (1u << 22)) break; }
            __builtin_amdgcn_fence(__ATOMIC_ACQUIRE, "agent"); }
        __syncthreads();
    }
    for (int c0 = bx; c0 < 256; c0 += G) { const int c = G == 256 ? (((c0 & 7) << 5) | (c0 >> 3)) : c0;
        if (tid < 128) w3c[tid] = w3[(tid & 63) * 512 + (tid >> 6) * 256 + c];
        __syncthreads();
        const float delta = min_decay + (float)c * ((max_decay - min_decay) / 255.0f);
        float asum = 0.f;
        if (coop) {
            const float* ff = FT + (size_t)(2 * mi) * SEQ; const float* fb = ff + SEQ;
#pragma unroll 8
            for (int r = 0; r < 32; ++r) { const int t = tid + NTHR * r;
                float df = ff[t], db = fb[t];
                const float dec = __builtin_amdgcn_exp2f(-1.4426950408889634f * delta * ((float)t * (1.0f / 16383.0f)));
                df *= dec; db *= dec;
                Xf[2 * fidx(t >> 1) + (t & 1)] = df; asum += __builtin_fabsf(df);
                if (t >= 1) { const int n = 32768 - t; Xf[2 * fidx(n >> 1) + (n & 1)] = db; asum += __builtin_fabsf(db); } }
        } else
        {
            const int r16 = lane & 15, g4 = lane >> 4;
            bf16x8 af[4][2];
#pragma unroll
            for (int i = 0; i < 4; ++i)
#pragma unroll
                for (int ks = 0; ks < 2; ++ks) { v4u w;
#pragma unroll
                    for (int j2 = 0; j2 < 4; ++j2) { const int kk = 32 * ks + 8 * g4 + 2 * j2;
                        const float lo = r16 == 4 * i ? w3c[kk] : (r16 == 4 * i + 1 ? w3c[64 + kk] : 0.f), hi = r16 == 4 * i ? w3c[kk + 1] : (r16 == 4 * i + 1 ? w3c[64 + kk + 1] : 0.f);
                        w[j2] = pk2(lo, hi); }
                    af[i][ks] = __builtin_bit_cast(bf16x8, w); }
#pragma unroll 2
            for (int r = 0; r < 32; ++r) { const int t = tid + NTHR * r, t0 = t - lane;
                f32x4 acc = {0.f, 0.f, 0.f, 0.f};
#pragma unroll
                for (int i = 0; i < 4; ++i)
#pragma unroll
                    for (int ks = 0; ks < 2; ++ks) { const bf16x8 hb8 = *(const bf16x8*)(H2 + (size_t)(t0 + 16 * i + r16) * 64 + 8 * g4 + 32 * ks);
                        acc = __builtin_amdgcn_mfma_f32_16x16x32_bf16(af[i][ks], hb8, acc, 0, 0, 0); }
                float df = acc[0], db = acc[1];
                const float dec = __builtin_amdgcn_exp2f(-1.4426950408889634f * delta * ((float)t * (1.0f / 16383.0f)));
                df *= dec; db *= dec;
                Xf[2 * fidx(t >> 1) + (t & 1)] = df; asum += __builtin_fabsf(df);
                if (t >= 1) { const int n = 32768 - t; Xf[2 * fidx(n >> 1) + (n & 1)] = db; asum += __builtin_fabsf(db); } }
        }
        if (tid == 0) Xf[2 * fidx(8192)] = 0.f;
        const float S1 = block_sum(asum, red, wave, lane);
        fft_fwd(X, tid);
        const float scale = 1.0f / (S1 * 16384.0f);
        f32x4* HF = (f32x4*)(ws + WS_HF) + (size_t)c * 8193;
        for (int r = tid; r <= 8192; r += NTHR) {
            int j, jp, k; bool ev; pair_slots(r, j, jp, k, ev);
            const f32x2 P = X[fidx(j)], Q = X[fidx(jp)]; const f32x2 A = ev ? P : Q, B = ev ? Q : P; f32x4 o;
            if (k == 0) o = (f32x4){A.x + A.y, 0.f, A.x - A.y, 0.f};
            else { const float Ex = 0.5f * (A.x + B.x), Ey = 0.5f * (A.y - B.y), Ox = 0.5f * (A.y + B.y), Oy = -0.5f * (A.x - B.x);
                const float ang = (float)k * (1.0f / 32768.0f), wc = __builtin_amdgcn_cosf(ang), wsn = -__builtin_amdgcn_sinf(ang);
                const float px = Ox * wc - Oy * wsn, py = Ox * wsn + Oy * wc;
                o = (f32x4){Ex + px, Ey + py, Ex - px, -(Ey - py)}; }
            HF[r] = o * scale; }
        __syncthreads();
        float as2 = 0.f;
        if (tid < CTXL) { const int t = tid; const v4u* hr = (const v4u*)(H2C + (size_t)t * 64); float df = 0.f, db = 0.f;
#pragma unroll
            for (int q = 0; q < 8; ++q) { const v4u hw = hr[q];
#pragma unroll
                for (int e = 0; e < 4; ++e) { const float h0 = __builtin_bit_cast(float, hw[e] << 16), h1 = __builtin_bit_cast(float, hw[e] & 0xffff0000u);
                    df += h0 * w3c[8 * q + 2 * e] + h1 * w3c[8 * q + 2 * e + 1]; db += h0 * w3c[64 + 8 * q + 2 * e] + h1 * w3c[64 + 8 * q + 2 * e + 1]; } }
            const float dec = __builtin_amdgcn_exp2f(-1.4426950408889634f * delta * ((float)t * (1.0f / 255.0f)));
            df *= dec; db *= dec; kc[t] = df; as2 += __builtin_fabsf(df);
            if (t >= 1) { kc[512 - t] = db; as2 += __builtin_fabsf(db); } else kc[256] = 0.f; }
        const float S2 = block_sum(as2, red, wave, lane);
        ((float*)(ws + WS_KCTX))[(size_t)c * 512 + tid] = kc[tid] / S2;
        __syncthreads();
    }
}

__device__ __forceinline__ void norm_load(const float* xr, int lane, f32x4 (&v)[4]) {
    const f32x4* xp = (const f32x4*)xr + lane;
#pragma unroll
    for (int j = 0; j < 4; ++j) v[j] = xp[64 * j];
}
__device__ __forceinline__ void norm_finish(f32x4 (&v)[4], const float* xr, const float* modl, int set, int which, const f32x4 (&g)[4], int lane, bf16* dst, f32x4 (&o)[4], const float* pend = nullptr) {
    float ss = 0.f;
#pragma unroll
    for (int j = 0; j < 4; ++j) {
        if (pend) { const f32x4* pp = (const f32x4*)(pend + (size_t)j * 4 * 65536) + lane; v[j] = (((v[j] + pp[0]) + pp[16384]) + pp[2 * 16384]) + pp[3 * 16384]; ((f32x4*)xr)[lane + 64 * j] = v[j]; }
        ss += (v[j].x * v[j].x + v[j].y * v[j].y) + (v[j].z * v[j].z + v[j].w * v[j].w); }
    const float rinv = __builtin_amdgcn_rsqf(wave_sum(ss) * (1.0f / DM) + 1e-6f);
    const f32x4* sh = (const f32x4*)(modl + set * 6144 + which * DM) + lane; const f32x4* sc = (const f32x4*)(modl + set * 6144 + (which + 1) * DM) + lane;
    v2u* dp = (v2u*)dst + lane;
#pragma unroll
    for (int j = 0; j < 4; ++j) { const f32x4 y = v[j] * rinv * g[j]; o[j] = y * (sc[64 * j] + 1.0f) + sh[64 * j];
        v2u w; w.x = pk2(o[j].x, o[j].y); w.y = pk2(o[j].z, o[j].w); dp[64 * j] = w; }
}
__device__ __forceinline__ const float* ctx_pending(const Args& a, int R) {
    const int b = R / RB, rr = R - b * RB; return rr < CTXL ? (const float*)(fresh_ptr(a.ws) + WS_SLAB) + (size_t)b * 16 * 65536 + rr * 256 : nullptr; }
__device__ __forceinline__ void norm_finish_lds(f32x4 (&v)[4], const float* xr, const LAS f32x4* mt, int set, const f32x4 (&g)[4], int lane, bf16* dst, const float* pend) {
    float ss = 0.f;
#pragma unroll
    for (int j = 0; j < 4; ++j) {
        if (pend) { const f32x4* pp = (const f32x4*)(pend + (size_t)j * 4 * 65536) + lane; v[j] = (((v[j] + pp[0]) + pp[16384]) + pp[2 * 16384]) + pp[3 * 16384]; ((f32x4*)xr)[lane + 64 * j] = v[j]; }
        ss += (v[j].x * v[j].x + v[j].y * v[j].y) + (v[j].z * v[j].z + v[j].w * v[j].w); }
    const float rinv = __builtin_amdgcn_rsqf(wave_sum(ss) * (1.0f / DM) + 1e-6f);
    const LAS f32x4* sh = mt + set * 512 + lane; const LAS f32x4* sc = sh + 256;
    v2u* dp = (v2u*)dst + lane;
#pragma unroll
    for (int j = 0; j < 4; ++j) { const f32x4 y = v[j] * rinv * g[j]; const f32x4 o = y * (sc[64 * j] + 1.0f) + sh[64 * j];
        v2u w; w.x = pk2(o.x, o.y); w.y = pk2(o.z, o.w); dp[64 * j] = w; }
}
__device__ __forceinline__ void phase_norm(const Args& a, int li, int which  , const float* xlat, LAS unsigned char* lds, int G, int bx) {
    const int tid = fresh_tid(), lane = tid & 63, wave = __builtin_amdgcn_readfirstlane(tid >> 6);
    const int gw = bx * NWAVES + wave, NGW = G * NWAVES;
    unsigned char* ws = fresh_ptr(a.ws); const float* modl = (const float*)(ws + WS_MOD) + (size_t)li * 3 * 6144; const float* hctx = (const float*)(ws + WS_HCTX);
    const float* gsrc = (which == 0 ? AIN(6) : AIN(7)) + li * DM; bf16* XN = (bf16*)(ws + WS_XN);
    LAS f32x4* mt = (LAS f32x4*)lds;
    __syncthreads();
    for (int idx = tid; idx < 3 * 512; idx += NTHR) { const int set = idx >> 9, rem = idx & 511; mt[idx] = ((const f32x4*)(modl + set * 6144 + which * DM))[rem]; }
    f32x4 g[4];
#pragma unroll
    for (int j = 0; j < 4; ++j) g[j] = ((const f32x4*)gsrc)[lane + 64 * j];
    __syncthreads();
    const bool pending = (which == 3) || (li & 1);
    constexpr int NR = 9;
    for (int R = gw; R < MROWS; R += NR * NGW) {
        f32x4 v[NR][4]; const float* xr[NR]; int Rq[NR];
#pragma unroll
        for (int q = 0; q < NR; ++q) { Rq[q] = R + q * NGW; xr[q] = xrow_in(Rq[q] < MROWS ? Rq[q] : R, xlat, hctx); norm_load(xr[q], lane, v[q]); }
#pragma unroll
        for (int q = 0; q < NR; ++q) if (Rq[q] < MROWS) norm_finish_lds(v[q], xr[q], mt, row_set(Rq[q]), g, lane, XN + (size_t)Rq[q] * DM, pending ? ctx_pending(a, Rq[q]) : nullptr); }
    __syncthreads();
}
__device__ __forceinline__ void phase_norm_router(const Args& a, int li, const float* xlat, LAS unsigned char* lds, int G, int bx) {
    const int tid = fresh_tid(), lane = tid & 63, wave = __builtin_amdgcn_readfirstlane(tid >> 6);
    unsigned char* ws = fresh_ptr(a.ws); const float* modl = (const float*)(ws + WS_MOD) + (size_t)li * 3 * 6144; const float* hctx = (const float*)(ws + WS_HCTX);
    const float* gsrc = AIN(7) + li * DM; bf16* XN = (bf16*)(ws + WS_XN); const int lj = li >> 1;
    const float* rw = AIN(28) + (size_t)lj * DM * NEXP;
    LAS float* rwT = (LAS float*)lds;
    LAS int* re = (LAS int*)(lds + 32768);
    LAS float* rg = (LAS float*)(lds + 32768 + 2048);
    LAS int* lcnt = (LAS int*)(lds + 32768 + 4096);
    for (int idx = tid; idx < DM * NEXP; idx += NTHR) rwT[(idx & 7) * DM + (idx >> 3)] = rw[idx];
    LAS f32x4* mt = (LAS f32x4*)(lds + 40960);
    for (int idx = tid; idx < 3 * 512; idx += NTHR) { const int set = idx >> 9, rem = idx & 511; mt[idx] = ((const f32x4*)(modl + set * 6144 + 3 * DM))[rem]; }
    if (tid < 32) lcnt[tid] = 0;
    __syncthreads();
    const int RPB = (MROWS + G - 1) / G, R0 = bx * RPB; int nrows = MROWS - R0; nrows = nrows > RPB ? RPB : nrows; nrows = nrows < 0 ? 0 : nrows;
    f32x4 g[4];
#pragma unroll
    for (int j = 0; j < 4; ++j) g[j] = ((const f32x4*)gsrc)[lane + 64 * j];
    f32x4 vnext[4];
    if (wave < nrows) norm_load(xrow_in(R0 + wave, xlat, hctx), lane, vnext);
    for (int i = wave; i < nrows; i += NWAVES) { const int R = R0 + i; f32x4 o[4], v[4];
#pragma unroll
        for (int j = 0; j < 4; ++j) v[j] = vnext[j];
        if (i + NWAVES < nrows) norm_load(xrow_in(R + NWAVES, xlat, hctx), lane, vnext);
        { const float* xr = xrow_in(R, xlat, hctx); const float* pend = ctx_pending(a, R); const int set = row_set(R); float ss = 0.f;
#pragma unroll
          for (int j = 0; j < 4; ++j) {
              if (pend) { const f32x4* pp = (const f32x4*)(pend + (size_t)j * 4 * 65536) + lane; v[j] = (((v[j] + pp[0]) + pp[16384]) + pp[2 * 16384]) + pp[3 * 16384]; ((f32x4*)xr)[lane + 64 * j] = v[j]; }
              ss += (v[j].x * v[j].x + v[j].y * v[j].y) + (v[j].z * v[j].z + v[j].w * v[j].w); }
          const float rinv = __builtin_amdgcn_rsqf(wave_sum(ss) * (1.0f / DM) + 1e-6f);
          const LAS f32x4* sh = mt + set * 512 + lane; const LAS f32x4* sc = sh + 256; v2u* dp = (v2u*)(XN + (size_t)R * DM) + lane;
#pragma unroll
          for (int j = 0; j < 4; ++j) { const f32x4 y = v[j] * rinv * g[j]; o[j] = y * (sc[64 * j] + 1.0f) + sh[64 * j];
              v2u w; w.x = pk2(o[j].x, o[j].y); w.y = pk2(o[j].z, o[j].w); dp[64 * j] = w; } }
        float lg[8];
#pragma unroll
        for (int e = 0; e < 8; ++e) { float s = 0.f;
#pragma unroll
            for (int j = 0; j < 4; ++j) { const f32x4 w = *(const LAS f32x4*)(rwT + e * DM + 4 * lane + 256 * j); s += (o[j].x * w.x + o[j].y * w.y) + (o[j].z * w.z + o[j].w * w.w); }
            lg[e] = wave_sum(s); }
        int e0 = 0; float v0 = lg[0];
#pragma unroll
        for (int e = 1; e < 8; ++e) if (lg[e] > v0) { v0 = lg[e]; e0 = e; }
        int e1 = -1; float v1 = -3.0e38f;
#pragma unroll
        for (int e = 0; e < 8; ++e) if (e != e0 && lg[e] > v1) { v1 = lg[e]; e1 = e; }
        if (lane == 0) { re[i] = e0 | (e1 << 8); rg[i] = 1.0f / (1.0f + __expf(v1 - v0)); }
    }
    __syncthreads();
    if (tid < nrows) { const int w = re[tid], e0 = w & 255, e1 = w >> 8; int r0 = 0, r1 = 0;
#pragma unroll 8
        for (int j = 0; j < nrows; ++j) { const int wj = re[j]; r0 += (j < tid && (wj & 255) == e0) ? 1 : 0; r1 += (j < tid && (wj >> 8) == e1) ? 1 : 0; }
        ((int*)(ws + WS_RREC))[R0 + tid] = e0 | (e1 << 4) | (r0 << 8) | (r1 << 20); ((float*)(ws + WS_RRECG))[R0 + tid] = rg[tid]; }
    if (tid < 16) { int c = 0;
#pragma unroll 8
        for (int j = 0; j < nrows; ++j) { const int wj = re[j]; c += ((tid < 8 ? (wj & 255) : (wj >> 8)) == (tid & 7)) ? 1 : 0; }
        ((int*)(ws + WS_CNTB))[bx * 16 + tid] = c; }
    __syncthreads();
}
__device__ __forceinline__ void moe_tables(const Args& a, int lj, LAS unsigned char* lds, int G, int bx) {
    LAS int* tab = (LAS int*)(lds + TAB_OFF); const int tid = fresh_tid(); const int* cntb = (const int*)(fresh_ptr(a.ws) + WS_CNTB);
    if (tid < 16) { tab[32 + tid] = 0; tab[116 + tid] = 0; }
    __syncthreads();
    { const int sg = tid & 15; int c = 0, below = 0;
        for (int b = tid >> 4; b < G; b += NTHR / 16) { const int v = cntb[b * 16 + sg]; c += v; below += b < bx ? v : 0; }
        atomicAdd((int*)(tab + 32 + sg), c); atomicAdd((int*)(tab + 116 + sg), below); }
    __syncthreads();
    if (tid == 0) { int tb = 0, tm = 0, n0 = 0, n1 = 0;
        for (int s = 0; s < 16; ++s) { const int c = tab[32 + s]; const int nt = (c + 255) >> 8;
            tab[s] = tb; tab[64 + s] = tm; tb += nt; tm += nt > 0 ? nt - 1 : 0;
            if (nt > 0) { if (s < 8) tab[96 + n0++] = s; else tab[104 + n1++] = s; } }
        tab[16] = tb; tab[80] = tm; tab[112] = n0; tab[113] = n1; }
    __syncthreads();
    (void)lj;
}
__device__ __forceinline__ void phase_moe_gather(const Args& a, int li, LAS unsigned char* lds, int G, int bx) {
    const int tid = fresh_tid(), lane = tid & 63, wave = __builtin_amdgcn_readfirstlane(tid >> 6);
    moe_tables(a, li >> 1, lds, G, bx);
    const LAS int* tab = (const LAS int*)(lds + TAB_OFF);
    unsigned char* ws = fresh_ptr(a.ws);
    int* rtok = (int*)(ws + WS_RTOK); float* rgate = (float*)(ws + WS_RGATE); const int* rec = (const int*)(ws + WS_RREC); const float* recg = (const float*)(ws + WS_RRECG);
    const bf16* XN = (const bf16*)(ws + WS_XN); bf16* AG = (bf16*)(ws + WS_AG);
    const int RPB = (MROWS + G - 1) / G, R0 = bx * RPB; int nrows = MROWS - R0; nrows = nrows > RPB ? RPB : nrows; nrows = nrows < 0 ? 0 : nrows;
    for (int it0 = wave; it0 < 2 * nrows; it0 += 4 * NWAVES) {
        int Rr[4], sg[4], ix[4]; float gg[4]; bool ok[4]; v4u x0[4], x1[4];
#pragma unroll
        for (int u = 0; u < 4; ++u) { const int it = it0 + u * NWAVES; ok[u] = it < 2 * nrows; const int itc = ok[u] ? it : it0; const int k = itc & 1; Rr[u] = R0 + (itc >> 1);
            const int w = rec[Rr[u]]; const float g0 = recg[Rr[u]];
            const int e = k ? ((w >> 4) & 15) : (w & 15), rk = k ? (w >> 20) : ((w >> 8) & 4095); sg[u] = k * 8 + e; ix[u] = tab[116 + sg[u]] + rk; gg[u] = k ? 1.0f - g0 : g0; }
#pragma unroll
        for (int u = 0; u < 4; ++u) { const v4u* sp = (const v4u*)(XN + (size_t)Rr[u] * DM) + lane; x0[u] = sp[0]; x1[u] = sp[64]; }
#pragma unroll
        for (int u = 0; u < 4; ++u) if (ok[u]) {
            if (lane == 0) { rtok[(size_t)sg[u] * SEGCAP + ix[u]] = Rr[u]; rgate[(size_t)sg[u] * SEGCAP + ix[u]] = gg[u]; }
            v4u* dp = (v4u*)(AG + ((size_t)tab[sg[u]] * 256 + ix[u]) * DM) + lane; dp[0] = x0[u]; dp[64] = x1[u]; }
    }
}
__device__ __forceinline__ void phase_moe_fix(const Args& a, int li, int k, LAS unsigned char* lds, int G, int bx) {
    const int tid = fresh_tid(), lane = tid & 63, wave = __builtin_amdgcn_readfirstlane(tid >> 6);
    const int gw = bx * NWAVES + wave, NGW = G * NWAVES;
    moe_tables(a, li >> 1, lds, G, bx);
    const LAS int* tab = (const LAS int*)(lds + TAB_OFF);
    const int nt = tab[112 + k]; const int* rtok = (const int*)(fresh_ptr(a.ws) + WS_RTOK); const float* slab = (const float*)(fresh_ptr(a.ws) + WS_SLAB);
    float* hctx = (float*)(fresh_ptr(a.ws) + WS_HCTX);
    for (int it = gw; it < nt * 256; it += NGW) { const int jl = it >> 8, r = it & 255, s = tab[96 + 8 * k + jl];
        const int idx = (tab[s + 1] - 1 - tab[s]) * 256 + r; if (idx >= tab[32 + s]) continue;
        const int R = rtok[(size_t)s * SEGCAP + idx]; f32x4* xp = (f32x4*)xrow_out(R, a.out, hctx) + lane;
        const f32x4* sp = (const f32x4*)(slab + (size_t)((k * 8 + jl) * 16) * 65536 + r * 256) + lane;
#pragma unroll
        for (int j = 0; j < 4; ++j) { const f32x4* pp = sp + (size_t)j * 4 * 16384; xp[64 * j] = (((xp[64 * j] + pp[0]) + pp[16384]) + pp[2 * 16384]) + pp[3 * 16384]; } }
}

constexpr int PL_ZT = 0, PL_DT = 40960, PL_LIN = 74752;
__device__ __forceinline__ void pool_load_lin(const Args& a, int li, LAS unsigned char* lds) {
    LAS bf16* linT = (LAS bf16*)(lds + PL_LIN); const float* src = AIN(10) + (size_t)li * 4 * 64 * 64;
    for (int idx = fresh_tid(); idx < 4 * 4096; idx += NTHR) { const int g = idx >> 12, c = (idx >> 6) & 63, e = idx & 63; linT[(g * 64 + e) * 72 + c] = (bf16)f2bf(src[idx]); }
    __syncthreads();
}
__device__ __forceinline__ void pool_unit(const Args& a, int li, int p, LAS unsigned char* lds) {
    const int tid = fresh_tid(), lane = tid & 63, r32 = lane & 31, hi = lane >> 5, wave = __builtin_amdgcn_readfirstlane(tid >> 6);
    const bf16* Z = (const bf16*)(fresh_ptr(a.ws) + WS_Z); bf16* Y = (bf16*)(fresh_ptr(a.ws) + WS_Y);
    const int b = p >> 8, t0 = (p & 255) * 64, rowbase = b * RB + CTXL;
    LAS bf16* zt = (LAS bf16*)(lds + PL_ZT); LAS bf16* dt = (LAS bf16*)(lds + PL_DT); const LAS bf16* linT = (const LAS bf16*)(lds + PL_LIN);
    for (int idx = tid; idx < 80 * 32; idx += NTHR) { const int row = idx >> 5, ch8 = idx & 31, t = t0 - 8 + row; v4u w = {0u, 0u, 0u, 0u};
        if (t >= 0 && t < SEQ) w = *(const v4u*)(Z + (size_t)(rowbase + t) * INW + ch8 * 8);
        *(LAS v4u*)(zt + row * 256 + ch8 * 8) = w; }
    __syncthreads();
    { const int ch = tid & 255, th = tid >> 8, hw = 1 << (ch >> 6), tb = t0 + 32 * th; const LAS bf16* zc = zt + ch;
        float s = 0.f;
        for (int q = -hw; q < hw; ++q) s += bf2f(zc[(32 * th + 8 + q) * 256]);
#pragma unroll 4
        for (int tt = 0; tt < 32; ++tt) { const int t = tb + tt, rel = 32 * th + tt + 8; int lo = t - hw; lo = lo < 0 ? 0 : lo; int hq = t + hw; hq = hq > SEQ ? SEQ : hq;
            dt[(32 * th + tt) * 264 + ch] = (bf16)f2bf(s * __builtin_amdgcn_rcpf((float)(hq - lo)) - bf2f(zc[rel * 256]));
            s += bf2f(zc[(rel + hw) * 256]) - bf2f(zc[(rel - hw) * 256]); } }
    __syncthreads();
    { const int g = wave >> 1, th = wave & 1;
        bf16x8 bfr[4], afr[2][4];
#pragma unroll
        for (int ks = 0; ks < 4; ++ks) { bfr[ks] = *(const LAS bf16x8*)(dt + (32 * th + r32) * 264 + g * 64 + 16 * ks + 8 * hi);
#pragma unroll
            for (int mt = 0; mt < 2; ++mt) afr[mt][ks] = *(const LAS bf16x8*)(linT + (g * 64 + 32 * mt + r32) * 72 + 16 * ks + 8 * hi); }
        f32x16 acc[2];
#pragma unroll
        for (int mt = 0; mt < 2; ++mt) {
#pragma unroll
            for (int r = 0; r < 16; ++r) acc[mt][r] = 0.f;
#pragma unroll
            for (int ks = 0; ks < 4; ++ks) acc[mt] = __builtin_amdgcn_mfma_f32_32x32x16_bf16(afr[mt][ks], bfr[ks], acc[mt], 0, 0, 0); }
        const float* ps = AIN(11) + li * 256 + g * 64;
        bf16* yp = Y + (size_t)(rowbase + t0 + 32 * th + r32) * DM + g * 64;
#pragma unroll
        for (int mt = 0; mt < 2; ++mt)
#pragma unroll
            for (int rq = 0; rq < 4; ++rq) { const int e0 = 32 * mt + 8 * rq + 4 * hi; const f32x4 sc = *(const f32x4*)(ps + e0);
                v2u w; w.x = pk2(acc[mt][4 * rq] * sc.x, acc[mt][4 * rq + 1] * sc.y); w.y = pk2(acc[mt][4 * rq + 2] * sc.z, acc[mt][4 * rq + 3] * sc.w);
                *(v2u*)(yp + e0) = w; }
    }
    __syncthreads();
}
__device__ __forceinline__ void pool_ctx_pair(const Args& a, int li, int cp, LAS unsigned char* lds) {
    const int tid = fresh_tid();
    const bf16* Z = (const bf16*)(fresh_ptr(a.ws) + WS_Z); bf16* Y = (bf16*)(fresh_ptr(a.ws) + WS_Y);
    LAS float* dm = (LAS float*)(lds + PL_ZT);
    const int ct = 2 * cp + (tid >> 8), b = ct >> 8, t = ct & 255, ch = tid & 255, hw = 1 << (ch >> 6), rowbase = b * RB;
    int lo = t - hw; lo = lo < 0 ? 0 : lo; int hq = t + hw; hq = hq > CTXL ? CTXL : hq; float s = 0.f;
    for (int q = lo; q < hq; ++q) s += bf2f(Z[(size_t)(rowbase + q) * INW + ch]);
    dm[tid] = s / (float)(hq - lo) - bf2f(Z[(size_t)(rowbase + t) * INW + ch]);
    __syncthreads();
    { const int g = ch >> 6, eo = ch & 63; const float* lin = AIN(10) + (size_t)li * 4 * 64 * 64 + g * 4096 + eo; const LAS float* dr = dm + (tid >> 8) * 256 + g * 64; float acc = 0.f;
#pragma unroll 8
        for (int c = 0; c < 64; ++c) acc += dr[c] * lin[c * 64];
        Y[(size_t)(rowbase + t) * DM + ch] = (bf16)f2bf(acc * AIN(11)[li * 256 + ch]); }
    __syncthreads();
}

__device__ __forceinline__ void sconv2(const bf16* zr, int t0, int L, float w0, float w1, float w2, float sb, float& y0, float& y1) {
    const unsigned pr = *(const unsigned*)(zr + t0); const float z0 = __builtin_bit_cast(float, pr << 16), z1 = __builtin_bit_cast(float, pr & 0xffff0000u);
    const float zm = t0 > 0 ? bf2f(zr[t0 - 1]) : 0.f, zp = (t0 + 2 < L) ? bf2f(zr[t0 + 2]) : 0.f;
    y0 = sb + zm * w0 + z0 * w1 + z1 * w2; y1 = sb + z0 * w0 + z1 * w1 + zp * w2;
}
__device__ __forceinline__ void sconv8(const bf16* zr, int t0, int L, float w0, float w1, float w2, float sb, float (&y)[8]) {
    const v4u w = *(const v4u*)(zr + t0); float z[10];
    z[0] = t0 > 0 ? bf2f(zr[t0 - 1]) : 0.f; z[9] = (t0 + 8 < L) ? bf2f(zr[t0 + 8]) : 0.f;
#pragma unroll
    for (int e = 0; e < 4; ++e) { z[1 + 2 * e] = __builtin_bit_cast(float, w[e] << 16); z[2 + 2 * e] = __builtin_bit_cast(float, w[e] & 0xffff0000u); }
#pragma unroll
    for (int e = 0; e < 8; ++e) y[e] = sb + z[e] * w0 + z[e + 1] * w1 + z[e + 2] * w2;
}
__device__ __forceinline__ void hyena_unit(const Args& a, int li, int cp, int b, LAS unsigned char* lds) {
    const int tid = fresh_tid();
    unsigned char* ws = fresh_ptr(a.ws); const bf16* ZT = (const bf16*)(ws + WS_ZT); const bf16* ZTC = (const bf16*)(ws + WS_ZTC); bf16* Y = (bf16*)(ws + WS_Y);
    const float* sw = AIN(12) + (size_t)li * 3 * 768; const float* sbp = AIN(13) + (size_t)li * 768;
    LAS f32x2* X = (LAS f32x2*)lds;
    float o0[4][8];
    for (int ch = 0; ch < 2; ++ch) {
        const int c = 2 * cp + ch; const float hb = AIN(21)[li * 256 + c];
        const float a0 = sw[c], a1 = sw[768 + c], a2 = sw[1536 + c], ab = sbp[c];
        const float b0 = sw[256 + c], b1 = sw[768 + 256 + c], b2 = sw[1536 + 256 + c], bb = sbp[256 + c];
        const float c0 = sw[512 + c], c1 = sw[768 + 512 + c], c2 = sw[1536 + 512 + c], cb = sbp[512 + c];
        const f32x4* HF = (const f32x4*)(ws + WS_HF) + (size_t)c * 8193;
        const bf16* px0 = ZT + (size_t)(b * 768 + c) * SEQ; const bf16* px1 = ZT + (size_t)(b * 768 + 256 + c) * SEQ; const bf16* pv = ZT + (size_t)(b * 768 + 512 + c) * SEQ;
        float u[4][8];
#pragma unroll
        for (int r = 0; r < 4; ++r) { const int m = tid + NTHR * r; float vv[8], gg[8];
            sconv8(pv, 8 * m, SEQ, c0, c1, c2, cb, vv); sconv8(px1, 8 * m, SEQ, b0, b1, b2, bb, gg);
#pragma unroll
            for (int e = 0; e < 8; ++e) u[r][e] = vv[e] * gg[e];
            const int i0 = fidx(4 * m), i1 = fidx(4 * m + 8192);
#pragma unroll
            for (int q = 0; q < 4; ++q) { X[i0 + q] = (f32x2){u[r][2 * q], u[r][2 * q + 1]}; X[i1 + q] = (f32x2){0.f, 0.f}; } }
        __syncthreads();
        fft_fwd(X, tid);
        for (int k0 = tid; k0 <= 8192; k0 += 4 * NTHR) {
            f32x4 Hq[4];
#pragma unroll
            for (int q = 0; q < 4; ++q) Hq[q] = HF[k0 + q * NTHR <= 8192 ? k0 + q * NTHR : k0];
#pragma unroll
            for (int q = 0; q < 4; ++q) { const int r = k0 + q * NTHR; if (r > 8192) break;
            int j, jp, k; bool ev; pair_slots(r, j, jp, k, ev);
            const int sj = fidx(j), sp = fidx(jp);
            const f32x2 P = X[sj], Q = X[sp]; const f32x2 A = ev ? P : Q, B = ev ? Q : P; const f32x4 H = Hq[q];
            if (k == 0) { const float Y0 = (A.x + A.y) * H.x, YN = (A.x - A.y) * H.z; X[sj] = (f32x2){0.5f * (Y0 + YN), 0.5f * (Y0 - YN)}; }
            else { const float Ex = 0.5f * (A.x + B.x), Ey = 0.5f * (A.y - B.y), Ox = 0.5f * (A.y + B.y), Oy = -0.5f * (A.x - B.x);
                const float ang = (float)k * (1.0f / 32768.0f), wc = __builtin_amdgcn_cosf(ang), wsn = -__builtin_amdgcn_sinf(ang);
                const float px = Ox * wc - Oy * wsn, py = Ox * wsn + Oy * wc;
                const float Xkx = Ex + px, Xky = Ey + py, Xnx = Ex - px, Xny = -(Ey - py);
                const float Ykx = Xkx * H.x - Xky * H.y, Yky = Xkx * H.y + Xky * H.x, Ynx = Xnx * H.z - Xny * H.w, Yny = Xnx * H.w + Xny * H.z;
                const float Epx = 0.5f * (Ykx + Ynx), Epy = 0.5f * (Yky - Yny), Dx = Ykx - Ynx, Dy = Yky + Yny;
                const float Opx = 0.5f * (Dx * wc + Dy * wsn), Opy = 0.5f * (Dy * wc - Dx * wsn);
                const f32x2 na = {Epx - Opy, Epy + Opx}, nb = {Epx + Opy, -Epy + Opx};
                X[sj] = ev ? na : nb;
                if (k != 8192) X[sp] = ev ? nb : na; } } }
        __syncthreads();
        fft_inv(X, tid);
#pragma unroll
        for (int r = 0; r < 4; ++r) { const int m = tid + NTHR * r; float xx[8];
            sconv8(px0, 8 * m, SEQ, a0, a1, a2, ab, xx);
            const int i0 = fidx(4 * m); const f32x2 y0 = X[i0], y1 = X[i0 + 1], y2 = X[i0 + 2], y3 = X[i0 + 3];
            const float yv[8] = {y0.x, y0.y, y1.x, y1.y, y2.x, y2.y, y3.x, y3.y};
            bf16* yp = Y + (size_t)(b * RB + CTXL + 8 * m) * DM + 256 + 2 * cp;
            if (ch == 0) {
#pragma unroll
                for (int e = 0; e < 8; ++e) o0[r][e] = (yv[e] + u[r][e] * hb) * xx[e]; }
            else {
#pragma unroll
                for (int e = 0; e < 8; ++e) *(unsigned*)(yp + (size_t)e * DM) = pk2(o0[r][e], (yv[e] + u[r][e] * hb) * xx[e]); } }
        __syncthreads();
    }
    {
        LAS float* kc = (LAS float*)lds; LAS float* uc = kc + 1024;
        const int ch = tid >> 8, c = 2 * cp + ch, t = tid & 255, te = t & ~1;
        kc[tid] = ((const float*)(ws + WS_KCTX))[(size_t)(2 * cp) * 512 + tid]; kc[512 + tid] = ((const float*)(ws + WS_KCTX))[(size_t)(2 * cp + 1) * 512 + tid];
        const float hb = AIN(21)[li * 256 + c];
        const float a0 = sw[c], a1 = sw[768 + c], a2 = sw[1536 + c], ab = sbp[c];
        const float b0 = sw[256 + c], b1 = sw[768 + 256 + c], b2 = sw[1536 + 256 + c], bb = sbp[256 + c];
        const float c0 = sw[512 + c], c1 = sw[768 + 512 + c], c2 = sw[1536 + 512 + c], cb = sbp[512 + c];
        const bf16* px0 = ZTC + (size_t)(b * 768 + c) * CTXL; const bf16* px1 = ZTC + (size_t)(b * 768 + 256 + c) * CTXL; const bf16* pv = ZTC + (size_t)(b * 768 + 512 + c) * CTXL;
        float v0, v1, g0, g1, x00, x01;
        sconv2(pv, te, CTXL, c0, c1, c2, cb, v0, v1); sconv2(px1, te, CTXL, b0, b1, b2, bb, g0, g1); sconv2(px0, te, CTXL, a0, a1, a2, ab, x00, x01);
        const float u = (t & 1) ? v1 * g1 : v0 * g0, x0v = (t & 1) ? x01 : x00;
        uc[tid] = u;
        __syncthreads();
        float y = 0.f;
#pragma unroll 8
        for (int s2 = 0; s2 < CTXL; ++s2) y += kc[ch * 512 + ((t - s2) & 511)] * uc[ch * 256 + s2];
        Y[(size_t)(b * RB + t) * DM + 256 + c] = (bf16)f2bf((y + u * hb) * x0v);
        __syncthreads();
    }
}

__device__ __forceinline__ void glds16(const void* gsrc, unsigned lds_dst) { unsigned keep;
    asm volatile("s_mov_b32 %0, m0\n\ts_mov_b32 m0, %2\n\ts_nop 0\n\tglobal_load_lds_dwordx4 %1, off\n\ts_mov_b32 m0, %0" : "=&s"(keep) : "v"(gsrc), "s"(lds_dst) : "memory"); }
__device__ __forceinline__ s16x4 vtr(const LAS unsigned char* p) { return __builtin_bit_cast(s16x4, __builtin_amdgcn_ds_read_tr16_b64_v4i16((LAS v4i16_t*)p)); }
typedef __bf16 bf16x2n __attribute__((ext_vector_type(2)));
__device__ __forceinline__ unsigned cvtpk_s(float lo, float hi) { f32x2 v = {lo, hi}; bf16x2n b = __builtin_convertvector(v, bf16x2n); return __builtin_bit_cast(unsigned, b); }
__device__ __forceinline__ int crow(int r, int hi) { return (r & 3) + 8 * (r >> 2) + 4 * hi; }
#define ATT_WAIT_BAR(N) asm volatile("s_waitcnt vmcnt(" #N ") lgkmcnt(0)\n\ts_barrier" ::: "memory")
constexpr int ATT_WS = 98304;
__device__ __forceinline__ void attn_unit(LAS unsigned char* lds, const bf16* Z, int qrow0, int krow0, int NT, int h, float negb, float lam, float oscale, const float* sg, bf16* Y) {
    const int tid = fresh_tid(), lane = tid & 63, r32 = lane & 31, hi = lane >> 5; const int wid = __builtin_amdgcn_readfirstlane(tid >> 6); const int mp = wid >> 2, wq = wid & 3;
    const unsigned lds0 = (unsigned)(uintptr_t)lds;
    const int dr = lane >> 4, dsl = lane & 15;
    const bf16* ks0 = Z + (size_t)(krow0 + 4 * wid + dr) * INW + K_OFF + h * 128 + (dsl ^ ((4 * wid + dr) & 15)) * 8;
    const bf16* vs0 = Z + (size_t)(krow0 + 4 * wid + dr) * INW + V_OFF + h * 128 + (dsl ^ (dr << 2)) * 8;
#define DMA_K(t) do { const size_t off_ = (size_t)(t) * 64 * INW; const unsigned sb_ = lds0 + (unsigned)((t) % 3) * 16384u + wid * 1024; \
        glds16(ks0 + off_, (unsigned)__builtin_amdgcn_readfirstlane(sb_)); glds16(ks0 + off_ + (size_t)32 * INW, (unsigned)__builtin_amdgcn_readfirstlane(sb_ + 8192)); } while (0)
#define DMA_V(t) do { const size_t off_ = (size_t)(t) * 64 * INW; const unsigned sb_ = lds0 + 49152u + (unsigned)((t) & 1) * 16384u + wid * 1024; \
        glds16(vs0 + off_, (unsigned)__builtin_amdgcn_readfirstlane(sb_)); glds16(vs0 + off_ + (size_t)32 * INW, (unsigned)__builtin_amdgcn_readfirstlane(sb_ + 8192)); } while (0)
    int kof[4], vof[4];
    { const int g1 = (lane >> 4) & 1, q = (lane & 15) >> 2, p = lane & 3;
#pragma unroll
        for (int d0 = 0; d0 < 4; ++d0) { kof[d0] = r32 * 256 + (((mp * 8 + 2 * d0 + hi) ^ (r32 & 15)) << 4);
            vof[d0] = 49152 + (4 * hi + q) * 256 + (((4 * d0 + 2 * g1 + (p >> 1)) ^ (q << 2)) << 4) + (p & 1) * 8; } }
    bf16x8 qr[4];
    { const bf16* qp = Z + (size_t)(qrow0 + wq * 32 + r32) * INW + Q_OFF + h * 128 + mp * 64 + hi * 8;
#pragma unroll
        for (int d0 = 0; d0 < 4; ++d0) qr[d0] = *(const bf16x8*)(qp + d0 * 16); }
    DMA_K(0); DMA_K(1);
    if (mp) __builtin_amdgcn_s_setprio(1);
    f32x16 o[4];
#pragma unroll
    for (int d0 = 0; d0 < 4; ++d0)
#pragma unroll
        for (int r = 0; r < 16; ++r) o[d0][r] = 0.f;
    const f32x16 zero16 = {0.f, 0.f, 0.f, 0.f, 0.f, 0.f, 0.f, 0.f, 0.f, 0.f, 0.f, 0.f, 0.f, 0.f, 0.f, 0.f};
    float l_reg = 0.f;
    v4u pw[4];
    (void)negb;
#define ATT_QK(P0, P1, t) do { const LAS unsigned char* kp_ = lds + ((t) % 3) * 16384; \
        { bf16x8 kf_[4]; _Pragma("unroll") for (int d0 = 0; d0 < 4; ++d0) kf_[d0] = *(const LAS bf16x8*)(kp_ + kof[d0]); \
          P0 = __builtin_amdgcn_mfma_f32_32x32x16_bf16(kf_[0], qr[0], zero16, 0, 0, 0); \
          _Pragma("unroll") for (int d0 = 1; d0 < 4; ++d0) P0 = __builtin_amdgcn_mfma_f32_32x32x16_bf16(kf_[d0], qr[d0], P0, 0, 0, 0); } \
        { bf16x8 kf_[4]; _Pragma("unroll") for (int d0 = 0; d0 < 4; ++d0) kf_[d0] = *(const LAS bf16x8*)(kp_ + kof[d0] + 8192); \
          P1 = __builtin_amdgcn_mfma_f32_32x32x16_bf16(kf_[0], qr[0], zero16, 0, 0, 0); \
          _Pragma("unroll") for (int d0 = 1; d0 < 4; ++d0) P1 = __builtin_amdgcn_mfma_f32_32x32x16_bf16(kf_[d0], qr[d0], P1, 0, 0, 0); } } while (0)
#define ATT_EXP(P0, P1) do { float sa_ = 0.f, sb_ = 0.f; \
        _Pragma("unroll") for (int r = 0; r < 16; ++r) { P0[r] = __builtin_amdgcn_exp2f(P0[r]); P1[r] = __builtin_amdgcn_exp2f(P1[r]); sa_ += P0[r]; sb_ += P1[r]; } \
        l_reg += sa_ + sb_; } while (0)
#define ATT_PACK(P0, P1) do { \
        _Pragma("unroll") for (int q = 0; q < 4; ++q) { pw[0][q] = cvtpk_s(P0[2 * q], P0[2 * q + 1]); pw[1][q] = cvtpk_s(P0[8 + 2 * q], P0[8 + 2 * q + 1]); \
            pw[2][q] = cvtpk_s(P1[2 * q], P1[2 * q + 1]); pw[3][q] = cvtpk_s(P1[8 + 2 * q], P1[8 + 2 * q + 1]); } } while (0)
#define VTR(dst, addr, off) dst = vtr((const LAS unsigned char*)(addr) + (off))
#define ATT_VLOAD(V, t, d0) do { const unsigned va_ = lds0 + (unsigned)((t) & 1) * 16384u + (unsigned)vof[d0]; \
        VTR(V[0], va_, 0); VTR(V[1], va_, 2048); VTR(V[2], va_, 4096); VTR(V[3], va_, 6144); VTR(V[4], va_, 8192); VTR(V[5], va_, 10240); VTR(V[6], va_, 12288); VTR(V[7], va_, 14336); } while (0)
#define ATT_LGKM(n) asm volatile("s_waitcnt lgkmcnt(" #n ")" ::: "memory")
#define VFR(V, ks) (bf16x8){V[2 * (ks)][0], V[2 * (ks)][1], V[2 * (ks)][2], V[2 * (ks)][3], V[2 * (ks) + 1][0], V[2 * (ks) + 1][1], V[2 * (ks) + 1][2], V[2 * (ks) + 1][3]}
#define ATT_PVX(V, d0, P, B) do { \
        _Pragma("unroll") for (int ks = 0; ks < 4; ++ks) { o[d0] = __builtin_amdgcn_mfma_f32_32x32x16_bf16(__builtin_bit_cast(bf16x8, pw[ks]), VFR(V, ks), o[d0], 0, 0, 0); \
            P[B + 2 * ks] = __builtin_amdgcn_exp2f(P[B + 2 * ks]); P[B + 2 * ks + 1] = __builtin_amdgcn_exp2f(P[B + 2 * ks + 1]); sa_ += P[B + 2 * ks]; sb_ += P[B + 2 * ks + 1]; } \
        _Pragma("unroll") for (int ks = 0; ks < 4; ++ks) { __builtin_amdgcn_sched_group_barrier(0x008, 1, 0); __builtin_amdgcn_sched_group_barrier(0x400, 2, 0); __builtin_amdgcn_sched_group_barrier(0x002, 2, 0); } \
        __builtin_amdgcn_sched_barrier(0); } while (0)
#define ATT_PVONLY(V, d0) do { _Pragma("unroll") for (int ks = 0; ks < 4; ++ks) o[d0] = __builtin_amdgcn_mfma_f32_32x32x16_bf16(__builtin_bit_cast(bf16x8, pw[ks]), VFR(V, ks), o[d0], 0, 0, 0); __builtin_amdgcn_sched_barrier(0); } while (0)
#define ATT_TOP(t) do { if ((t) + 1 < NT) ATT_WAIT_BAR(2); else ATT_WAIT_BAR(0); DMA_V(t); if ((t) + 2 < NT) DMA_K((t) + 2); } while (0)
    { f32x16 p0, p1;
        ATT_TOP(0); ATT_QK(p0, p1, 0); ATT_EXP(p0, p1); ATT_PACK(p0, p1); }
    s16x4 va[8], vb[8];
    for (int t = 1; t < NT; ++t) {
        f32x16 p0, p1; float sa_ = 0.f, sb_ = 0.f;
        ATT_TOP(t);
        ATT_VLOAD(va, t - 1, 0); __builtin_amdgcn_sched_barrier(0);
        ATT_QK(p0, p1, t); __builtin_amdgcn_sched_barrier(0);
        ATT_VLOAD(vb, t - 1, 1); ATT_LGKM(8); __builtin_amdgcn_sched_barrier(0);
        ATT_PVX(va, 0, p0, 0);
        ATT_VLOAD(va, t - 1, 2); ATT_LGKM(8); __builtin_amdgcn_sched_barrier(0);
        ATT_PVX(vb, 1, p0, 8);
        ATT_VLOAD(vb, t - 1, 3); ATT_LGKM(8); __builtin_amdgcn_sched_barrier(0);
        ATT_PVX(va, 2, p1, 0);
        ATT_LGKM(0); __builtin_amdgcn_sched_barrier(0);
        ATT_PVX(vb, 3, p1, 8);
        l_reg += sa_ + sb_;
        ATT_PACK(p0, p1); }
    ATT_WAIT_BAR(0);
    ATT_VLOAD(va, NT - 1, 0); ATT_VLOAD(vb, NT - 1, 1); ATT_LGKM(8); ATT_PVONLY(va, 0);
    ATT_VLOAD(va, NT - 1, 2); ATT_LGKM(8); ATT_PVONLY(vb, 1);
    ATT_VLOAD(vb, NT - 1, 3); ATT_LGKM(8); ATT_PVONLY(va, 2);
    ATT_LGKM(0); ATT_PVONLY(vb, 3);
#undef ATT_EXP
#undef VTR
#undef ATT_VLOAD
#undef ATT_LGKM
#undef VFR
#undef ATT_PVX
#undef ATT_PVONLY
#undef ATT_PACK
#undef ATT_TOP
#undef ATT_QK
#undef ATT_PV
#undef DMA_K
#undef DMA_V
    __builtin_amdgcn_s_setprio(0);
    { auto rr = __builtin_amdgcn_permlane32_swap(__float_as_uint(l_reg), __float_as_uint(l_reg), false, false); l_reg = __uint_as_float(rr[0]) + __uint_as_float(rr[1]); }
    LAS float* wsf = (LAS float*)(lds + ATT_WS) + wid * 64;
    if (hi == 0) wsf[r32] = l_reg;
    LDS_WAIT();
    float rl[16];
#pragma unroll
    for (int r = 0; r < 16; ++r) rl[r] = __builtin_amdgcn_rcpf(wsf[crow(r, hi)]) * (mp ? lam : 1.0f);
    ATT_WAIT_BAR(0);
    LAS float* stg = (LAS float*)lds + wq * (32 * 132);
    if (mp == 1) {
#pragma unroll
        for (int d0 = 0; d0 < 4; ++d0)
#pragma unroll
            for (int r = 0; r < 16; ++r) stg[crow(r, hi) * 132 + d0 * 32 + r32] = o[d0][r] * rl[r];
    }
    ATT_WAIT_BAR(0);
    if (mp == 0) {
#pragma unroll
        for (int d0 = 0; d0 < 4; ++d0)
#pragma unroll
            for (int r = 0; r < 16; ++r) { const int ix = crow(r, hi) * 132 + d0 * 32 + r32; stg[ix] = o[d0][r] * rl[r] - stg[ix]; }
        LDS_WAIT();
        const int q = lane >> 1, half = lane & 1; const LAS float* rp = stg + q * 132 + half * 64;
        f32x4 v[16]; float ss = 0.f;
#pragma unroll
        for (int i = 0; i < 16; ++i) { v[i] = *(const LAS f32x4*)(rp + 4 * i); ss += (v[i].x * v[i].x + v[i].y * v[i].y) + (v[i].z * v[i].z + v[i].w * v[i].w); }
        ss += xor1_f(ss);
        const float rinv = __builtin_amdgcn_rsqf(ss * (1.0f / 128.0f) + 1e-6f) * oscale;
        bf16* yp = Y + (size_t)(qrow0 + wq * 32 + q) * DM + 512 + h * 128 + half * 64;
        const f32x4* sgp = (const f32x4*)(sg + half * 64);
#pragma unroll
        for (int i = 0; i < 8; ++i) { const f32x4 a0 = v[2 * i] * sgp[2 * i] * rinv, a1 = v[2 * i + 1] * sgp[2 * i + 1] * rinv;
            v4u w; w.x = pk2(a0.x, a0.y); w.y = pk2(a0.z, a0.w); w.z = pk2(a1.x, a1.y); w.w = pk2(a1.z, a1.w); *(v4u*)(yp + 8 * i) = w; }
    }
    ATT_WAIT_BAR(0);
}

__device__ __forceinline__ void attn_unit16(LAS unsigned char* lds, const bf16* Z, int qrow0, int krow0, int NT, int h, float lam, float oscale, const float* sg, bf16* Y) {
    const int tid = fresh_tid(), lane = tid & 63, r16 = lane & 15, g = lane >> 4; const int wid = __builtin_amdgcn_readfirstlane(tid >> 6); const int mp = wid >> 2, wq = wid & 3;
    const unsigned lds0 = (unsigned)(uintptr_t)lds;
    const int dr = lane >> 4, dsl = lane & 15;
    const bf16* ks0 = Z + (size_t)(krow0 + 4 * wid + dr) * INW + K_OFF + h * 128 + (dsl ^ ((4 * wid + dr) & 15)) * 8;
    const bf16* vs0 = Z + (size_t)(krow0 + 4 * wid + dr) * INW + V_OFF + h * 128 + (dsl ^ (dr << 2) ^ ((wid & 1) << 1)) * 8;
#define DMA_K(t) do { const size_t off_ = (size_t)(t) * 64 * INW; const unsigned sb_ = lds0 + (unsigned)((t) % 3) * 16384u + wid * 1024; \
        glds16(ks0 + off_, (unsigned)__builtin_amdgcn_readfirstlane(sb_)); glds16(ks0 + off_ + (size_t)32 * INW, (unsigned)__builtin_amdgcn_readfirstlane(sb_ + 8192)); } while (0)
#define DMA_V(t) do { const size_t off_ = (size_t)(t) * 64 * INW; const unsigned sb_ = lds0 + 49152u + (unsigned)((t) & 1) * 16384u + wid * 1024; \
        glds16(vs0 + off_, (unsigned)__builtin_amdgcn_readfirstlane(sb_)); glds16(vs0 + off_ + (size_t)32 * INW, (unsigned)__builtin_amdgcn_readfirstlane(sb_ + 8192)); } while (0)
    int kof[2];
    kof[0] = r16 * 256 + (((mp * 8 + g) ^ r16) << 4); kof[1] = r16 * 256 + (((mp * 8 + 4 + g) ^ r16) << 4);
    const int q4 = r16 >> 2, pq = r16 & 3;
    const int vrow = 49152 + (4 * g + q4) * 256 + (pq & 1) * 8, vx = (q4 << 2) ^ ((g & 1) << 1) ^ (pq >> 1);
    bf16x8 qf[2][2];
    { const bf16* qp = Z + (size_t)(qrow0 + wq * 32 + r16) * INW + Q_OFF + h * 128 + mp * 64 + g * 8;
#pragma unroll
        for (int qb = 0; qb < 2; ++qb)
#pragma unroll
            for (int ks = 0; ks < 2; ++ks) qf[qb][ks] = *(const bf16x8*)(qp + (size_t)qb * 16 * INW + ks * 32); }
    DMA_K(0); DMA_K(1);
    if (mp) __builtin_amdgcn_s_setprio(1);
    f32x4 o[2][8];
#pragma unroll
    for (int qb = 0; qb < 2; ++qb)
#pragma unroll
        for (int db = 0; db < 8; ++db) o[qb][db] = (f32x4){0.f, 0.f, 0.f, 0.f};
    const f32x4 zero4 = {0.f, 0.f, 0.f, 0.f};
    float l0 = 0.f, l1 = 0.f;
    v4u pw[2][2];
    f32x4 S[4][2];
#define ATT_QK(t) do { const LAS unsigned char* kp_ = lds + ((t) % 3) * 16384; \
        _Pragma("unroll") for (int kh = 0; kh < 2; ++kh) { bf16x8 kf_[2][2]; \
            _Pragma("unroll") for (int kb = 0; kb < 2; ++kb) _Pragma("unroll") for (int ks = 0; ks < 2; ++ks) kf_[kb][ks] = *(const LAS bf16x8*)(kp_ + kof[ks] + (2 * kh + kb) * 4096); \
            _Pragma("unroll") for (int kb = 0; kb < 2; ++kb) _Pragma("unroll") for (int qb = 0; qb < 2; ++qb) { \
                S[2 * kh + kb][qb] = __builtin_amdgcn_mfma_f32_16x16x32_bf16(kf_[kb][0], qf[qb][0], zero4, 0, 0, 0); \
                S[2 * kh + kb][qb] = __builtin_amdgcn_mfma_f32_16x16x32_bf16(kf_[kb][1], qf[qb][1], S[2 * kh + kb][qb], 0, 0, 0); } } } while (0)
#define ATT_EXPB(kb) do { _Pragma("unroll") for (int r = 0; r < 4; ++r) { S[kb][0][r] = __builtin_amdgcn_exp2f(S[kb][0][r]); S[kb][1][r] = __builtin_amdgcn_exp2f(S[kb][1][r]); sa_ += S[kb][0][r]; sb_ += S[kb][1][r]; } } while (0)
#define ATT_PACK() do { _Pragma("unroll") for (int qb = 0; qb < 2; ++qb) _Pragma("unroll") for (int s_ = 0; s_ < 2; ++s_) { \
        pw[qb][s_][0] = cvtpk_s(S[2 * s_][qb][0], S[2 * s_][qb][1]); pw[qb][s_][1] = cvtpk_s(S[2 * s_][qb][2], S[2 * s_][qb][3]); \
        pw[qb][s_][2] = cvtpk_s(S[2 * s_ + 1][qb][0], S[2 * s_ + 1][qb][1]); pw[qb][s_][3] = cvtpk_s(S[2 * s_ + 1][qb][2], S[2 * s_ + 1][qb][3]); } } while (0)
#define ATT_VLOAD(V, t, dg) do { const LAS unsigned char* vp_ = lds + ((t) & 1) * 16384 + vrow; \
        _Pragma("unroll") for (int dbl = 0; dbl < 2; ++dbl) { const int va_ = ((2 * (2 * (dg) + dbl)) ^ vx) << 4; \
            _Pragma("unroll") for (int s_ = 0; s_ < 2; ++s_) { V[(dbl * 2 + s_) * 2] = vtr(vp_ + va_ + s_ * 8192); V[(dbl * 2 + s_) * 2 + 1] = vtr(vp_ + va_ + s_ * 8192 + 4096); } } } while (0)
#define VFR(V, i) (bf16x8){V[2 * (i)][0], V[2 * (i)][1], V[2 * (i)][2], V[2 * (i)][3], V[2 * (i) + 1][0], V[2 * (i) + 1][1], V[2 * (i) + 1][2], V[2 * (i) + 1][3]}
#define ATT_PVG(V, dg) do { _Pragma("unroll") for (int dbl = 0; dbl < 2; ++dbl) _Pragma("unroll") for (int qb = 0; qb < 2; ++qb) _Pragma("unroll") for (int s_ = 0; s_ < 2; ++s_) \
            o[qb][2 * (dg) + dbl] = __builtin_amdgcn_mfma_f32_16x16x32_bf16(__builtin_bit_cast(bf16x8, pw[qb][s_]), VFR(V, dbl * 2 + s_), o[qb][2 * (dg) + dbl], 0, 0, 0); } while (0)
#define ATT_PVX(V, dg) do { ATT_PVG(V, dg); ATT_EXPB(dg); \
        _Pragma("unroll") for (int i_ = 0; i_ < 4; ++i_) { __builtin_amdgcn_sched_group_barrier(0x008, 2, 0); __builtin_amdgcn_sched_group_barrier(0x400, 2, 0); __builtin_amdgcn_sched_group_barrier(0x002, 2, 0); } \
        __builtin_amdgcn_sched_barrier(0); } while (0)
#define ATT_TOP(t) do { if ((t) + 1 < NT) ATT_WAIT_BAR(2); else ATT_WAIT_BAR(0); DMA_V(t); if ((t) + 2 < NT) DMA_K((t) + 2); } while (0)
#define ATT_LGKM(n) asm volatile("s_waitcnt lgkmcnt(" #n ")" ::: "memory")
    { float sa_ = 0.f, sb_ = 0.f; ATT_TOP(0); ATT_QK(0); ATT_EXPB(0); ATT_EXPB(1); ATT_EXPB(2); ATT_EXPB(3); l0 += sa_; l1 += sb_; ATT_PACK(); }
    s16x4 va[8], vb[8];
    for (int t = 1; t < NT; ++t) {
        float sa_ = 0.f, sb_ = 0.f;
        ATT_TOP(t);
        ATT_VLOAD(va, t - 1, 0); __builtin_amdgcn_sched_barrier(0);
        ATT_QK(t); __builtin_amdgcn_sched_barrier(0);
        ATT_VLOAD(vb, t - 1, 1); ATT_LGKM(8); __builtin_amdgcn_sched_barrier(0);
        ATT_PVX(va, 0);
        ATT_VLOAD(va, t - 1, 2); ATT_LGKM(8); __builtin_amdgcn_sched_barrier(0);
        ATT_PVX(vb, 1);
        ATT_VLOAD(vb, t - 1, 3); ATT_LGKM(8); __builtin_amdgcn_sched_barrier(0);
        ATT_PVX(va, 2);
        ATT_LGKM(0); __builtin_amdgcn_sched_barrier(0);
        ATT_PVX(vb, 3);
        l0 += sa_; l1 += sb_;
        ATT_PACK(); }
    ATT_WAIT_BAR(0);
    ATT_VLOAD(va, NT - 1, 0); ATT_VLOAD(vb, NT - 1, 1); ATT_LGKM(8); ATT_PVG(va, 0); __builtin_amdgcn_sched_barrier(0);
    ATT_VLOAD(va, NT - 1, 2); ATT_LGKM(8); ATT_PVG(vb, 1); __builtin_amdgcn_sched_barrier(0);
    ATT_VLOAD(vb, NT - 1, 3); ATT_LGKM(8); ATT_PVG(va, 2); __builtin_amdgcn_sched_barrier(0);
    ATT_LGKM(0); ATT_PVG(vb, 3);
#undef DMA_K
#undef DMA_V
#undef ATT_QK
#undef ATT_EXPB
#undef ATT_PACK
#undef ATT_VLOAD
#undef VFR
#undef ATT_PVG
#undef ATT_PVX
#undef ATT_TOP
#undef ATT_LGKM
    __builtin_amdgcn_s_setprio(0);
    l0 += xor16_f(l0); l0 = sum32_f(l0); l1 += xor16_f(l1); l1 = sum32_f(l1);
    LAS float* wsf = (LAS float*)(lds + ATT_WS) + wid * 64;
    if (g == 0) { wsf[r16] = l0; wsf[16 + r16] = l1; }
    LDS_WAIT();
    float rl[2][4];
#pragma unroll
    for (int qb = 0; qb < 2; ++qb)
#pragma unroll
        for (int r = 0; r < 4; ++r) rl[qb][r] = __builtin_amdgcn_rcpf(wsf[16 * qb + 4 * g + r]) * (mp ? lam : 1.0f);
    ATT_WAIT_BAR(0);
    LAS float* stg = (LAS float*)lds + wq * (32 * 132);
    if (mp == 1) {
#pragma unroll
        for (int qb = 0; qb < 2; ++qb)
#pragma unroll
            for (int db = 0; db < 8; ++db)
#pragma unroll
                for (int r = 0; r < 4; ++r) stg[(16 * qb + 4 * g + r) * 132 + 16 * db + r16] = o[qb][db][r] * rl[qb][r];
    }
    ATT_WAIT_BAR(0);
    if (mp == 0) {
#pragma unroll
        for (int qb = 0; qb < 2; ++qb)
#pragma unroll
            for (int db = 0; db < 8; ++db)
#pragma unroll
                for (int r = 0; r < 4; ++r) { const int ix = (16 * qb + 4 * g + r) * 132 + 16 * db + r16; stg[ix] = o[qb][db][r] * rl[qb][r] - stg[ix]; }
        LDS_WAIT();
        const int q = lane >> 1, half = lane & 1; const LAS float* rp = stg + q * 132 + half * 64;
        f32x4 v[16]; float ss = 0.f;
#pragma unroll
        for (int i = 0; i < 16; ++i) { v[i] = *(const LAS f32x4*)(rp + 4 * i); ss += (v[i].x * v[i].x + v[i].y * v[i].y) + (v[i].z * v[i].z + v[i].w * v[i].w); }
        ss += xor1_f(ss);
        const float rinv = __builtin_amdgcn_rsqf(ss * (1.0f / 128.0f) + 1e-6f) * oscale;
        bf16* yp = Y + (size_t)(qrow0 + wq * 32 + q) * DM + 512 + h * 128 + half * 64;
        const f32x4* sgp = (const f32x4*)(sg + half * 64);
#pragma unroll
        for (int i = 0; i < 8; ++i) { const f32x4 a0 = v[2 * i] * sgp[2 * i] * rinv, a1 = v[2 * i + 1] * sgp[2 * i + 1] * rinv;
            v4u w; w.x = pk2(a0.x, a0.y); w.y = pk2(a0.z, a0.w); w.z = pk2(a1.x, a1.y); w.w = pk2(a1.z, a1.w); *(v4u*)(yp + 8 * i) = w; }
    }
    ATT_WAIT_BAR(0);
}

__device__ __forceinline__ void phase_mixers(const Args& a, int li, LAS unsigned char* lds, int G, int bx) {
    unsigned char* ws = fresh_ptr(a.ws);
    for (int rep = 0; rep <= DUP_HY; ++rep) if (PHEN(13)) for (int c = bx; c < 256; c += G) { const int v = G == 256 ? (((c & 7) << 5) | (c >> 3)) : c; hyena_unit(a, li, v >> 1, v & 1, lds); }
    for (int rep = 0; rep <= DUP_POOL; ++rep) if (PHEN(14)) { pool_load_lin(a, li, lds);
    for (int p = bx; p < 512; p += G) pool_unit(a, li, p, lds);
    for (int cp = bx; cp < 256; cp += G) pool_ctx_pair(a, li, cp, lds); }
    if (!PHEN(15)) return;
    const float* qkg = AIN(22) + li * 128; const float* dl = AIN(23) + li * 256; const float* sg = AIN(24) + li * 128;
    float mq = 0.f, mk = 0.f, d1 = 0.f, d2 = 0.f;
    for (int q = 0; q < 64; ++q) { mq = __builtin_fmaxf(mq, __builtin_fabsf(qkg[q])); mk = __builtin_fmaxf(mk, __builtin_fabsf(qkg[64 + q])); d1 += dl[q] * dl[64 + q]; d2 += dl[128 + q] * dl[192 + q]; }
    const float lam_init = 0.8f - 0.6f * __expf(-0.3f * (float)li);
    const float lam = __expf(d1) - __expf(d2) + lam_init;
    const float negb = -(64.0f * mq * mk * C2);
    const bf16* Z = (const bf16*)(ws + WS_Z); bf16* Y = (bf16*)(ws + WS_Y);
    for (int rep = 0; rep <= DUP_ATT; ++rep)
    for (int i = 0; i * G + bx < 1024; ++i) {
        int bh, qb;
        if (G == 256) { const int vcu = (bx & 7) * 32 + (bx >> 3); bh = vcu >> 5; qb = (vcu & 31) + 32 * i; } else { const int u = i * G + bx; bh = u >> 7; qb = u & 127; }
        const int b = bh >> 2, h = bh & 3;
        attn_unit16(lds, Z, b * RB + CTXL + qb * 128, b * RB, RB / 64, h, lam, 1.0f - lam_init, sg, Y);
    }
    if (li < DEPTH - 1) for (int u = bx; u < 16; u += G) { const int b = u >> 3, h = (u >> 1) & 3, qh = u & 1;
        attn_unit16(lds, Z, b * RB + qh * 128, b * RB, CTXL / 64, h, lam, 1.0f - lam_init, sg, Y); }
}

constexpr int NPHASES = 2 * 9 + 2 * 13 - 6;
__global__ void __launch_bounds__(NTHR, 2) fwd(Args a) {
    extern __shared__ __attribute__((aligned(16))) unsigned char lds_raw[];
    LAS unsigned char* lds = (LAS unsigned char*)lds_raw;
    volatile LAS unsigned* MISC = (volatile LAS unsigned*)(lds + MISC_OFF);
    const int tid = threadIdx.x, G = gridDim.x, bx = blockIdx.x;
    if (tid < 128) MISC[tid] = 0u;
    if (tid < 64) ((LAS unsigned*)(lds + PTAB_OFF))[tid] = ((const __attribute__((address_space(4))) unsigned*)__builtin_amdgcn_kernarg_segment_ptr())[tid];
    __syncthreads();
    const int lo = a.ph_lo, hi = a.ph_hi;
    unsigned* ctl = (unsigned*)(fresh_ptr(a.ws) + WS_CTL);
    XcdBarrier bar; bar.bar = ctl + CW_BAR; bar.x = 0; bar.st = MISC + 8;
    if (hi - lo > 1) bar = xcd_barrier_post(ctl + CW_BAR, MISC + 8);
    int ph = 0;
#define ON() (ph >= lo && ph < hi)
#define ENDPH() do { if (ON() && ph + 1 < hi) xcd_barrier(bar); ++ph; } while (0)
#define WSP(off) (fresh_ptr(a.ws) + (off))
#define XN ((bf16*)WSP(WS_XN))
#define Zb ((bf16*)WSP(WS_Z))
#define Yb ((bf16*)WSP(WS_Y))
#define HID ((bf16*)WSP(WS_HID))
#define win_t ((bf16*)WSP(WS_WIN))
#define wout_t ((bf16*)WSP(WS_WOUT))
#define wup_t ((bf16*)WSP(WS_WUP))
#define wdn_t ((bf16*)WSP(WS_WDN))
#define hctx ((float*)WSP(WS_HCTX))
#define WSB WSP(0)
#define modl ((const float*)WSP(WS_MOD) + (size_t)li * 3 * 6144)
    for (int li = 0; li < DEPTH; ++li) {
        const bool moe = (li & 1) != 0;
        const float* xlat = li == 0 ? AIN(0) : (const float*)fresh_ptr(a.out);
        if (li == 0) {
            if (PHEN(0) && ON()) phase_prep_a(a, li, lds, G, bx);
            ENDPH();
            if (PHEN(1) && ON()) phase_prep_b(a, li, lds, G, bx);
            ENDPH();
            if (PHEN(2) && ON()) phase_norm(a, li, 0, xlat, lds, G, bx);
            ENDPH();
        } else {
            if (ON()) { if (PHEN(0)) phase_prep_a(a, li, lds, G, bx); if (PHEN(1)) phase_prep_b(a, li, lds, G, bx); if (PHEN(2)) phase_norm(a, li, 0, xlat, lds, G, bx); }
            ENDPH();
        }
        for (int rep = 0; rep <= DUP_GEMM; ++rep) if (PHEN(3) && ON()) { pg8::Gemm g{XN, win_t, MROWS, INW, DM}; pg8::StaticOrder S; S.init(MROWS, INW, DM, G, bx);
            EpiIn E{Zb, (bf16*)(WSB + WS_ZT), (bf16*)(WSB + WS_ZTC), (const float*)(WSB + WS_ROPE), (const float*)(WSB + WS_ROPE) + 4096, AIN(22) + li * 128};
            pg8::gemm_phase<EpiIn, pg8::StaticOrder, true, true>(lds, g, S, E); }
        ENDPH();
        if (PHEN(4) && ON()) phase_mixers(a, li, lds, G, bx);
        ENDPH();
#if DUP_ADD
        if (PHEN(5) && ON()) { pg8::Gemm g{Yb, wout_t, MROWS, DM, DM}; SplitTailOrder S; S.init(DM, DM, G, bx);
            EpiRes E{xlat, a.out, hctx, modl + 2 * DM, DM / 64, (float*)(WSB + WS_SLAB), 0.f};
            pg8::gemm_phase<EpiRes, SplitTailOrder, true, true>(lds, g, S, E); }
#endif
        if (PHEN(5) && ON()) { pg8::Gemm g{Yb, wout_t, MROWS, DM, DM}; SplitTailOrder S; S.init(DM, DM, G, bx);
            EpiRes E{xlat, a.out, hctx, modl + 2 * DM, DM / 64, (float*)(WSB + WS_SLAB), 1.f};
            pg8::gemm_phase<EpiRes, SplitTailOrder, true, true>(lds, g, S, E); }
        ENDPH();
        if (!moe) {
            if (PHEN(6) && ON()) phase_norm(a, li, 3, a.out, lds, G, bx);
            ENDPH();
            for (int rep = 0; rep <= DUP_GEMM; ++rep) if (PHEN(7) && ON()) { pg8::Gemm g{XN, wup_t, MROWS, 2 * DFF, DM}; pg8::StaticOrder S; S.init(MROWS, 2 * DFF, DM, G, bx);
                EpiGlu E{HID, DFF, DFF / 128};
                pg8::gemm_phase<EpiGlu, pg8::StaticOrder, true, true>(lds, g, S, E); }
            ENDPH();
#if DUP_ADD
            if (PHEN(8) && ON()) { pg8::Gemm g{HID, wdn_t, MROWS, DM, DFF}; SplitTailOrder S; S.init(DM, DFF, G, bx);
                EpiRes E{a.out, a.out, hctx, modl + 5 * DM, DFF / 64, (float*)(WSB + WS_SLAB), 0.f};
                pg8::gemm_phase<EpiRes, SplitTailOrder, true, true>(lds, g, S, E); }
#endif
            if (PHEN(8) && ON()) { pg8::Gemm g{HID, wdn_t, MROWS, DM, DFF}; SplitTailOrder S; S.init(DM, DFF, G, bx);
                EpiRes E{a.out, a.out, hctx, modl + 5 * DM, DFF / 64, (float*)(WSB + WS_SLAB), 1.f};
                pg8::gemm_phase<EpiRes, SplitTailOrder, true, true>(lds, g, S, E); }
            ENDPH();
        } else {
            const LAS int* tab = (const LAS int*)(lds + TAB_OFF);
            if (PHEN(9) && ON()) phase_norm_router(a, li, a.out, lds, G, bx);
            ENDPH();
            if (PHEN(10) && ON()) phase_moe_gather(a, li, lds, G, bx);
            ENDPH();
            for (int rep = 0; rep <= DUP_GEMM; ++rep) if (PHEN(11) && ON()) { moe_tables(a, li >> 1, lds, G, bx);
                pg8::Gemm g{(const bf16*)(WSB + WS_AG), wup_t, 0, 0, DM}; MoeOrder S{G, bx, 2 * DFE / 256, 0, tab[16] * (2 * DFE / 256), tab, DM / 64};
                EpiGlu E{HID, DFE, DFE / 128};
                pg8::gemm_phase<EpiGlu, MoeOrder, true, true>(lds, g, S, E); }
            ENDPH();
            for (int k = 0; k < 2; ++k) {
#if DUP_ADD
                if (PHEN(12) && ON()) { moe_tables(a, li >> 1, lds, G, bx);
                    pg8::Gemm g{HID, wdn_t, 0, 0, DFE}; MoeDownOrder S; S.init(G, bx, k, tab);
                    EpiMoeDown E{a.out, hctx, modl + 5 * DM, (const int*)(WSB + WS_RTOK), (const float*)(WSB + WS_RGATE), tab, (float*)(WSB + WS_SLAB), 0.f};
                    pg8::gemm_phase<EpiMoeDown, MoeDownOrder, true, true>(lds, g, S, E); }
#endif
                if (PHEN(12) && ON()) { moe_tables(a, li >> 1, lds, G, bx);
                    pg8::Gemm g{HID, wdn_t, 0, 0, DFE}; MoeDownOrder S; S.init(G, bx, k, tab);
                    EpiMoeDown E{a.out, hctx, modl + 5 * DM, (const int*)(WSB + WS_RTOK), (const float*)(WSB + WS_RGATE), tab, (float*)(WSB + WS_SLAB), 1.f};
                    pg8::gemm_phase<EpiMoeDown, MoeDownOrder, true, true>(lds, g, S, E); }
                ENDPH();
            }
            for (int k = 0; k < 2; ++k) { if (ON()) phase_moe_fix(a, li, k, lds, G, bx); ENDPH(); }
        }
    }
#undef ON
#undef ENDPH
#undef WSP
#undef XN
#undef Zb
#undef Yb
#undef HID
#undef win_t
#undef wout_t
#undef wup_t
#undef wdn_t
#undef hctx
#undef WSB
#undef modl
}

extern "C" void kernel_launch(void* const* d_in, const int* in_sizes, int n_in, void* d_out, int out_size, void* d_ws, size_t ws_size, hipStream_t stream) {
    static int grid = 0;
    if (grid == 0) {
        if (n_in != 32 || in_sizes[0] != NB * SEQ * DM || out_size != NB * SEQ * DM || ws_size < WS_END) {
            fprintf(stderr, "kernel_launch: unexpected problem: n_in %d in0 %d out %d ws %zu (need %zu)\n", n_in, n_in > 0 ? in_sizes[0] : -1, out_size, ws_size, (size_t)WS_END); grid = -1; return; }
        int dev = 0, cus = 0, per_cu = 0;
        if (hipGetDevice(&dev) != hipSuccess || hipDeviceGetAttribute(&cus, hipDeviceAttributeMultiprocessorCount, dev) != hipSuccess) { grid = -1; return; }
        if (hipFuncSetAttribute((const void*)fwd, hipFuncAttributeMaxDynamicSharedMemorySize, LDS_BYTES) != hipSuccess) { fprintf(stderr, "kernel_launch: hipFuncSetAttribute failed\n"); grid = -1; return; }
        if (hipOccupancyMaxActiveBlocksPerMultiprocessor(&per_cu, (const void*)fwd, NTHR, LDS_BYTES) != hipSuccess || per_cu < 1) { fprintf(stderr, "kernel_launch: occupancy query says %d\n", per_cu); }
        (void)hipGetLastError();
        grid = cus;
    }
    if (grid < 0) return;
    (void)hipMemsetAsync((char*)d_ws + WS_CTL, 0, CTL_ZERO_BYTES, stream);
    Args a{};
    for (int i = 0; i < 32; ++i) a.in[i] = (const float*)d_in[i];
    a.out = (float*)d_out; a.ws = (unsigned char*)d_ws;
#if MK_ONE_LAUNCH
    a.ph_lo = 0; a.ph_hi = NPHASES;
    hipLaunchKernelGGL(fwd, dim3(grid), dim3(NTHR), LDS_BYTES, stream, a);
#else
    for (int p = 0; p < NPHASES; ++p) { a.ph_lo = p; a.ph_hi = p + 1; hipLaunchKernelGGL(fwd, dim3(grid), dim3(NTHR), LDS_BYTES, stream, a); }
#endif
}
```

```cpp
#include <hip/hip_runtime.h>
#include <cstdio>
#include <cstdint>

#ifndef MK_ONE_LAUNCH
#define MK_ONE_LAUNCH 1
#endif
#ifndef PH_MASK
#define PH_MASK 0xFFFF
#endif
#define PHEN(n) (((PH_MASK) >> (n)) & 1)
#define DUP_ATT 0
#define DUP_HY 0
#define DUP_POOL 0
#define DUP_PREP 0
#define DUP_PREPB 0
#define DUP_GEMM 0
#define DUP_ADD 0

#define GAS __attribute__((address_space(1)))
#define LAS __attribute__((address_space(3)))
typedef unsigned short bf16;
typedef unsigned v4u __attribute__((ext_vector_type(4)));
typedef unsigned v2u __attribute__((ext_vector_type(2)));
typedef float f32x4 __attribute__((ext_vector_type(4)));
typedef float f32x2 __attribute__((ext_vector_type(2)));
typedef float f32x16 __attribute__((ext_vector_type(16)));
typedef short bf16x8 __attribute__((ext_vector_type(8)));
typedef short s16x4 __attribute__((ext_vector_type(4)));
typedef short v4i16_t __attribute__((ext_vector_type(4)));

constexpr int DM = 1024, NB = 2, SEQ = 16384, DEPTH = 4, CTXL = 256;
constexpr int RB = CTXL + SEQ;
constexpr int MROWS = NB * RB;
constexpr int TPB = RB / 256;
constexpr int INW = 2560, Q_OFF = 1024, K_OFF = 1536, V_OFF = 2048;
constexpr int DFF = 2816, DFE = 3584, NEXP = 8;
constexpr int NWAVES = 8, NTHR = 512;
constexpr int SEGCAP = MROWS;
constexpr float C2 = 0.125f * 1.4426950408889634f;

constexpr size_t MiB = 1u << 20;
constexpr size_t WS_CTL = 0, CTL_ZERO_BYTES = 1 * MiB;
constexpr size_t WS_MODP = 1 * MiB;
constexpr size_t WS_MOD = 4 * MiB;
constexpr size_t WS_ROPE = 4 * MiB + 512 * 1024;
constexpr size_t WS_H2C = 4 * MiB + 640 * 1024;
constexpr size_t WS_KCTX = 5 * MiB;
constexpr size_t WS_HCTX = 6 * MiB;
constexpr size_t WS_H2 = 8 * MiB;
constexpr size_t WS_RTOK = 12 * MiB;
constexpr size_t WS_RGATE = 15 * MiB;
constexpr size_t WS_RREC = 18 * MiB;
constexpr size_t WS_RRECG = 18 * MiB + 256 * 1024;
constexpr size_t WS_CNTB = 18 * MiB + 512 * 1024;
constexpr size_t WS_H2B = 19 * MiB;
constexpr size_t WS_W = 32 * MiB;
constexpr size_t WS_WIN = WS_W, WS_WOUT = WS_W + 5 * MiB, WS_WUP = WS_W + 8 * MiB, WS_WDN = WS_W + 120 * MiB;
constexpr size_t WS_XN = 224 * MiB;
constexpr size_t WS_Z = 289 * MiB;
constexpr size_t WS_ZT = 452 * MiB;
constexpr size_t WS_ZTC = WS_ZT + 48 * MiB;
constexpr size_t WS_Y = 501 * MiB;
constexpr size_t WS_HF = 566 * MiB;
constexpr size_t WS_HID = 289 * MiB;
constexpr size_t WS_AG = 772 * MiB;
constexpr size_t WS_SLAB = 910 * MiB;
constexpr size_t WS_END = 974 * MiB;

constexpr int CW_TMO = 0, CW_BAR = 4096, CW_MOECNT = 8192;

constexpr int LDS_BYTES = 159744;
constexpr int MISC_OFF = 155648;
constexpr int TAB_OFF = MISC_OFF + 256;

__device__ __forceinline__ unsigned f2bf(float f) { unsigned u = __builtin_bit_cast(unsigned, f); return (u + 0x7fffu + ((u >> 16) & 1u)) >> 16; }
__device__ __forceinline__ unsigned pk2(float lo, float hi) { return f2bf(lo) | (f2bf(hi) << 16); }
__device__ __forceinline__ float bf2f(bf16 b) { return __builtin_bit_cast(float, (unsigned)b << 16); }
template <int CTRL> __device__ __forceinline__ float dpp_f(float v) { return __builtin_bit_cast(float, __builtin_amdgcn_mov_dpp(__builtin_bit_cast(int, v), CTRL, 0xf, 0xf, true)); }
__device__ __forceinline__ float xor1_f(float v) { return dpp_f<0xB1>(v); }
__device__ __forceinline__ float xor2_f(float v) { return dpp_f<0x4E>(v); }
__device__ __forceinline__ float xor16_f(float v) { return __builtin_bit_cast(float, __builtin_amdgcn_ds_swizzle(__builtin_bit_cast(int, v), 0x401F)); }
__device__ __forceinline__ float xor32_f(float v) { auto rr = __builtin_amdgcn_permlane32_swap(__builtin_bit_cast(unsigned, v), __builtin_bit_cast(unsigned, v), false, false);
    return __builtin_bit_cast(float, (unsigned)rr[0]) == v ? __builtin_bit_cast(float, (unsigned)rr[1]) : __builtin_bit_cast(float, (unsigned)rr[0]); }
__device__ __forceinline__ float sum32_f(float v) { auto rr = __builtin_amdgcn_permlane32_swap(__builtin_bit_cast(unsigned, v), __builtin_bit_cast(unsigned, v), false, false);
    return __builtin_bit_cast(float, (unsigned)rr[0]) + __builtin_bit_cast(float, (unsigned)rr[1]); }
__device__ __forceinline__ float wave_sum(float v) {
    v += xor1_f(v); v += xor2_f(v); v += dpp_f<0x141>(v)  ; v += dpp_f<0x140>(v)  ; v += xor16_f(v);
    auto rr = __builtin_amdgcn_permlane32_swap(__builtin_bit_cast(unsigned, v), __builtin_bit_cast(unsigned, v), false, false);
    return __builtin_bit_cast(float, (unsigned)rr[0]) + __builtin_bit_cast(float, (unsigned)rr[1]);
}
__device__ __forceinline__ float sin_rev(float r) { return __builtin_amdgcn_sinf(__builtin_amdgcn_fractf(r)); }
__device__ __forceinline__ float cos_rev(float r) { return __builtin_amdgcn_cosf(__builtin_amdgcn_fractf(r)); }
__device__ __forceinline__ float sin_rad(float x) { return sin_rev(x * 0.15915494309189535f); }
__device__ __forceinline__ int fresh_tid() { int t = threadIdx.x; asm volatile("" : "+v"(t)); return t; }
template <class T> __device__ __forceinline__ T* fresh_ptr(T* p) { asm volatile("" : "+s"(p)); return (T*)(GAS T*)(unsigned long long)p; }
#define LDS_WAIT() asm volatile("s_waitcnt lgkmcnt(0)" ::: "memory")
#define VM_WAIT() asm volatile("s_waitcnt vmcnt(0)" ::: "memory")

namespace pg8 {
typedef unsigned short bf16_t;
typedef unsigned u32x4 __attribute__((ext_vector_type(4)));
constexpr int BM = 256, BK = 64, HALF = 128, HTB = HALF * BK * 2, STAGE_BYTES = 8 * HTB, NXCD = 8, WGM = 8;
__host__ __device__ __forceinline__ int lds_byte(int r, int c) { const int st = (r >> 4) * 2 + (c >> 5), rr = r & 15, cc = c & 31, ob = rr * 64 + cc * 2; return st * 1024 + (ob ^ (((ob >> 9) & 1) << 5)); }
__host__ __device__ __forceinline__ void stage_rc(int b, int& R, int& C) { const int st = b / 1024, sb = b % 1024, swz = sb ^ (((sb >> 9) & 1) << 5); R = (st >> 1) * 16 + swz / 64; C = (st & 1) * 32 + (swz % 64) / 2; }
__host__ __device__ __forceinline__ int perm32(int rho) { const int n = rho >> 4, i = rho & 15; return 8 * (i >> 2) + 4 * n + (i & 3); }
struct Unit { int pm, pn, ko, nt, sl; };
struct Gemm { const bf16_t* A; const bf16_t* Bt; int M, N, K; };
struct StaticOrder {
    int nM, nN, nwg, G, c;
    int ntk;
    __host__ __device__ void init(int M, int N, int K, int G_, int c_) { nM = M / BM; nN = N / BM; nwg = nM * nN; G = G_; c = c_; ntk = K / BK; }
    __host__ __device__ __forceinline__ bool next(int i, Unit& u) const { return map((long)i * G + c, u); }
    __host__ __device__ __forceinline__ bool map(long L, Unit& u) const {
        if (L >= nwg) return false; u.ko = 0; u.nt = ntk; u.sl = -1;
        int wgid = (int)L; { const int q = nwg / NXCD, r = nwg % NXCD, xcd = wgid % NXCD, off = wgid / NXCD; wgid = (xcd < r ? xcd * (q + 1) : r * (q + 1) + (xcd - r) * q) + off; }
        const int nig = WGM * nN, gid = wgid / nig, fm = gid * WGM, gsz = (nM - fm) < WGM ? (nM - fm) : WGM;
        u.pm = fm + ((wgid % nig) % gsz); u.pn = (wgid % nig) / gsz; return true;
    }
    __device__ __forceinline__ void a_ready(const Unit&) const {}
    __device__ __forceinline__ void done(const Unit&) const {}
};
__device__ __forceinline__ unsigned cvt_pk_bf16(float lo, float hi) { unsigned r; asm volatile("v_cvt_pk_bf16_f32 %0, %1, %2" : "=v"(r) : "v"(lo), "v"(hi)); return r; }

template <class Epi, class Sched, bool ALIGN_EPI = false, bool SP2 = false>
__device__ __forceinline__ void gemm_phase(LAS unsigned char* lds, const Gemm g, const Sched& S, const Epi& E) {
    const int tid = fresh_tid(), wid = __builtin_amdgcn_readfirstlane(tid >> 6), lane = tid & 63, wr = wid >> 2, wc = wid & 3, fr = lane & 15, fq = lane >> 4;
    const int K = g.K;
    unsigned voffA[2], voffB[2];
#pragma unroll
    for (int i = 0; i < 2; ++i) { int R, C; stage_rc(tid * 16 + i * 8192, R, C); const int Rb = Epi::PERM ? ((R & ~31) + perm32(R & 31)) : R;
        voffA[i] = (unsigned)(R * K + C) * 2u; voffB[i] = (unsigned)(Rb * K + C) * 2u; }
    const size_t kstep = (size_t)(BK * 2);
    const size_t hstep = (size_t)HALF * K * 2;
    const size_t tstep = 2 * hstep;
    const unsigned ldsw = (unsigned)wid * 1024u;
    const int aoff = lds_byte(wr * 64 + fr, fq * 8), boff = lds_byte(wc * 32 + fr, fq * 8);
#define PG8_SA(b, h) (((b) * 2 + (h)) * HTB)
#define PG8_SB(b, h) ((4 + (b) * 2 + (h)) * HTB)
#define PG8_STAGE(bufoff, gbase, voff) do { _Pragma("unroll") for (int _i = 0; _i < 2; ++_i) \
        __builtin_amdgcn_global_load_lds((const unsigned*)((const char*)(gbase) + (voff)[_i]), (LAS unsigned*)(lds + (bufoff) + ldsw + _i * 8192), 16, 0, 0); } while (0)
#define PG8_LDA(dst, b, h) do { _Pragma("unroll") for (int m = 0; m < 4; ++m) _Pragma("unroll") for (int k = 0; k < 2; ++k) dst[m][k] = *(const LAS bf16x8*)(lds + PG8_SA(b, h) + aoff + m * 2048 + k * 1024); } while (0)
#define PG8_LDB(dst, b, h) do { _Pragma("unroll") for (int n = 0; n < 2; ++n) _Pragma("unroll") for (int k = 0; k < 2; ++k) dst[n][k] = *(const LAS bf16x8*)(lds + PG8_SB(b, h) + boff + n * 2048 + k * 1024); } while (0)
#define PG8_MMA(ai, bj, At, Bt) do { __builtin_amdgcn_s_setprio(1); _Pragma("unroll") for (int m = 0; m < 4; ++m) _Pragma("unroll") for (int n = 0; n < 2; ++n) _Pragma("unroll") for (int k = 0; k < 2; ++k) \
        acc[ai][bj][m][n] = __builtin_amdgcn_mfma_f32_16x16x32_bf16(Bt[n][k], At[m][k], acc[ai][bj][m][n], 0, 0, 0); __builtin_amdgcn_s_setprio(0); } while (0)
#define PG8_WAIT_V(n) asm volatile("s_waitcnt vmcnt(" #n ")" ::: "memory")
#define PG8_WAIT_L(n) asm volatile("s_waitcnt lgkmcnt(" #n ")" ::: "memory")
#define PG8_BAR __builtin_amdgcn_s_barrier()
#define PG8_SCHED __builtin_amdgcn_sched_barrier(0)
    Unit cur, nxt; int ui = 0;
    if (!S.next(0, cur)) return;
    f32x4 acc[2][2][4][2];
#pragma unroll
    for (int a = 0; a < 2; ++a)
#pragma unroll
        for (int b = 0; b < 2; ++b)
#pragma unroll
            for (int m = 0; m < 4; ++m)
#pragma unroll
                for (int n = 0; n < 2; ++n) acc[a][b][m][n] = (f32x4){0.f, 0.f, 0.f, 0.f};
    bf16x8 At[4][2], B0[2][2], B1[2][2];
    const char* cA = (const char*)g.A + (size_t)cur.pm * tstep + (size_t)cur.ko * 2; const char* cB = (const char*)g.Bt + (size_t)cur.pn * tstep + (size_t)cur.ko * 2;
    S.a_ready(cur);
    if constexpr (SP2) {
        PG8_STAGE(PG8_SB(0, 0), cB, voffB); PG8_STAGE(PG8_SB(0, 1), cB + hstep, voffB); PG8_STAGE(PG8_SA(0, 0), cA, voffA); PG8_STAGE(PG8_SA(0, 1), cA + hstep, voffA);
        if (wr == 1) PG8_BAR;
        PG8_WAIT_V(2); PG8_BAR;
        PG8_STAGE(PG8_SB(1, 0), cB + kstep, voffB); PG8_STAGE(PG8_SA(1, 0), cA + kstep, voffA); PG8_STAGE(PG8_SB(1, 1), cB + hstep + kstep, voffB);
        PG8_WAIT_V(6); PG8_BAR;
    } else {
        PG8_STAGE(PG8_SB(0, 0), cB, voffB); PG8_STAGE(PG8_SA(0, 0), cA, voffA); PG8_STAGE(PG8_SB(0, 1), cB + hstep, voffB); PG8_STAGE(PG8_SA(0, 1), cA + hstep, voffA);
        if (wr == 1) PG8_BAR;
        PG8_WAIT_V(4); PG8_BAR;
        PG8_STAGE(PG8_SB(1, 0), cB + kstep, voffB); PG8_STAGE(PG8_SA(1, 0), cA + kstep, voffA); PG8_STAGE(PG8_SB(1, 1), cB + hstep + kstep, voffB);
        PG8_WAIT_V(6); PG8_BAR;
    }
    for (;;) {
        const bool has_next = S.next(ui + 1, nxt);
        const char* nA = has_next ? (const char*)g.A + (size_t)nxt.pm * tstep + (size_t)nxt.ko * 2 : cA; const char* nB = has_next ? (const char*)g.Bt + (size_t)nxt.pn * tstep + (size_t)nxt.ko * 2 : cB;
        const int nt = cur.nt;
        for (int t = 0; t < nt; t += 2) {
            const bool last = (t == nt - 2);
            const char* a1 = cA + (size_t)(t + 1) * kstep;
            const char* a2 = last ? nA : cA + (size_t)(t + 2) * kstep; const char* b2 = last ? nB : cB + (size_t)(t + 2) * kstep;
            const char* a3 = a2 + kstep; const char* b3 = b2 + kstep;
            if (last && has_next) S.a_ready(nxt);
            if constexpr (SP2) {
            PG8_LDB(B0, 0, 0); PG8_LDB(B1, 0, 1); PG8_SCHED; PG8_LDA(At, 0, 0); PG8_STAGE(PG8_SA(1, 1), a1 + hstep, voffA);
            PG8_WAIT_V(8); PG8_WAIT_L(0); PG8_BAR; PG8_MMA(0, 0, At, B0); PG8_MMA(0, 1, At, B1); PG8_BAR; PG8_SCHED;
            PG8_LDA(At, 0, 1); PG8_STAGE(PG8_SB(0, 0), b2, voffB); PG8_STAGE(PG8_SB(0, 1), b2 + hstep, voffB); PG8_STAGE(PG8_SA(0, 0), a2, voffA);
            PG8_WAIT_V(8); PG8_WAIT_L(0); PG8_BAR; PG8_MMA(1, 0, At, B0); PG8_MMA(1, 1, At, B1); PG8_BAR; PG8_SCHED;
            PG8_LDB(B0, 1, 0); PG8_LDB(B1, 1, 1); PG8_SCHED; PG8_LDA(At, 1, 0); PG8_STAGE(PG8_SA(0, 1), a2 + hstep, voffA);
            PG8_WAIT_V(8); PG8_WAIT_L(0); PG8_BAR; PG8_MMA(0, 0, At, B0); PG8_MMA(0, 1, At, B1); PG8_BAR; PG8_SCHED;
            PG8_LDA(At, 1, 1); PG8_STAGE(PG8_SB(1, 0), b3, voffB); PG8_STAGE(PG8_SB(1, 1), b3 + hstep, voffB); PG8_STAGE(PG8_SA(1, 0), a3, voffA);
            PG8_WAIT_V(8); PG8_WAIT_L(0); PG8_BAR; PG8_MMA(1, 0, At, B0); PG8_MMA(1, 1, At, B1); PG8_BAR; PG8_SCHED;
            } else {
            PG8_LDB(B0, 0, 0); PG8_SCHED; PG8_LDA(At, 0, 0); PG8_STAGE(PG8_SA(1, 1), a1 + hstep, voffA);
            PG8_WAIT_L(8); PG8_BAR; PG8_WAIT_L(0); PG8_MMA(0, 0, At, B0); PG8_BAR; PG8_SCHED;
            PG8_LDB(B1, 0, 1); PG8_STAGE(PG8_SB(0, 0), b2, voffB);
            PG8_BAR; PG8_WAIT_L(0); PG8_MMA(0, 1, At, B1); PG8_BAR;
            PG8_LDA(At, 0, 1); PG8_STAGE(PG8_SA(0, 0), a2, voffA);
            PG8_BAR; PG8_WAIT_L(0); PG8_MMA(1, 0, At, B0); PG8_BAR; PG8_SCHED;
            PG8_STAGE(PG8_SB(0, 1), b2 + hstep, voffB);
            PG8_WAIT_V(6); PG8_BAR; PG8_MMA(1, 1, At, B1); PG8_BAR;
            PG8_LDB(B0, 1, 0); PG8_SCHED; PG8_LDA(At, 1, 0); PG8_STAGE(PG8_SA(0, 1), a2 + hstep, voffA);
            PG8_WAIT_L(8); PG8_BAR; PG8_WAIT_L(0); PG8_MMA(0, 0, At, B0); PG8_BAR; PG8_SCHED;
            PG8_LDB(B1, 1, 1); PG8_STAGE(PG8_SB(1, 0), b3, voffB);
            PG8_BAR; PG8_WAIT_L(0); PG8_MMA(0, 1, At, B1); PG8_BAR;
            PG8_LDA(At, 1, 1); PG8_STAGE(PG8_SA(1, 0), a3, voffA);
            PG8_BAR; PG8_WAIT_L(0); PG8_MMA(1, 0, At, B0); PG8_BAR; PG8_SCHED;
            PG8_STAGE(PG8_SB(1, 1), b3 + hstep, voffB);
            PG8_WAIT_V(6); PG8_BAR; PG8_MMA(1, 1, At, B1); PG8_BAR;
            }
        }
        if constexpr (ALIGN_EPI) { if (wr == 0) PG8_BAR; }
        E(acc, cur, wr, wc, fr, fq); S.done(cur);
        if (!has_next) break;
#pragma unroll
        for (int a = 0; a < 2; ++a)
#pragma unroll
            for (int b = 0; b < 2; ++b)
#pragma unroll
                for (int m = 0; m < 4; ++m)
#pragma unroll
                    for (int n = 0; n < 2; ++n) acc[a][b][m][n] = (f32x4){0.f, 0.f, 0.f, 0.f};
        cur = nxt; cA = nA; cB = nB; ++ui;
        if constexpr (ALIGN_EPI) { if (wr == 1) PG8_BAR; }
    }
    PG8_WAIT_V(0);
    if constexpr (!ALIGN_EPI) { if (wr == 0) PG8_BAR; }
    PG8_BAR;
#undef PG8_SA
#undef PG8_SB
#undef PG8_STAGE
#undef PG8_LDA
#undef PG8_LDB
#undef PG8_MMA
#undef PG8_WAIT_V
#undef PG8_WAIT_L
#undef PG8_BAR
#undef PG8_SCHED
}
}

#define XB_TMO      128
#define XB_XCNT(j)  (256  + 64 * (j))
#define XB_XSUB(j)  (1280 + 64 * (j))
#define XB_XGEN(j)  (2304 + 64 * (j))
#define XB_TOP      3328
#define XB_TOPGEN   3392
#define XCD_BAR_WORDS 3456
#define XB_SPIN_CAP (1u << 18)
__device__ __forceinline__ unsigned xb_ld(unsigned* p)              { return __hip_atomic_load(p, __ATOMIC_RELAXED, __HIP_MEMORY_SCOPE_AGENT); }
__device__ __forceinline__ unsigned xb_add(unsigned* p, unsigned v) { return __hip_atomic_fetch_add(p, v, __ATOMIC_RELAXED, __HIP_MEMORY_SCOPE_AGENT); }
__device__ __forceinline__ unsigned xb_xcc_id() { return (unsigned)__builtin_amdgcn_s_getreg((3 << 11) | 20) & 0xFu; }
#define XB_SPIN(cond, bar) do { unsigned _sp = 0; while (cond) { __builtin_amdgcn_s_sleep(1); \
    if ((++_sp & 255u) == 0u) { if (xb_ld(&(bar)[XB_TMO])) break; if (_sp > XB_SPIN_CAP) { atomicAdd(&(bar)[XB_TMO], 1u); break; } } } } while (0)
struct XcdBarrier { unsigned* bar; unsigned x; volatile LAS unsigned* st; };
__device__ __forceinline__ XcdBarrier xcd_barrier_post(unsigned* bar, volatile LAS unsigned* st) {
    XcdBarrier b; b.bar = bar; b.x = xb_xcc_id(); b.st = st;
    if (threadIdx.x == 0) (void)xb_add(&bar[XB_XCNT(b.x)], 1u);
    return b;
}
__device__ __forceinline__ void xcd_barrier_complete(unsigned* bar, unsigned x, unsigned& nloc, unsigned& nx) {
    const unsigned G = gridDim.x * gridDim.y * gridDim.z;
    unsigned sum, cnt, mine, sp = 0u;
    for (;;) {
        sum = 0u; cnt = 0u; mine = 0u;
#pragma unroll
        for (unsigned j = 0; j < 16; ++j) { const unsigned c = xb_ld(&bar[XB_XCNT(j)]); sum += c; cnt += (c > 0u) ? 1u : 0u; mine = (j == x) ? c : mine; }
        if (sum == G) break;
        __builtin_amdgcn_s_sleep(1);
        if ((++sp & 255u) == 0u) { if (xb_ld(&bar[XB_TMO])) break; if (sp > XB_SPIN_CAP) { atomicAdd(&bar[XB_TMO], 1u); break; } }
    }
    nloc = mine > 0u ? mine : 1u; nx = cnt > 0u ? cnt : 1u;
}
__device__ __forceinline__ void xcd_barrier(const XcdBarrier& b) {
    asm volatile("s_waitcnt vmcnt(0)" ::: "memory");
    __syncthreads();
    if (threadIdx.x == 0) {
        unsigned* bar = b.bar;
        __builtin_amdgcn_s_waitcnt(0);
        unsigned nloc = b.st[0], nx = b.st[1];
        if (nloc == 0u) { xcd_barrier_complete(bar, b.x, nloc, nx); b.st[0] = nloc; b.st[1] = nx; }
        const unsigned old = xb_add(&bar[XB_XSUB(b.x)], 1u);
        const unsigned gen = old / nloc;
        if (old + 1u == (gen + 1u) * nloc) {
            __builtin_amdgcn_fence(__ATOMIC_RELEASE, "agent");
            asm volatile("s_waitcnt vmcnt(0)" ::: "memory");
            const unsigned og = xb_add(&bar[XB_TOP], 1u);
            const unsigned tg = og / nx;
            if (og + 1u == (tg + 1u) * nx) xb_add(&bar[XB_TOPGEN], 1u);
            else XB_SPIN(xb_ld(&bar[XB_TOPGEN]) == tg, bar);
            __builtin_amdgcn_fence(__ATOMIC_ACQUIRE, "agent");
            xb_add(&bar[XB_XGEN(b.x)], 1u);
            asm volatile("s_waitcnt vmcnt(0)" ::: "memory");
        } else {
            XB_SPIN(xb_ld(&bar[XB_XGEN(b.x)]) == gen, bar);
            __builtin_amdgcn_fence(__ATOMIC_ACQUIRE, "agent");
            asm volatile("s_waitcnt vmcnt(0)" ::: "memory");
        }
    }
    __syncthreads();
}

__device__ __forceinline__ const float* xrow_in(int R, const float* xlat, const float* hctx) {
    const int b = R / RB, rr = R - b * RB;
    return rr < CTXL ? hctx + (size_t)(b * CTXL + rr) * DM : xlat + (size_t)(b * SEQ + rr - CTXL) * DM;
}
__device__ __forceinline__ float* xrow_out(int R, float* xlat, float* hctx) {
    const int b = R / RB, rr = R - b * RB;
    return rr < CTXL ? hctx + (size_t)(b * CTXL + rr) * DM : xlat + (size_t)(b * SEQ + rr - CTXL) * DM;
}
__device__ __forceinline__ int row_set(int R) { const int b = R / RB, rr = R - b * RB; return rr < CTXL ? 2 : b; }

__device__ __forceinline__ int qk_perm(int c) {
    const int bj = c >> 7, wc = (c >> 5) & 3, fq = (c >> 3) & 3, n = (c >> 2) & 1, j = c & 3;
    return 64 * wc + 32 * (fq >> 1) + 16 * bj + 8 * (fq & 1) + 4 * n + j;
}
struct EpiIn {
    static constexpr bool PERM = true;
    bf16* Z; bf16* ZT; bf16* ZTC; const float* ropec; const float* ropes; const float* qkg;
    __device__ __forceinline__ void operator()(const f32x4 (&acc)[2][2][4][2], const pg8::Unit& u, int wr, int wc, int fr, int fq) const {
        const int b = u.pm / TPB, jt = u.pm - b * TPB; const bool isctx = (jt == 0);
        if (u.pn == 0 || u.pn >= 8) {
#pragma unroll
            for (int ai = 0; ai < 2; ++ai)
#pragma unroll
                for (int m = 0; m < 4; ++m) { const int r = 128 * ai + 64 * wr + 16 * m + fr; bf16* rowp = Z + (size_t)(u.pm * 256 + r) * INW + u.pn * 256 + 32 * wc + 8 * fq;
#pragma unroll
                    for (int bj = 0; bj < 2; ++bj) { const f32x4 v0 = acc[ai][bj][m][0], v1 = acc[ai][bj][m][1];
                        v4u w; w.x = pg8::cvt_pk_bf16(v0[0], v0[1]); w.y = pg8::cvt_pk_bf16(v0[2], v0[3]); w.z = pg8::cvt_pk_bf16(v1[0], v1[1]); w.w = pg8::cvt_pk_bf16(v1[2], v1[3]);
                        *(v4u*)(rowp + bj * 128) = w; } }
        } else if (u.pn <= 3) {
            bf16* base = isctx ? ZTC + (size_t)b * 768 * CTXL : ZT + (size_t)b * 768 * SEQ + (size_t)(jt - 1) * 256;
            const size_t cstride = isctx ? CTXL : SEQ;
#pragma unroll
            for (int bj = 0; bj < 2; ++bj)
#pragma unroll
                for (int n = 0; n < 2; ++n)
#pragma unroll
                    for (int j = 0; j < 4; ++j) { const int ch = 256 * (u.pn - 1) + 128 * bj + 32 * wc + 8 * fq + 4 * n + j; bf16* cp = base + (size_t)ch * cstride;
#pragma unroll
                        for (int ai = 0; ai < 2; ++ai)
#pragma unroll
                            for (int m = 0; m < 4; ++m) { const int r = 128 * ai + 64 * wr + 16 * m + fr; cp[r] = (bf16)f2bf(acc[ai][bj][m][n][j]); } }
        } else {
            const int which = (u.pn >= 6) ? 1 : 0; const float osc = which ? 1.0f : C2;
            const int axis = fq >> 1, f0 = 8 * (fq & 1);
            float ga[2][4], gb[2][4];
#pragma unroll
            for (int n = 0; n < 2; ++n)
#pragma unroll
                for (int j = 0; j < 4; ++j) { ga[n][j] = qkg[which * 64 + 32 * axis + f0 + 4 * n + j]; gb[n][j] = qkg[which * 64 + 32 * axis + 16 + f0 + 4 * n + j]; }
#pragma unroll
            for (int ai = 0; ai < 2; ++ai)
#pragma unroll
                for (int m = 0; m < 4; ++m) {
                    const int r = 128 * ai + 64 * wr + 16 * m + fr;
                    float ss = 0.f;
#pragma unroll
                    for (int bj = 0; bj < 2; ++bj)
#pragma unroll
                        for (int n = 0; n < 2; ++n) { const f32x4 x = acc[ai][bj][m][n]; ss += (x[0] * x[0] + x[1] * x[1]) + (x[2] * x[2] + x[3] * x[3]); }
                    ss += xor16_f(ss); ss = sum32_f(ss);
                    const float rinv = __builtin_amdgcn_rsqf(ss * (1.0f / 64.0f) + 1e-6f);
                    f32x4 cv[2], sv[2];
                    if (!isctx) { const int t = (jt - 1) * 256 + r; const int pos = axis ? (t & 63) : (t >> 6);
                        cv[0] = *(const f32x4*)(ropec + pos * 16 + f0); cv[1] = *(const f32x4*)(ropec + pos * 16 + f0 + 4);
                        sv[0] = *(const f32x4*)(ropes + pos * 16 + f0); sv[1] = *(const f32x4*)(ropes + pos * 16 + f0 + 4); }
                    else { cv[0] = cv[1] = (f32x4){1.f, 1.f, 1.f, 1.f}; sv[0] = sv[1] = (f32x4){0.f, 0.f, 0.f, 0.f}; }
                    float oa[8], ob[8];
#pragma unroll
                    for (int n = 0; n < 2; ++n)
#pragma unroll
                        for (int j = 0; j < 4; ++j) { const float a = acc[ai][0][m][n][j] * rinv * ga[n][j], bb = acc[ai][1][m][n][j] * rinv * gb[n][j];
                            oa[4 * n + j] = (a * cv[n][j] - bb * sv[n][j]) * osc; ob[4 * n + j] = (bb * cv[n][j] + a * sv[n][j]) * osc; }
                    bf16* rowp = Z + (size_t)(u.pm * 256 + r) * INW + u.pn * 256 + 64 * wc + 32 * axis + f0;
                    v4u w; w.x = pg8::cvt_pk_bf16(oa[0], oa[1]); w.y = pg8::cvt_pk_bf16(oa[2], oa[3]); w.z = pg8::cvt_pk_bf16(oa[4], oa[5]); w.w = pg8::cvt_pk_bf16(oa[6], oa[7]);
                    *(v4u*)(rowp) = w;
                    w.x = pg8::cvt_pk_bf16(ob[0], ob[1]); w.y = pg8::cvt_pk_bf16(ob[2], ob[3]); w.z = pg8::cvt_pk_bf16(ob[4], ob[5]); w.w = pg8::cvt_pk_bf16(ob[6], ob[7]);
                    *(v4u*)(rowp + 16) = w;
                }
        }
    }
};
struct EpiRes {
    static constexpr bool PERM = false;
    const float* xin; float* xout; float* hctx; const float* gate; int ntk_full; float* slab; float gsc;
    __device__ __forceinline__ void operator()(const f32x4 (&acc)[2][2][4][2], const pg8::Unit& u, int wr, int wc, int fr, int fq) const {
        const int b = u.pm / TPB, jt = u.pm - b * TPB; const bool isctx = (jt == 0); const int set = isctx ? 2 : b;
        const int col0 = u.pn * 256 + wc * 32 + 4 * fq;
        f32x4 gv[2][2];
#pragma unroll
        for (int bj = 0; bj < 2; ++bj)
#pragma unroll
            for (int n = 0; n < 2; ++n) gv[bj][n] = *(const f32x4*)(gate + set * 6144 + col0 + bj * 128 + n * 16) * gsc;
        const unsigned long long coff = (unsigned long long)(b * CTXL) * DM * 4, loff = (unsigned long long)(b * SEQ + (jt - 1) * 256) * DM * 4;
        const unsigned long long ia = isctx ? (unsigned long long)hctx + coff : (unsigned long long)xin + loff, oa = isctx ? (unsigned long long)hctx + coff : (unsigned long long)xout + loff;
        const GAS char* ib = (const GAS char*)ia; GAS char* ob = (GAS char*)oa;
        const unsigned lo = (unsigned)((64 * wr + fr) * DM + col0) * 4u;
        if (u.nt == ntk_full) {
#pragma unroll
            for (int ai = 0; ai < 2; ++ai)
#pragma unroll
                for (int m = 0; m < 4; ++m) { const unsigned off = lo + (unsigned)(128 * ai + 16 * m) * DM * 4u;
#pragma unroll
                    for (int bj = 0; bj < 2; ++bj)
#pragma unroll
                        for (int n = 0; n < 2; ++n) { const f32x4 xi = *(const GAS f32x4*)(ib + off + (bj * 128 + n * 16) * 4); *(GAS f32x4*)(ob + off + (bj * 128 + n * 16) * 4) = xi + gv[bj][n] * acc[ai][bj][m][n]; }
                    if (m == 3) asm volatile("" ::: "memory"); }
        } else {
            int fr_ = fr; asm volatile("" : "+v"(fr_));
            GAS float* sp = (GAS float*)(slab + (size_t)u.sl * 65536) + (unsigned)((64 * wr + fr_) * 256 + wc * 32 + 4 * fq);
#pragma unroll
            for (int ai = 0; ai < 2; ++ai)
#pragma unroll
                for (int m = 0; m < 4; ++m)
#pragma unroll
                    for (int bj = 0; bj < 2; ++bj)
#pragma unroll
                        for (int n = 0; n < 2; ++n) *(GAS f32x4*)(sp + (128 * ai + 16 * m) * 256 + bj * 128 + n * 16) = gv[bj][n] * acc[ai][bj][m][n];
        }
    }
};
__device__ __forceinline__ float silu_mul(float g, float u) { return g * u * __builtin_amdgcn_rcpf(1.0f + __builtin_amdgcn_exp2f(-1.4426950408889634f * g)); }
struct EpiGlu {
    static constexpr bool PERM = true;
    bf16* H; int ldh; int NT;
    __device__ __forceinline__ void operator()(const f32x4 (&acc)[2][2][4][2], const pg8::Unit& u, int wr, int wc, int fr, int fq) const {
        const int nt = u.pn % NT;
#pragma unroll
        for (int ai = 0; ai < 2; ++ai)
#pragma unroll
            for (int m = 0; m < 4; ++m) { const int r = 128 * ai + 64 * wr + 16 * m + fr; bf16* rowp = H + (size_t)(u.pm * 256 + r) * ldh + nt * 128 + 32 * wc + 8 * fq;
                float o[8];
#pragma unroll
                for (int n = 0; n < 2; ++n)
#pragma unroll
                    for (int j = 0; j < 4; ++j) o[4 * n + j] = silu_mul(acc[ai][0][m][n][j], acc[ai][1][m][n][j]);
                v4u w; w.x = pg8::cvt_pk_bf16(o[0], o[1]); w.y = pg8::cvt_pk_bf16(o[2], o[3]); w.z = pg8::cvt_pk_bf16(o[4], o[5]); w.w = pg8::cvt_pk_bf16(o[6], o[7]);
                *(v4u*)rowp = w; }
    }
};
__device__ __forceinline__ void k_quarter(int ntk, int kq, int& ko, int& nt) {
    const int pairs = ntk >> 1; int start = 0, len = 0;
#pragma unroll
    for (int q = 0; q < 4; ++q) { const int l = (pairs + 3 - q) >> 2; if (q < kq) start += l; if (q == kq) len = l; }
    ko = start * 128; nt = len * 2;
}
struct SplitTailOrder {
    pg8::StaticOrder S; int nN, nmain;
    __device__ __forceinline__ void init(int N, int K, int G, int c) { S.init(NB * SEQ, N, K, G, c); nN = N / 256; nmain = (NB * SEQ / 256) * nN; }
    __device__ __forceinline__ bool next(int i, pg8::Unit& u) const {
        const long L = (long)i * S.G + S.c;
        if (L < nmain) { S.map(L, u); u.pm += 1 + (u.pm >= SEQ / 256 ? 1 : 0); return true; }
        const int Lt = (int)(L - nmain); if (Lt >= 2 * nN * 4) return false;
        const int kq = Lt & 3, r = Lt >> 2; u.pn = r % nN; u.pm = (r / nN) * TPB; k_quarter(S.ntk, kq, u.ko, u.nt); u.sl = ((r / nN) * 4 + u.pn) * 4 + kq; return true;
    }
    __device__ __forceinline__ void a_ready(const pg8::Unit&) const {}
    __device__ __forceinline__ void done(const pg8::Unit&) const {}
};
struct MoeOrder {
    int G, c, NT, tlo, nunits; const LAS int* tab; int ntk;
    __device__ __forceinline__ bool next(int i, pg8::Unit& u) const {
        const int L = i * G + c; if (L >= nunits) return false;
        const int tau = tlo + L / NT, nt = L - (L / NT) * NT;
        int s = 0;
#pragma unroll
        for (int q = 1; q < 16; ++q) s += (tab[q] <= tau) ? 1 : 0;
        u.pm = tau; u.pn = (s & 7) * NT + nt; u.ko = 0; u.nt = ntk; u.sl = -1; return true;
    }
    __device__ __forceinline__ void a_ready(const pg8::Unit&) const {}
    __device__ __forceinline__ void done(const pg8::Unit&) const {}
};
struct MoeDownOrder {
    int G, c, k, nmain, ntailu; const LAS int* tab;
    __device__ __forceinline__ void init(int G_, int c_, int k_, const LAS int* tab_) { G = G_; c = c_; k = k_; tab = tab_; nmain = (tab[64 + 8 * k + 8] - tab[64 + 8 * k]) * 4; ntailu = tab[112 + k] * 16; }
    __device__ __forceinline__ bool next(int i, pg8::Unit& u) const {
        const int L = i * G + c;
        if (L < nmain) { const int mu = tab[64 + 8 * k] + (L >> 2); int s = 0;
#pragma unroll
            for (int q = 1; q < 16; ++q) s += (tab[64 + q] <= mu) ? 1 : 0;
            u.pm = tab[s] + (mu - tab[64 + s]); u.pn = (s & 7) * 4 + (L & 3); u.ko = 0; u.nt = DFE / 64; u.sl = -1; return true; }
        const int Lt = L - nmain; if (Lt >= ntailu) return false;
        const int s = tab[96 + 8 * k + (Lt >> 4)]; u.pm = tab[s + 1] - 1; u.pn = (s & 7) * 4 + ((Lt >> 2) & 3); k_quarter(DFE / 64, Lt & 3, u.ko, u.nt); u.sl = 8 * 16 * k + Lt; return true;
    }
    __device__ __forceinline__ void a_ready(const pg8::Unit&) const {}
    __device__ __forceinline__ void done(const pg8::Unit&) const {}
};
struct EpiMoeDown {
    static constexpr bool PERM = false;
    float* xlat; float* hctx; const float* gate; const int* rtok; const float* rgate; const LAS int* tab; float* slab; float gsc;
    __device__ __forceinline__ void operator()(const f32x4 (&acc)[2][2][4][2], const pg8::Unit& u, int wr, int wc, int fr, int fq) const {
        const int tau = u.pm; int s = 0;
#pragma unroll
        for (int q = 1; q < 16; ++q) s += (tab[q] <= tau) ? 1 : 0;
        const int idx0 = (tau - tab[s]) * 256, cnt = tab[32 + s];
        const int col0 = (u.pn & 3) * 256 + wc * 32 + 4 * fq;
        const bool full = (u.nt == DFE / 64);
        if (full) {
            int Rr[8]; float gt[8]; bool ok[8];
#pragma unroll
            for (int q = 0; q < 8; ++q) { const int idx = idx0 + 128 * (q >> 2) + 64 * wr + 16 * (q & 3) + fr; ok[q] = idx < cnt; const int ic = ok[q] ? idx : idx0;
                Rr[q] = rtok[(size_t)s * SEGCAP + ic]; gt[q] = rgate[(size_t)s * SEGCAP + ic] * gsc; }
#pragma unroll
            for (int rp = 0; rp < 4; ++rp) {
                f32x4 gv[2][2][2], xi[2][2][2]; float* xp[2];
#pragma unroll
                for (int j = 0; j < 2; ++j) { const int q = 2 * rp + j; xp[j] = xrow_out(Rr[q], xlat, hctx) + col0; const float* gp = gate + row_set(Rr[q]) * 6144 + col0;
#pragma unroll
                    for (int bj = 0; bj < 2; ++bj)
#pragma unroll
                        for (int n = 0; n < 2; ++n) { gv[j][bj][n] = *(const f32x4*)(gp + bj * 128 + n * 16); xi[j][bj][n] = *(const f32x4*)(xp[j] + bj * 128 + n * 16); } }
#pragma unroll
                for (int j = 0; j < 2; ++j) { const int q = 2 * rp + j;
                    if (ok[q]) {
#pragma unroll
                        for (int bj = 0; bj < 2; ++bj)
#pragma unroll
                            for (int n = 0; n < 2; ++n) *(f32x4*)(xp[j] + bj * 128 + n * 16) = xi[j][bj][n] + gv[j][bj][n] * gt[q] * acc[q >> 2][bj][q & 3][n]; } }
            }
        } else {
#pragma unroll
        for (int ai = 0; ai < 2; ++ai)
#pragma unroll
            for (int m = 0; m < 4; ++m) { const int idx = idx0 + 128 * ai + 64 * wr + 16 * m + fr;
                if (idx < cnt) { const int R = rtok[(size_t)s * SEGCAP + idx]; const float gt = rgate[(size_t)s * SEGCAP + idx] * gsc;
                    const float* gp = gate + row_set(R) * 6144 + col0;
#pragma unroll
                    for (int bj = 0; bj < 2; ++bj)
#pragma unroll
                        for (int n = 0; n < 2; ++n) { const f32x4 gv = *(const f32x4*)(gp + bj * 128 + n * 16); const f32x4 v = gv * gt * acc[ai][bj][m][n];
                            int fr_ = fr; asm volatile("" : "+v"(fr_));
                            *(GAS f32x4*)((GAS char*)(slab + (size_t)u.sl * 65536) + (unsigned)(((128 * ai + 64 * wr + 16 * m + fr_) * 256 + wc * 32 + 4 * fq + bj * 128 + n * 16) * 4)) = v; } } }
        }
    }
};

__device__ __forceinline__ void transpose_item(const float* colp  , int ldw, int K, bf16* WT, int kb, int n0, int lane) {
    const int hh = lane >> 5, m = lane & 31, k0 = 64 * kb + 32 * hh;
    f32x4 v[32];
#pragma unroll
    for (int i = 0; i < 32; ++i) v[i] = *(const f32x4*)(colp + (size_t)(k0 + i) * ldw);
    bf16* dp = WT + (size_t)(n0 + 4 * m) * K + k0;
#pragma unroll
    for (int jj = 0; jj < 4; ++jj)
#pragma unroll
        for (int h8 = 0; h8 < 4; ++h8) { v4u o; o.x = pk2(v[8 * h8][jj], v[8 * h8 + 1][jj]); o.y = pk2(v[8 * h8 + 2][jj], v[8 * h8 + 3][jj]); o.z = pk2(v[8 * h8 + 4][jj], v[8 * h8 + 5][jj]); o.w = pk2(v[8 * h8 + 6][jj], v[8 * h8 + 7][jj]);
            *(v4u*)(dp + (size_t)jj * K + 8 * h8) = o; }
}
__device__ __forceinline__ int src_in_col(int nd) { const int t = nd >> 8, c = nd & 255; return (t >= 4 && t <= 7) ? (t * 256 + qk_perm(c)) : nd; }

struct Args { const float* in[32]; float* out; unsigned char* ws; int ph_lo, ph_hi; };
constexpr int PTAB_OFF = MISC_OFF + 1024;
__device__ __forceinline__ const float* inptr(LAS unsigned char* lds, int k) {
    const LAS unsigned* p = (const LAS unsigned*)(lds + PTAB_OFF) + 2 * k;
    const unsigned lo = (unsigned)__builtin_amdgcn_readfirstlane((int)p[0]), hi = (unsigned)__builtin_amdgcn_readfirstlane((int)p[1]);
    return (const float*)(const GAS float*)(((unsigned long long)hi << 32) | lo);
}
#define AIN(k) inptr(lds, (k))

__device__ __forceinline__ float block_sum(float v, LAS float* red, int wave, int lane) {
    v = wave_sum(v);
    if (lane == 0) red[wave] = v;
    __syncthreads();
    float s = 0.f;
#pragma unroll
    for (int w = 0; w < NWAVES; ++w) s += red[w];
    __syncthreads();
    return s;
}

__device__ __forceinline__ void phase_prep_a(const Args& a, int li, LAS unsigned char* lds, int G, int bx) {
    const int tid = fresh_tid(), lane = tid & 63, wave = __builtin_amdgcn_readfirstlane(tid >> 6);
    const int gw = bx * NWAVES + wave, NGW = G * NWAVES;
    unsigned char* ws = fresh_ptr(a.ws);
    const bool moe = (li & 1) != 0; const int lj = li >> 1;
    {
        bf16* win_t = (bf16*)(ws + WS_WIN); bf16* wout_t = (bf16*)(ws + WS_WOUT); bf16* wup_t = (bf16*)(ws + WS_WUP); bf16* wdn_t = (bf16*)(ws + WS_WDN);
        const float* w_in = AIN(8) + (size_t)li * DM * INW; const float* w_out = AIN(9) + (size_t)li * DM * DM;
        constexpr int I_IN = 16 * 20, I_OUT = 16 * 8, I_UPD = 16 * 44, I_DND = 44 * 8, I_UPE = 16 * 56, I_DNE = 56 * 8;
        const int NIT = moe ? (I_IN + I_OUT + NEXP * (I_UPE + I_DNE)) : (I_IN + I_OUT + I_UPD + I_DND);
        const int m4 = 4 * (lane & 31);
        for (int it = gw; it < NIT; it += NGW) {
            int r = it;
            if (r < I_IN) { const int nb = r % 20; transpose_item(w_in + src_in_col(128 * nb + m4), INW, DM, win_t, r / 20, 128 * nb, lane); continue; } r -= I_IN;
            if (r < I_OUT) { const int nb = r % 8; transpose_item(w_out + 128 * nb + m4, DM, DM, wout_t, r / 8, 128 * nb, lane); continue; } r -= I_OUT;
            if (!moe) {
                if (r < I_UPD) { const int nb = r % 44; const float* W = (nb & 1) ? AIN(26) : AIN(25);
                    transpose_item(W + (size_t)lj * DM * DFF + (nb >> 1) * 128 + m4, DFF, DM, wup_t, r / 44, 128 * nb, lane); continue; } r -= I_UPD;
                { const int nb = r % 8; transpose_item(AIN(27) + (size_t)lj * DFF * DM + 128 * nb + m4, DM, DFF, wdn_t, r / 8, 128 * nb, lane); }
            } else {
                if (r < NEXP * I_UPE) { const int e = r / I_UPE, r2 = r % I_UPE, nb = r2 % 56; const size_t wo = (size_t)(lj * NEXP + e) * DM * DFE;
                    const float* W = (nb & 1) ? AIN(30) : AIN(29);
                    transpose_item(W + wo + (nb >> 1) * 128 + m4, DFE, DM, wup_t + (size_t)e * 2 * DFE * DM, r2 / 56, 128 * nb, lane); continue; } r -= NEXP * I_UPE;
                const int e = r / I_DNE, r2 = r % I_DNE, nb = r2 % 8;
                transpose_item(AIN(31) + (size_t)(lj * NEXP + e) * DFE * DM + 128 * nb + m4, DM, DFE, wdn_t + (size_t)e * DM * DFE, r2 / 8, 128 * nb, lane);
            }
        }
    }
    if (li == 0) for (int l = 0; l < DEPTH; ++l) {
        const float* w1 = AIN(14) + l * 33 * 64; const float* w2 = AIN(17) + l * 64 * 64;
        const float bb1 = AIN(15)[l * 64 + lane], ff1 = AIN(16)[l * 64 + lane], bb2 = AIN(18)[l * 64 + lane], ff2 = AIN(19)[l * 64 + lane];
        float w1c[33], w2c[64];
#pragma unroll
        for (int q = 0; q < 33; ++q) w1c[q] = w1[q * 64 + lane];
#pragma unroll
        for (int q = 0; q < 64; ++q) w2c[q] = w2[q * 64 + lane];
        bf16* H2B = (bf16*)(ws + WS_H2B) + (size_t)l * (SEQ + CTXL) * 64;
        for (int tt = gw; tt < SEQ + CTXL; tt += NGW) {
            const int L = tt < SEQ ? SEQ : CTXL, t = tt < SEQ ? tt : tt - SEQ;
            float feat = 0.f;
            if (lane == 0) feat = (float)t / (float)(L - 1);
            else if (lane <= 32) { const int jb = (lane - 1) & 15; const float rev = (float)((jb * t) & (L - 1)) / (float)L + 1e-4f * (1.0f - (float)jb * (1.0f / 15.0f)) * (float)t / (float)L;
                feat = lane <= 16 ? __builtin_amdgcn_cosf(__builtin_amdgcn_fractf(rev)) : -__builtin_amdgcn_sinf(__builtin_amdgcn_fractf(rev)); }
            float z1 = 0.f;
#pragma unroll
            for (int q = 0; q < 33; ++q) z1 += __builtin_bit_cast(float, __builtin_amdgcn_readlane(__builtin_bit_cast(int, feat), q)) * w1c[q];
            const float h1 = sin_rad(ff1 * (z1 + bb1));
            float z2 = 0.f;
#pragma unroll
            for (int q = 0; q < 64; ++q) z2 += __builtin_bit_cast(float, __builtin_amdgcn_readlane(__builtin_bit_cast(int, h1), q)) * w2c[q];
            H2B[(size_t)tt * 64 + lane] = (bf16)f2bf(sin_rad(ff2 * (z2 + bb2)));
        }
    }
    if (li == 0) {
        __syncthreads();
        LAS float* sv = (LAS float*)lds;
        for (int idx = tid; idx < 3 * DM; idx += NTHR) { const int s = idx >> 10, k = idx & 1023; const float v = s < 2 ? AIN(1)[s * DM + k] : AIN(3)[k];
            sv[idx] = v * __builtin_amdgcn_rcpf(1.0f + __builtin_amdgcn_exp2f(-1.4426950408889634f * v)); }
        __syncthreads();
        float* MODP = (float*)(ws + WS_MODP);
        for (int it = bx; it < 4 * 8 * 12; it += G) {
            const int l = it / 96, q = (it / 12) & 7, jc = it % 12, j = jc * 512 + tid;
            const float* wp = AIN(4) + ((size_t)l * DM + q * 128) * 6144 + j;
            float a0 = 0.f, a1 = 0.f, a2 = 0.f;
#pragma unroll 8
            for (int k = 0; k < 128; ++k) { const float w = wp[(size_t)k * 6144]; a0 += sv[q * 128 + k] * w; a1 += sv[DM + q * 128 + k] * w; a2 += sv[2 * DM + q * 128 + k] * w; }
            float* dp = MODP + (size_t)((q * 4 + l) * 3) * 6144 + j;
            dp[0] = a0; dp[6144] = a1; dp[2 * 6144] = a2;
        }
        const int gid = bx * NTHR + tid;
        if (gid < 4096) { const int pos = gid >> 4, f = gid & 15; const float inv = __builtin_amdgcn_exp2f(-(float)f * 0.83048202372184059f);
            const float rev = (float)pos * inv * 0.15915494309189535f; float* RT = (float*)(ws + WS_ROPE);
            RT[gid] = __builtin_amdgcn_cosf(__builtin_amdgcn_fractf(rev)); RT[4096 + gid] = __builtin_amdgcn_sinf(__builtin_amdgcn_fractf(rev)); }
        const f32x4* cs = (const f32x4*)AIN(2); f32x4* cd = (f32x4*)(ws + WS_HCTX);
        for (int idx = gid; idx < NB * CTXL * DM / 4; idx += G * NTHR) cd[idx] = cs[idx];
        __syncthreads();
    }
}

__device__ __forceinline__ int fidx(int i) { return i + (i >> 7); }
__device__ __forceinline__ void fft4_index(int b, int q, int& i, int& j) {
    if (q >= 64) { j = b & (q - 1); i = ((b & ~(q - 1)) << 2) + j; }
    else { const int rr = b & 127, qq = b >> 7; j = qq & (q - 1); i = rr * 128 + ((qq & ~(q - 1)) << 2) + j; }
}
__device__ __forceinline__ f32x2 cmulf(f32x2 a, f32x2 w) { return (f32x2){a.x * w.x - a.y * w.y, a.x * w.y + a.y * w.x}; }
__device__ __forceinline__ void fft4_pass_fwd(LAS f32x2* X, int tid, int p) {
    const int h = 8192 >> (2 * p), q = h >> 1; const float inv2h = 0.5f / (float)h;
#pragma unroll 2
    for (int r = 0; r < 8; ++r) { int i, j; fft4_index(tid + NTHR * r, q, i, j);
        const float ang = (float)j * inv2h; const f32x2 w1 = {__builtin_amdgcn_cosf(ang), -__builtin_amdgcn_sinf(ang)}; const f32x2 w2 = cmulf(w1, w1);
        const int i0 = fidx(i), i1 = fidx(i + q), i2 = fidx(i + 2 * q), i3 = fidx(i + 3 * q);
        const f32x2 x0 = X[i0], x1 = X[i1], x2 = X[i2], x3 = X[i3];
        const f32x2 a0 = x0 + x2, a1 = x1 + x3, d02 = cmulf(x0 - x2, w1), t13 = cmulf(x1 - x3, w1); const f32x2 d13 = {t13.y, -t13.x};
        X[i0] = a0 + a1; X[i1] = cmulf(a0 - a1, w2); X[i2] = d02 + d13; X[i3] = cmulf(d02 - d13, w2); }
    __syncthreads();
}
__device__ __forceinline__ void fft4_pass_inv(LAS f32x2* X, int tid, int p) {
    const int h = 8192 >> (2 * p), q = h >> 1; const float inv2h = 0.5f / (float)h;
#pragma unroll 2
    for (int r = 0; r < 8; ++r) { int i, j; fft4_index(tid + NTHR * r, q, i, j);
        const float ang = (float)j * inv2h; const f32x2 w1 = {__builtin_amdgcn_cosf(ang), __builtin_amdgcn_sinf(ang)}; const f32x2 w2 = cmulf(w1, w1);
        const int i0 = fidx(i), i1 = fidx(i + q), i2 = fidx(i + 2 * q), i3 = fidx(i + 3 * q);
        const f32x2 b0 = X[i0], b1 = X[i1], b2 = X[i2], b3 = X[i3];
        const f32x2 t1 = cmulf(b1, w2), t3 = cmulf(b3, w2); const f32x2 a0 = b0 + t1, a1 = b0 - t1, a2 = b2 + t3, a3 = b2 - t3;
        const f32x2 u2 = cmulf(a2, w1), v3 = cmulf(a3, w1); const f32x2 u3 = {-v3.y, v3.x};
        X[i0] = a0 + u2; X[i2] = a0 - u2; X[i1] = a1 + u3; X[i3] = a1 - u3; }
    __syncthreads();
}
__device__ __forceinline__ void fft16_index(int g, int q, int& i0, int& j0) {
    const int qp = q >> 2;
    if (qp >= 64) { j0 = g & (qp - 1); i0 = ((g & ~(qp - 1)) << 4) + j0; }
    else { const int rr = g & 127, gq = g >> 7; j0 = gq & (qp - 1); i0 = rr * 128 + ((gq & ~(qp - 1)) << 4) + j0; }
}
__device__ __forceinline__ void bfly_fwd(f32x2& x0, f32x2& x1, f32x2& x2, f32x2& x3, f32x2 w1, f32x2 w2) {
    const f32x2 a0 = x0 + x2, a1 = x1 + x3, d02 = cmulf(x0 - x2, w1), t13 = cmulf(x1 - x3, w1); const f32x2 d13 = {t13.y, -t13.x};
    x0 = a0 + a1; x1 = cmulf(a0 - a1, w2); x2 = d02 + d13; x3 = cmulf(d02 - d13, w2);
}
__device__ __forceinline__ void bfly_inv(f32x2& b0, f32x2& b1, f32x2& b2, f32x2& b3, f32x2 w1, f32x2 w2) {
    const f32x2 t1 = cmulf(b1, w2), t3 = cmulf(b3, w2); const f32x2 a0 = b0 + t1, a1 = b0 - t1, a2 = b2 + t3, a3 = b2 - t3;
    const f32x2 u2 = cmulf(a2, w1), v3 = cmulf(a3, w1); const f32x2 u3 = {-v3.y, v3.x};
    b0 = a0 + u2; b2 = a0 - u2; b1 = a1 + u3; b3 = a1 - u3;
}
template <bool INV, int P> __device__ __forceinline__ void fft16_pass(LAS f32x2* X, int tid) {
    constexpr int h = 8192 >> (2 * P), q = h >> 1, qp = q >> 2; constexpr float inv2h = 0.5f / (float)h;
    constexpr float sg = INV ? 1.0f : -1.0f;
#pragma unroll 1
    for (int r = 0; r < 2; ++r) { int i0, j0; fft16_index(tid + NTHR * r, q, i0, j0);
        const float ang = (float)j0 * inv2h; const f32x2 w10 = {__builtin_amdgcn_cosf(ang), sg * __builtin_amdgcn_sinf(ang)};
        f32x2 v[4][4];
#pragma unroll
        for (int a = 0; a < 4; ++a)
#pragma unroll
            for (int b = 0; b < 4; ++b) v[a][b] = X[fidx(i0 + a * q + b * qp)];
        const f32x2 w20 = cmulf(w10, w10), w1p = cmulf(w20, w20), w2p = cmulf(w1p, w1p);
        float k1 = 0.92387953251128674f, k2 = 0.38268343236508977f, k3 = 0.70710678118654752f;
        asm volatile("" : "+v"(k1), "+v"(k2), "+v"(k3));
        const f32x2 c1 = {k1, sg * k2}, c2 = {k3, sg * k3}, c3 = {k2, sg * k1};
        const f32x2 w1b[4] = {w10, cmulf(w10, c1), cmulf(w10, c2), cmulf(w10, c3)};
        if (!INV) {
#pragma unroll
            for (int b = 0; b < 4; ++b) bfly_fwd(v[0][b], v[1][b], v[2][b], v[3][b], w1b[b], cmulf(w1b[b], w1b[b]));
#pragma unroll
            for (int a = 0; a < 4; ++a) bfly_fwd(v[a][0], v[a][1], v[a][2], v[a][3], w1p, w2p);
        } else {
#pragma unroll
            for (int a = 0; a < 4; ++a) bfly_inv(v[a][0], v[a][1], v[a][2], v[a][3], w1p, w2p);
#pragma unroll
            for (int b = 0; b < 4; ++b) bfly_inv(v[0][b], v[1][b], v[2][b], v[3][b], w1b[b], cmulf(w1b[b], w1b[b]));
        }
#pragma unroll
        for (int a = 0; a < 4; ++a)
#pragma unroll
            for (int b = 0; b < 4; ++b) X[fidx(i0 + a * q + b * qp)] = v[a][b]; }
    __syncthreads();
}
__device__ __forceinline__ void fft_fwd(LAS f32x2* X, int tid) {
    fft16_pass<false, 0>(X, tid); fft16_pass<false, 2>(X, tid); fft16_pass<false, 4>(X, tid); fft4_pass_fwd(X, tid, 6);
}
__device__ __forceinline__ void fft_inv(LAS f32x2* X, int tid) {
    fft4_pass_inv(X, tid, 6); fft16_pass<true, 4>(X, tid); fft16_pass<true, 2>(X, tid); fft16_pass<true, 0>(X, tid);
}
__device__ __forceinline__ int brev14(int k) { return (int)(__builtin_bitreverse32((unsigned)k) >> 18); }
__device__ __forceinline__ void pair_slots(int r, int& j, int& jp, int& k, bool& ev) {
    if (r == 0) { j = 0; jp = 0; k = 0; ev = true; return; }
    if (r == 8192) { j = 1; jp = 1; k = 8192; ev = true; return; }
    const int hb = 31 - __builtin_clz((unsigned)r), base = 2 << hb; j = base + (r - (1 << hb)); jp = 3 * base - 1 - j; ev = (j & 1) == 0; k = brev14(ev ? j : jp);
}
constexpr int FFT_AUX = 133120;

__device__ __forceinline__ void phase_prep_b(const Args& a, int li, LAS unsigned char* lds, int G, int bx) {
    const int tid = fresh_tid(), lane = tid & 63, wave = __builtin_amdgcn_readfirstlane(tid >> 6);
    unsigned char* ws = fresh_ptr(a.ws);
    if (li == 0) {
        const float* MODP = (const float*)(ws + WS_MODP); float* MOD = (float*)(ws + WS_MOD);
        for (int idx = bx * NTHR + tid; idx < 4 * 3 * 6144; idx += G * NTHR) { const int l = idx / 18432, j = idx % 6144; float s = AIN(5)[l * 6144 + j];
#pragma unroll
            for (int q = 0; q < 8; ++q) s += MODP[(size_t)q * 73728 + idx];
            MOD[idx] = s; }
    }
    LAS f32x2* X = (LAS f32x2*)lds; LAS float* Xf = (LAS float*)lds;
    LAS float* w3c = (LAS float*)(lds + FFT_AUX); LAS float* red = w3c + 128; LAS float* kc = (LAS float*)(lds + FFT_AUX + 1024);
    const bf16* H2 = (const bf16*)(ws + WS_H2B) + (size_t)li * (SEQ + CTXL) * 64; const bf16* H2C = H2 + (size_t)SEQ * 64;
    const float* w3 = AIN(20) + (size_t)li * 64 * 512;
    const float min_decay = 3.0701134573253945f, max_decay = 15.350567286626973f;
    const bool coop = (G == 256);
    const int xg = bx & 7, mi = bx >> 3;
    float* FT = (float*)(ws + WS_Z) + (size_t)xg * 64 * SEQ;
    if (coop) {
        const int r16 = lane & 15, g4 = lane >> 4, t0 = 512 * mi + 64 * wave;
        bf16x8 wf[4][2], hf[4][2];
#pragma unroll
        for (int blk = 0; blk < 4; ++blk)
#pragma unroll
            for (int ks = 0; ks < 2; ++ks) hf[blk][ks] = *(const bf16x8*)(H2 + (size_t)(t0 + 16 * blk + r16) * 64 + 8 * g4 + 32 * ks);
#pragma unroll
        for (int tau = 0; tau < 4; ++tau)
#pragma unroll
            for (int ks = 0; ks < 2; ++ks) { v4u w; const int o = 16 * tau + r16, col = (o & 1) * 256 + 32 * xg + (o >> 1);
#pragma unroll
                for (int j2 = 0; j2 < 4; ++j2) { const int kk = 32 * ks + 8 * g4 + 2 * j2; w[j2] = pk2(w3[kk * 512 + col], w3[(kk + 1) * 512 + col]); }
                wf[tau][ks] = __builtin_bit_cast(bf16x8, w); }
#pragma unroll
        for (int tau = 0; tau < 4; ++tau)
#pragma unroll
            for (int blk = 0; blk < 4; ++blk) { f32x4 acc = {0.f, 0.f, 0.f, 0.f};
#pragma unroll
                for (int ks = 0; ks < 2; ++ks) acc = __builtin_amdgcn_mfma_f32_16x16x32_bf16(hf[blk][ks], wf[tau][ks], acc, 0, 0, 0);
                *(f32x4*)(FT + (size_t)(16 * tau + r16) * SEQ + t0 + 16 * blk + 4 * g4) = acc; }
        asm volatile("s_waitcnt vmcnt(0)" ::: "memory");
        __syncthreads();
        if (tid == 0) { unsigned* cnt = (unsigned*)(ws + WS_CTL) + CW_MOECNT + li * 8 + xg;
            __builtin_amdgcn_fence(__ATOMIC_RELEASE, "agent"); (void)xb_add(cnt, 1u);
            unsigned sp = 0; while (xb_ld(cnt) < 32u) { __builtin_amdgcn_s_sleep(1); if (++sp > (1u << 22)) break; }
            __builtin_amdgcn_fence(__ATOMIC_ACQUIRE, "agent"); }
        __syncthreads();
    }
    for (int c0 = bx; c0 < 256; c0 += G) { const int c = G == 256 ? (((c0 & 7) << 5) | (c0 >> 3)) : c0;
        if (tid < 128) w3c[tid] = w3[(tid & 63) * 512 + (tid >> 6) * 256 + c];
        __syncthreads();
        const float delta = min_decay + (float)c * ((max_decay - min_decay) / 255.0f);
        float asum = 0.f;
        if (coop) {
            const float* ff = FT + (size_t)(2 * mi) * SEQ; const float* fb = ff + SEQ;
#pragma unroll 8
            for (int r = 0; r < 32; ++r) { const int t = tid + NTHR * r;
                float df = ff[t], db = fb[t];
                const float dec = __builtin_amdgcn_exp2f(-1.4426950408889634f * delta * ((float)t * (1.0f / 16383.0f)));
                df *= dec; db *= dec;
                Xf[2 * fidx(t >> 1) + (t & 1)] = df; asum += __builtin_fabsf(df);
                if (t >= 1) { const int n = 32768 - t; Xf[2 * fidx(n >> 1) + (n & 1)] = db; asum += __builtin_fabsf(db); } }
        } else
        {
            const int r16 = lane & 15, g4 = lane >> 4;
            bf16x8 af[4][2];
#pragma unroll
            for (int i = 0; i < 4; ++i)
#pragma unroll
                for (int ks = 0; ks < 2; ++ks) { v4u w;
#pragma unroll
                    for (int j2 = 0; j2 < 4; ++j2) { const int kk = 32 * ks + 8 * g4 + 2 * j2;
                        const float lo = r16 == 4 * i ? w3c[kk] : (r16 == 4 * i + 1 ? w3c[64 + kk] : 0.f), hi = r16 == 4 * i ? w3c[kk + 1] : (r16 == 4 * i + 1 ? w3c[64 + kk + 1] : 0.f);
                        w[j2] = pk2(lo, hi); }
                    af[i][ks] = __builtin_bit_cast(bf16x8, w); }
#pragma unroll 2
            for (int r = 0; r < 32; ++r) { const int t = tid + NTHR * r, t0 = t - lane;
                f32x4 acc = {0.f, 0.f, 0.f, 0.f};
#pragma unroll
                for (int i = 0; i < 4; ++i)
#pragma unroll
                    for (int ks = 0; ks < 2; ++ks) { const bf16x8 hb8 = *(const bf16x8*)(H2 + (size_t)(t0 + 16 * i + r16) * 64 + 8 * g4 + 32 * ks);
                        acc = __builtin_amdgcn_mfma_f32_16x16x32_bf16(af[i][ks], hb8, acc, 0, 0, 0); }
                float df = acc[0], db = acc[1];
                const float dec = __builtin_amdgcn_exp2f(-1.4426950408889634f * delta * ((float)t * (1.0f / 16383.0f)));
                df *= dec; db *= dec;
                Xf[2 * fidx(t >> 1) + (t & 1)] = df; asum += __builtin_fabsf(df);
                if (t >= 1) { const int n = 32768 - t; Xf[2 * fidx(n >> 1) + (n & 1)] = db; asum += __builtin_fabsf(db); } }
        }
        if (tid == 0) Xf[2 * fidx(8192)] = 0.f;
        const float S1 = block_sum(asum, red, wave, lane);
        fft_fwd(X, tid);
        const float scale = 1.0f / (S1 * 16384.0f);
        f32x4* HF = (f32x4*)(ws + WS_HF) + (size_t)c * 8193;
        for (int r = tid; r <= 8192; r += NTHR) {
            int j, jp, k; bool ev; pair_slots(r, j, jp, k, ev);
            const f32x2 P = X[fidx(j)], Q = X[fidx(jp)]; const f32x2 A = ev ? P : Q, B = ev ? Q : P; f32x4 o;
            if (k == 0) o = (f32x4){A.x + A.y, 0.f, A.x - A.y, 0.f};
            else { const float Ex = 0.5f * (A.x + B.x), Ey = 0.5f * (A.y - B.y), Ox = 0.5f * (A.y + B.y), Oy = -0.5f * (A.x - B.x);
                const float ang = (float)k * (1.0f / 32768.0f), wc = __builtin_amdgcn_cosf(ang), wsn = -__builtin_amdgcn_sinf(ang);
                const float px = Ox * wc - Oy * wsn, py = Ox * wsn + Oy * wc;
                o = (f32x4){Ex + px, Ey + py, Ex - px, -(Ey - py)}; }
            HF[r] = o * scale; }
        __syncthreads();
        float as2 = 0.f;
        if (tid < CTXL) { const int t = tid; const v4u* hr = (const v4u*)(H2C + (size_t)t * 64); float df = 0.f, db = 0.f;
#pragma unroll
            for (int q = 0; q < 8; ++q) { const v4u hw = hr[q];
#pragma unroll
                for (int e = 0; e < 4; ++e) { const float h0 = __builtin_bit_cast(float, hw[e] << 16), h1 = __builtin_bit_cast(float, hw[e] & 0xffff0000u);
                    df += h0 * w3c[8 * q + 2 * e] + h1 * w3c[8 * q + 2 * e + 1]; db += h0 * w3c[64 + 8 * q + 2 * e] + h1 * w3c[64 + 8 * q + 2 * e + 1]; } }
            const float dec = __builtin_amdgcn_exp2f(-1.4426950408889634f * delta * ((float)t * (1.0f / 255.0f)));
            df *= dec; db *= dec; kc[t] = df; as2 += __builtin_fabsf(df);
            if (t >= 1) { kc[512 - t] = db; as2 += __builtin_fabsf(db); } else kc[256] = 0.f; }
        const float S2 = block_sum(as2, red, wave, lane);
        ((float*)(ws + WS_KCTX))[(size_t)c * 512 + tid] = kc[tid] / S2;
        __syncthreads();
    }
}

__device__ __forceinline__ void norm_load(const float* xr, int lane, f32x4 (&v)[4]) {
    const f32x4* xp = (const f32x4*)xr + lane;
#pragma unroll
    for (int j = 0; j < 4; ++j) v[j] = xp[64 * j];
}
__device__ __forceinline__ void norm_finish(f32x4 (&v)[4], const float* xr, const float* modl, int set, int which, const f32x4 (&g)[4], int lane, bf16* dst, f32x4 (&o)[4], const float* pend = nullptr) {
    float ss = 0.f;
#pragma unroll
    for (int j = 0; j < 4; ++j) {
        if (pend) { const f32x4* pp = (const f32x4*)(pend + (size_t)j * 4 * 65536) + lane; v[j] = (((v[j] + pp[0]) + pp[16384]) + pp[2 * 16384]) + pp[3 * 16384]; ((f32x4*)xr)[lane + 64 * j] = v[j]; }
        ss += (v[j].x * v[j].x + v[j].y * v[j].y) + (v[j].z * v[j].z + v[j].w * v[j].w); }
    const float rinv = __builtin_amdgcn_rsqf(wave_sum(ss) * (1.0f / DM) + 1e-6f);
    const f32x4* sh = (const f32x4*)(modl + set * 6144 + which * DM) + lane; const f32x4* sc = (const f32x4*)(modl + set * 6144 + (which + 1) * DM) + lane;
    v2u* dp = (v2u*)dst + lane;
#pragma unroll
    for (int j = 0; j < 4; ++j) { const f32x4 y = v[j] * rinv * g[j]; o[j] = y * (sc[64 * j] + 1.0f) + sh[64 * j];
        v2u w; w.x = pk2(o[j].x, o[j].y); w.y = pk2(o[j].z, o[j].w); dp[64 * j] = w; }
}
__device__ __forceinline__ const float* ctx_pending(const Args& a, int R) {
    const int b = R / RB, rr = R - b * RB; return rr < CTXL ? (const float*)(fresh_ptr(a.ws) + WS_SLAB) + (size_t)b * 16 * 65536 + rr * 256 : nullptr; }
__device__ __forceinline__ void norm_finish_lds(f32x4 (&v)[4], const float* xr, const LAS f32x4* mt, int set, const f32x4 (&g)[4], int lane, bf16* dst, const float* pend) {
    float ss = 0.f;
#pragma unroll
    for (int j = 0; j < 4; ++j) {
        if (pend) { const f32x4* pp = (const f32x4*)(pend + (size_t)j * 4 * 65536) + lane; v[j] = (((v[j] + pp[0]) + pp[16384]) + pp[2 * 16384]) + pp[3 * 16384]; ((f32x4*)xr)[lane + 64 * j] = v[j]; }
        ss += (v[j].x * v[j].x + v[j].y * v[j].y) + (v[j].z * v[j].z + v[j].w * v[j].w); }
    const float rinv = __builtin_amdgcn_rsqf(wave_sum(ss) * (1.0f / DM) + 1e-6f);
    const LAS f32x4* sh = mt + set * 512 + lane; const LAS f32x4* sc = sh + 256;
    v2u* dp = (v2u*)dst + lane;
#pragma unroll
    for (int j = 0; j < 4; ++j) { const f32x4 y = v[j] * rinv * g[j]; const f32x4 o = y * (sc[64 * j] + 1.0f) + sh[64 * j];
        v2u w; w.x = pk2(o.x, o.y); w.y = pk2(o.z, o.w); dp[64 * j] = w; }
}
__device__ __forceinline__ void phase_norm(const Args& a, int li, int which  , const float* xlat, LAS unsigned char* lds, int G, int bx) {
    const int tid = fresh_tid(), lane = tid & 63, wave = __builtin_amdgcn_readfirstlane(tid >> 6);
    const int gw = bx * NWAVES + wave, NGW = G * NWAVES;
    unsigned char* ws = fresh_ptr(a.ws); const float* modl = (const float*)(ws + WS_MOD) + (size_t)li * 3 * 6144; const float* hctx = (const float*)(ws + WS_HCTX);
    const float* gsrc = (which == 0 ? AIN(6) : AIN(7)) + li * DM; bf16* XN = (bf16*)(ws + WS_XN);
    LAS f32x4* mt = (LAS f32x4*)lds;
    __syncthreads();
    for (int idx = tid; idx < 3 * 512; idx += NTHR) { const int set = idx >> 9, rem = idx & 511; mt[idx] = ((const f32x4*)(modl + set * 6144 + which * DM))[rem]; }
    f32x4 g[4];
#pragma unroll
    for (int j = 0; j < 4; ++j) g[j] = ((const f32x4*)gsrc)[lane + 64 * j];
    __syncthreads();
    const bool pending = (which == 3) || (li & 1);
    constexpr int NR = 9;
    for (int R = gw; R < MROWS; R += NR * NGW) {
        f32x4 v[NR][4]; const float* xr[NR]; int Rq[NR];
#pragma unroll
        for (int q = 0; q < NR; ++q) { Rq[q] = R + q * NGW; xr[q] = xrow_in(Rq[q] < MROWS ? Rq[q] : R, xlat, hctx); norm_load(xr[q], lane, v[q]); }
#pragma unroll
        for (int q = 0; q < NR; ++q) if (Rq[q] < MROWS) norm_finish_lds(v[q], xr[q], mt, row_set(Rq[q]), g, lane, XN + (size_t)Rq[q] * DM, pending ? ctx_pending(a, Rq[q]) : nullptr); }
    __syncthreads();
}
__device__ __forceinline__ void phase_norm_router(const Args& a, int li, const float* xlat, LAS unsigned char* lds, int G, int bx) {
    const int tid = fresh_tid(), lane = tid & 63, wave = __builtin_amdgcn_readfirstlane(tid >> 6);
    unsigned char* ws = fresh_ptr(a.ws); const float* modl = (const float*)(ws + WS_MOD) + (size_t)li * 3 * 6144; const float* hctx = (const float*)(ws + WS_HCTX);
    const float* gsrc = AIN(7) + li * DM; bf16* XN = (bf16*)(ws + WS_XN); const int lj = li >> 1;
    const float* rw = AIN(28) + (size_t)lj * DM * NEXP;
    LAS float* rwT = (LAS float*)lds;
    LAS int* re = (LAS int*)(lds + 32768);
    LAS float* rg = (LAS float*)(lds + 32768 + 2048);
    LAS int* lcnt = (LAS int*)(lds + 32768 + 4096);
    for (int idx = tid; idx < DM * NEXP; idx += NTHR) rwT[(idx & 7) * DM + (idx >> 3)] = rw[idx];
    LAS f32x4* mt = (LAS f32x4*)(lds + 40960);
    for (int idx = tid; idx < 3 * 512; idx += NTHR) { const int set = idx >> 9, rem = idx & 511; mt[idx] = ((const f32x4*)(modl + set * 6144 + 3 * DM))[rem]; }
    if (tid < 32) lcnt[tid] = 0;
    __syncthreads();
    const int RPB = (MROWS + G - 1) / G, R0 = bx * RPB; int nrows = MROWS - R0; nrows = nrows > RPB ? RPB : nrows; nrows = nrows < 0 ? 0 : nrows;
    f32x4 g[4];
#pragma unroll
    for (int j = 0; j < 4; ++j) g[j] = ((const f32x4*)gsrc)[lane + 64 * j];
    f32x4 vnext[4];
    if (wave < nrows) norm_load(xrow_in(R0 + wave, xlat, hctx), lane, vnext);
    for (int i = wave; i < nrows; i += NWAVES) { const int R = R0 + i; f32x4 o[4], v[4];
#pragma unroll
        for (int j = 0; j < 4; ++j) v[j] = vnext[j];
        if (i + NWAVES < nrows) norm_load(xrow_in(R + NWAVES, xlat, hctx), lane, vnext);
        { const float* xr = xrow_in(R, xlat, hctx); const float* pend = ctx_pending(a, R); const int set = row_set(R); float ss = 0.f;
#pragma unroll
          for (int j = 0; j < 4; ++j) {
              if (pend) { const f32x4* pp = (const f32x4*)(pend + (size_t)j * 4 * 65536) + lane; v[j] = (((v[j] + pp[0]) + pp[16384]) + pp[2 * 16384]) + pp[3 * 16384]; ((f32x4*)xr)[lane + 64 * j] = v[j]; }
              ss += (v[j].x * v[j].x + v[j].y * v[j].y) + (v[j].z * v[j].z + v[j].w * v[j].w); }
          const float rinv = __builtin_amdgcn_rsqf(wave_sum(ss) * (1.0f / DM) + 1e-6f);
          const LAS f32x4* sh = mt + set * 512 + lane; const LAS f32x4* sc = sh + 256; v2u* dp = (v2u*)(XN + (size_t)R * DM) + lane;
#pragma unroll
          for (int j = 0; j < 4; ++j) { const f32x4 y = v[j] * rinv * g[j]; o[j] = y * (sc[64 * j] + 1.0f) + sh[64 * j];
              v2u w; w.x = pk2(o[j].x, o[j].y); w.y = pk2(o[j].z, o[j].w); dp[64 * j] = w; } }
        float lg[8];
#pragma unroll
        for (int e = 0; e < 8; ++e) { float s = 0.f;
#pragma unroll
            for (int j = 0; j < 4; ++j) { const f32x4 w = *(const LAS f32x4*)(rwT + e * DM + 4 * lane + 256 * j); s += (o[j].x * w.x + o[j].y * w.y) + (o[j].z * w.z + o[j].w * w.w); }
            lg[e] = wave_sum(s); }
        int e0 = 0; float v0 = lg[0];
#pragma unroll
        for (int e = 1; e < 8; ++e) if (lg[e] > v0) { v0 = lg[e]; e0 = e; }
        int e1 = -1; float v1 = -3.0e38f;
#pragma unroll
        for (int e = 0; e < 8; ++e) if (e != e0 && lg[e] > v1) { v1 = lg[e]; e1 = e; }
        if (lane == 0) { re[i] = e0 | (e1 << 8); rg[i] = 1.0f / (1.0f + __expf(v1 - v0)); }
    }
    __syncthreads();
    if (tid < nrows) { const int w = re[tid], e0 = w & 255, e1 = w >> 8; int r0 = 0, r1 = 0;
#pragma unroll 8
        for (int j = 0; j < nrows; ++j) { const int wj = re[j]; r0 += (j < tid && (wj & 255) == e0) ? 1 : 0; r1 += (j < tid && (wj >> 8) == e1) ? 1 : 0; }
        ((int*)(ws + WS_RREC))[R0 + tid] = e0 | (e1 << 4) | (r0 << 8) | (r1 << 20); ((float*)(ws + WS_RRECG))[R0 + tid] = rg[tid]; }
    if (tid < 16) { int c = 0;
#pragma unroll 8
        for (int j = 0; j < nrows; ++j) { const int wj = re[j]; c += ((tid < 8 ? (wj & 255) : (wj >> 8)) == (tid & 7)) ? 1 : 0; }
        ((int*)(ws + WS_CNTB))[bx * 16 + tid] = c; }
    __syncthreads();
}
__device__ __forceinline__ void moe_tables(const Args& a, int lj, LAS unsigned char* lds, int G, int bx) {
    LAS int* tab = (LAS int*)(lds + TAB_OFF); const int tid = fresh_tid(); const int* cntb = (const int*)(fresh_ptr(a.ws) + WS_CNTB);
    if (tid < 16) { tab[32 + tid] = 0; tab[116 + tid] = 0; }
    __syncthreads();
    { const int sg = tid & 15; int c = 0, below = 0;
        for (int b = tid >> 4; b < G; b += NTHR / 16) { const int v = cntb[b * 16 + sg]; c += v; below += b < bx ? v : 0; }
        atomicAdd((int*)(tab + 32 + sg), c); atomicAdd((int*)(tab + 116 + sg), below); }
    __syncthreads();
    if (tid == 0) { int tb = 0, tm = 0, n0 = 0, n1 = 0;
        for (int s = 0; s < 16; ++s) { const int c = tab[32 + s]; const int nt = (c + 255) >> 8;
            tab[s] = tb; tab[64 + s] = tm; tb += nt; tm += nt > 0 ? nt - 1 : 0;
            if (nt > 0) { if (s < 8) tab[96 + n0++] = s; else tab[104 + n1++] = s; } }
        tab[16] = tb; tab[80] = tm; tab[112] = n0; tab[113] = n1; }
    __syncthreads();
    (void)lj;
}
__device__ __forceinline__ void phase_moe_gather(const Args& a, int li, LAS unsigned char* lds, int G, int bx) {
    const int tid = fresh_tid(), lane = tid & 63, wave = __builtin_amdgcn_readfirstlane(tid >> 6);
    moe_tables(a, li >> 1, lds, G, bx);
    const LAS int* tab = (const LAS int*)(lds + TAB_OFF);
    unsigned char* ws = fresh_ptr(a.ws);
    int* rtok = (int*)(ws + WS_RTOK); float* rgate = (float*)(ws + WS_RGATE); const int* rec = (const int*)(ws + WS_RREC); const float* recg = (const float*)(ws + WS_RRECG);
    const bf16* XN = (const bf16*)(ws + WS_XN); bf16* AG = (bf16*)(ws + WS_AG);
    const int RPB = (MROWS + G - 1) / G, R0 = bx * RPB; int nrows = MROWS - R0; nrows = nrows > RPB ? RPB : nrows; nrows = nrows < 0 ? 0 : nrows;
    for (int it0 = wave; it0 < 2 * nrows; it0 += 4 * NWAVES) {
        int Rr[4], sg[4], ix[4]; float gg[4]; bool ok[4]; v4u x0[4], x1[4];
#pragma unroll
        for (int u = 0; u < 4; ++u) { const int it = it0 + u * NWAVES; ok[u] = it < 2 * nrows; const int itc = ok[u] ? it : it0; const int k = itc & 1; Rr[u] = R0 + (itc >> 1);
            const int w = rec[Rr[u]]; const float g0 = recg[Rr[u]];
            const int e = k ? ((w >> 4) & 15) : (w & 15), rk = k ? (w >> 20) : ((w >> 8) & 4095); sg[u] = k * 8 + e; ix[u] = tab[116 + sg[u]] + rk; gg[u] = k ? 1.0f - g0 : g0; }
#pragma unroll
        for (int u = 0; u < 4; ++u) { const v4u* sp = (const v4u*)(XN + (size_t)Rr[u] * DM) + lane; x0[u] = sp[0]; x1[u] = sp[64]; }
#pragma unroll
        for (int u = 0; u < 4; ++u) if (ok[u]) {
            if (lane == 0) { rtok[(size_t)sg[u] * SEGCAP + ix[u]] = Rr[u]; rgate[(size_t)sg[u] * SEGCAP + ix[u]] = gg[u]; }
            v4u* dp = (v4u*)(AG + ((size_t)tab[sg[u]] * 256 + ix[u]) * DM) + lane; dp[0] = x0[u]; dp[64] = x1[u]; }
    }
}
__device__ __forceinline__ void phase_moe_fix(const Args& a, int li, int k, LAS unsigned char* lds, int G, int bx) {
    const int tid = fresh_tid(), lane = tid & 63, wave = __builtin_amdgcn_readfirstlane(tid >> 6);
    const int gw = bx * NWAVES + wave, NGW = G * NWAVES;
    moe_tables(a, li >> 1, lds, G, bx);
    const LAS int* tab = (const LAS int*)(lds + TAB_OFF);
    const int nt = tab[112 + k]; const int* rtok = (const int*)(fresh_ptr(a.ws) + WS_RTOK); const float* slab = (const float*)(fresh_ptr(a.ws) + WS_SLAB);
    float* hctx = (float*)(fresh_ptr(a.ws) + WS_HCTX);
    for (int it = gw; it < nt * 256; it += NGW) { const int jl = it >> 8, r = it & 255, s = tab[96 + 8 * k + jl];
        const int idx = (tab[s + 1] - 1 - tab[s]) * 256 + r; if (idx >= tab[32 + s]) continue;
        const int R = rtok[(size_t)s * SEGCAP + idx]; f32x4* xp = (f32x4*)xrow_out(R, a.out, hctx) + lane;
        const f32x4* sp = (const f32x4*)(slab + (size_t)((k * 8 + jl) * 16) * 65536 + r * 256) + lane;
#pragma unroll
        for (int j = 0; j < 4; ++j) { const f32x4* pp = sp + (size_t)j * 4 * 16384; xp[64 * j] = (((xp[64 * j] + pp[0]) + pp[16384]) + pp[2 * 16384]) + pp[3 * 16384]; } }
}

constexpr int PL_ZT = 0, PL_DT = 40960, PL_LIN = 74752;
__device__ __forceinline__ void pool_load_lin(const Args& a, int li, LAS unsigned char* lds) {
    LAS bf16* linT = (LAS bf16*)(lds + PL_LIN); const float* src = AIN(10) + (size_t)li * 4 * 64 * 64;
    for (int idx = fresh_tid(); idx < 4 * 4096; idx += NTHR) { const int g = idx >> 12, c = (idx >> 6) & 63, e = idx & 63; linT[(g * 64 + e) * 72 + c] = (bf16)f2bf(src[idx]); }
    __syncthreads();
}
__device__ __forceinline__ void pool_unit(const Args& a, int li, int p, LAS unsigned char* lds) {
    const int tid = fresh_tid(), lane = tid & 63, r32 = lane & 31, hi = lane >> 5, wave = __builtin_amdgcn_readfirstlane(tid >> 6);
    const bf16* Z = (const bf16*)(fresh_ptr(a.ws) + WS_Z); bf16* Y = (bf16*)(fresh_ptr(a.ws) + WS_Y);
    const int b = p >> 8, t0 = (p & 255) * 64, rowbase = b * RB + CTXL;
    LAS bf16* zt = (LAS bf16*)(lds + PL_ZT); LAS bf16* dt = (LAS bf16*)(lds + PL_DT); const LAS bf16* linT = (const LAS bf16*)(lds + PL_LIN);
    for (int idx = tid; idx < 80 * 32; idx += NTHR) { const int row = idx >> 5, ch8 = idx & 31, t = t0 - 8 + row; v4u w = {0u, 0u, 0u, 0u};
        if (t >= 0 && t < SEQ) w = *(const v4u*)(Z + (size_t)(rowbase + t) * INW + ch8 * 8);
        *(LAS v4u*)(zt + row * 256 + ch8 * 8) = w; }
    __syncthreads();
    { const int ch = tid & 255, th = tid >> 8, hw = 1 << (ch >> 6), tb = t0 + 32 * th; const LAS bf16* zc = zt + ch;
        float s = 0.f;
        for (int q = -hw; q < hw; ++q) s += bf2f(zc[(32 * th + 8 + q) * 256]);
#pragma unroll 4
        for (int tt = 0; tt < 32; ++tt) { const int t = tb + tt, rel = 32 * th + tt + 8; int lo = t - hw; lo = lo < 0 ? 0 : lo; int hq = t + hw; hq = hq > SEQ ? SEQ : hq;
            dt[(32 * th + tt) * 264 + ch] = (bf16)f2bf(s * __builtin_amdgcn_rcpf((float)(hq - lo)) - bf2f(zc[rel * 256]));
            s += bf2f(zc[(rel + hw) * 256]) - bf2f(zc[(rel - hw) * 256]); } }
    __syncthreads();
    { const int g = wave >> 1, th = wave & 1;
        bf16x8 bfr[4], afr[2][4];
#pragma unroll
        for (int ks = 0; ks < 4; ++ks) { bfr[ks] = *(const LAS bf16x8*)(dt + (32 * th + r32) * 264 + g * 64 + 16 * ks + 8 * hi);
#pragma unroll
            for (int mt = 0; mt < 2; ++mt) afr[mt][ks] = *(const LAS bf16x8*)(linT + (g * 64 + 32 * mt + r32) * 72 + 16 * ks + 8 * hi); }
        f32x16 acc[2];
#pragma unroll
        for (int mt = 0; mt < 2; ++mt) {
#pragma unroll
            for (int r = 0; r < 16; ++r) acc[mt][r] = 0.f;
#pragma unroll
            for (int ks = 0; ks < 4; ++ks) acc[mt] = __builtin_amdgcn_mfma_f32_32x32x16_bf16(afr[mt][ks], bfr[ks], acc[mt], 0, 0, 0); }
        const float* ps = AIN(11) + li * 256 + g * 64;
        bf16* yp = Y + (size_t)(rowbase + t0 + 32 * th + r32) * DM + g * 64;
#pragma unroll
        for (int mt = 0; mt < 2; ++mt)
#pragma unroll
            for (int rq = 0; rq < 4; ++rq) { const int e0 = 32 * mt + 8 * rq + 4 * hi; const f32x4 sc = *(const f32x4*)(ps + e0);
                v2u w; w.x = pk2(acc[mt][4 * rq] * sc.x, acc[mt][4 * rq + 1] * sc.y); w.y = pk2(acc[mt][4 * rq + 2] * sc.z, acc[mt][4 * rq + 3] * sc.w);
                *(v2u*)(yp + e0) = w; }
    }
    __syncthreads();
}
__device__ __forceinline__ void pool_ctx_pair(const Args& a, int li, int cp, LAS unsigned char* lds) {
    const int tid = fresh_tid();
    const bf16* Z = (const bf16*)(fresh_ptr(a.ws) + WS_Z); bf16* Y = (bf16*)(fresh_ptr(a.ws) + WS_Y);
    LAS float* dm = (LAS float*)(lds + PL_ZT);
    const int ct = 2 * cp + (tid >> 8), b = ct >> 8, t = ct & 255, ch = tid & 255, hw = 1 << (ch >> 6), rowbase = b * RB;
    int lo = t - hw; lo = lo < 0 ? 0 : lo; int hq = t + hw; hq = hq > CTXL ? CTXL : hq; float s = 0.f;
    for (int q = lo; q < hq; ++q) s += bf2f(Z[(size_t)(rowbase + q) * INW + ch]);
    dm[tid] = s / (float)(hq - lo) - bf2f(Z[(size_t)(rowbase + t) * INW + ch]);
    __syncthreads();
    { const int g = ch >> 6, eo = ch & 63; const float* lin = AIN(10) + (size_t)li * 4 * 64 * 64 + g * 4096 + eo; const LAS float* dr = dm + (tid >> 8) * 256 + g * 64; float acc = 0.f;
#pragma unroll 8
        for (int c = 0; c < 64; ++c) acc += dr[c] * lin[c * 64];
        Y[(size_t)(rowbase + t) * DM + ch] = (bf16)f2bf(acc * AIN(11)[li * 256 + ch]); }
    __syncthreads();
}

__device__ __forceinline__ void sconv2(const bf16* zr, int t0, int L, float w0, float w1, float w2, float sb, float& y0, float& y1) {
    const unsigned pr = *(const unsigned*)(zr + t0); const float z0 = __builtin_bit_cast(float, pr << 16), z1 = __builtin_bit_cast(float, pr & 0xffff0000u);
    const float zm = t0 > 0 ? bf2f(zr[t0 - 1]) : 0.f, zp = (t0 + 2 < L) ? bf2f(zr[t0 + 2]) : 0.f;
    y0 = sb + zm * w0 + z0 * w1 + z1 * w2; y1 = sb + z0 * w0 + z1 * w1 + zp * w2;
}
__device__ __forceinline__ void sconv8(const bf16* zr, int t0, int L, float w0, float w1, float w2, float sb, float (&y)[8]) {
    const v4u w = *(const v4u*)(zr + t0); float z[10];
    z[0] = t0 > 0 ? bf2f(zr[t0 - 1]) : 0.f; z[9] = (t0 + 8 < L) ? bf2f(zr[t0 + 8]) : 0.f;
#pragma unroll
    for (int e = 0; e < 4; ++e) { z[1 + 2 * e] = __builtin_bit_cast(float, w[e] << 16); z[2 + 2 * e] = __builtin_bit_cast(float, w[e] & 0xffff0000u); }
#pragma unroll
    for (int e = 0; e < 8; ++e) y[e] = sb + z[e] * w0 + z[e + 1] * w1 + z[e + 2] * w2;
}
__device__ __forceinline__ void hyena_unit(const Args& a, int li, int cp, int b, LAS unsigned char* lds) {
    const int tid = fresh_tid();
    unsigned char* ws = fresh_ptr(a.ws); const bf16* ZT = (const bf16*)(ws + WS_ZT); const bf16* ZTC = (const bf16*)(ws + WS_ZTC); bf16* Y = (bf16*)(ws + WS_Y);
    const float* sw = AIN(12) + (size_t)li * 3 * 768; const float* sbp = AIN(13) + (size_t)li * 768;
    LAS f32x2* X = (LAS f32x2*)lds;
    float o0[4][8];
    for (int ch = 0; ch < 2; ++ch) {
        const int c = 2 * cp + ch; const float hb = AIN(21)[li * 256 + c];
        const float a0 = sw[c], a1 = sw[768 + c], a2 = sw[1536 + c], ab = sbp[c];
        const float b0 = sw[256 + c], b1 = sw[768 + 256 + c], b2 = sw[1536 + 256 + c], bb = sbp[256 + c];
        const float c0 = sw[512 + c], c1 = sw[768 + 512 + c], c2 = sw[1536 + 512 + c], cb = sbp[512 + c];
        const f32x4* HF = (const f32x4*)(ws + WS_HF) + (size_t)c * 8193;
        const bf16* px0 = ZT + (size_t)(b * 768 + c) * SEQ; const bf16* px1 = ZT + (size_t)(b * 768 + 256 + c) * SEQ; const bf16* pv = ZT + (size_t)(b * 768 + 512 + c) * SEQ;
        float u[4][8];
#pragma unroll
        for (int r = 0; r < 4; ++r) { const int m = tid + NTHR * r; float vv[8], gg[8];
            sconv8(pv, 8 * m, SEQ, c0, c1, c2, cb, vv); sconv8(px1, 8 * m, SEQ, b0, b1, b2, bb, gg);
#pragma unroll
            for (int e = 0; e < 8; ++e) u[r][e] = vv[e] * gg[e];
            const int i0 = fidx(4 * m), i1 = fidx(4 * m + 8192);
#pragma unroll
            for (int q = 0; q < 4; ++q) { X[i0 + q] = (f32x2){u[r][2 * q], u[r][2 * q + 1]}; X[i1 + q] = (f32x2){0.f, 0.f}; } }
        __syncthreads();
        fft_fwd(X, tid);
        for (int k0 = tid; k0 <= 8192; k0 += 4 * NTHR) {
            f32x4 Hq[4];
#pragma unroll
            for (int q = 0; q < 4; ++q) Hq[q] = HF[k0 + q * NTHR <= 8192 ? k0 + q * NTHR : k0];
#pragma unroll
            for (int q = 0; q < 4; ++q) { const int r = k0 + q * NTHR; if (r > 8192) break;
            int j, jp, k; bool ev; pair_slots(r, j, jp, k, ev);
            const int sj = fidx(j), sp = fidx(jp);
            const f32x2 P = X[sj], Q = X[sp]; const f32x2 A = ev ? P : Q, B = ev ? Q : P; const f32x4 H = Hq[q];
            if (k == 0) { const float Y0 = (A.x + A.y) * H.x, YN = (A.x - A.y) * H.z; X[sj] = (f32x2){0.5f * (Y0 + YN), 0.5f * (Y0 - YN)}; }
            else { const float Ex = 0.5f * (A.x + B.x), Ey = 0.5f * (A.y - B.y), Ox = 0.5f * (A.y + B.y), Oy = -0.5f * (A.x - B.x);
                const float ang = (float)k * (1.0f / 32768.0f), wc = __builtin_amdgcn_cosf(ang), wsn = -__builtin_amdgcn_sinf(ang);
                const float px = Ox * wc - Oy * wsn, py = Ox * wsn + Oy * wc;
                const float Xkx = Ex + px, Xky = Ey + py, Xnx = Ex - px, Xny = -(Ey - py);
                const float Ykx = Xkx * H.x - Xky * H.y, Yky = Xkx * H.y + Xky * H.x, Ynx = Xnx * H.z - Xny * H.w, Yny = Xnx * H.w + Xny * H.z;
                const float Epx = 0.5f * (Ykx + Ynx), Epy = 0.5f * (Yky - Yny), Dx = Ykx - Ynx, Dy = Yky + Yny;
                const float Opx = 0.5f * (Dx * wc + Dy * wsn), Opy = 0.5f * (Dy * wc - Dx * wsn);
                const f32x2 na = {Epx - Opy, Epy + Opx}, nb = {Epx + Opy, -Epy + Opx};
                X[sj] = ev ? na : nb;
                if (k != 8192) X[sp] = ev ? nb : na; } } }
        __syncthreads();
        fft_inv(X, tid);
#pragma unroll
        for (int r = 0; r < 4; ++r) { const int m = tid + NTHR * r; float xx[8];
            sconv8(px0, 8 * m, SEQ, a0, a1, a2, ab, xx);
            const int i0 = fidx(4 * m); const f32x2 y0 = X[i0], y1 = X[i0 + 1], y2 = X[i0 + 2], y3 = X[i0 + 3];
            const float yv[8] = {y0.x, y0.y, y1.x, y1.y, y2.x, y2.y, y3.x, y3.y};
            int m2 = m; asm volatile("" : "+v"(m2));
            bf16* yp = Y + (size_t)(b * RB + CTXL + 8 * m2) * DM + 256 + 2 * cp;
            if (ch == 0) {
#pragma unroll
                for (int e = 0; e < 8; ++e) o0[r][e] = (yv[e] + u[r][e] * hb) * xx[e]; }
            else {
#pragma unroll
                for (int e = 0; e < 8; ++e) *(unsigned*)(yp + (size_t)e * DM) = pk2(o0[r][e], (yv[e] + u[r][e] * hb) * xx[e]); } }
        __syncthreads();
    }
    {
        LAS float* kc = (LAS float*)lds; LAS float* uc = kc + 1024;
        const int ch = tid >> 8, c = 2 * cp + ch, t = tid & 255, te = t & ~1;
        kc[tid] = ((const float*)(ws + WS_KCTX))[(size_t)(2 * cp) * 512 + tid]; kc[512 + tid] = ((const float*)(ws + WS_KCTX))[(size_t)(2 * cp + 1) * 512 + tid];
        const float hb = AIN(21)[li * 256 + c];
        const float a0 = sw[c], a1 = sw[768 + c], a2 = sw[1536 + c], ab = sbp[c];
        const float b0 = sw[256 + c], b1 = sw[768 + 256 + c], b2 = sw[1536 + 256 + c], bb = sbp[256 + c];
        const float c0 = sw[512 + c], c1 = sw[768 + 512 + c], c2 = sw[1536 + 512 + c], cb = sbp[512 + c];
        const bf16* px0 = ZTC + (size_t)(b * 768 + c) * CTXL; const bf16* px1 = ZTC + (size_t)(b * 768 + 256 + c) * CTXL; const bf16* pv = ZTC + (size_t)(b * 768 + 512 + c) * CTXL;
        float v0, v1, g0, g1, x00, x01;
        sconv2(pv, te, CTXL, c0, c1, c2, cb, v0, v1); sconv2(px1, te, CTXL, b0, b1, b2, bb, g0, g1); sconv2(px0, te, CTXL, a0, a1, a2, ab, x00, x01);
        const float u = (t & 1) ? v1 * g1 : v0 * g0, x0v = (t & 1) ? x01 : x00;
        uc[tid] = u;
        __syncthreads();
        float y = 0.f;
#pragma unroll 8
        for (int s2 = 0; s2 < CTXL; ++s2) y += kc[ch * 512 + ((t - s2) & 511)] * uc[ch * 256 + s2];
        Y[(size_t)(b * RB + t) * DM + 256 + c] = (bf16)f2bf((y + u * hb) * x0v);
        __syncthreads();
    }
}

__device__ __forceinline__ void glds16(const void* gsrc, unsigned lds_dst) { unsigned keep;
    asm volatile("s_mov_b32 %0, m0\n\ts_mov_b32 m0, %2\n\ts_nop 0\n\tglobal_load_lds_dwordx4 %1, off\n\ts_mov_b32 m0, %0" : "=&s"(keep) : "v"(gsrc), "s"(lds_dst) : "memory"); }
__device__ __forceinline__ s16x4 vtr(const LAS unsigned char* p) { return __builtin_bit_cast(s16x4, __builtin_amdgcn_ds_read_tr16_b64_v4i16((LAS v4i16_t*)p)); }
typedef __bf16 bf16x2n __attribute__((ext_vector_type(2)));
__device__ __forceinline__ unsigned cvtpk_s(float lo, float hi) { f32x2 v = {lo, hi}; bf16x2n b = __builtin_convertvector(v, bf16x2n); return __builtin_bit_cast(unsigned, b); }
__device__ __forceinline__ int crow(int r, int hi) { return (r & 3) + 8 * (r >> 2) + 4 * hi; }
#define ATT_WAIT_BAR(N) asm volatile("s_waitcnt vmcnt(" #N ") lgkmcnt(0)\n\ts_barrier" ::: "memory")
constexpr int ATT_WS = 98304;
__device__ __forceinline__ void attn_unit(LAS unsigned char* lds, const bf16* Z, int qrow0, int krow0, int NT, int h, float negb, float lam, float oscale, const float* sg, bf16* Y) {
    const int tid = fresh_tid(), lane = tid & 63, r32 = lane & 31, hi = lane >> 5; const int wid = __builtin_amdgcn_readfirstlane(tid >> 6); const int mp = wid >> 2, wq = wid & 3;
    const unsigned lds0 = (unsigned)(uintptr_t)lds;
    const int dr = lane >> 4, dsl = lane & 15;
    const bf16* ks0 = Z + (size_t)(krow0 + 4 * wid + dr) * INW + K_OFF + h * 128 + (dsl ^ ((4 * wid + dr) & 15)) * 8;
    const bf16* vs0 = Z + (size_t)(krow0 + 4 * wid + dr) * INW + V_OFF + h * 128 + (dsl ^ (dr << 2)) * 8;
#define DMA_K(t) do { const size_t off_ = (size_t)(t) * 64 * INW; const unsigned sb_ = lds0 + (unsigned)((t) % 3) * 16384u + wid * 1024; \
        glds16(ks0 + off_, (unsigned)__builtin_amdgcn_readfirstlane(sb_)); glds16(ks0 + off_ + (size_t)32 * INW, (unsigned)__builtin_amdgcn_readfirstlane(sb_ + 8192)); } while (0)
#define DMA_V(t) do { const size_t off_ = (size_t)(t) * 64 * INW; const unsigned sb_ = lds0 + 49152u + (unsigned)((t) & 1) * 16384u + wid * 1024; \
        glds16(vs0 + off_, (unsigned)__builtin_amdgcn_readfirstlane(sb_)); glds16(vs0 + off_ + (size_t)32 * INW, (unsigned)__builtin_amdgcn_readfirstlane(sb_ + 8192)); } while (0)
    int kof[4], vof[4];
    { const int g1 = (lane >> 4) & 1, q = (lane & 15) >> 2, p = lane & 3;
#pragma unroll
        for (int d0 = 0; d0 < 4; ++d0) { kof[d0] = r32 * 256 + (((mp * 8 + 2 * d0 + hi) ^ (r32 & 15)) << 4);
            vof[d0] = 49152 + (4 * hi + q) * 256 + (((4 * d0 + 2 * g1 + (p >> 1)) ^ (q << 2)) << 4) + (p & 1) * 8; } }
    bf16x8 qr[4];
    { const bf16* qp = Z + (size_t)(qrow0 + wq * 32 + r32) * INW + Q_OFF + h * 128 + mp * 64 + hi * 8;
#pragma unroll
        for (int d0 = 0; d0 < 4; ++d0) qr[d0] = *(const bf16x8*)(qp + d0 * 16); }
    DMA_K(0); DMA_K(1);
    if (mp) __builtin_amdgcn_s_setprio(1);
    f32x16 o[4];
#pragma unroll
    for (int d0 = 0; d0 < 4; ++d0)
#pragma unroll
        for (int r = 0; r < 16; ++r) o[d0][r] = 0.f;
    const f32x16 zero16 = {0.f, 0.f, 0.f, 0.f, 0.f, 0.f, 0.f, 0.f, 0.f, 0.f, 0.f, 0.f, 0.f, 0.f, 0.f, 0.f};
    float l_reg = 0.f;
    v4u pw[4];
    (void)negb;
#define ATT_QK(P0, P1, t) do { const LAS unsigned char* kp_ = lds + ((t) % 3) * 16384; \
        { bf16x8 kf_[4]; _Pragma("unroll") for (int d0 = 0; d0 < 4; ++d0) kf_[d0] = *(const LAS bf16x8*)(kp_ + kof[d0]); \
          P0 = __builtin_amdgcn_mfma_f32_32x32x16_bf16(kf_[0], qr[0], zero16, 0, 0, 0); \
          _Pragma("unroll") for (int d0 = 1; d0 < 4; ++d0) P0 = __builtin_amdgcn_mfma_f32_32x32x16_bf16(kf_[d0], qr[d0], P0, 0, 0, 0); } \
        { bf16x8 kf_[4]; _Pragma("unroll") for (int d0 = 0; d0 < 4; ++d0) kf_[d0] = *(const LAS bf16x8*)(kp_ + kof[d0] + 8192); \
          P1 = __builtin_amdgcn_mfma_f32_32x32x16_bf16(kf_[0], qr[0], zero16, 0, 0, 0); \
          _Pragma("unroll") for (int d0 = 1; d0 < 4; ++d0) P1 = __builtin_amdgcn_mfma_f32_32x32x16_bf16(kf_[d0], qr[d0], P1, 0, 0, 0); } } while (0)
#define ATT_EXP(P0, P1) do { float sa_ = 0.f, sb_ = 0.f; \
        _Pragma("unroll") for (int r = 0; r < 16; ++r) { P0[r] = __builtin_amdgcn_exp2f(P0[r]); P1[r] = __builtin_amdgcn_exp2f(P1[r]); sa_ += P0[r]; sb_ += P1[r]; } \
        l_reg += sa_ + sb_; } while (0)
#define ATT_PACK(P0, P1) do { \
        _Pragma("unroll") for (int q = 0; q < 4; ++q) { pw[0][q] = cvtpk_s(P0[2 * q], P0[2 * q + 1]); pw[1][q] = cvtpk_s(P0[8 + 2 * q], P0[8 + 2 * q + 1]); \
            pw[2][q] = cvtpk_s(P1[2 * q], P1[2 * q + 1]); pw[3][q] = cvtpk_s(P1[8 + 2 * q], P1[8 + 2 * q + 1]); } } while (0)
#define VTR(dst, addr, off) dst = vtr((const LAS unsigned char*)(addr) + (off))
#define ATT_VLOAD(V, t, d0) do { const unsigned va_ = lds0 + (unsigned)((t) & 1) * 16384u + (unsigned)vof[d0]; \
        VTR(V[0], va_, 0); VTR(V[1], va_, 2048); VTR(V[2], va_, 4096); VTR(V[3], va_, 6144); VTR(V[4], va_, 8192); VTR(V[5], va_, 10240); VTR(V[6], va_, 12288); VTR(V[7], va_, 14336); } while (0)
#define ATT_LGKM(n) asm volatile("s_waitcnt lgkmcnt(" #n ")" ::: "memory")
#define VFR(V, ks) (bf16x8){V[2 * (ks)][0], V[2 * (ks)][1], V[2 * (ks)][2], V[2 * (ks)][3], V[2 * (ks) + 1][0], V[2 * (ks) + 1][1], V[2 * (ks) + 1][2], V[2 * (ks) + 1][3]}
#define ATT_PVX(V, d0, P, B) do { \
        _Pragma("unroll") for (int ks = 0; ks < 4; ++ks) { o[d0] = __builtin_amdgcn_mfma_f32_32x32x16_bf16(__builtin_bit_cast(bf16x8, pw[ks]), VFR(V, ks), o[d0], 0, 0, 0); \
            P[B + 2 * ks] = __builtin_amdgcn_exp2f(P[B + 2 * ks]); P[B + 2 * ks + 1] = __builtin_amdgcn_exp2f(P[B + 2 * ks + 1]); sa_ += P[B + 2 * ks]; sb_ += P[B + 2 * ks + 1]; } \
        _Pragma("unroll") for (int ks = 0; ks < 4; ++ks) { __builtin_amdgcn_sched_group_barrier(0x008, 1, 0); __builtin_amdgcn_sched_group_barrier(0x400, 2, 0); __builtin_amdgcn_sched_group_barrier(0x002, 2, 0); } \
        __builtin_amdgcn_sched_barrier(0); } while (0)
#define ATT_PVONLY(V, d0) do { _Pragma("unroll") for (int ks = 0; ks < 4; ++ks) o[d0] = __builtin_amdgcn_mfma_f32_32x32x16_bf16(__builtin_bit_cast(bf16x8, pw[ks]), VFR(V, ks), o[d0], 0, 0, 0); __builtin_amdgcn_sched_barrier(0); } while (0)
#define ATT_TOP(t) do { if ((t) + 1 < NT) ATT_WAIT_BAR(2); else ATT_WAIT_BAR(0); DMA_V(t); if ((t) + 2 < NT) DMA_K((t) + 2); } while (0)
    { f32x16 p0, p1;
        ATT_TOP(0); ATT_QK(p0, p1, 0); ATT_EXP(p0, p1); ATT_PACK(p0, p1); }
    s16x4 va[8], vb[8];
    for (int t = 1; t < NT; ++t) {
        f32x16 p0, p1; float sa_ = 0.f, sb_ = 0.f;
        ATT_TOP(t);
        ATT_VLOAD(va, t - 1, 0); __builtin_amdgcn_sched_barrier(0);
        ATT_QK(p0, p1, t); __builtin_amdgcn_sched_barrier(0);
        ATT_VLOAD(vb, t - 1, 1); ATT_LGKM(8); __builtin_amdgcn_sched_barrier(0);
        ATT_PVX(va, 0, p0, 0);
        ATT_VLOAD(va, t - 1, 2); ATT_LGKM(8); __builtin_amdgcn_sched_barrier(0);
        ATT_PVX(vb, 1, p0, 8);
        ATT_VLOAD(vb, t - 1, 3); ATT_LGKM(8); __builtin_amdgcn_sched_barrier(0);
        ATT_PVX(va, 2, p1, 0);
        ATT_LGKM(0); __builtin_amdgcn_sched_barrier(0);
        ATT_PVX(vb, 3, p1, 8);
        l_reg += sa_ + sb_;
        ATT_PACK(p0, p1); }
    ATT_WAIT_BAR(0);
    ATT_VLOAD(va, NT - 1, 0); ATT_VLOAD(vb, NT - 1, 1); ATT_LGKM(8); ATT_PVONLY(va, 0);
    ATT_VLOAD(va, NT - 1, 2); ATT_LGKM(8); ATT_PVONLY(vb, 1);
    ATT_VLOAD(vb, NT - 1, 3); ATT_LGKM(8); ATT_PVONLY(va, 2);
    ATT_LGKM(0); ATT_PVONLY(vb, 3);
#undef ATT_EXP
#undef VTR
#undef ATT_VLOAD
#undef ATT_LGKM
#undef VFR
#undef ATT_PVX
#undef ATT_PVONLY
#undef ATT_PACK
#undef ATT_TOP
#undef ATT_QK
#undef ATT_PV
#undef DMA_K
#undef DMA_V
    __builtin_amdgcn_s_setprio(0);
    { auto rr = __builtin_amdgcn_permlane32_swap(__float_as_uint(l_reg), __float_as_uint(l_reg), false, false); l_reg = __uint_as_float(rr[0]) + __uint_as_float(rr[1]); }
    LAS float* wsf = (LAS float*)(lds + ATT_WS) + wid * 64;
    if (hi == 0) wsf[r32] = l_reg;
    LDS_WAIT();
    float rl[16];
#pragma unroll
    for (int r = 0; r < 16; ++r) rl[r] = __builtin_amdgcn_rcpf(wsf[crow(r, hi)]) * (mp ? lam : 1.0f);
    ATT_WAIT_BAR(0);
    LAS float* stg = (LAS float*)lds + wq * (32 * 132);
    if (mp == 1) {
#pragma unroll
        for (int d0 = 0; d0 < 4; ++d0)
#pragma unroll
            for (int r = 0; r < 16; ++r) stg[crow(r, hi) * 132 + d0 * 32 + r32] = o[d0][r] * rl[r];
    }
    ATT_WAIT_BAR(0);
    if (mp == 0) {
#pragma unroll
        for (int d0 = 0; d0 < 4; ++d0)
#pragma unroll
            for (int r = 0; r < 16; ++r) { const int ix = crow(r, hi) * 132 + d0 * 32 + r32; stg[ix] = o[d0][r] * rl[r] - stg[ix]; }
        LDS_WAIT();
        const int q = lane >> 1, half = lane & 1; const LAS float* rp = stg + q * 132 + half * 64;
        f32x4 v[16]; float ss = 0.f;
#pragma unroll
        for (int i = 0; i < 16; ++i) { v[i] = *(const LAS f32x4*)(rp + 4 * i); ss += (v[i].x * v[i].x + v[i].y * v[i].y) + (v[i].z * v[i].z + v[i].w * v[i].w); }
        ss += xor1_f(ss);
        const float rinv = __builtin_amdgcn_rsqf(ss * (1.0f / 128.0f) + 1e-6f) * oscale;
        bf16* yp = Y + (size_t)(qrow0 + wq * 32 + q) * DM + 512 + h * 128 + half * 64;
        const f32x4* sgp = (const f32x4*)(sg + half * 64);
#pragma unroll
        for (int i = 0; i < 8; ++i) { const f32x4 a0 = v[2 * i] * sgp[2 * i] * rinv, a1 = v[2 * i + 1] * sgp[2 * i + 1] * rinv;
            v4u w; w.x = pk2(a0.x, a0.y); w.y = pk2(a0.z, a0.w); w.z = pk2(a1.x, a1.y); w.w = pk2(a1.z, a1.w); *(v4u*)(yp + 8 * i) = w; }
    }
    ATT_WAIT_BAR(0);
}

__device__ __forceinline__ void attn_unit16(LAS unsigned char* lds, const bf16* Z, int qrow0, int krow0, int NT, int h, float lam, float oscale, const float* sg, bf16* Y) {
    const int tid = fresh_tid(), lane = tid & 63, r16 = lane & 15, g = lane >> 4; const int wid = __builtin_amdgcn_readfirstlane(tid >> 6); const int mp = wid >> 2, wq = wid & 3;
    const unsigned lds0 = (unsigned)(uintptr_t)lds;
    const int dr = lane >> 4, dsl = lane & 15;
    const bf16* ks0 = Z + (size_t)(krow0 + 4 * wid + dr) * INW + K_OFF + h * 128 + (dsl ^ ((4 * wid + dr) & 15)) * 8;
    const bf16* vs0 = Z + (size_t)(krow0 + 4 * wid + dr) * INW + V_OFF + h * 128 + (dsl ^ (dr << 2) ^ ((wid & 1) << 1)) * 8;
#define DMA_K(t) do { const size_t off_ = (size_t)(t) * 64 * INW; const unsigned sb_ = lds0 + (unsigned)((t) % 3) * 16384u + wid * 1024; \
        glds16(ks0 + off_, (unsigned)__builtin_amdgcn_readfirstlane(sb_)); glds16(ks0 + off_ + (size_t)32 * INW, (unsigned)__builtin_amdgcn_readfirstlane(sb_ + 8192)); } while (0)
#define DMA_V(t) do { const size_t off_ = (size_t)(t) * 64 * INW; const unsigned sb_ = lds0 + 49152u + (unsigned)((t) & 1) * 16384u + wid * 1024; \
        glds16(vs0 + off_, (unsigned)__builtin_amdgcn_readfirstlane(sb_)); glds16(vs0 + off_ + (size_t)32 * INW, (unsigned)__builtin_amdgcn_readfirstlane(sb_ + 8192)); } while (0)
    int kof[2];
    kof[0] = r16 * 256 + (((mp * 8 + g) ^ r16) << 4); kof[1] = r16 * 256 + (((mp * 8 + 4 + g) ^ r16) << 4);
    const int q4 = r16 >> 2, pq = r16 & 3;
    const int vrow = 49152 + (4 * g + q4) * 256 + (pq & 1) * 8, vx = (q4 << 2) ^ ((g & 1) << 1) ^ (pq >> 1);
    bf16x8 qf[2][2];
    { const bf16* qp = Z + (size_t)(qrow0 + wq * 32 + r16) * INW + Q_OFF + h * 128 + mp * 64 + g * 8;
#pragma unroll
        for (int qb = 0; qb < 2; ++qb)
#pragma unroll
            for (int ks = 0; ks < 2; ++ks) qf[qb][ks] = *(const bf16x8*)(qp + (size_t)qb * 16 * INW + ks * 32); }
    DMA_K(0); DMA_K(1);
    if (mp) __builtin_amdgcn_s_setprio(1);
    f32x4 o[2][8];
#pragma unroll
    for (int qb = 0; qb < 2; ++qb)
#pragma unroll
        for (int db = 0; db < 8; ++db) o[qb][db] = (f32x4){0.f, 0.f, 0.f, 0.f};
    const f32x4 zero4 = {0.f, 0.f, 0.f, 0.f};
    float l0 = 0.f, l1 = 0.f;
    v4u pw[2][2];
    f32x4 S[4][2];
#define ATT_QK(t) do { const LAS unsigned char* kp_ = lds + ((t) % 3) * 16384; \
        _Pragma("unroll") for (int kh = 0; kh < 2; ++kh) { bf16x8 kf_[2][2]; \
            _Pragma("unroll") for (int kb = 0; kb < 2; ++kb) _Pragma("unroll") for (int ks = 0; ks < 2; ++ks) kf_[kb][ks] = *(const LAS bf16x8*)(kp_ + kof[ks] + (2 * kh + kb) * 4096); \
            _Pragma("unroll") for (int kb = 0; kb < 2; ++kb) _Pragma("unroll") for (int qb = 0; qb < 2; ++qb) { \
                S[2 * kh + kb][qb] = __builtin_amdgcn_mfma_f32_16x16x32_bf16(kf_[kb][0], qf[qb][0], zero4, 0, 0, 0); \
                S[2 * kh + kb][qb] = __builtin_amdgcn_mfma_f32_16x16x32_bf16(kf_[kb][1], qf[qb][1], S[2 * kh + kb][qb], 0, 0, 0); } } } while (0)
#define ATT_EXPB(kb) do { _Pragma("unroll") for (int r = 0; r < 4; ++r) { S[kb][0][r] = __builtin_amdgcn_exp2f(S[kb][0][r]); S[kb][1][r] = __builtin_amdgcn_exp2f(S[kb][1][r]); sa_ += S[kb][0][r]; sb_ += S[kb][1][r]; } } while (0)
#define ATT_PACK() do { _Pragma("unroll") for (int qb = 0; qb < 2; ++qb) _Pragma("unroll") for (int s_ = 0; s_ < 2; ++s_) { \
        pw[qb][s_][0] = cvtpk_s(S[2 * s_][qb][0], S[2 * s_][qb][1]); pw[qb][s_][1] = cvtpk_s(S[2 * s_][qb][2], S[2 * s_][qb][3]); \
        pw[qb][s_][2] = cvtpk_s(S[2 * s_ + 1][qb][0], S[2 * s_ + 1][qb][1]); pw[qb][s_][3] = cvtpk_s(S[2 * s_ + 1][qb][2], S[2 * s_ + 1][qb][3]); } } while (0)
#define ATT_VLOAD(V, t, dg) do { const LAS unsigned char* vp_ = lds + ((t) & 1) * 16384 + vrow; \
        _Pragma("unroll") for (int dbl = 0; dbl < 2; ++dbl) { const int va_ = ((2 * (2 * (dg) + dbl)) ^ vx) << 4; \
            _Pragma("unroll") for (int s_ = 0; s_ < 2; ++s_) { V[(dbl * 2 + s_) * 2] = vtr(vp_ + va_ + s_ * 8192); V[(dbl * 2 + s_) * 2 + 1] = vtr(vp_ + va_ + s_ * 8192 + 4096); } } } while (0)
#define VFR(V, i) (bf16x8){V[2 * (i)][0], V[2 * (i)][1], V[2 * (i)][2], V[2 * (i)][3], V[2 * (i) + 1][0], V[2 * (i) + 1][1], V[2 * (i) + 1][2], V[2 * (i) + 1][3]}
#define ATT_PVG(V, dg) do { _Pragma("unroll") for (int dbl = 0; dbl < 2; ++dbl) _Pragma("unroll") for (int qb = 0; qb < 2; ++qb) _Pragma("unroll") for (int s_ = 0; s_ < 2; ++s_) \
            o[qb][2 * (dg) + dbl] = __builtin_amdgcn_mfma_f32_16x16x32_bf16(__builtin_bit_cast(bf16x8, pw[qb][s_]), VFR(V, dbl * 2 + s_), o[qb][2 * (dg) + dbl], 0, 0, 0); } while (0)
#define ATT_PVX(V, dg) do { ATT_PVG(V, dg); ATT_EXPB(dg); \
        _Pragma("unroll") for (int i_ = 0; i_ < 4; ++i_) { __builtin_amdgcn_sched_group_barrier(0x008, 2, 0); __builtin_amdgcn_sched_group_barrier(0x400, 2, 0); __builtin_amdgcn_sched_group_barrier(0x002, 2, 0); } \
        __builtin_amdgcn_sched_barrier(0); } while (0)
#define ATT_TOP(t) do { if ((t) + 1 < NT) ATT_WAIT_BAR(2); else ATT_WAIT_BAR(0); DMA_V(t); if ((t) + 2 < NT) DMA_K((t) + 2); } while (0)
#define ATT_LGKM(n) asm volatile("s_waitcnt lgkmcnt(" #n ")" ::: "memory")
    { float sa_ = 0.f, sb_ = 0.f; ATT_TOP(0); ATT_QK(0); ATT_EXPB(0); ATT_EXPB(1); ATT_EXPB(2); ATT_EXPB(3); l0 += sa_; l1 += sb_; ATT_PACK(); }
    s16x4 va[8], vb[8];
    for (int t = 1; t < NT; ++t) {
        float sa_ = 0.f, sb_ = 0.f;
        ATT_TOP(t);
        ATT_VLOAD(va, t - 1, 0); __builtin_amdgcn_sched_barrier(0);
        ATT_QK(t); __builtin_amdgcn_sched_barrier(0);
        ATT_VLOAD(vb, t - 1, 1); ATT_LGKM(8); __builtin_amdgcn_sched_barrier(0);
        ATT_PVX(va, 0);
        ATT_VLOAD(va, t - 1, 2); ATT_LGKM(8); __builtin_amdgcn_sched_barrier(0);
        ATT_PVX(vb, 1);
        ATT_VLOAD(vb, t - 1, 3); ATT_LGKM(8); __builtin_amdgcn_sched_barrier(0);
        ATT_PVX(va, 2);
        ATT_LGKM(0); __builtin_amdgcn_sched_barrier(0);
        ATT_PVX(vb, 3);
        l0 += sa_; l1 += sb_;
        ATT_PACK(); }
    ATT_WAIT_BAR(0);
    ATT_VLOAD(va, NT - 1, 0); ATT_VLOAD(vb, NT - 1, 1); ATT_LGKM(8); ATT_PVG(va, 0); __builtin_amdgcn_sched_barrier(0);
    ATT_VLOAD(va, NT - 1, 2); ATT_LGKM(8); ATT_PVG(vb, 1); __builtin_amdgcn_sched_barrier(0);
    ATT_VLOAD(vb, NT - 1, 3); ATT_LGKM(8); ATT_PVG(va, 2); __builtin_amdgcn_sched_barrier(0);
    ATT_LGKM(0); ATT_PVG(vb, 3);
#undef DMA_K
#undef DMA_V
#undef ATT_QK
#undef ATT_EXPB
#undef ATT_PACK
#undef ATT_VLOAD
#undef VFR
#undef ATT_PVG
#undef ATT_PVX
#undef ATT_TOP
#undef ATT_LGKM
    __builtin_amdgcn_s_setprio(0);
    l0 += xor16_f(l0); l0 = sum32_f(l0); l1 += xor16_f(l1); l1 = sum32_f(l1);
    LAS float* wsf = (LAS float*)(lds + ATT_WS) + wid * 64;
    if (g == 0) { wsf[r16] = l0; wsf[16 + r16] = l1; }
    LDS_WAIT();
    float rl[2][4];
#pragma unroll
    for (int qb = 0; qb < 2; ++qb)
#pragma unroll
        for (int r = 0; r < 4; ++r) rl[qb][r] = __builtin_amdgcn_rcpf(wsf[16 * qb + 4 * g + r]) * (mp ? lam : 1.0f);
    ATT_WAIT_BAR(0);
    LAS float* stg = (LAS float*)lds + wq * (32 * 132);
    if (mp == 1) {
#pragma unroll
        for (int qb = 0; qb < 2; ++qb)
#pragma unroll
            for (int db = 0; db < 8; ++db)
#pragma unroll
                for (int r = 0; r < 4; ++r) stg[(16 * qb + 4 * g + r) * 132 + 16 * db + r16] = o[qb][db][r] * rl[qb][r];
    }
    ATT_WAIT_BAR(0);
    if (mp == 0) {
#pragma unroll
        for (int qb = 0; qb < 2; ++qb)
#pragma unroll
            for (int db = 0; db < 8; ++db)
#pragma unroll
                for (int r = 0; r < 4; ++r) { const int ix = (16 * qb + 4 * g + r) * 132 + 16 * db + r16; stg[ix] = o[qb][db][r] * rl[qb][r] - stg[ix]; }
        LDS_WAIT();
        const int q = lane >> 1, half = lane & 1; const LAS float* rp = stg + q * 132 + half * 64;
        f32x4 v[16]; float ss = 0.f;
#pragma unroll
        for (int i = 0; i < 16; ++i) { v[i] = *(const LAS f32x4*)(rp + 4 * i); ss += (v[i].x * v[i].x + v[i].y * v[i].y) + (v[i].z * v[i].z + v[i].w * v[i].w); }
        ss += xor1_f(ss);
        const float rinv = __builtin_amdgcn_rsqf(ss * (1.0f / 128.0f) + 1e-6f) * oscale;
        bf16* yp = Y + (size_t)(qrow0 + wq * 32 + q) * DM + 512 + h * 128 + half * 64;
        const f32x4* sgp = (const f32x4*)(sg + half * 64);
#pragma unroll
        for (int i = 0; i < 8; ++i) { const f32x4 a0 = v[2 * i] * sgp[2 * i] * rinv, a1 = v[2 * i + 1] * sgp[2 * i + 1] * rinv;
            v4u w; w.x = pk2(a0.x, a0.y); w.y = pk2(a0.z, a0.w); w.z = pk2(a1.x, a1.y); w.w = pk2(a1.z, a1.w); *(v4u*)(yp + 8 * i) = w; }
    }
    ATT_WAIT_BAR(0);
}

__device__ __forceinline__ void phase_mixers(const Args& a, int li, LAS unsigned char* lds, int G, int bx) {
    unsigned char* ws = fresh_ptr(a.ws);
    for (int rep = 0; rep <= DUP_HY; ++rep) if (PHEN(13)) for (int c = bx; c < 256; c += G) { const int v = G == 256 ? (((c & 7) << 5) | (c >> 3)) : c; hyena_unit(a, li, v >> 1, v & 1, lds); }
    for (int rep = 0; rep <= DUP_POOL; ++rep) if (PHEN(14)) { pool_load_lin(a, li, lds);
    for (int p = bx; p < 512; p += G) pool_unit(a, li, p, lds);
    for (int cp = bx; cp < 256; cp += G) pool_ctx_pair(a, li, cp, lds); }
    if (!PHEN(15)) return;
    const float* qkg = AIN(22) + li * 128; const float* dl = AIN(23) + li * 256; const float* sg = AIN(24) + li * 128;
    float mq = 0.f, mk = 0.f, d1 = 0.f, d2 = 0.f;
    for (int q = 0; q < 64; ++q) { mq = __builtin_fmaxf(mq, __builtin_fabsf(qkg[q])); mk = __builtin_fmaxf(mk, __builtin_fabsf(qkg[64 + q])); d1 += dl[q] * dl[64 + q]; d2 += dl[128 + q] * dl[192 + q]; }
    const float lam_init = 0.8f - 0.6f * __expf(-0.3f * (float)li);
    const float lam = __expf(d1) - __expf(d2) + lam_init;
    const float negb = -(64.0f * mq * mk * C2);
    const bf16* Z = (const bf16*)(ws + WS_Z); bf16* Y = (bf16*)(ws + WS_Y);
    for (int rep = 0; rep <= DUP_ATT; ++rep)
    for (int i = 0; i * G + bx < 1024; ++i) {
        int bh, qb;
        if (G == 256) { const int vcu = (bx & 7) * 32 + (bx >> 3); bh = vcu >> 5; qb = (vcu & 31) + 32 * i; } else { const int u = i * G + bx; bh = u >> 7; qb = u & 127; }
        const int b = bh >> 2, h = bh & 3;
        attn_unit16(lds, Z, b * RB + CTXL + qb * 128, b * RB, RB / 64, h, lam, 1.0f - lam_init, sg, Y);
    }
    if (li < DEPTH - 1) for (int u = bx; u < 16; u += G) { const int b = u >> 3, h = (u >> 1) & 3, qh = u & 1;
        attn_unit16(lds, Z, b * RB + qh * 128, b * RB, CTXL / 64, h, lam, 1.0f - lam_init, sg, Y); }
}

constexpr int NPHASES = 2 * 9 + 2 * 13 - 6;
__global__ void __launch_bounds__(NTHR, 2) fwd(Args a) {
    extern __shared__ __attribute__((aligned(16))) unsigned char lds_raw[];
    LAS unsigned char* lds = (LAS unsigned char*)lds_raw;
    volatile LAS unsigned* MISC = (volatile LAS unsigned*)(lds + MISC_OFF);
    const int tid = threadIdx.x, G = gridDim.x, bx = blockIdx.x;
    if (tid < 128) MISC[tid] = 0u;
    if (tid < 64) ((LAS unsigned*)(lds + PTAB_OFF))[tid] = ((const __attribute__((address_space(4))) unsigned*)__builtin_amdgcn_kernarg_segment_ptr())[tid];
    __syncthreads();
    const int lo = a.ph_lo, hi = a.ph_hi;
    unsigned* ctl = (unsigned*)(fresh_ptr(a.ws) + WS_CTL);
    XcdBarrier bar; bar.bar = ctl + CW_BAR; bar.x = 0; bar.st = MISC + 8;
    if (hi - lo > 1) bar = xcd_barrier_post(ctl + CW_BAR, MISC + 8);
    int ph = 0;
#define ON() (ph >= lo && ph < hi)
#define ENDPH() do { if (ON() && ph + 1 < hi) xcd_barrier(bar); ++ph; } while (0)
#define WSP(off) (fresh_ptr(a.ws) + (off))
#define XN ((bf16*)WSP(WS_XN))
#define Zb ((bf16*)WSP(WS_Z))
#define Yb ((bf16*)WSP(WS_Y))
#define HID ((bf16*)WSP(WS_HID))
#define win_t ((bf16*)WSP(WS_WIN))
#define wout_t ((bf16*)WSP(WS_WOUT))
#define wup_t ((bf16*)WSP(WS_WUP))
#define wdn_t ((bf16*)WSP(WS_WDN))
#define hctx ((float*)WSP(WS_HCTX))
#define WSB WSP(0)
#define modl ((const float*)WSP(WS_MOD) + (size_t)li * 3 * 6144)
    for (int li = 0; li < DEPTH; ++li) {
        const bool moe = (li & 1) != 0;
        const float* xlat = li == 0 ? AIN(0) : (const float*)fresh_ptr(a.out);
        if (li == 0) {
            if (PHEN(0) && ON()) phase_prep_a(a, li, lds, G, bx);
            ENDPH();
            if (PHEN(1) && ON()) phase_prep_b(a, li, lds, G, bx);
            ENDPH();
            if (PHEN(2) && ON()) phase_norm(a, li, 0, xlat, lds, G, bx);
            ENDPH();
        } else {
            if (ON()) { if (PHEN(0)) phase_prep_a(a, li, lds, G, bx); if (PHEN(1)) phase_prep_b(a, li, lds, G, bx); if (PHEN(2)) phase_norm(a, li, 0, xlat, lds, G, bx); }
            ENDPH();
        }
        for (int rep = 0; rep <= DUP_GEMM; ++rep) if (PHEN(3) && ON()) { pg8::Gemm g{XN, win_t, MROWS, INW, DM}; pg8::StaticOrder S; S.init(MROWS, INW, DM, G, bx);
            EpiIn E{Zb, (bf16*)(WSB + WS_ZT), (bf16*)(WSB + WS_ZTC), (const float*)(WSB + WS_ROPE), (const float*)(WSB + WS_ROPE) + 4096, AIN(22) + li * 128};
            pg8::gemm_phase<EpiIn, pg8::StaticOrder, true, true>(lds, g, S, E); }
        ENDPH();
        if (PHEN(4) && ON()) phase_mixers(a, li, lds, G, bx);
        ENDPH();
#if DUP_ADD
        if (PHEN(5) && ON()) { pg8::Gemm g{Yb, wout_t, MROWS, DM, DM}; SplitTailOrder S; S.init(DM, DM, G, bx);
            EpiRes E{xlat, a.out, hctx, modl + 2 * DM, DM / 64, (float*)(WSB + WS_SLAB), 0.f};
            pg8::gemm_phase<EpiRes, SplitTailOrder, true, true>(lds, g, S, E); }
#endif
        if (PHEN(5) && ON()) { pg8::Gemm g{Yb, wout_t, MROWS, DM, DM}; SplitTailOrder S; S.init(DM, DM, G, bx);
            EpiRes E{xlat, a.out, hctx, modl + 2 * DM, DM / 64, (float*)(WSB + WS_SLAB), 1.f};
            pg8::gemm_phase<EpiRes, SplitTailOrder, true, true>(lds, g, S, E); }
        ENDPH();
        if (!moe) {
            if (PHEN(6) && ON()) phase_norm(a, li, 3, a.out, lds, G, bx);
            ENDPH();
            for (int rep = 0; rep <= DUP_GEMM; ++rep) if (PHEN(7) && ON()) { pg8::Gemm g{XN, wup_t, MROWS, 2 * DFF, DM}; pg8::StaticOrder S; S.init(MROWS, 2 * DFF, DM, G, bx);
                EpiGlu E{HID, DFF, DFF / 128};
                pg8::gemm_phase<EpiGlu, pg8::StaticOrder, true, true>(lds, g, S, E); }
            ENDPH();
#if DUP_ADD
            if (PHEN(8) && ON()) { pg8::Gemm g{HID, wdn_t, MROWS, DM, DFF}; SplitTailOrder S; S.init(DM, DFF, G, bx);
                EpiRes E{a.out, a.out, hctx, modl + 5 * DM, DFF / 64, (float*)(WSB + WS_SLAB), 0.f};
                pg8::gemm_phase<EpiRes, SplitTailOrder, true, true>(lds, g, S, E); }
#endif
            if (PHEN(8) && ON()) { pg8::Gemm g{HID, wdn_t, MROWS, DM, DFF}; SplitTailOrder S; S.init(DM, DFF, G, bx);
                EpiRes E{a.out, a.out, hctx, modl + 5 * DM, DFF / 64, (float*)(WSB + WS_SLAB), 1.f};
                pg8::gemm_phase<EpiRes, SplitTailOrder, true, true>(lds, g, S, E); }
            ENDPH();
        } else {
            const LAS int* tab = (const LAS int*)(lds + TAB_OFF);
            if (PHEN(9) && ON()) phase_norm_router(a, li, a.out, lds, G, bx);
            ENDPH();
            if (PHEN(10) && ON()) phase_moe_gather(a, li, lds, G, bx);
            ENDPH();
            for (int rep = 0; rep <= DUP_GEMM; ++rep) if (PHEN(11) && ON()) { moe_tables(a, li >> 1, lds, G, bx);
                pg8::Gemm g{(const bf16*)(WSB + WS_AG), wup_t, 0, 0, DM}; MoeOrder S{G, bx, 2 * DFE / 256, 0, tab[16] * (2 * DFE / 256), tab, DM / 64};
                EpiGlu E{HID, DFE, DFE / 128};
                pg8::gemm_phase<EpiGlu, MoeOrder, true, true>(lds, g, S, E); }
            ENDPH();
            for (int k = 0; k < 2; ++k) {
#if DUP_ADD
                if (PHEN(12) && ON()) { moe_tables(a, li >> 1, lds, G, bx);
                    pg8::Gemm g{HID, wdn_t, 0, 0, DFE}; MoeDownOrder S; S.init(G, bx, k, tab);
                    EpiMoeDown E{a.out, hctx, modl + 5 * DM, (const int*)(WSB + WS_RTOK), (const float*)(WSB + WS_RGATE), tab, (float*)(WSB + WS_SLAB), 0.f};
                    pg8::gemm_phase<EpiMoeDown, MoeDownOrder, true, true>(lds, g, S, E); }
#endif
                if (PHEN(12) && ON()) { moe_tables(a, li >> 1, lds, G, bx);
                    pg8::Gemm g{HID, wdn_t, 0, 0, DFE}; MoeDownOrder S; S.init(G, bx, k, tab);
                    EpiMoeDown E{a.out, hctx, modl + 5 * DM, (const int*)(WSB + WS_RTOK), (const float*)(WSB + WS_RGATE), tab, (float*)(WSB + WS_SLAB), 1.f};
                    pg8::gemm_phase<EpiMoeDown, MoeDownOrder, true, true>(lds, g, S, E); }
                ENDPH();
            }
            for (int k = 0; k < 2; ++k) { if (ON()) phase_moe_fix(a, li, k, lds, G, bx); ENDPH(); }
        }
    }
#undef ON
#undef ENDPH
#undef WSP
#undef XN
#undef Zb
#undef Yb
#undef HID
#undef win_t
#undef wout_t
#undef wup_t
#undef wdn_t
#undef hctx
#undef WSB
#undef modl
}

extern "C" void kernel_launch(void* const* d_in, const int* in_sizes, int n_in, void* d_out, int out_size, void* d_ws, size_t ws_size, hipStream_t stream) {
    static int grid = 0;
    if (grid == 0) {
        if (n_in != 32 || in_sizes[0] != NB * SEQ * DM || out_size != NB * SEQ * DM || ws_size < WS_END) {
            fprintf(stderr, "kernel_launch: unexpected problem: n_in %d in0 %d out %d ws %zu (need %zu)\n", n_in, n_in > 0 ? in_sizes[0] : -1, out_size, ws_size, (size_t)WS_END); grid = -1; return; }
        int dev = 0, cus = 0, per_cu = 0;
        if (hipGetDevice(&dev) != hipSuccess || hipDeviceGetAttribute(&cus, hipDeviceAttributeMultiprocessorCount, dev) != hipSuccess) { grid = -1; return; }
        if (hipFuncSetAttribute((const void*)fwd, hipFuncAttributeMaxDynamicSharedMemorySize, LDS_BYTES) != hipSuccess) { fprintf(stderr, "kernel_launch: hipFuncSetAttribute failed\n"); grid = -1; return; }
        if (hipOccupancyMaxActiveBlocksPerMultiprocessor(&per_cu, (const void*)fwd, NTHR, LDS_BYTES) != hipSuccess || per_cu < 1) { fprintf(stderr, "kernel_launch: occupancy query says %d\n", per_cu); }
        (void)hipGetLastError();
        grid = cus;
    }
    if (grid < 0) return;
    (void)hipMemsetAsync((char*)d_ws + WS_CTL, 0, CTL_ZERO_BYTES, stream);
    Args a{};
    for (int i = 0; i < 32; ++i) a.in[i] = (const float*)d_in[i];
    a.out = (float*)d_out; a.ws = (unsigned char*)d_ws;
#if MK_ONE_LAUNCH
    a.ph_lo = 0; a.ph_hi = NPHASES;
    hipLaunchKernelGGL(fwd, dim3(grid), dim3(NTHR), LDS_BYTES, stream, a);
#else
    for (int p = 0; p < NPHASES; ++p) { a.ph_lo = p; a.ph_hi = p + 1; hipLaunchKernelGGL(fwd, dim3(grid), dim3(NTHR), LDS_BYTES, stream, a); }
#endif
}
```

```cpp
#include <hip/hip_runtime.h>
#include <cstdio>
#include <cstdint>

#ifndef MK_ONE_LAUNCH
#define MK_ONE_LAUNCH 1
#endif
#ifndef PH_MASK
#define PH_MASK 0xFFFF
#endif
#define PHEN(n) (((PH_MASK) >> (n)) & 1)
#define DUP_ATT 0
#define DUP_HY 0
#define DUP_POOL 0
#define DUP_PREP 0
#define DUP_PREPB 0
#define DUP_GEMM 0
#define DUP_ADD 0

#define GAS __attribute__((address_space(1)))
#define LAS __attribute__((address_space(3)))
typedef unsigned short bf16;
typedef unsigned v4u __attribute__((ext_vector_type(4)));
typedef unsigned v2u __attribute__((ext_vector_type(2)));
typedef float f32x4 __attribute__((ext_vector_type(4)));
typedef float f32x2 __attribute__((ext_vector_type(2)));
typedef float f32x16 __attribute__((ext_vector_type(16)));
typedef short bf16x8 __attribute__((ext_vector_type(8)));
typedef short s16x4 __attribute__((ext_vector_type(4)));
typedef short v4i16_t __attribute__((ext_vector_type(4)));

constexpr int DM = 1024, NB = 2, SEQ = 16384, DEPTH = 4, CTXL = 256;
constexpr int RB = CTXL + SEQ;
constexpr int MROWS = NB * RB;
constexpr int TPB = RB / 256;
constexpr int INW = 2560, Q_OFF = 1024, K_OFF = 1536, V_OFF = 2048;
constexpr int DFF = 2816, DFE = 3584, NEXP = 8;
constexpr int NWAVES = 8, NTHR = 512;
constexpr int SEGCAP = MROWS;
constexpr float C2 = 0.125f * 1.4426950408889634f;

constexpr size_t MiB = 1u << 20;
constexpr size_t WS_CTL = 0, CTL_ZERO_BYTES = 1 * MiB;
constexpr size_t WS_MODP = 1 * MiB;
constexpr size_t WS_MOD = 4 * MiB;
constexpr size_t WS_ROPE = 4 * MiB + 512 * 1024;
constexpr size_t WS_H2C = 4 * MiB + 640 * 1024;
constexpr size_t WS_KCTX = 5 * MiB;
constexpr size_t WS_HCTX = 6 * MiB;
constexpr size_t WS_H2 = 8 * MiB;
constexpr size_t WS_RTOK = 12 * MiB;
constexpr size_t WS_RGATE = 15 * MiB;
constexpr size_t WS_RREC = 18 * MiB;
constexpr size_t WS_RRECG = 18 * MiB + 256 * 1024;
constexpr size_t WS_CNTB = 18 * MiB + 512 * 1024;
constexpr size_t WS_H2B = 19 * MiB;
constexpr size_t WS_W = 32 * MiB;
constexpr size_t WS_WIN = WS_W, WS_WOUT = WS_W + 5 * MiB, WS_WUP = WS_W + 8 * MiB, WS_WDN = WS_W + 120 * MiB;
constexpr size_t WS_XN = 224 * MiB;
constexpr size_t WS_Z = 289 * MiB;
constexpr size_t WS_ZT = 452 * MiB;
constexpr size_t WS_ZTC = WS_ZT + 48 * MiB;
constexpr size_t WS_Y = 501 * MiB;
constexpr size_t WS_HF = 566 * MiB;
constexpr size_t WS_HID = 289 * MiB;
constexpr size_t WS_AG = 772 * MiB;
constexpr size_t WS_SLAB = 910 * MiB;
constexpr size_t WS_END = 974 * MiB;

constexpr int CW_TMO = 0, CW_BAR = 4096, CW_MOECNT = 8192;

constexpr int LDS_BYTES = 159744;
constexpr int MISC_OFF = 155648;
constexpr int TAB_OFF = MISC_OFF + 256;

__device__ __forceinline__ unsigned f2bf(float f) { unsigned u = __builtin_bit_cast(unsigned, f); return (u + 0x7fffu + ((u >> 16) & 1u)) >> 16; }
__device__ __forceinline__ unsigned pk2(float lo, float hi) { return f2bf(lo) | (f2bf(hi) << 16); }
__device__ __forceinline__ float bf2f(bf16 b) { return __builtin_bit_cast(float, (unsigned)b << 16); }
template <int CTRL> __device__ __forceinline__ float dpp_f(float v) { return __builtin_bit_cast(float, __builtin_amdgcn_mov_dpp(__builtin_bit_cast(int, v), CTRL, 0xf, 0xf, true)); }
__device__ __forceinline__ float xor1_f(float v) { return dpp_f<0xB1>(v); }
__device__ __forceinline__ float xor2_f(float v) { return dpp_f<0x4E>(v); }
__device__ __forceinline__ float xor16_f(float v) { return __builtin_bit_cast(float, __builtin_amdgcn_ds_swizzle(__builtin_bit_cast(int, v), 0x401F)); }
__device__ __forceinline__ float xor32_f(float v) { auto rr = __builtin_amdgcn_permlane32_swap(__builtin_bit_cast(unsigned, v), __builtin_bit_cast(unsigned, v), false, false);
    return __builtin_bit_cast(float, (unsigned)rr[0]) == v ? __builtin_bit_cast(float, (unsigned)rr[1]) : __builtin_bit_cast(float, (unsigned)rr[0]); }
__device__ __forceinline__ float sum32_f(float v) { auto rr = __builtin_amdgcn_permlane32_swap(__builtin_bit_cast(unsigned, v), __builtin_bit_cast(unsigned, v), false, false);
    return __builtin_bit_cast(float, (unsigned)rr[0]) + __builtin_bit_cast(float, (unsigned)rr[1]); }
__device__ __forceinline__ float wave_sum(float v) {
    v += xor1_f(v); v += xor2_f(v); v += dpp_f<0x141>(v)  ; v += dpp_f<0x140>(v)  ; v += xor16_f(v);
    auto rr = __builtin_amdgcn_permlane32_swap(__builtin_bit_cast(unsigned, v), __builtin_bit_cast(unsigned, v), false, false);
    return __builtin_bit_cast(float, (unsigned)rr[0]) + __builtin_bit_cast(float, (unsigned)rr[1]);
}
__device__ __forceinline__ float sin_rev(float r) { return __builtin_amdgcn_sinf(__builtin_amdgcn_fractf(r)); }
__device__ __forceinline__ float cos_rev(float r) { return __builtin_amdgcn_cosf(__builtin_amdgcn_fractf(r)); }
__device__ __forceinline__ float sin_rad(float x) { return sin_rev(x * 0.15915494309189535f); }
__device__ __forceinline__ int fresh_tid() { int t = threadIdx.x; asm volatile("" : "+v"(t)); return t; }
template <class T> __device__ __forceinline__ T* fresh_ptr(T* p) { asm volatile("" : "+s"(p)); return (T*)(GAS T*)(unsigned long long)p; }
#define LDS_WAIT() asm volatile("s_waitcnt lgkmcnt(0)" ::: "memory")
#define VM_WAIT() asm volatile("s_waitcnt vmcnt(0)" ::: "memory")

namespace pg8 {
typedef unsigned short bf16_t;
typedef unsigned u32x4 __attribute__((ext_vector_type(4)));
constexpr int BM = 256, BK = 64, HALF = 128, HTB = HALF * BK * 2, STAGE_BYTES = 8 * HTB, NXCD = 8, WGM = 8;
__host__ __device__ __forceinline__ int lds_byte(int r, int c) { const int st = (r >> 4) * 2 + (c >> 5), rr = r & 15, cc = c & 31, ob = rr * 64 + cc * 2; return st * 1024 + (ob ^ (((ob >> 9) & 1) << 5)); }
__host__ __device__ __forceinline__ void stage_rc(int b, int& R, int& C) { const int st = b / 1024, sb = b % 1024, swz = sb ^ (((sb >> 9) & 1) << 5); R = (st >> 1) * 16 + swz / 64; C = (st & 1) * 32 + (swz % 64) / 2; }
__host__ __device__ __forceinline__ int perm32(int rho) { const int n = rho >> 4, i = rho & 15; return 8 * (i >> 2) + 4 * n + (i & 3); }
struct Unit { int pm, pn, ko, nt, sl; };
struct Gemm { const bf16_t* A; const bf16_t* Bt; int M, N, K; };
struct StaticOrder {
    int nM, nN, nwg, G, c;
    int ntk;
    __host__ __device__ void init(int M, int N, int K, int G_, int c_) { nM = M / BM; nN = N / BM; nwg = nM * nN; G = G_; c = c_; ntk = K / BK; }
    __host__ __device__ __forceinline__ bool next(int i, Unit& u) const { return map((long)i * G + c, u); }
    __host__ __device__ __forceinline__ bool map(long L, Unit& u) const {
        if (L >= nwg) return false; u.ko = 0; u.nt = ntk; u.sl = -1;
        int wgid = (int)L; { const int q = nwg / NXCD, r = nwg % NXCD, xcd = wgid % NXCD, off = wgid / NXCD; wgid = (xcd < r ? xcd * (q + 1) : r * (q + 1) + (xcd - r) * q) + off; }
        const int nig = WGM * nN, gid = wgid / nig, fm = gid * WGM, gsz = (nM - fm) < WGM ? (nM - fm) : WGM;
        u.pm = fm + ((wgid % nig) % gsz); u.pn = (wgid % nig) / gsz; return true;
    }
    __device__ __forceinline__ void a_ready(const Unit&) const {}
    __device__ __forceinline__ void done(const Unit&) const {}
};
__device__ __forceinline__ unsigned cvt_pk_bf16(float lo, float hi) { unsigned r; asm volatile("v_cvt_pk_bf16_f32 %0, %1, %2" : "=v"(r) : "v"(lo), "v"(hi)); return r; }

template <class Epi, class Sched, bool ALIGN_EPI = false, bool SP2 = false>
__device__ __forceinline__ void gemm_phase(LAS unsigned char* lds, const Gemm g, const Sched& S, const Epi& E) {
    const int tid = fresh_tid(), wid = __builtin_amdgcn_readfirstlane(tid >> 6), lane = tid & 63, wr = wid >> 2, wc = wid & 3, fr = lane & 15, fq = lane >> 4;
    const int K = g.K;
    unsigned voffA[2], voffB[2];
#pragma unroll
    for (int i = 0; i < 2; ++i) { int R, C; stage_rc(tid * 16 + i * 8192, R, C); const int Rb = Epi::PERM ? ((R & ~31) + perm32(R & 31)) : R;
        voffA[i] = (unsigned)(R * K + C) * 2u; voffB[i] = (unsigned)(Rb * K + C) * 2u; }
    const size_t kstep = (size_t)(BK * 2);
    const size_t hstep = (size_t)HALF * K * 2;
    const size_t tstep = 2 * hstep;
    const unsigned ldsw = (unsigned)wid * 1024u;
    const int aoff = lds_byte(wr * 64 + fr, fq * 8), boff = lds_byte(wc * 32 + fr, fq * 8);
#define PG8_SA(b, h) (((b) * 2 + (h)) * HTB)
#define PG8_SB(b, h) ((4 + (b) * 2 + (h)) * HTB)
#define PG8_STAGE(bufoff, gbase, voff) do { _Pragma("unroll") for (int _i = 0; _i < 2; ++_i) \
        __builtin_amdgcn_global_load_lds((const unsigned*)((const char*)(gbase) + (voff)[_i]), (LAS unsigned*)(lds + (bufoff) + ldsw + _i * 8192), 16, 0, 0); } while (0)
#define PG8_LDA(dst, b, h) do { _Pragma("unroll") for (int m = 0; m < 4; ++m) _Pragma("unroll") for (int k = 0; k < 2; ++k) dst[m][k] = *(const LAS bf16x8*)(lds + PG8_SA(b, h) + aoff + m * 2048 + k * 1024); } while (0)
#define PG8_LDB(dst, b, h) do { _Pragma("unroll") for (int n = 0; n < 2; ++n) _Pragma("unroll") for (int k = 0; k < 2; ++k) dst[n][k] = *(const LAS bf16x8*)(lds + PG8_SB(b, h) + boff + n * 2048 + k * 1024); } while (0)
#define PG8_MMA(ai, bj, At, Bt) do { __builtin_amdgcn_s_setprio(1); _Pragma("unroll") for (int m = 0; m < 4; ++m) _Pragma("unroll") for (int n = 0; n < 2; ++n) _Pragma("unroll") for (int k = 0; k < 2; ++k) \
        acc[ai][bj][m][n] = __builtin_amdgcn_mfma_f32_16x16x32_bf16(Bt[n][k], At[m][k], acc[ai][bj][m][n], 0, 0, 0); __builtin_amdgcn_s_setprio(0); } while (0)
#define PG8_WAIT_V(n) asm volatile("s_waitcnt vmcnt(" #n ")" ::: "memory")
#define PG8_WAIT_L(n) asm volatile("s_waitcnt lgkmcnt(" #n ")" ::: "memory")
#define PG8_BAR __builtin_amdgcn_s_barrier()
#define PG8_SCHED __builtin_amdgcn_sched_barrier(0)
    Unit cur, nxt; int ui = 0;
    if (!S.next(0, cur)) return;
    f32x4 acc[2][2][4][2];
#pragma unroll
    for (int a = 0; a < 2; ++a)
#pragma unroll
        for (int b = 0; b < 2; ++b)
#pragma unroll
            for (int m = 0; m < 4; ++m)
#pragma unroll
                for (int n = 0; n < 2; ++n) acc[a][b][m][n] = (f32x4){0.f, 0.f, 0.f, 0.f};
    bf16x8 At[4][2], B0[2][2], B1[2][2];
    const char* cA = (const char*)g.A + (size_t)cur.pm * tstep + (size_t)cur.ko * 2; const char* cB = (const char*)g.Bt + (size_t)cur.pn * tstep + (size_t)cur.ko * 2;
    S.a_ready(cur);
    if constexpr (SP2) {
        PG8_STAGE(PG8_SB(0, 0), cB, voffB); PG8_STAGE(PG8_SB(0, 1), cB + hstep, voffB); PG8_STAGE(PG8_SA(0, 0), cA, voffA); PG8_STAGE(PG8_SA(0, 1), cA + hstep, voffA);
        if (wr == 1) PG8_BAR;
        PG8_WAIT_V(2); PG8_BAR;
        PG8_STAGE(PG8_SB(1, 0), cB + kstep, voffB); PG8_STAGE(PG8_SA(1, 0), cA + kstep, voffA); PG8_STAGE(PG8_SB(1, 1), cB + hstep + kstep, voffB);
        PG8_WAIT_V(6); PG8_BAR;
    } else {
        PG8_STAGE(PG8_SB(0, 0), cB, voffB); PG8_STAGE(PG8_SA(0, 0), cA, voffA); PG8_STAGE(PG8_SB(0, 1), cB + hstep, voffB); PG8_STAGE(PG8_SA(0, 1), cA + hstep, voffA);
        if (wr == 1) PG8_BAR;
        PG8_WAIT_V(4); PG8_BAR;
        PG8_STAGE(PG8_SB(1, 0), cB + kstep, voffB); PG8_STAGE(PG8_SA(1, 0), cA + kstep, voffA); PG8_STAGE(PG8_SB(1, 1), cB + hstep + kstep, voffB);
        PG8_WAIT_V(6); PG8_BAR;
    }
    for (;;) {
        const bool has_next = S.next(ui + 1, nxt);
        const char* nA = has_next ? (const char*)g.A + (size_t)nxt.pm * tstep + (size_t)nxt.ko * 2 : cA; const char* nB = has_next ? (const char*)g.Bt + (size_t)nxt.pn * tstep + (size_t)nxt.ko * 2 : cB;
        const int nt = cur.nt;
        for (int t = 0; t < nt; t += 2) {
            const bool last = (t == nt - 2);
            const char* a1 = cA + (size_t)(t + 1) * kstep;
            const char* a2 = last ? nA : cA + (size_t)(t + 2) * kstep; const char* b2 = last ? nB : cB + (size_t)(t + 2) * kstep;
            const char* a3 = a2 + kstep; const char* b3 = b2 + kstep;
            if (last && has_next) S.a_ready(nxt);
            if constexpr (SP2) {
            PG8_LDB(B0, 0, 0); PG8_LDB(B1, 0, 1); PG8_SCHED; PG8_LDA(At, 0, 0); PG8_STAGE(PG8_SA(1, 1), a1 + hstep, voffA);
            PG8_WAIT_V(8); PG8_WAIT_L(0); PG8_BAR; PG8_MMA(0, 0, At, B0); PG8_MMA(0, 1, At, B1); PG8_BAR; PG8_SCHED;
            PG8_LDA(At, 0, 1); PG8_STAGE(PG8_SB(0, 0), b2, voffB); PG8_STAGE(PG8_SB(0, 1), b2 + hstep, voffB); PG8_STAGE(PG8_SA(0, 0), a2, voffA);
            PG8_WAIT_V(8); PG8_WAIT_L(0); PG8_BAR; PG8_MMA(1, 0, At, B0); PG8_MMA(1, 1, At, B1); PG8_BAR; PG8_SCHED;
            PG8_LDB(B0, 1, 0); PG8_LDB(B1, 1, 1); PG8_SCHED; PG8_LDA(At, 1, 0); PG8_STAGE(PG8_SA(0, 1), a2 + hstep, voffA);
            PG8_WAIT_V(8); PG8_WAIT_L(0); PG8_BAR; PG8_MMA(0, 0, At, B0); PG8_MMA(0, 1, At, B1); PG8_BAR; PG8_SCHED;
            PG8_LDA(At, 1, 1); PG8_STAGE(PG8_SB(1, 0), b3, voffB); PG8_STAGE(PG8_SB(1, 1), b3 + hstep, voffB); PG8_STAGE(PG8_SA(1, 0), a3, voffA);
            PG8_WAIT_V(8); PG8_WAIT_L(0); PG8_BAR; PG8_MMA(1, 0, At, B0); PG8_MMA(1, 1, At, B1); PG8_BAR; PG8_SCHED;
            } else {
            PG8_LDB(B0, 0, 0); PG8_SCHED; PG8_LDA(At, 0, 0); PG8_STAGE(PG8_SA(1, 1), a1 + hstep, voffA);
            PG8_WAIT_L(8); PG8_BAR; PG8_WAIT_L(0); PG8_MMA(0, 0, At, B0); PG8_BAR; PG8_SCHED;
            PG8_LDB(B1, 0, 1); PG8_STAGE(PG8_SB(0, 0), b2, voffB);
            PG8_BAR; PG8_WAIT_L(0); PG8_MMA(0, 1, At, B1); PG8_BAR;
            PG8_LDA(At, 0, 1); PG8_STAGE(PG8_SA(0, 0), a2, voffA);
            PG8_BAR; PG8_WAIT_L(0); PG8_MMA(1, 0, At, B0); PG8_BAR; PG8_SCHED;
            PG8_STAGE(PG8_SB(0, 1), b2 + hstep, voffB);
            PG8_WAIT_V(6); PG8_BAR; PG8_MMA(1, 1, At, B1); PG8_BAR;
            PG8_LDB(B0, 1, 0); PG8_SCHED; PG8_LDA(At, 1, 0); PG8_STAGE(PG8_SA(0, 1), a2 + hstep, voffA);
            PG8_WAIT_L(8); PG8_BAR; PG8_WAIT_L(0); PG8_MMA(0, 0, At, B0); PG8_BAR; PG8_SCHED;
            PG8_LDB(B1, 1, 1); PG8_STAGE(PG8_SB(1, 0), b3, voffB);
            PG8_BAR; PG8_WAIT_L(0); PG8_MMA(0, 1, At, B1); PG8_BAR;
            PG8_LDA(At, 1, 1); PG8_STAGE(PG8_SA(1, 0), a3, voffA);
            PG8_BAR; PG8_WAIT_L(0); PG8_MMA(1, 0, At, B0); PG8_BAR; PG8_SCHED;
            PG8_STAGE(PG8_SB(1, 1), b3 + hstep, voffB);
            PG8_WAIT_V(6); PG8_BAR; PG8_MMA(1, 1, At, B1); PG8_BAR;
            }
        }
        if constexpr (ALIGN_EPI) { if (wr == 0) PG8_BAR; }
        E(acc, cur, wr, wc, fr, fq); S.done(cur);
        if (!has_next) break;
#pragma unroll
        for (int a = 0; a < 2; ++a)
#pragma unroll
            for (int b = 0; b < 2; ++b)
#pragma unroll
                for (int m = 0; m < 4; ++m)
#pragma unroll
                    for (int n = 0; n < 2; ++n) acc[a][b][m][n] = (f32x4){0.f, 0.f, 0.f, 0.f};
        cur = nxt; cA = nA; cB = nB; ++ui;
        if constexpr (ALIGN_EPI) { if (wr == 1) PG8_BAR; }
    }
    PG8_WAIT_V(0);
    if constexpr (!ALIGN_EPI) { if (wr == 0) PG8_BAR; }
    PG8_BAR;
#undef PG8_SA
#undef PG8_SB
#undef PG8_STAGE
#undef PG8_LDA
#undef PG8_LDB
#undef PG8_MMA
#undef PG8_WAIT_V
#undef PG8_WAIT_L
#undef PG8_BAR
#undef PG8_SCHED
}
}

#define XB_TMO      128
#define XB_XCNT(j)  (256  + 64 * (j))
#define XB_XSUB(j)  (1280 + 64 * (j))
#define XB_XGEN(j)  (2304 + 64 * (j))
#define XB_TOP      3328
#define XB_TOPGEN   3392
#define XCD_BAR_WORDS 3456
#define XB_SPIN_CAP (1u << 18)
__device__ __forceinline__ unsigned xb_ld(unsigned* p)              { return __hip_atomic_load(p, __ATOMIC_RELAXED, __HIP_MEMORY_SCOPE_AGENT); }
__device__ __forceinline__ unsigned xb_add(unsigned* p, unsigned v) { return __hip_atomic_fetch_add(p, v, __ATOMIC_RELAXED, __HIP_MEMORY_SCOPE_AGENT); }
__device__ __forceinline__ unsigned xb_xcc_id() { return (unsigned)__builtin_amdgcn_s_getreg((3 << 11) | 20) & 0xFu; }
#define XB_SPIN(cond, bar) do { unsigned _sp = 0; while (cond) { __builtin_amdgcn_s_sleep(1); \
    if ((++_sp & 255u) == 0u) { if (xb_ld(&(bar)[XB_TMO])) break; if (_sp > XB_SPIN_CAP) { atomicAdd(&(bar)[XB_TMO], 1u); break; } } } } while (0)
struct XcdBarrier { unsigned* bar; unsigned x; volatile LAS unsigned* st; };
__device__ __forceinline__ XcdBarrier xcd_barrier_post(unsigned* bar, volatile LAS unsigned* st) {
    XcdBarrier b; b.bar = bar; b.x = xb_xcc_id(); b.st = st;
    if (threadIdx.x == 0) (void)xb_add(&bar[XB_XCNT(b.x)], 1u);
    return b;
}
__device__ __forceinline__ void xcd_barrier_complete(unsigned* bar, unsigned x, unsigned& nloc, unsigned& nx) {
    const unsigned G = gridDim.x * gridDim.y * gridDim.z;
    unsigned sum, cnt, mine, sp = 0u;
    for (;;) {
        sum = 0u; cnt = 0u; mine = 0u;
#pragma unroll
        for (unsigned j = 0; j < 16; ++j) { const unsigned c = xb_ld(&bar[XB_XCNT(j)]); sum += c; cnt += (c > 0u) ? 1u : 0u; mine = (j == x) ? c : mine; }
        if (sum == G) break;
        __builtin_amdgcn_s_sleep(1);
        if ((++sp & 255u) == 0u) { if (xb_ld(&bar[XB_TMO])) break; if (sp > XB_SPIN_CAP) { atomicAdd(&bar[XB_TMO], 1u); break; } }
    }
    nloc = mine > 0u ? mine : 1u; nx = cnt > 0u ? cnt : 1u;
}
__device__ __forceinline__ void xcd_barrier(const XcdBarrier& b) {
    asm volatile("s_waitcnt vmcnt(0)" ::: "memory");
    __syncthreads();
    if (threadIdx.x == 0) {
        unsigned* bar = b.bar;
        __builtin_amdgcn_s_waitcnt(0);
        unsigned nloc = b.st[0], nx = b.st[1];
        if (nloc == 0u) { xcd_barrier_complete(bar, b.x, nloc, nx); b.st[0] = nloc; b.st[1] = nx; }
        const unsigned old = xb_add(&bar[XB_XSUB(b.x)], 1u);
        const unsigned gen = old / nloc;
        if (old + 1u == (gen + 1u) * nloc) {
            __builtin_amdgcn_fence(__ATOMIC_RELEASE, "agent");
            asm volatile("s_waitcnt vmcnt(0)" ::: "memory");
            const unsigned og = xb_add(&bar[XB_TOP], 1u);
            const unsigned tg = og / nx;
            if (og + 1u == (tg + 1u) * nx) xb_add(&bar[XB_TOPGEN], 1u);
            else XB_SPIN(xb_ld(&bar[XB_TOPGEN]) == tg, bar);
            __builtin_amdgcn_fence(__ATOMIC_ACQUIRE, "agent");
            xb_add(&bar[XB_XGEN(b.x)], 1u);
            asm volatile("s_waitcnt vmcnt(0)" ::: "memory");
        } else {
            XB_SPIN(xb_ld(&bar[XB_XGEN(b.x)]) == gen, bar);
            __builtin_amdgcn_fence(__ATOMIC_ACQUIRE, "agent");
            asm volatile("s_waitcnt vmcnt(0)" ::: "memory");
        }
    }
    __syncthreads();
}

__device__ __forceinline__ const float* xrow_in(int R, const float* xlat, const float* hctx) {
    const int b = R / RB, rr = R - b * RB;
    return rr < CTXL ? hctx + (size_t)(b * CTXL + rr) * DM : xlat + (size_t)(b * SEQ + rr - CTXL) * DM;
}
__device__ __forceinline__ float* xrow_out(int R, float* xlat, float* hctx) {
    const int b = R / RB, rr = R - b * RB;
    return rr < CTXL ? hctx + (size_t)(b * CTXL + rr) * DM : xlat + (size_t)(b * SEQ + rr - CTXL) * DM;
}
__device__ __forceinline__ int row_set(int R) { const int b = R / RB, rr = R - b * RB; return rr < CTXL ? 2 : b; }

__device__ __forceinline__ int qk_perm(int c) {
    const int bj = c >> 7, wc = (c >> 5) & 3, fq = (c >> 3) & 3, n = (c >> 2) & 1, j = c & 3;
    return 64 * wc + 32 * (fq >> 1) + 16 * bj + 8 * (fq & 1) + 4 * n + j;
}
struct EpiIn {
    static constexpr bool PERM = true;
    bf16* Z; bf16* ZT; bf16* ZTC; const float* ropec; const float* ropes; const float* qkg;
    __device__ __forceinline__ void operator()(const f32x4 (&acc)[2][2][4][2], const pg8::Unit& u, int wr, int wc, int fr, int fq) const {
        const int b = u.pm / TPB, jt = u.pm - b * TPB; const bool isctx = (jt == 0);
        if (u.pn == 0 || u.pn >= 8) {
#pragma unroll
            for (int ai = 0; ai < 2; ++ai)
#pragma unroll
                for (int m = 0; m < 4; ++m) { const int r = 128 * ai + 64 * wr + 16 * m + fr; bf16* rowp = Z + (size_t)(u.pm * 256 + r) * INW + u.pn * 256 + 32 * wc + 8 * fq;
#pragma unroll
                    for (int bj = 0; bj < 2; ++bj) { const f32x4 v0 = acc[ai][bj][m][0], v1 = acc[ai][bj][m][1];
                        v4u w; w.x = pg8::cvt_pk_bf16(v0[0], v0[1]); w.y = pg8::cvt_pk_bf16(v0[2], v0[3]); w.z = pg8::cvt_pk_bf16(v1[0], v1[1]); w.w = pg8::cvt_pk_bf16(v1[2], v1[3]);
                        *(v4u*)(rowp + bj * 128) = w; } }
        } else if (u.pn <= 3) {
            bf16* base = isctx ? ZTC + (size_t)b * 768 * CTXL : ZT + (size_t)b * 768 * SEQ + (size_t)(jt - 1) * 256;
            const size_t cstride = isctx ? CTXL : SEQ;
#pragma unroll
            for (int bj = 0; bj < 2; ++bj)
#pragma unroll
                for (int n = 0; n < 2; ++n)
#pragma unroll
                    for (int j = 0; j < 4; ++j) { const int ch = 256 * (u.pn - 1) + 128 * bj + 32 * wc + 8 * fq + 4 * n + j; bf16* cp = base + (size_t)ch * cstride;
#pragma unroll
                        for (int ai = 0; ai < 2; ++ai)
#pragma unroll
                            for (int m = 0; m < 4; ++m) { const int r = 128 * ai + 64 * wr + 16 * m + fr; cp[r] = (bf16)f2bf(acc[ai][bj][m][n][j]); } }
        } else {
            const int which = (u.pn >= 6) ? 1 : 0; const float osc = which ? 1.0f : C2;
            const int axis = fq >> 1, f0 = 8 * (fq & 1);
            float ga[2][4], gb[2][4];
#pragma unroll
            for (int n = 0; n < 2; ++n)
#pragma unroll
                for (int j = 0; j < 4; ++j) { ga[n][j] = qkg[which * 64 + 32 * axis + f0 + 4 * n + j]; gb[n][j] = qkg[which * 64 + 32 * axis + 16 + f0 + 4 * n + j]; }
#pragma unroll
            for (int ai = 0; ai < 2; ++ai)
#pragma unroll
                for (int m = 0; m < 4; ++m) {
                    const int r = 128 * ai + 64 * wr + 16 * m + fr;
                    float ss = 0.f;
#pragma unroll
                    for (int bj = 0; bj < 2; ++bj)
#pragma unroll
                        for (int n = 0; n < 2; ++n) { const f32x4 x = acc[ai][bj][m][n]; ss += (x[0] * x[0] + x[1] * x[1]) + (x[2] * x[2] + x[3] * x[3]); }
                    ss += xor16_f(ss); ss = sum32_f(ss);
                    const float rinv = __builtin_amdgcn_rsqf(ss * (1.0f / 64.0f) + 1e-6f);
                    f32x4 cv[2], sv[2];
                    if (!isctx) { const int t = (jt - 1) * 256 + r; const int pos = axis ? (t & 63) : (t >> 6);
                        cv[0] = *(const f32x4*)(ropec + pos * 16 + f0); cv[1] = *(const f32x4*)(ropec + pos * 16 + f0 + 4);
                        sv[0] = *(const f32x4*)(ropes + pos * 16 + f0); sv[1] = *(const f32x4*)(ropes + pos * 16 + f0 + 4); }
                    else { cv[0] = cv[1] = (f32x4){1.f, 1.f, 1.f, 1.f}; sv[0] = sv[1] = (f32x4){0.f, 0.f, 0.f, 0.f}; }
                    float oa[8], ob[8];
#pragma unroll
                    for (int n = 0; n < 2; ++n)
#pragma unroll
                        for (int j = 0; j < 4; ++j) { const float a = acc[ai][0][m][n][j] * rinv * ga[n][j], bb = acc[ai][1][m][n][j] * rinv * gb[n][j];
                            oa[4 * n + j] = (a * cv[n][j] - bb * sv[n][j]) * osc; ob[4 * n + j] = (bb * cv[n][j] + a * sv[n][j]) * osc; }
                    bf16* rowp = Z + (size_t)(u.pm * 256 + r) * INW + u.pn * 256 + 64 * wc + 32 * axis + f0;
                    v4u w; w.x = pg8::cvt_pk_bf16(oa[0], oa[1]); w.y = pg8::cvt_pk_bf16(oa[2], oa[3]); w.z = pg8::cvt_pk_bf16(oa[4], oa[5]); w.w = pg8::cvt_pk_bf16(oa[6], oa[7]);
                    *(v4u*)(rowp) = w;
                    w.x = pg8::cvt_pk_bf16(ob[0], ob[1]); w.y = pg8::cvt_pk_bf16(ob[2], ob[3]); w.z = pg8::cvt_pk_bf16(ob[4], ob[5]); w.w = pg8::cvt_pk_bf16(ob[6], ob[7]);
                    *(v4u*)(rowp + 16) = w;
                }
        }
    }
};
struct EpiRes {
    static constexpr bool PERM = false;
    const float* xin; float* xout; float* hctx; const float* gate; int ntk_full; float* slab; float gsc;
    __device__ __forceinline__ void operator()(const f32x4 (&acc)[2][2][4][2], const pg8::Unit& u, int wr, int wc, int fr, int fq) const {
        const int b = u.pm / TPB, jt = u.pm - b * TPB; const bool isctx = (jt == 0); const int set = isctx ? 2 : b;
        const int col0 = u.pn * 256 + wc * 32 + 4 * fq;
        f32x4 gv[2][2];
#pragma unroll
        for (int bj = 0; bj < 2; ++bj)
#pragma unroll
            for (int n = 0; n < 2; ++n) gv[bj][n] = *(const f32x4*)(gate + set * 6144 + col0 + bj * 128 + n * 16) * gsc;
        const unsigned long long coff = (unsigned long long)(b * CTXL) * DM * 4, loff = (unsigned long long)(b * SEQ + (jt - 1) * 256) * DM * 4;
        const unsigned long long ia = isctx ? (unsigned long long)hctx + coff : (unsigned long long)xin + loff, oa = isctx ? (unsigned long long)hctx + coff : (unsigned long long)xout + loff;
        const GAS char* ib = (const GAS char*)ia; GAS char* ob = (GAS char*)oa;
        const unsigned lo = (unsigned)((64 * wr + fr) * DM + col0) * 4u;
        if (u.nt == ntk_full) {
#pragma unroll
            for (int ai = 0; ai < 2; ++ai)
#pragma unroll
                for (int m = 0; m < 4; ++m) { const unsigned off = lo + (unsigned)(128 * ai + 16 * m) * DM * 4u;
#pragma unroll
                    for (int bj = 0; bj < 2; ++bj)
#pragma unroll
                        for (int n = 0; n < 2; ++n) { const f32x4 xi = *(const GAS f32x4*)(ib + off + (bj * 128 + n * 16) * 4); *(GAS f32x4*)(ob + off + (bj * 128 + n * 16) * 4) = xi + gv[bj][n] * acc[ai][bj][m][n]; }
                    if (m == 3) asm volatile("" ::: "memory"); }
        } else {
            int fr_ = fr; asm volatile("" : "+v"(fr_));
            GAS float* sp = (GAS float*)(slab + (size_t)u.sl * 65536) + (unsigned)((64 * wr + fr_) * 256 + wc * 32 + 4 * fq);
#pragma unroll
            for (int ai = 0; ai < 2; ++ai)
#pragma unroll
                for (int m = 0; m < 4; ++m)
#pragma unroll
                    for (int bj = 0; bj < 2; ++bj)
#pragma unroll
                        for (int n = 0; n < 2; ++n) *(GAS f32x4*)(sp + (128 * ai + 16 * m) * 256 + bj * 128 + n * 16) = gv[bj][n] * acc[ai][bj][m][n];
        }
    }
};
__device__ __forceinline__ float silu_mul(float g, float u) { return g * u * __builtin_amdgcn_rcpf(1.0f + __builtin_amdgcn_exp2f(-1.4426950408889634f * g)); }
struct EpiGlu {
    static constexpr bool PERM = true;
    bf16* H; int ldh; int NT;
    __device__ __forceinline__ void operator()(const f32x4 (&acc)[2][2][4][2], const pg8::Unit& u, int wr, int wc, int fr, int fq) const {
        const int nt = u.pn % NT;
#pragma unroll
        for (int ai = 0; ai < 2; ++ai)
#pragma unroll
            for (int m = 0; m < 4; ++m) { const int r = 128 * ai + 64 * wr + 16 * m + fr; bf16* rowp = H + (size_t)(u.pm * 256 + r) * ldh + nt * 128 + 32 * wc + 8 * fq;
                float o[8];
#pragma unroll
                for (int n = 0; n < 2; ++n)
#pragma unroll
                    for (int j = 0; j < 4; ++j) o[4 * n + j] = silu_mul(acc[ai][0][m][n][j], acc[ai][1][m][n][j]);
                v4u w; w.x = pg8::cvt_pk_bf16(o[0], o[1]); w.y = pg8::cvt_pk_bf16(o[2], o[3]); w.z = pg8::cvt_pk_bf16(o[4], o[5]); w.w = pg8::cvt_pk_bf16(o[6], o[7]);
                *(v4u*)rowp = w; }
    }
};
__device__ __forceinline__ void k_quarter(int ntk, int kq, int& ko, int& nt) {
    const int pairs = ntk >> 1; int start = 0, len = 0;
#pragma unroll
    for (int q = 0; q < 4; ++q) { const int l = (pairs + 3 - q) >> 2; if (q < kq) start += l; if (q == kq) len = l; }
    ko = start * 128; nt = len * 2;
}
struct SplitTailOrder {
    pg8::StaticOrder S; int nN, nmain;
    __device__ __forceinline__ void init(int N, int K, int G, int c) { S.init(NB * SEQ, N, K, G, c); nN = N / 256; nmain = (NB * SEQ / 256) * nN; }
    __device__ __forceinline__ bool next(int i, pg8::Unit& u) const {
        const long L = (long)i * S.G + S.c;
        if (L < nmain) { S.map(L, u); u.pm += 1 + (u.pm >= SEQ / 256 ? 1 : 0); return true; }
        const int Lt = (int)(L - nmain); if (Lt >= 2 * nN * 4) return false;
        const int kq = Lt & 3, r = Lt >> 2; u.pn = r % nN; u.pm = (r / nN) * TPB; k_quarter(S.ntk, kq, u.ko, u.nt); u.sl = ((r / nN) * 4 + u.pn) * 4 + kq; return true;
    }
    __device__ __forceinline__ void a_ready(const pg8::Unit&) const {}
    __device__ __forceinline__ void done(const pg8::Unit&) const {}
};
struct MoeOrder {
    int G, c, NT, tlo, nunits; const LAS int* tab; int ntk;
    __device__ __forceinline__ bool next(int i, pg8::Unit& u) const {
        const int L = i * G + c; if (L >= nunits) return false;
        const int tau = tlo + L / NT, nt = L - (L / NT) * NT;
        int s = 0;
#pragma unroll
        for (int q = 1; q < 16; ++q) s += (tab[q] <= tau) ? 1 : 0;
        u.pm = tau; u.pn = (s & 7) * NT + nt; u.ko = 0; u.nt = ntk; u.sl = -1; return true;
    }
    __device__ __forceinline__ void a_ready(const pg8::Unit&) const {}
    __device__ __forceinline__ void done(const pg8::Unit&) const {}
};
struct MoeDownOrder {
    int G, c, k, nmain, ntailu; const LAS int* tab;
    __device__ __forceinline__ void init(int G_, int c_, int k_, const LAS int* tab_) { G = G_; c = c_; k = k_; tab = tab_; nmain = (tab[64 + 8 * k + 8] - tab[64 + 8 * k]) * 4; ntailu = tab[112 + k] * 16; }
    __device__ __forceinline__ bool next(int i, pg8::Unit& u) const {
        const int L = i * G + c;
        if (L < nmain) { const int mu = tab[64 + 8 * k] + (L >> 2); int s = 0;
#pragma unroll
            for (int q = 1; q < 16; ++q) s += (tab[64 + q] <= mu) ? 1 : 0;
            u.pm = tab[s] + (mu - tab[64 + s]); u.pn = (s & 7) * 4 + (L & 3); u.ko = 0; u.nt = DFE / 64; u.sl = -1; return true; }
        const int Lt = L - nmain; if (Lt >= ntailu) return false;
        const int s = tab[96 + 8 * k + (Lt >> 4)]; u.pm = tab[s + 1] - 1; u.pn = (s & 7) * 4 + ((Lt >> 2) & 3); k_quarter(DFE / 64, Lt & 3, u.ko, u.nt); u.sl = 8 * 16 * k + Lt; return true;
    }
    __device__ __forceinline__ void a_ready(const pg8::Unit&) const {}
    __device__ __forceinline__ void done(const pg8::Unit&) const {}
};
struct EpiMoeDown {
    static constexpr bool PERM = false;
    float* xlat; float* hctx; const float* gate; const int* rtok; const float* rgate; const LAS int* tab; float* slab; float gsc;
    __device__ __forceinline__ void operator()(const f32x4 (&acc)[2][2][4][2], const pg8::Unit& u, int wr, int wc, int fr, int fq) const {
        const int tau = u.pm; int s = 0;
#pragma unroll
        for (int q = 1; q < 16; ++q) s += (tab[q] <= tau) ? 1 : 0;
        const int idx0 = (tau - tab[s]) * 256, cnt = tab[32 + s];
        const int col0 = (u.pn & 3) * 256 + wc * 32 + 4 * fq;
        const bool full = (u.nt == DFE / 64);
        if (full) {
            int Rr[8]; float gt[8]; bool ok[8];
#pragma unroll
            for (int q = 0; q < 8; ++q) { const int idx = idx0 + 128 * (q >> 2) + 64 * wr + 16 * (q & 3) + fr; ok[q] = idx < cnt; const int ic = ok[q] ? idx : idx0;
                Rr[q] = rtok[(size_t)s * SEGCAP + ic]; gt[q] = rgate[(size_t)s * SEGCAP + ic] * gsc; }
#pragma unroll
            for (int rp = 0; rp < 4; ++rp) {
                f32x4 gv[2][2][2], xi[2][2][2]; float* xp[2];
#pragma unroll
                for (int j = 0; j < 2; ++j) { const int q = 2 * rp + j; xp[j] = xrow_out(Rr[q], xlat, hctx) + col0; const float* gp = gate + row_set(Rr[q]) * 6144 + col0;
#pragma unroll
                    for (int bj = 0; bj < 2; ++bj)
#pragma unroll
                        for (int n = 0; n < 2; ++n) { gv[j][bj][n] = *(const f32x4*)(gp + bj * 128 + n * 16); xi[j][bj][n] = *(const f32x4*)(xp[j] + bj * 128 + n * 16); } }
#pragma unroll
                for (int j = 0; j < 2; ++j) { const int q = 2 * rp + j;
                    if (ok[q]) {
#pragma unroll
                        for (int bj = 0; bj < 2; ++bj)
#pragma unroll
                            for (int n = 0; n < 2; ++n) *(f32x4*)(xp[j] + bj * 128 + n * 16) = xi[j][bj][n] + gv[j][bj][n] * gt[q] * acc[q >> 2][bj][q & 3][n]; } }
            }
        } else {
#pragma unroll
        for (int ai = 0; ai < 2; ++ai)
#pragma unroll
            for (int m = 0; m < 4; ++m) { const int idx = idx0 + 128 * ai + 64 * wr + 16 * m + fr;
                if (idx < cnt) { const int R = rtok[(size_t)s * SEGCAP + idx]; const float gt = rgate[(size_t)s * SEGCAP + idx] * gsc;
                    const float* gp = gate + row_set(R) * 6144 + col0;
#pragma unroll
                    for (int bj = 0; bj < 2; ++bj)
#pragma unroll
                        for (int n = 0; n < 2; ++n) { const f32x4 gv = *(const f32x4*)(gp + bj * 128 + n * 16); const f32x4 v = gv * gt * acc[ai][bj][m][n];
                            int fr_ = fr; asm volatile("" : "+v"(fr_));
                            *(GAS f32x4*)((GAS char*)(slab + (size_t)u.sl * 65536) + (unsigned)(((128 * ai + 64 * wr + 16 * m + fr_) * 256 + wc * 32 + 4 * fq + bj * 128 + n * 16) * 4)) = v; } } }
        }
    }
};

__device__ __forceinline__ void transpose_item(const float* colp  , int ldw, int K, bf16* WT, int kb, int n0, int lane) {
    const int hh = lane >> 5, m = lane & 31, k0 = 64 * kb + 32 * hh;
    f32x4 v[32];
#pragma unroll
    for (int i = 0; i < 32; ++i) v[i] = *(const f32x4*)(colp + (size_t)(k0 + i) * ldw);
    bf16* dp = WT + (size_t)(n0 + 4 * m) * K + k0;
#pragma unroll
    for (int jj = 0; jj < 4; ++jj)
#pragma unroll
        for (int h8 = 0; h8 < 4; ++h8) { v4u o; o.x = pk2(v[8 * h8][jj], v[8 * h8 + 1][jj]); o.y = pk2(v[8 * h8 + 2][jj], v[8 * h8 + 3][jj]); o.z = pk2(v[8 * h8 + 4][jj], v[8 * h8 + 5][jj]); o.w = pk2(v[8 * h8 + 6][jj], v[8 * h8 + 7][jj]);
            *(v4u*)(dp + (size_t)jj * K + 8 * h8) = o; }
}
__device__ __forceinline__ int src_in_col(int nd) { const int t = nd >> 8, c = nd & 255; return (t >= 4 && t <= 7) ? (t * 256 + qk_perm(c)) : nd; }

struct Args { const float* in[32]; float* out; unsigned char* ws; int ph_lo, ph_hi; };
constexpr int PTAB_OFF = MISC_OFF + 1024;
__device__ __forceinline__ const float* inptr(LAS unsigned char* lds, int k) {
    const LAS unsigned* p = (const LAS unsigned*)(lds + PTAB_OFF) + 2 * k;
    const unsigned lo = (unsigned)__builtin_amdgcn_readfirstlane((int)p[0]), hi = (unsigned)__builtin_amdgcn_readfirstlane((int)p[1]);
    return (const float*)(const GAS float*)(((unsigned long long)hi << 32) | lo);
}
#define AIN(k) inptr(lds, (k))

__device__ __forceinline__ float block_sum(float v, LAS float* red, int wave, int lane) {
    v = wave_sum(v);
    if (lane == 0) red[wave] = v;
    __syncthreads();
    float s = 0.f;
#pragma unroll
    for (int w = 0; w < NWAVES; ++w) s += red[w];
    __syncthreads();
    return s;
}

__device__ __forceinline__ void phase_prep_a(const Args& a, int li, LAS unsigned char* lds, int G, int bx) {
    const int tid = fresh_tid(), lane = tid & 63, wave = __builtin_amdgcn_readfirstlane(tid >> 6);
    const int gw = bx * NWAVES + wave, NGW = G * NWAVES;
    unsigned char* ws = fresh_ptr(a.ws);
    const bool moe = (li & 1) != 0; const int lj = li >> 1;
    {
        bf16* win_t = (bf16*)(ws + WS_WIN); bf16* wout_t = (bf16*)(ws + WS_WOUT); bf16* wup_t = (bf16*)(ws + WS_WUP); bf16* wdn_t = (bf16*)(ws + WS_WDN);
        const float* w_in = AIN(8) + (size_t)li * DM * INW; const float* w_out = AIN(9) + (size_t)li * DM * DM;
        constexpr int I_IN = 16 * 20, I_OUT = 16 * 8, I_UPD = 16 * 44, I_DND = 44 * 8, I_UPE = 16 * 56, I_DNE = 56 * 8;
        const int NIT = moe ? (I_IN + I_OUT + NEXP * (I_UPE + I_DNE)) : (I_IN + I_OUT + I_UPD + I_DND);
        const int m4 = 4 * (lane & 31);
        for (int it = gw; it < NIT; it += NGW) {
            int r = it;
            if (r < I_IN) { const int nb = r % 20; transpose_item(w_in + src_in_col(128 * nb + m4), INW, DM, win_t, r / 20, 128 * nb, lane); continue; } r -= I_IN;
            if (r < I_OUT) { const int nb = r % 8; transpose_item(w_out + 128 * nb + m4, DM, DM, wout_t, r / 8, 128 * nb, lane); continue; } r -= I_OUT;
            if (!moe) {
                if (r < I_UPD) { const int nb = r % 44; const float* W = (nb & 1) ? AIN(26) : AIN(25);
                    transpose_item(W + (size_t)lj * DM * DFF + (nb >> 1) * 128 + m4, DFF, DM, wup_t, r / 44, 128 * nb, lane); continue; } r -= I_UPD;
                { const int nb = r % 8; transpose_item(AIN(27) + (size_t)lj * DFF * DM + 128 * nb + m4, DM, DFF, wdn_t, r / 8, 128 * nb, lane); }
            } else {
                if (r < NEXP * I_UPE) { const int e = r / I_UPE, r2 = r % I_UPE, nb = r2 % 56; const size_t wo = (size_t)(lj * NEXP + e) * DM * DFE;
                    const float* W = (nb & 1) ? AIN(30) : AIN(29);
                    transpose_item(W + wo + (nb >> 1) * 128 + m4, DFE, DM, wup_t + (size_t)e * 2 * DFE * DM, r2 / 56, 128 * nb, lane); continue; } r -= NEXP * I_UPE;
                const int e = r / I_DNE, r2 = r % I_DNE, nb = r2 % 8;
                transpose_item(AIN(31) + (size_t)(lj * NEXP + e) * DFE * DM + 128 * nb + m4, DM, DFE, wdn_t + (size_t)e * DM * DFE, r2 / 8, 128 * nb, lane);
            }
        }
    }
    if (li == 0) for (int l = 0; l < DEPTH; ++l) {
        const float* w1 = AIN(14) + l * 33 * 64; const float* w2 = AIN(17) + l * 64 * 64;
        const float bb1 = AIN(15)[l * 64 + lane], ff1 = AIN(16)[l * 64 + lane], bb2 = AIN(18)[l * 64 + lane], ff2 = AIN(19)[l * 64 + lane];
        float w1c[33], w2c[64];
#pragma unroll
        for (int q = 0; q < 33; ++q) w1c[q] = w1[q * 64 + lane];
#pragma unroll
        for (int q = 0; q < 64; ++q) w2c[q] = w2[q * 64 + lane];
        bf16* H2B = (bf16*)(ws + WS_H2B) + (size_t)l * (SEQ + CTXL) * 64;
        for (int tt = gw; tt < SEQ + CTXL; tt += NGW) {
            const int L = tt < SEQ ? SEQ : CTXL, t = tt < SEQ ? tt : tt - SEQ;
            float feat = 0.f;
            if (lane == 0) feat = (float)t / (float)(L - 1);
            else if (lane <= 32) { const int jb = (lane - 1) & 15; const float rev = (float)((jb * t) & (L - 1)) / (float)L + 1e-4f * (1.0f - (float)jb * (1.0f / 15.0f)) * (float)t / (float)L;
                feat = lane <= 16 ? __builtin_amdgcn_cosf(__builtin_amdgcn_fractf(rev)) : -__builtin_amdgcn_sinf(__builtin_amdgcn_fractf(rev)); }
            float z1 = 0.f;
#pragma unroll
            for (int q = 0; q < 33; ++q) z1 += __builtin_bit_cast(float, __builtin_amdgcn_readlane(__builtin_bit_cast(int, feat), q)) * w1c[q];
            const float h1 = sin_rad(ff1 * (z1 + bb1));
            float z2 = 0.f;
#pragma unroll
            for (int q = 0; q < 64; ++q) z2 += __builtin_bit_cast(float, __builtin_amdgcn_readlane(__builtin_bit_cast(int, h1), q)) * w2c[q];
            H2B[(size_t)tt * 64 + lane] = (bf16)f2bf(sin_rad(ff2 * (z2 + bb2)));
        }
    }
    if (li == 0) {
        __syncthreads();
        LAS float* sv = (LAS float*)lds;
        for (int idx = tid; idx < 3 * DM; idx += NTHR) { const int s = idx >> 10, k = idx & 1023; const float v = s < 2 ? AIN(1)[s * DM + k] : AIN(3)[k];
            sv[idx] = v * __builtin_amdgcn_rcpf(1.0f + __builtin_amdgcn_exp2f(-1.4426950408889634f * v)); }
        __syncthreads();
        float* MODP = (float*)(ws + WS_MODP);
        for (int it = bx; it < 4 * 8 * 12; it += G) {
            const int l = it / 96, q = (it / 12) & 7, jc = it % 12, j = jc * 512 + tid;
            const float* wp = AIN(4) + ((size_t)l * DM + q * 128) * 6144 + j;
            float a0 = 0.f, a1 = 0.f, a2 = 0.f;
#pragma unroll 8
            for (int k = 0; k < 128; ++k) { const float w = wp[(size_t)k * 6144]; a0 += sv[q * 128 + k] * w; a1 += sv[DM + q * 128 + k] * w; a2 += sv[2 * DM + q * 128 + k] * w; }
            float* dp = MODP + (size_t)((q * 4 + l) * 3) * 6144 + j;
            dp[0] = a0; dp[6144] = a1; dp[2 * 6144] = a2;
        }
        const int gid = bx * NTHR + tid;
        if (gid < 4096) { const int pos = gid >> 4, f = gid & 15; const float inv = __builtin_amdgcn_exp2f(-(float)f * 0.83048202372184059f);
            const float rev = (float)pos * inv * 0.15915494309189535f; float* RT = (float*)(ws + WS_ROPE);
            RT[gid] = __builtin_amdgcn_cosf(__builtin_amdgcn_fractf(rev)); RT[4096 + gid] = __builtin_amdgcn_sinf(__builtin_amdgcn_fractf(rev)); }
        const f32x4* cs = (const f32x4*)AIN(2); f32x4* cd = (f32x4*)(ws + WS_HCTX);
        for (int idx = gid; idx < NB * CTXL * DM / 4; idx += G * NTHR) cd[idx] = cs[idx];
        __syncthreads();
    }
}

__device__ __forceinline__ int fidx(int i) { return i + (i >> 7); }
__device__ __forceinline__ void fft4_index(int b, int q, int& i, int& j) {
    if (q >= 64) { j = b & (q - 1); i = ((b & ~(q - 1)) << 2) + j; }
    else { const int rr = b & 127, qq = b >> 7; j = qq & (q - 1); i = rr * 128 + ((qq & ~(q - 1)) << 2) + j; }
}
__device__ __forceinline__ f32x2 cmulf(f32x2 a, f32x2 w) { return (f32x2){a.x * w.x - a.y * w.y, a.x * w.y + a.y * w.x}; }
__device__ __forceinline__ void fft4_pass_fwd(LAS f32x2* X, int tid, int p) {
    const int h = 8192 >> (2 * p), q = h >> 1; const float inv2h = 0.5f / (float)h;
#pragma unroll 2
    for (int r = 0; r < 8; ++r) { int i, j; fft4_index(tid + NTHR * r, q, i, j);
        const float ang = (float)j * inv2h; const f32x2 w1 = {__builtin_amdgcn_cosf(ang), -__builtin_amdgcn_sinf(ang)}; const f32x2 w2 = cmulf(w1, w1);
        const int i0 = fidx(i), i1 = fidx(i + q), i2 = fidx(i + 2 * q), i3 = fidx(i + 3 * q);
        const f32x2 x0 = X[i0], x1 = X[i1], x2 = X[i2], x3 = X[i3];
        const f32x2 a0 = x0 + x2, a1 = x1 + x3, d02 = cmulf(x0 - x2, w1), t13 = cmulf(x1 - x3, w1); const f32x2 d13 = {t13.y, -t13.x};
        X[i0] = a0 + a1; X[i1] = cmulf(a0 - a1, w2); X[i2] = d02 + d13; X[i3] = cmulf(d02 - d13, w2); }
    __syncthreads();
}
__device__ __forceinline__ void fft4_pass_inv(LAS f32x2* X, int tid, int p) {
    const int h = 8192 >> (2 * p), q = h >> 1; const float inv2h = 0.5f / (float)h;
#pragma unroll 2
    for (int r = 0; r < 8; ++r) { int i, j; fft4_index(tid + NTHR * r, q, i, j);
        const float ang = (float)j * inv2h; const f32x2 w1 = {__builtin_amdgcn_cosf(ang), __builtin_amdgcn_sinf(ang)}; const f32x2 w2 = cmulf(w1, w1);
        const int i0 = fidx(i), i1 = fidx(i + q), i2 = fidx(i + 2 * q), i3 = fidx(i + 3 * q);
        const f32x2 b0 = X[i0], b1 = X[i1], b2 = X[i2], b3 = X[i3];
        const f32x2 t1 = cmulf(b1, w2), t3 = cmulf(b3, w2); const f32x2 a0 = b0 + t1, a1 = b0 - t1, a2 = b2 + t3, a3 = b2 - t3;
        const f32x2 u2 = cmulf(a2, w1), v3 = cmulf(a3, w1); const f32x2 u3 = {-v3.y, v3.x};
        X[i0] = a0 + u2; X[i2] = a0 - u2; X[i1] = a1 + u3; X[i3] = a1 - u3; }
    __syncthreads();
}
__device__ __forceinline__ void fft16_index(int g, int q, int& i0, int& j0) {
    const int qp = q >> 2;
    if (qp >= 64) { j0 = g & (qp - 1); i0 = ((g & ~(qp - 1)) << 4) + j0; }
    else { const int rr = g & 127, gq = g >> 7; j0 = gq & (qp - 1); i0 = rr * 128 + ((gq & ~(qp - 1)) << 4) + j0; }
}
__device__ __forceinline__ void bfly_fwd(f32x2& x0, f32x2& x1, f32x2& x2, f32x2& x3, f32x2 w1, f32x2 w2) {
    const f32x2 a0 = x0 + x2, a1 = x1 + x3, d02 = cmulf(x0 - x2, w1), t13 = cmulf(x1 - x3, w1); const f32x2 d13 = {t13.y, -t13.x};
    x0 = a0 + a1; x1 = cmulf(a0 - a1, w2); x2 = d02 + d13; x3 = cmulf(d02 - d13, w2);
}
__device__ __forceinline__ void bfly_inv(f32x2& b0, f32x2& b1, f32x2& b2, f32x2& b3, f32x2 w1, f32x2 w2) {
    const f32x2 t1 = cmulf(b1, w2), t3 = cmulf(b3, w2); const f32x2 a0 = b0 + t1, a1 = b0 - t1, a2 = b2 + t3, a3 = b2 - t3;
    const f32x2 u2 = cmulf(a2, w1), v3 = cmulf(a3, w1); const f32x2 u3 = {-v3.y, v3.x};
    b0 = a0 + u2; b2 = a0 - u2; b1 = a1 + u3; b3 = a1 - u3;
}
template <bool INV, int P> __device__ __forceinline__ void fft16_pass(LAS f32x2* X, int tid) {
    constexpr int h = 8192 >> (2 * P), q = h >> 1, qp = q >> 2; constexpr float inv2h = 0.5f / (float)h;
    constexpr float sg = INV ? 1.0f : -1.0f;
#pragma unroll 1
    for (int r = 0; r < 2; ++r) { int i0, j0; fft16_index(tid + NTHR * r, q, i0, j0);
        const float ang = (float)j0 * inv2h; const f32x2 w10 = {__builtin_amdgcn_cosf(ang), sg * __builtin_amdgcn_sinf(ang)};
        f32x2 v[4][4];
#pragma unroll
        for (int a = 0; a < 4; ++a)
#pragma unroll
            for (int b = 0; b < 4; ++b) v[a][b] = X[fidx(i0 + a * q + b * qp)];
        const f32x2 w20 = cmulf(w10, w10), w1p = cmulf(w20, w20), w2p = cmulf(w1p, w1p);
        float k1 = 0.92387953251128674f, k2 = 0.38268343236508977f, k3 = 0.70710678118654752f;
        asm volatile("" : "+v"(k1), "+v"(k2), "+v"(k3));
        const f32x2 c1 = {k1, sg * k2}, c2 = {k3, sg * k3}, c3 = {k2, sg * k1};
        const f32x2 w1b[4] = {w10, cmulf(w10, c1), cmulf(w10, c2), cmulf(w10, c3)};
        if (!INV) {
#pragma unroll
            for (int b = 0; b < 4; ++b) bfly_fwd(v[0][b], v[1][b], v[2][b], v[3][b], w1b[b], cmulf(w1b[b], w1b[b]));
#pragma unroll
            for (int a = 0; a < 4; ++a) bfly_fwd(v[a][0], v[a][1], v[a][2], v[a][3], w1p, w2p);
        } else {
#pragma unroll
            for (int a = 0; a < 4; ++a) bfly_inv(v[a][0], v[a][1], v[a][2], v[a][3], w1p, w2p);
#pragma unroll
            for (int b = 0; b < 4; ++b) bfly_inv(v[0][b], v[1][b], v[2][b], v[3][b], w1b[b], cmulf(w1b[b], w1b[b]));
        }
#pragma unroll
        for (int a = 0; a < 4; ++a)
#pragma unroll
            for (int b = 0; b < 4; ++b) X[fidx(i0 + a * q + b * qp)] = v[a][b]; }
    __syncthreads();
}
__device__ __forceinline__ void fft_fwd(LAS f32x2* X, int tid) {
    fft16_pass<false, 0>(X, tid); fft16_pass<false, 2>(X, tid); fft16_pass<false, 4>(X, tid); fft4_pass_fwd(X, tid, 6);
}
__device__ __forceinline__ void fft_inv(LAS f32x2* X, int tid) {
    fft4_pass_inv(X, tid, 6); fft16_pass<true, 4>(X, tid); fft16_pass<true, 2>(X, tid); fft16_pass<true, 0>(X, tid);
}
__device__ __forceinline__ int brev14(int k) { return (int)(__builtin_bitreverse32((unsigned)k) >> 18); }
__device__ __forceinline__ void pair_slots(int r, int& j, int& jp, int& k, bool& ev) {
    if (r == 0) { j = 0; jp = 0; k = 0; ev = true; return; }
    if (r == 8192) { j = 1; jp = 1; k = 8192; ev = true; return; }
    const int hb = 31 - __builtin_clz((unsigned)r), base = 2 << hb; j = base + (r - (1 << hb)); jp = 3 * base - 1 - j; ev = (j & 1) == 0; k = brev14(ev ? j : jp);
}
constexpr int FFT_AUX = 133120;

__device__ __forceinline__ void phase_prep_b(const Args& a, int li, LAS unsigned char* lds, int G, int bx) {
    const int tid = fresh_tid(), lane = tid & 63, wave = __builtin_amdgcn_readfirstlane(tid >> 6);
    unsigned char* ws = fresh_ptr(a.ws);
    if (li == 0) {
        const float* MODP = (const float*)(ws + WS_MODP); float* MOD = (float*)(ws + WS_MOD);
        for (int idx = bx * NTHR + tid; idx < 4 * 3 * 6144; idx += G * NTHR) { const int l = idx / 18432, j = idx % 6144; float s = AIN(5)[l * 6144 + j];
#pragma unroll
            for (int q = 0; q < 8; ++q) s += MODP[(size_t)q * 73728 + idx];
            MOD[idx] = s; }
    }
    LAS f32x2* X = (LAS f32x2*)lds; LAS float* Xf = (LAS float*)lds;
    LAS float* w3c = (LAS float*)(lds + FFT_AUX); LAS float* red = w3c + 128; LAS float* kc = (LAS float*)(lds + FFT_AUX + 1024);
    const bf16* H2 = (const bf16*)(ws + WS_H2B) + (size_t)li * (SEQ + CTXL) * 64; const bf16* H2C = H2 + (size_t)SEQ * 64;
    const float* w3 = AIN(20) + (size_t)li * 64 * 512;
    const float min_decay = 3.0701134573253945f, max_decay = 15.350567286626973f;
    const bool coop = (G == 256);
    const int xg = bx & 7, mi = bx >> 3;
    float* FT = (float*)(ws + WS_Z) + (size_t)xg * 64 * SEQ;
    if (coop) {
        const int r16 = lane & 15, g4 = lane >> 4, t0 = 512 * mi + 64 * wave;
        bf16x8 wf[4][2], hf[4][2];
#pragma unroll
        for (int blk = 0; blk < 4; ++blk)
#pragma unroll
            for (int ks = 0; ks < 2; ++ks) hf[blk][ks] = *(const bf16x8*)(H2 + (size_t)(t0 + 16 * blk + r16) * 64 + 8 * g4 + 32 * ks);
#pragma unroll
        for (int tau = 0; tau < 4; ++tau)
#pragma unroll
            for (int ks = 0; ks < 2; ++ks) { v4u w; const int o = 16 * tau + r16, col = (o & 1) * 256 + 32 * xg + (o >> 1);
#pragma unroll
                for (int j2 = 0; j2 < 4; ++j2) { const int kk = 32 * ks + 8 * g4 + 2 * j2; w[j2] = pk2(w3[kk * 512 + col], w3[(kk + 1) * 512 + col]); }
                wf[tau][ks] = __builtin_bit_cast(bf16x8, w); }
#pragma unroll
        for (int tau = 0; tau < 4; ++tau)
#pragma unroll
            for (int blk = 0; blk < 4; ++blk) { f32x4 acc = {0.f, 0.f, 0.f, 0.f};
#pragma unroll
                for (int ks = 0; ks < 2; ++ks) acc = __builtin_amdgcn_mfma_f32_16x16x32_bf16(hf[blk][ks], wf[tau][ks], acc, 0, 0, 0);
                *(f32x4*)(FT + (size_t)(16 * tau + r16) * SEQ + t0 + 16 * blk + 4 * g4) = acc; }
        asm volatile("s_waitcnt vmcnt(0)" ::: "memory");
        __syncthreads();
        if (tid == 0) { unsigned* cnt = (unsigned*)(ws + WS_CTL) + CW_MOECNT + li * 8 + xg;
            __builtin_amdgcn_fence(__ATOMIC_RELEASE, "agent"); (void)xb_add(cnt, 1u);
            unsigned sp = 0; while (xb_ld(cnt) < 32u) { __builtin_amdgcn_s_sleep(1); if (++sp > (1u << 22)) break; }
            __builtin_amdgcn_fence(__ATOMIC_ACQUIRE, "agent"); }
        __syncthreads();
    }
    for (int c0 = bx; c0 < 256; c0 += G) { const int c = G == 256 ? (((c0 & 7) << 5) | (c0 >> 3)) : c0;
        if (tid < 128) w3c[tid] = w3[(tid & 63) * 512 + (tid >> 6) * 256 + c];
        __syncthreads();
        const float delta = min_decay + (float)c * ((max_decay - min_decay) / 255.0f);
        float asum = 0.f;
        if (coop) {
            const float* ff = FT + (size_t)(2 * mi) * SEQ; const float* fb = ff + SEQ;
#pragma unroll 8
            for (int r = 0; r < 32; ++r) { const int t = tid + NTHR * r;
                float df = ff[t], db = fb[t];
                const float dec = __builtin_amdgcn_exp2f(-1.4426950408889634f * delta * ((float)t * (1.0f / 16383.0f)));
                df *= dec; db *= dec;
                Xf[2 * fidx(t >> 1) + (t & 1)] = df; asum += __builtin_fabsf(df);
                if (t >= 1) { const int n = 32768 - t; Xf[2 * fidx(n >> 1) + (n & 1)] = db; asum += __builtin_fabsf(db); } }
        } else
        {
            const int r16 = lane & 15, g4 = lane >> 4;
            bf16x8 af[4][2];
#pragma unroll
            for (int i = 0; i < 4; ++i)
#pragma unroll
                for (int ks = 0; ks < 2; ++ks) { v4u w;
#pragma unroll
                    for (int j2 = 0; j2 < 4; ++j2) { const int kk = 32 * ks + 8 * g4 + 2 * j2;
                        const float lo = r16 == 4 * i ? w3c[kk] : (r16 == 4 * i + 1 ? w3c[64 + kk] : 0.f), hi = r16 == 4 * i ? w3c[kk + 1] : (r16 == 4 * i + 1 ? w3c[64 + kk + 1] : 0.f);
                        w[j2] = pk2(lo, hi); }
                    af[i][ks] = __builtin_bit_cast(bf16x8, w); }
#pragma unroll 2
            for (int r = 0; r < 32; ++r) { const int t = tid + NTHR * r, t0 = t - lane;
                f32x4 acc = {0.f, 0.f, 0.f, 0.f};
#pragma unroll
                for (int i = 0; i < 4; ++i)
#pragma unroll
                    for (int ks = 0; ks < 2; ++ks) { const bf16x8 hb8 = *(const bf16x8*)(H2 + (size_t)(t0 + 16 * i + r16) * 64 + 8 * g4 + 32 * ks);
                        acc = __builtin_amdgcn_mfma_f32_16x16x32_bf16(af[i][ks], hb8, acc, 0, 0, 0); }
                float df = acc[0], db = acc[1];
                const float dec = __builtin_amdgcn_exp2f(-1.4426950408889634f * delta * ((float)t * (1.0f / 16383.0f)));
                df *= dec; db *= dec;
                Xf[2 * fidx(t >> 1) + (t & 1)] = df; asum += __builtin_fabsf(df);
                if (t >= 1) { const int n = 32768 - t; Xf[2 * fidx(n >> 1) + (n & 1)] = db; asum += __builtin_fabsf(db); } }
        }
        if (tid == 0) Xf[2 * fidx(8192)] = 0.f;
        const float S1 = block_sum(asum, red, wave, lane);
        fft_fwd(X, tid);
        const float scale = 1.0f / (S1 * 16384.0f);
        f32x4* HF = (f32x4*)(ws + WS_HF) + (size_t)c * 8193;
        for (int r = tid; r <= 8192; r += NTHR) {
            int j, jp, k; bool ev; pair_slots(r, j, jp, k, ev);
            const f32x2 P = X[fidx(j)], Q = X[fidx(jp)]; const f32x2 A = ev ? P : Q, B = ev ? Q : P; f32x4 o;
            if (k == 0) o = (f32x4){A.x + A.y, 0.f, A.x - A.y, 0.f};
            else { const float Ex = 0.5f * (A.x + B.x), Ey = 0.5f * (A.y - B.y), Ox = 0.5f * (A.y + B.y), Oy = -0.5f * (A.x - B.x);
                const float ang = (float)k * (1.0f / 32768.0f), wc = __builtin_amdgcn_cosf(ang), wsn = -__builtin_amdgcn_sinf(ang);
                const float px = Ox * wc - Oy * wsn, py = Ox * wsn + Oy * wc;
                o = (f32x4){Ex + px, Ey + py, Ex - px, -(Ey - py)}; }
            HF[r] = o * scale; }
        __syncthreads();
        float as2 = 0.f;
        if (tid < CTXL) { const int t = tid; const v4u* hr = (const v4u*)(H2C + (size_t)t * 64); float df = 0.f, db = 0.f;
#pragma unroll
            for (int q = 0; q < 8; ++q) { const v4u hw = hr[q];
#pragma unroll
                for (int e = 0; e < 4; ++e) { const float h0 = __builtin_bit_cast(float, hw[e] << 16), h1 = __builtin_bit_cast(float, hw[e] & 0xffff0000u);
                    df += h0 * w3c[8 * q + 2 * e] + h1 * w3c[8 * q + 2 * e + 1]; db += h0 * w3c[64 + 8 * q + 2 * e] + h1 * w3c[64 + 8 * q + 2 * e + 1]; } }
            const float dec = __builtin_amdgcn_exp2f(-1.4426950408889634f * delta * ((float)t * (1.0f / 255.0f)));
            df *= dec; db *= dec; kc[t] = df; as2 += __builtin_fabsf(df);
            if (t >= 1) { kc[512 - t] = db; as2 += __builtin_fabsf(db); } else kc[256] = 0.f; }
        const float S2 = block_sum(as2, red, wave, lane);
        ((float*)(ws + WS_KCTX))[(size_t)c * 512 + tid] = kc[tid] / S2;
        __syncthreads();
    }
}

__device__ __forceinline__ void norm_load(const float* xr, int lane, f32x4 (&v)[4]) {
    const f32x4* xp = (const f32x4*)xr + lane;
#pragma unroll
    for (int j = 0; j < 4; ++j) v[j] = xp[64 * j];
}
__device__ __forceinline__ void norm_finish(f32x4 (&v)[4], const float* xr, const float* modl, int set, int which, const f32x4 (&g)[4], int lane, bf16* dst, f32x4 (&o)[4], const float* pend = nullptr) {
    float ss = 0.f;
#pragma unroll
    for (int j = 0; j < 4; ++j) {
        if (pend) { const f32x4* pp = (const f32x4*)(pend + (size_t)j * 4 * 65536) + lane; v[j] = (((v[j] + pp[0]) + pp[16384]) + pp[2 * 16384]) + pp[3 * 16384]; ((f32x4*)xr)[lane + 64 * j] = v[j]; }
        ss += (v[j].x * v[j].x + v[j].y * v[j].y) + (v[j].z * v[j].z + v[j].w * v[j].w); }
    const float rinv = __builtin_amdgcn_rsqf(wave_sum(ss) * (1.0f / DM) + 1e-6f);
    const f32x4* sh = (const f32x4*)(modl + set * 6144 + which * DM) + lane; const f32x4* sc = (const f32x4*)(modl + set * 6144 + (which + 1) * DM) + lane;
    v2u* dp = (v2u*)dst + lane;
#pragma unroll
    for (int j = 0; j < 4; ++j) { const f32x4 y = v[j] * rinv * g[j]; o[j] = y * (sc[64 * j] + 1.0f) + sh[64 * j];
        v2u w; w.x = pk2(o[j].x, o[j].y); w.y = pk2(o[j].z, o[j].w); dp[64 * j] = w; }
}
__device__ __forceinline__ const float* ctx_pending(const Args& a, int R) {
    const int b = R / RB, rr = R - b * RB; return rr < CTXL ? (const float*)(fresh_ptr(a.ws) + WS_SLAB) + (size_t)b * 16 * 65536 + rr * 256 : nullptr; }
__device__ __forceinline__ void norm_finish_lds(f32x4 (&v)[4], const float* xr, const LAS f32x4* mt, int set, const f32x4 (&g)[4], int lane, bf16* dst, const float* pend) {
    float ss = 0.f;
#pragma unroll
    for (int j = 0; j < 4; ++j) {
        if (pend) { const f32x4* pp = (const f32x4*)(pend + (size_t)j * 4 * 65536) + lane; v[j] = (((v[j] + pp[0]) + pp[16384]) + pp[2 * 16384]) + pp[3 * 16384]; ((f32x4*)xr)[lane + 64 * j] = v[j]; }
        ss += (v[j].x * v[j].x + v[j].y * v[j].y) + (v[j].z * v[j].z + v[j].w * v[j].w); }
    const float rinv = __builtin_amdgcn_rsqf(wave_sum(ss) * (1.0f / DM) + 1e-6f);
    const LAS f32x4* sh = mt + set * 512 + lane; const LAS f32x4* sc = sh + 256;
    v2u* dp = (v2u*)dst + lane;
#pragma unroll
    for (int j = 0; j < 4; ++j) { const f32x4 y = v[j] * rinv * g[j]; const f32x4 o = y * (sc[64 * j] + 1.0f) + sh[64 * j];
        v2u w; w.x = pk2(o.x, o.y); w.y = pk2(o.z, o.w); dp[64 * j] = w; }
}
__device__ __forceinline__ void phase_norm(const Args& a, int li, int which  , const float* xlat, LAS unsigned char* lds, int G, int bx) {
    const int tid = fresh_tid(), lane = tid & 63, wave = __builtin_amdgcn_readfirstlane(tid >> 6);
    const int gw = bx * NWAVES + wave, NGW = G * NWAVES;
    unsigned char* ws = fresh_ptr(a.ws); const float* modl = (const float*)(ws + WS_MOD) + (size_t)li * 3 * 6144; const float* hctx = (const float*)(ws + WS_HCTX);
    const float* gsrc = (which == 0 ? AIN(6) : AIN(7)) + li * DM; bf16* XN = (bf16*)(ws + WS_XN);
    LAS f32x4* mt = (LAS f32x4*)lds;
    __syncthreads();
    for (int idx = tid; idx < 3 * 512; idx += NTHR) { const int set = idx >> 9, rem = idx & 511; mt[idx] = ((const f32x4*)(modl + set * 6144 + which * DM))[rem]; }
    f32x4 g[4];
#pragma unroll
    for (int j = 0; j < 4; ++j) g[j] = ((const f32x4*)gsrc)[lane + 64 * j];
    __syncthreads();
    const bool pending = (which == 3) || (li & 1);
    constexpr int NR = 9;
    for (int R = gw; R < MROWS; R += NR * NGW) {
        f32x4 v[NR][4]; const float* xr[NR]; int Rq[NR];
#pragma unroll
        for (int q = 0; q < NR; ++q) { Rq[q] = R + q * NGW; xr[q] = xrow_in(Rq[q] < MROWS ? Rq[q] : R, xlat, hctx); norm_load(xr[q], lane, v[q]); }
#pragma unroll
        for (int q = 0; q < NR; ++q) if (Rq[q] < MROWS) norm_finish_lds(v[q], xr[q], mt, row_set(Rq[q]), g, lane, XN + (size_t)Rq[q] * DM, pending ? ctx_pending(a, Rq[q]) : nullptr); }
    __syncthreads();
}
__device__ __forceinline__ void phase_norm_router(const Args& a, int li, const float* xlat, LAS unsigned char* lds, int G, int bx) {
    const int tid = fresh_tid(), lane = tid & 63, wave = __builtin_amdgcn_readfirstlane(tid >> 6);
    unsigned char* ws = fresh_ptr(a.ws); const float* modl = (const float*)(ws + WS_MOD) + (size_t)li * 3 * 6144; const float* hctx = (const float*)(ws + WS_HCTX);
    const float* gsrc = AIN(7) + li * DM; bf16* XN = (bf16*)(ws + WS_XN); const int lj = li >> 1;
    const float* rw = AIN(28) + (size_t)lj * DM * NEXP;
    LAS float* rwT = (LAS float*)lds;
    LAS int* re = (LAS int*)(lds + 32768);
    LAS float* rg = (LAS float*)(lds + 32768 + 2048);
    LAS int* lcnt = (LAS int*)(lds + 32768 + 4096);
    for (int idx = tid; idx < DM * NEXP; idx += NTHR) rwT[(idx & 7) * DM + (idx >> 3)] = rw[idx];
    LAS f32x4* mt = (LAS f32x4*)(lds + 40960);
    for (int idx = tid; idx < 3 * 512; idx += NTHR) { const int set = idx >> 9, rem = idx & 511; mt[idx] = ((const f32x4*)(modl + set * 6144 + 3 * DM))[rem]; }
    if (tid < 32) lcnt[tid] = 0;
    __syncthreads();
    const int RPB = (MROWS + G - 1) / G; const bool ilv = (MROWS % G) == 0; const int R0 = ilv ? bx : bx * RPB, RS = ilv ? G : 1;
    int nrows = ilv ? RPB : MROWS - R0; nrows = nrows > RPB ? RPB : nrows; nrows = nrows < 0 ? 0 : nrows;
    f32x4 g[4];
#pragma unroll
    for (int j = 0; j < 4; ++j) g[j] = ((const f32x4*)gsrc)[lane + 64 * j];
    f32x4 rwv[8][4];
#pragma unroll
    for (int e = 0; e < 8; ++e)
#pragma unroll
        for (int j = 0; j < 4; ++j) rwv[e][j] = *(const LAS f32x4*)(rwT + e * DM + 4 * lane + 256 * j);
    const bool lb0 = (lane & 1) != 0, lb1 = (lane & 2) != 0, lb2 = (lane & 4) != 0;
    f32x4 vnext[4];
    if (wave < nrows) norm_load(xrow_in(R0 + RS * wave, xlat, hctx), lane, vnext);
    for (int i = wave; i < nrows; i += NWAVES) { const int R = R0 + RS * i; f32x4 o[4], v[4];
#pragma unroll
        for (int j = 0; j < 4; ++j) v[j] = vnext[j];
        if (i + NWAVES < nrows) norm_load(xrow_in(R + RS * NWAVES, xlat, hctx), lane, vnext);
        { const float* xr = xrow_in(R, xlat, hctx); const float* pend = ctx_pending(a, R); const int set = row_set(R); float ss = 0.f;
#pragma unroll
          for (int j = 0; j < 4; ++j) {
              if (pend) { const f32x4* pp = (const f32x4*)(pend + (size_t)j * 4 * 65536) + lane; v[j] = (((v[j] + pp[0]) + pp[16384]) + pp[2 * 16384]) + pp[3 * 16384]; ((f32x4*)xr)[lane + 64 * j] = v[j]; }
              ss += (v[j].x * v[j].x + v[j].y * v[j].y) + (v[j].z * v[j].z + v[j].w * v[j].w); }
          const float rinv = __builtin_amdgcn_rsqf(wave_sum(ss) * (1.0f / DM) + 1e-6f);
          const LAS f32x4* sh = mt + set * 512 + lane; const LAS f32x4* sc = sh + 256; v2u* dp = (v2u*)(XN + (size_t)R * DM) + lane;
#pragma unroll
          for (int j = 0; j < 4; ++j) { const f32x4 y = v[j] * rinv * g[j]; o[j] = y * (sc[64 * j] + 1.0f) + sh[64 * j];
              v2u w; w.x = pk2(o[j].x, o[j].y); w.y = pk2(o[j].z, o[j].w); dp[64 * j] = w; } }
        float lg[8];
        {
            float sp[8];
#pragma unroll
            for (int e = 0; e < 8; ++e) { float s2 = 0.f;
#pragma unroll
                for (int j = 0; j < 4; ++j) { const f32x4 w = rwv[e][j]; s2 += (o[j].x * w.x + o[j].y * w.y) + (o[j].z * w.z + o[j].w * w.w); }
                sp[e] = s2; }
            float t4[4], u2[2];
#pragma unroll
            for (int i2 = 0; i2 < 4; ++i2) { const float keep = lb0 ? sp[4 + i2] : sp[i2], snd = lb0 ? sp[i2] : sp[4 + i2]; t4[i2] = keep + xor1_f(snd); }
#pragma unroll
            for (int i2 = 0; i2 < 2; ++i2) { const float keep = lb1 ? t4[2 + i2] : t4[i2], snd = lb1 ? t4[i2] : t4[2 + i2]; u2[i2] = keep + xor2_f(snd); }
            float wv; { const float keep = lb2 ? u2[1] : u2[0], snd = lb2 ? u2[0] : u2[1];
                wv = keep + __builtin_bit_cast(float, __builtin_amdgcn_ds_swizzle(__builtin_bit_cast(int, snd), 0x101F)); }
            wv += dpp_f<0x128>(wv);
            wv += xor16_f(wv); wv = sum32_f(wv);
#pragma unroll
            for (int e = 0; e < 8; ++e) lg[e] = __builtin_bit_cast(float, __builtin_amdgcn_readlane(__builtin_bit_cast(int, wv), (e >> 2) | (((e >> 1) & 1) << 1) | ((e & 1) << 2))); }
        int e0 = 0; float v0 = lg[0];
#pragma unroll
        for (int e = 1; e < 8; ++e) if (lg[e] > v0) { v0 = lg[e]; e0 = e; }
        int e1 = -1; float v1 = -3.0e38f;
#pragma unroll
        for (int e = 0; e < 8; ++e) if (e != e0 && lg[e] > v1) { v1 = lg[e]; e1 = e; }
        if (lane == 0) { re[i] = e0 | (e1 << 8); rg[i] = 1.0f / (1.0f + __expf(v1 - v0)); }
    }
    __syncthreads();
    if (tid < nrows) { const int w = re[tid], e0 = w & 255, e1 = w >> 8; int r0 = 0, r1 = 0;
#pragma unroll 8
        for (int j = 0; j < nrows; ++j) { const int wj = re[j]; r0 += (j < tid && (wj & 255) == e0) ? 1 : 0; r1 += (j < tid && (wj >> 8) == e1) ? 1 : 0; }
        ((int*)(ws + WS_RREC))[R0 + RS * tid] = e0 | (e1 << 4) | (r0 << 8) | (r1 << 20); ((float*)(ws + WS_RRECG))[R0 + RS * tid] = rg[tid]; }
    if (tid < 16) { int c = 0;
#pragma unroll 8
        for (int j = 0; j < nrows; ++j) { const int wj = re[j]; c += ((tid < 8 ? (wj & 255) : (wj >> 8)) == (tid & 7)) ? 1 : 0; }
        ((int*)(ws + WS_CNTB))[bx * 16 + tid] = c; }
    __syncthreads();
}
__device__ __forceinline__ void moe_tables(const Args& a, int lj, LAS unsigned char* lds, int G, int bx) {
    LAS int* tab = (LAS int*)(lds + TAB_OFF); const int tid = fresh_tid(); const int* cntb = (const int*)(fresh_ptr(a.ws) + WS_CNTB);
    if (tid < 16) { tab[32 + tid] = 0; tab[116 + tid] = 0; }
    __syncthreads();
    { const int sg = tid & 15; int c = 0, below = 0;
        for (int b = tid >> 4; b < G; b += NTHR / 16) { const int v = cntb[b * 16 + sg]; c += v; below += b < bx ? v : 0; }
        atomicAdd((int*)(tab + 32 + sg), c); atomicAdd((int*)(tab + 116 + sg), below); }
    __syncthreads();
    if (tid == 0) { int tb = 0, tm = 0, n0 = 0, n1 = 0;
        for (int s = 0; s < 16; ++s) { const int c = tab[32 + s]; const int nt = (c + 255) >> 8;
            tab[s] = tb; tab[64 + s] = tm; tb += nt; tm += nt > 0 ? nt - 1 : 0;
            if (nt > 0) { if (s < 8) tab[96 + n0++] = s; else tab[104 + n1++] = s; } }
        tab[16] = tb; tab[80] = tm; tab[112] = n0; tab[113] = n1; }
    __syncthreads();
    (void)lj;
}
__device__ __forceinline__ void phase_moe_gather(const Args& a, int li, LAS unsigned char* lds, int G, int bx) {
    const int tid = fresh_tid(), lane = tid & 63, wave = __builtin_amdgcn_readfirstlane(tid >> 6);
    moe_tables(a, li >> 1, lds, G, bx);
    const LAS int* tab = (const LAS int*)(lds + TAB_OFF);
    unsigned char* ws = fresh_ptr(a.ws);
    int* rtok = (int*)(ws + WS_RTOK); float* rgate = (float*)(ws + WS_RGATE); const int* rec = (const int*)(ws + WS_RREC); const float* recg = (const float*)(ws + WS_RRECG);
    const bf16* XN = (const bf16*)(ws + WS_XN); bf16* AG = (bf16*)(ws + WS_AG);
    const int RPB = (MROWS + G - 1) / G; const bool ilv = (MROWS % G) == 0; const int R0 = ilv ? bx : bx * RPB, RS = ilv ? G : 1;
    int nrows = ilv ? RPB : MROWS - R0; nrows = nrows > RPB ? RPB : nrows; nrows = nrows < 0 ? 0 : nrows;
    for (int it0 = wave; it0 < 2 * nrows; it0 += 4 * NWAVES) {
        int Rr[4], sg[4], ix[4]; float gg[4]; bool ok[4]; v4u x0[4], x1[4];
#pragma unroll
        for (int u = 0; u < 4; ++u) { const int it = it0 + u * NWAVES; ok[u] = it < 2 * nrows; const int itc = ok[u] ? it : it0; const int k = itc & 1; Rr[u] = R0 + RS * (itc >> 1);
            const int w = rec[Rr[u]]; const float g0 = recg[Rr[u]];
            const int e = k ? ((w >> 4) & 15) : (w & 15), rk = k ? (w >> 20) : ((w >> 8) & 4095); sg[u] = k * 8 + e; ix[u] = tab[116 + sg[u]] + rk; gg[u] = k ? 1.0f - g0 : g0; }
#pragma unroll
        for (int u = 0; u < 4; ++u) { const v4u* sp = (const v4u*)(XN + (size_t)Rr[u] * DM) + lane; x0[u] = sp[0]; x1[u] = sp[64]; }
#pragma unroll
        for (int u = 0; u < 4; ++u) if (ok[u]) {
            if (lane == 0) { rtok[(size_t)sg[u] * SEGCAP + ix[u]] = Rr[u]; rgate[(size_t)sg[u] * SEGCAP + ix[u]] = gg[u]; }
            v4u* dp = (v4u*)(AG + ((size_t)tab[sg[u]] * 256 + ix[u]) * DM) + lane; dp[0] = x0[u]; dp[64] = x1[u]; }
    }
}
__device__ __forceinline__ void phase_moe_fix(const Args& a, int li, int k, LAS unsigned char* lds, int G, int bx) {
    const int tid = fresh_tid(), lane = tid & 63, wave = __builtin_amdgcn_readfirstlane(tid >> 6);
    const int gw = bx * NWAVES + wave, NGW = G * NWAVES;
    moe_tables(a, li >> 1, lds, G, bx);
    const LAS int* tab = (const LAS int*)(lds + TAB_OFF);
    const int nt = tab[112 + k]; const int* rtok = (const int*)(fresh_ptr(a.ws) + WS_RTOK); const float* slab = (const float*)(fresh_ptr(a.ws) + WS_SLAB);
    float* hctx = (float*)(fresh_ptr(a.ws) + WS_HCTX);
    for (int it = gw; it < nt * 256; it += NGW) { const int jl = it >> 8, r = it & 255, s = tab[96 + 8 * k + jl];
        const int idx = (tab[s + 1] - 1 - tab[s]) * 256 + r; if (idx >= tab[32 + s]) continue;
        const int R = rtok[(size_t)s * SEGCAP + idx]; f32x4* xp = (f32x4*)xrow_out(R, a.out, hctx) + lane;
        const f32x4* sp = (const f32x4*)(slab + (size_t)((k * 8 + jl) * 16) * 65536 + r * 256) + lane;
#pragma unroll
        for (int j = 0; j < 4; ++j) { const f32x4* pp = sp + (size_t)j * 4 * 16384; xp[64 * j] = (((xp[64 * j] + pp[0]) + pp[16384]) + pp[2 * 16384]) + pp[3 * 16384]; } }
}

constexpr int PL_ZT = 0, PL_DT = 40960, PL_LIN = 74752;
__device__ __forceinline__ void pool_load_lin(const Args& a, int li, LAS unsigned char* lds) {
    LAS bf16* linT = (LAS bf16*)(lds + PL_LIN); const float* src = AIN(10) + (size_t)li * 4 * 64 * 64;
    for (int idx = fresh_tid(); idx < 4 * 4096; idx += NTHR) { const int g = idx >> 12, c = (idx >> 6) & 63, e = idx & 63; linT[(g * 64 + e) * 72 + c] = (bf16)f2bf(src[idx]); }
    __syncthreads();
}
__device__ __forceinline__ void pool_unit(const Args& a, int li, int p, LAS unsigned char* lds) {
    const int tid = fresh_tid(), lane = tid & 63, r32 = lane & 31, hi = lane >> 5, wave = __builtin_amdgcn_readfirstlane(tid >> 6);
    const bf16* Z = (const bf16*)(fresh_ptr(a.ws) + WS_Z); bf16* Y = (bf16*)(fresh_ptr(a.ws) + WS_Y);
    const int b = p >> 8, t0 = (p & 255) * 64, rowbase = b * RB + CTXL;
    LAS bf16* zt = (LAS bf16*)(lds + PL_ZT); LAS bf16* dt = (LAS bf16*)(lds + PL_DT); const LAS bf16* linT = (const LAS bf16*)(lds + PL_LIN);
    for (int idx = tid; idx < 80 * 32; idx += NTHR) { const int row = idx >> 5, ch8 = idx & 31, t = t0 - 8 + row; v4u w = {0u, 0u, 0u, 0u};
        if (t >= 0 && t < SEQ) w = *(const v4u*)(Z + (size_t)(rowbase + t) * INW + ch8 * 8);
        *(LAS v4u*)(zt + row * 256 + ch8 * 8) = w; }
    __syncthreads();
    { const int ch = tid & 255, th = tid >> 8, hw = 1 << (ch >> 6), tb = t0 + 32 * th; const LAS bf16* zc = zt + ch;
        float s = 0.f;
        for (int q = -hw; q < hw; ++q) s += bf2f(zc[(32 * th + 8 + q) * 256]);
#pragma unroll 4
        for (int tt = 0; tt < 32; ++tt) { const int t = tb + tt, rel = 32 * th + tt + 8; int lo = t - hw; lo = lo < 0 ? 0 : lo; int hq = t + hw; hq = hq > SEQ ? SEQ : hq;
            dt[(32 * th + tt) * 264 + ch] = (bf16)f2bf(s * __builtin_amdgcn_rcpf((float)(hq - lo)) - bf2f(zc[rel * 256]));
            s += bf2f(zc[(rel + hw) * 256]) - bf2f(zc[(rel - hw) * 256]); } }
    __syncthreads();
    { const int g = wave >> 1, th = wave & 1;
        bf16x8 bfr[4], afr[2][4];
#pragma unroll
        for (int ks = 0; ks < 4; ++ks) { bfr[ks] = *(const LAS bf16x8*)(dt + (32 * th + r32) * 264 + g * 64 + 16 * ks + 8 * hi);
#pragma unroll
            for (int mt = 0; mt < 2; ++mt) afr[mt][ks] = *(const LAS bf16x8*)(linT + (g * 64 + 32 * mt + r32) * 72 + 16 * ks + 8 * hi); }
        f32x16 acc[2];
#pragma unroll
        for (int mt = 0; mt < 2; ++mt) {
#pragma unroll
            for (int r = 0; r < 16; ++r) acc[mt][r] = 0.f;
#pragma unroll
            for (int ks = 0; ks < 4; ++ks) acc[mt] = __builtin_amdgcn_mfma_f32_32x32x16_bf16(afr[mt][ks], bfr[ks], acc[mt], 0, 0, 0); }
        const float* ps = AIN(11) + li * 256 + g * 64;
        bf16* yp = Y + (size_t)(rowbase + t0 + 32 * th + r32) * DM + g * 64;
#pragma unroll
        for (int mt = 0; mt < 2; ++mt)
#pragma unroll
            for (int rq = 0; rq < 4; ++rq) { const int e0 = 32 * mt + 8 * rq + 4 * hi; const f32x4 sc = *(const f32x4*)(ps + e0);
                v2u w; w.x = pk2(acc[mt][4 * rq] * sc.x, acc[mt][4 * rq + 1] * sc.y); w.y = pk2(acc[mt][4 * rq + 2] * sc.z, acc[mt][4 * rq + 3] * sc.w);
                *(v2u*)(yp + e0) = w; }
    }
    __syncthreads();
}
__device__ __forceinline__ void pool_ctx_pair(const Args& a, int li, int cp, LAS unsigned char* lds) {
    const int tid = fresh_tid();
    const bf16* Z = (const bf16*)(fresh_ptr(a.ws) + WS_Z); bf16* Y = (bf16*)(fresh_ptr(a.ws) + WS_Y);
    LAS float* dm = (LAS float*)(lds + PL_ZT);
    const int ct = 2 * cp + (tid >> 8), b = ct >> 8, t = ct & 255, ch = tid & 255, hw = 1 << (ch >> 6), rowbase = b * RB;
    int lo = t - hw; lo = lo < 0 ? 0 : lo; int hq = t + hw; hq = hq > CTXL ? CTXL : hq; float s = 0.f;
    for (int q = lo; q < hq; ++q) s += bf2f(Z[(size_t)(rowbase + q) * INW + ch]);
    dm[tid] = s / (float)(hq - lo) - bf2f(Z[(size_t)(rowbase + t) * INW + ch]);
    __syncthreads();
    { const int g = ch >> 6, eo = ch & 63; const float* lin = AIN(10) + (size_t)li * 4 * 64 * 64 + g * 4096 + eo; const LAS float* dr = dm + (tid >> 8) * 256 + g * 64; float acc = 0.f;
#pragma unroll 8
        for (int c = 0; c < 64; ++c) acc += dr[c] * lin[c * 64];
        Y[(size_t)(rowbase + t) * DM + ch] = (bf16)f2bf(acc * AIN(11)[li * 256 + ch]); }
    __syncthreads();
}

__device__ __forceinline__ void sconv2(const bf16* zr, int t0, int L, float w0, float w1, float w2, float sb, float& y0, float& y1) {
    const unsigned pr = *(const unsigned*)(zr + t0); const float z0 = __builtin_bit_cast(float, pr << 16), z1 = __builtin_bit_cast(float, pr & 0xffff0000u);
    const float zm = t0 > 0 ? bf2f(zr[t0 - 1]) : 0.f, zp = (t0 + 2 < L) ? bf2f(zr[t0 + 2]) : 0.f;
    y0 = sb + zm * w0 + z0 * w1 + z1 * w2; y1 = sb + z0 * w0 + z1 * w1 + zp * w2;
}
__device__ __forceinline__ void sconv8(const bf16* zr, int t0, int L, float w0, float w1, float w2, float sb, float (&y)[8]) {
    const v4u w = *(const v4u*)(zr + t0); float z[10];
    z[0] = t0 > 0 ? bf2f(zr[t0 - 1]) : 0.f; z[9] = (t0 + 8 < L) ? bf2f(zr[t0 + 8]) : 0.f;
#pragma unroll
    for (int e = 0; e < 4; ++e) { z[1 + 2 * e] = __builtin_bit_cast(float, w[e] << 16); z[2 + 2 * e] = __builtin_bit_cast(float, w[e] & 0xffff0000u); }
#pragma unroll
    for (int e = 0; e < 8; ++e) y[e] = sb + z[e] * w0 + z[e + 1] * w1 + z[e + 2] * w2;
}
__device__ __forceinline__ void hyena_unit(const Args& a, int li, int cp, int b, LAS unsigned char* lds) {
    const int tid = fresh_tid();
    unsigned char* ws = fresh_ptr(a.ws); const bf16* ZT = (const bf16*)(ws + WS_ZT); const bf16* ZTC = (const bf16*)(ws + WS_ZTC); bf16* Y = (bf16*)(ws + WS_Y);
    const float* sw = AIN(12) + (size_t)li * 3 * 768; const float* sbp = AIN(13) + (size_t)li * 768;
    LAS f32x2* X = (LAS f32x2*)lds;
    float o0[4][8];
    for (int ch = 0; ch < 2; ++ch) {
        const int c = 2 * cp + ch; const float hb = AIN(21)[li * 256 + c];
        const float a0 = sw[c], a1 = sw[768 + c], a2 = sw[1536 + c], ab = sbp[c];
        const float b0 = sw[256 + c], b1 = sw[768 + 256 + c], b2 = sw[1536 + 256 + c], bb = sbp[256 + c];
        const float c0 = sw[512 + c], c1 = sw[768 + 512 + c], c2 = sw[1536 + 512 + c], cb = sbp[512 + c];
        const f32x4* HF = (const f32x4*)(ws + WS_HF) + (size_t)c * 8193;
        const bf16* px0 = ZT + (size_t)(b * 768 + c) * SEQ; const bf16* px1 = ZT + (size_t)(b * 768 + 256 + c) * SEQ; const bf16* pv = ZT + (size_t)(b * 768 + 512 + c) * SEQ;
        float u[4][8];
#pragma unroll
        for (int r = 0; r < 4; ++r) { const int m = tid + NTHR * r; float vv[8], gg[8];
            sconv8(pv, 8 * m, SEQ, c0, c1, c2, cb, vv); sconv8(px1, 8 * m, SEQ, b0, b1, b2, bb, gg);
#pragma unroll
            for (int e = 0; e < 8; ++e) u[r][e] = vv[e] * gg[e];
            const int i0 = fidx(4 * m), i1 = fidx(4 * m + 8192);
#pragma unroll
            for (int q = 0; q < 4; ++q) { X[i0 + q] = (f32x2){u[r][2 * q], u[r][2 * q + 1]}; X[i1 + q] = (f32x2){0.f, 0.f}; } }
        __syncthreads();
        fft_fwd(X, tid);
        for (int k0 = tid; k0 <= 8192; k0 += 4 * NTHR) {
            f32x4 Hq[4];
#pragma unroll
            for (int q = 0; q < 4; ++q) Hq[q] = HF[k0 + q * NTHR <= 8192 ? k0 + q * NTHR : k0];
#pragma unroll
            for (int q = 0; q < 4; ++q) { const int r = k0 + q * NTHR; if (r > 8192) break;
            int j, jp, k; bool ev; pair_slots(r, j, jp, k, ev);
            const int sj = fidx(j), sp = fidx(jp);
            const f32x2 P = X[sj], Q = X[sp]; const f32x2 A = ev ? P : Q, B = ev ? Q : P; const f32x4 H = Hq[q];
            if (k == 0) { const float Y0 = (A.x + A.y) * H.x, YN = (A.x - A.y) * H.z; X[sj] = (f32x2){0.5f * (Y0 + YN), 0.5f * (Y0 - YN)}; }
            else { const float Ex = 0.5f * (A.x + B.x), Ey = 0.5f * (A.y - B.y), Ox = 0.5f * (A.y + B.y), Oy = -0.5f * (A.x - B.x);
                const float ang = (float)k * (1.0f / 32768.0f), wc = __builtin_amdgcn_cosf(ang), wsn = -__builtin_amdgcn_sinf(ang);
                const float px = Ox * wc - Oy * wsn, py = Ox * wsn + Oy * wc;
                const float Xkx = Ex + px, Xky = Ey + py, Xnx = Ex - px, Xny = -(Ey - py);
                const float Ykx = Xkx * H.x - Xky * H.y, Yky = Xkx * H.y + Xky * H.x, Ynx = Xnx * H.z - Xny * H.w, Yny = Xnx * H.w + Xny * H.z;
                const float Epx = 0.5f * (Ykx + Ynx), Epy = 0.5f * (Yky - Yny), Dx = Ykx - Ynx, Dy = Yky + Yny;
                const float Opx = 0.5f * (Dx * wc + Dy * wsn), Opy = 0.5f * (Dy * wc - Dx * wsn);
                const f32x2 na = {Epx - Opy, Epy + Opx}, nb = {Epx + Opy, -Epy + Opx};
                X[sj] = ev ? na : nb;
                if (k != 8192) X[sp] = ev ? nb : na; } } }
        __syncthreads();
        fft_inv(X, tid);
#pragma unroll
        for (int r = 0; r < 4; ++r) { const int m = tid + NTHR * r; float xx[8];
            sconv8(px0, 8 * m, SEQ, a0, a1, a2, ab, xx);
            const int i0 = fidx(4 * m); const f32x2 y0 = X[i0], y1 = X[i0 + 1], y2 = X[i0 + 2], y3 = X[i0 + 3];
            const float yv[8] = {y0.x, y0.y, y1.x, y1.y, y2.x, y2.y, y3.x, y3.y};
            int m2 = m; asm volatile("" : "+v"(m2));
            bf16* yp = Y + (size_t)(b * RB + CTXL + 8 * m2) * DM + 256 + 2 * cp;
            if (ch == 0) {
#pragma unroll
                for (int e = 0; e < 8; ++e) o0[r][e] = (yv[e] + u[r][e] * hb) * xx[e]; }
            else {
#pragma unroll
                for (int e = 0; e < 8; ++e) *(unsigned*)(yp + (size_t)e * DM) = pk2(o0[r][e], (yv[e] + u[r][e] * hb) * xx[e]); } }
        __syncthreads();
    }
    {
        LAS float* kc = (LAS float*)lds; LAS float* uc = kc + 1024;
        const int ch = tid >> 8, c = 2 * cp + ch, t = tid & 255, te = t & ~1;
        kc[tid] = ((const float*)(ws + WS_KCTX))[(size_t)(2 * cp) * 512 + tid]; kc[512 + tid] = ((const float*)(ws + WS_KCTX))[(size_t)(2 * cp + 1) * 512 + tid];
        const float hb = AIN(21)[li * 256 + c];
        const float a0 = sw[c], a1 = sw[768 + c], a2 = sw[1536 + c], ab = sbp[c];
        const float b0 = sw[256 + c], b1 = sw[768 + 256 + c], b2 = sw[1536 + 256 + c], bb = sbp[256 + c];
        const float c0 = sw[512 + c], c1 = sw[768 + 512 + c], c2 = sw[1536 + 512 + c], cb = sbp[512 + c];
        const bf16* px0 = ZTC + (size_t)(b * 768 + c) * CTXL; const bf16* px1 = ZTC + (size_t)(b * 768 + 256 + c) * CTXL; const bf16* pv = ZTC + (size_t)(b * 768 + 512 + c) * CTXL;
        float v0, v1, g0, g1, x00, x01;
        sconv2(pv, te, CTXL, c0, c1, c2, cb, v0, v1); sconv2(px1, te, CTXL, b0, b1, b2, bb, g0, g1); sconv2(px0, te, CTXL, a0, a1, a2, ab, x00, x01);
        const float u = (t & 1) ? v1 * g1 : v0 * g0, x0v = (t & 1) ? x01 : x00;
        uc[tid] = u;
        __syncthreads();
        float y = 0.f;
#pragma unroll 8
        for (int s2 = 0; s2 < CTXL; ++s2) y += kc[ch * 512 + ((t - s2) & 511)] * uc[ch * 256 + s2];
        Y[(size_t)(b * RB + t) * DM + 256 + c] = (bf16)f2bf((y + u * hb) * x0v);
        __syncthreads();
    }
}

__device__ __forceinline__ void glds16(const void* gsrc, unsigned lds_dst) { unsigned keep;
    asm volatile("s_mov_b32 %0, m0\n\ts_mov_b32 m0, %2\n\ts_nop 0\n\tglobal_load_lds_dwordx4 %1, off\n\ts_mov_b32 m0, %0" : "=&s"(keep) : "v"(gsrc), "s"(lds_dst) : "memory"); }
__device__ __forceinline__ s16x4 vtr(const LAS unsigned char* p) { return __builtin_bit_cast(s16x4, __builtin_amdgcn_ds_read_tr16_b64_v4i16((LAS v4i16_t*)p)); }
typedef __bf16 bf16x2n __attribute__((ext_vector_type(2)));
__device__ __forceinline__ unsigned cvtpk_s(float lo, float hi) { f32x2 v = {lo, hi}; bf16x2n b = __builtin_convertvector(v, bf16x2n); return __builtin_bit_cast(unsigned, b); }
__device__ __forceinline__ int crow(int r, int hi) { return (r & 3) + 8 * (r >> 2) + 4 * hi; }
#define ATT_WAIT_BAR(N) asm volatile("s_waitcnt vmcnt(" #N ") lgkmcnt(0)\n\ts_barrier" ::: "memory")
constexpr int ATT_WS = 98304;
__device__ __forceinline__ void attn_unit(LAS unsigned char* lds, const bf16* Z, int qrow0, int krow0, int NT, int h, float negb, float lam, float oscale, const float* sg, bf16* Y) {
    const int tid = fresh_tid(), lane = tid & 63, r32 = lane & 31, hi = lane >> 5; const int wid = __builtin_amdgcn_readfirstlane(tid >> 6); const int mp = wid >> 2, wq = wid & 3;
    const unsigned lds0 = (unsigned)(uintptr_t)lds;
    const int dr = lane >> 4, dsl = lane & 15;
    const bf16* ks0 = Z + (size_t)(krow0 + 4 * wid + dr) * INW + K_OFF + h * 128 + (dsl ^ ((4 * wid + dr) & 15)) * 8;
    const bf16* vs0 = Z + (size_t)(krow0 + 4 * wid + dr) * INW + V_OFF + h * 128 + (dsl ^ (dr << 2)) * 8;
#define DMA_K(t) do { const size_t off_ = (size_t)(t) * 64 * INW; const unsigned sb_ = lds0 + (unsigned)((t) % 3) * 16384u + wid * 1024; \
        glds16(ks0 + off_, (unsigned)__builtin_amdgcn_readfirstlane(sb_)); glds16(ks0 + off_ + (size_t)32 * INW, (unsigned)__builtin_amdgcn_readfirstlane(sb_ + 8192)); } while (0)
#define DMA_V(t) do { const size_t off_ = (size_t)(t) * 64 * INW; const unsigned sb_ = lds0 + 49152u + (unsigned)((t) & 1) * 16384u + wid * 1024; \
        glds16(vs0 + off_, (unsigned)__builtin_amdgcn_readfirstlane(sb_)); glds16(vs0 + off_ + (size_t)32 * INW, (unsigned)__builtin_amdgcn_readfirstlane(sb_ + 8192)); } while (0)
    int kof[4], vof[4];
    { const int g1 = (lane >> 4) & 1, q = (lane & 15) >> 2, p = lane & 3;
#pragma unroll
        for (int d0 = 0; d0 < 4; ++d0) { kof[d0] = r32 * 256 + (((mp * 8 + 2 * d0 + hi) ^ (r32 & 15)) << 4);
            vof[d0] = 49152 + (4 * hi + q) * 256 + (((4 * d0 + 2 * g1 + (p >> 1)) ^ (q << 2)) << 4) + (p & 1) * 8; } }
    bf16x8 qr[4];
    { const bf16* qp = Z + (size_t)(qrow0 + wq * 32 + r32) * INW + Q_OFF + h * 128 + mp * 64 + hi * 8;
#pragma unroll
        for (int d0 = 0; d0 < 4; ++d0) qr[d0] = *(const bf16x8*)(qp + d0 * 16); }
    DMA_K(0); DMA_K(1);
    if (mp) __builtin_amdgcn_s_setprio(1);
    f32x16 o[4];
#pragma unroll
    for (int d0 = 0; d0 < 4; ++d0)
#pragma unroll
        for (int r = 0; r < 16; ++r) o[d0][r] = 0.f;
    const f32x16 zero16 = {0.f, 0.f, 0.f, 0.f, 0.f, 0.f, 0.f, 0.f, 0.f, 0.f, 0.f, 0.f, 0.f, 0.f, 0.f, 0.f};
    float l_reg = 0.f;
    v4u pw[4];
    (void)negb;
#define ATT_QK(P0, P1, t) do { const LAS unsigned char* kp_ = lds + ((t) % 3) * 16384; \
        { bf16x8 kf_[4]; _Pragma("unroll") for (int d0 = 0; d0 < 4; ++d0) kf_[d0] = *(const LAS bf16x8*)(kp_ + kof[d0]); \
          P0 = __builtin_amdgcn_mfma_f32_32x32x16_bf16(kf_[0], qr[0], zero16, 0, 0, 0); \
          _Pragma("unroll") for (int d0 = 1; d0 < 4; ++d0) P0 = __builtin_amdgcn_mfma_f32_32x32x16_bf16(kf_[d0], qr[d0], P0, 0, 0, 0); } \
        { bf16x8 kf_[4]; _Pragma("unroll") for (int d0 = 0; d0 < 4; ++d0) kf_[d0] = *(const LAS bf16x8*)(kp_ + kof[d0] + 8192); \
          P1 = __builtin_amdgcn_mfma_f32_32x32x16_bf16(kf_[0], qr[0], zero16, 0, 0, 0); \
          _Pragma("unroll") for (int d0 = 1; d0 < 4; ++d0) P1 = __builtin_amdgcn_mfma_f32_32x32x16_bf16(kf_[d0], qr[d0], P1, 0, 0, 0); } } while (0)
#define ATT_EXP(P0, P1) do { float sa_ = 0.f, sb_ = 0.f; \
        _Pragma("unroll") for (int r = 0; r < 16; ++r) { P0[r] = __builtin_amdgcn_exp2f(P0[r]); P1[r] = __builtin_amdgcn_exp2f(P1[r]); sa_ += P0[r]; sb_ += P1[r]; } \
        l_reg += sa_ + sb_; } while (0)
#define ATT_PACK(P0, P1) do { \
        _Pragma("unroll") for (int q = 0; q < 4; ++q) { pw[0][q] = cvtpk_s(P0[2 * q], P0[2 * q + 1]); pw[1][q] = cvtpk_s(P0[8 + 2 * q], P0[8 + 2 * q + 1]); \
            pw[2][q] = cvtpk_s(P1[2 * q], P1[2 * q + 1]); pw[3][q] = cvtpk_s(P1[8 + 2 * q], P1[8 + 2 * q + 1]); } } while (0)
#define VTR(dst, addr, off) dst = vtr((const LAS unsigned char*)(addr) + (off))
#define ATT_VLOAD(V, t, d0) do { const unsigned va_ = lds0 + (unsigned)((t) & 1) * 16384u + (unsigned)vof[d0]; \
        VTR(V[0], va_, 0); VTR(V[1], va_, 2048); VTR(V[2], va_, 4096); VTR(V[3], va_, 6144); VTR(V[4], va_, 8192); VTR(V[5], va_, 10240); VTR(V[6], va_, 12288); VTR(V[7], va_, 14336); } while (0)
#define ATT_LGKM(n) asm volatile("s_waitcnt lgkmcnt(" #n ")" ::: "memory")
#define VFR(V, ks) (bf16x8){V[2 * (ks)][0], V[2 * (ks)][1], V[2 * (ks)][2], V[2 * (ks)][3], V[2 * (ks) + 1][0], V[2 * (ks) + 1][1], V[2 * (ks) + 1][2], V[2 * (ks) + 1][3]}
#define ATT_PVX(V, d0, P, B) do { \
        _Pragma("unroll") for (int ks = 0; ks < 4; ++ks) { o[d0] = __builtin_amdgcn_mfma_f32_32x32x16_bf16(__builtin_bit_cast(bf16x8, pw[ks]), VFR(V, ks), o[d0], 0, 0, 0); \
            P[B + 2 * ks] = __builtin_amdgcn_exp2f(P[B + 2 * ks]); P[B + 2 * ks + 1] = __builtin_amdgcn_exp2f(P[B + 2 * ks + 1]); sa_ += P[B + 2 * ks]; sb_ += P[B + 2 * ks + 1]; } \
        _Pragma("unroll") for (int ks = 0; ks < 4; ++ks) { __builtin_amdgcn_sched_group_barrier(0x008, 1, 0); __builtin_amdgcn_sched_group_barrier(0x400, 2, 0); __builtin_amdgcn_sched_group_barrier(0x002, 2, 0); } \
        __builtin_amdgcn_sched_barrier(0); } while (0)
#define ATT_PVONLY(V, d0) do { _Pragma("unroll") for (int ks = 0; ks < 4; ++ks) o[d0] = __builtin_amdgcn_mfma_f32_32x32x16_bf16(__builtin_bit_cast(bf16x8, pw[ks]), VFR(V, ks), o[d0], 0, 0, 0); __builtin_amdgcn_sched_barrier(0); } while (0)
#define ATT_TOP(t) do { if ((t) + 1 < NT) ATT_WAIT_BAR(2); else ATT_WAIT_BAR(0); DMA_V(t); if ((t) + 2 < NT) DMA_K((t) + 2); } while (0)
    { f32x16 p0, p1;
        ATT_TOP(0); ATT_QK(p0, p1, 0); ATT_EXP(p0, p1); ATT_PACK(p0, p1); }
    s16x4 va[8], vb[8];
    for (int t = 1; t < NT; ++t) {
        f32x16 p0, p1; float sa_ = 0.f, sb_ = 0.f;
        ATT_TOP(t);
        ATT_VLOAD(va, t - 1, 0); __builtin_amdgcn_sched_barrier(0);
        ATT_QK(p0, p1, t); __builtin_amdgcn_sched_barrier(0);
        ATT_VLOAD(vb, t - 1, 1); ATT_LGKM(8); __builtin_amdgcn_sched_barrier(0);
        ATT_PVX(va, 0, p0, 0);
        ATT_VLOAD(va, t - 1, 2); ATT_LGKM(8); __builtin_amdgcn_sched_barrier(0);
        ATT_PVX(vb, 1, p0, 8);
        ATT_VLOAD(vb, t - 1, 3); ATT_LGKM(8); __builtin_amdgcn_sched_barrier(0);
        ATT_PVX(va, 2, p1, 0);
        ATT_LGKM(0); __builtin_amdgcn_sched_barrier(0);
        ATT_PVX(vb, 3, p1, 8);
        l_reg += sa_ + sb_;
        ATT_PACK(p0, p1); }
    ATT_WAIT_BAR(0);
    ATT_VLOAD(va, NT - 1, 0); ATT_VLOAD(vb, NT - 1, 1); ATT_LGKM(8); ATT_PVONLY(va, 0);
    ATT_VLOAD(va, NT - 1, 2); ATT_LGKM(8); ATT_PVONLY(vb, 1);
    ATT_VLOAD(vb, NT - 1, 3); ATT_LGKM(8); ATT_PVONLY(va, 2);
    ATT_LGKM(0); ATT_PVONLY(vb, 3);
#undef ATT_EXP
#undef VTR
#undef ATT_VLOAD
#undef ATT_LGKM
#undef VFR
#undef ATT_PVX
#undef ATT_PVONLY
#undef ATT_PACK
#undef ATT_TOP
#undef ATT_QK
#undef ATT_PV
#undef DMA_K
#undef DMA_V
    __builtin_amdgcn_s_setprio(0);
    { auto rr = __builtin_amdgcn_permlane32_swap(__float_as_uint(l_reg), __float_as_uint(l_reg), false, false); l_reg = __uint_as_float(rr[0]) + __uint_as_float(rr[1]); }
    LAS float* wsf = (LAS float*)(lds + ATT_WS) + wid * 64;
    if (hi == 0) wsf[r32] = l_reg;
    LDS_WAIT();
    float rl[16];
#pragma unroll
    for (int r = 0; r < 16; ++r) rl[r] = __builtin_amdgcn_rcpf(wsf[crow(r, hi)]) * (mp ? lam : 1.0f);
    ATT_WAIT_BAR(0);
    LAS float* stg = (LAS float*)lds + wq * (32 * 132);
    if (mp == 1) {
#pragma unroll
        for (int d0 = 0; d0 < 4; ++d0)
#pragma unroll
            for (int r = 0; r < 16; ++r) stg[crow(r, hi) * 132 + d0 * 32 + r32] = o[d0][r] * rl[r];
    }
    ATT_WAIT_BAR(0);
    if (mp == 0) {
#pragma unroll
        for (int d0 = 0; d0 < 4; ++d0)
#pragma unroll
            for (int r = 0; r < 16; ++r) { const int ix = crow(r, hi) * 132 + d0 * 32 + r32; stg[ix] = o[d0][r] * rl[r] - stg[ix]; }
        LDS_WAIT();
        const int q = lane >> 1, half = lane & 1; const LAS float* rp = stg + q * 132 + half * 64;
        f32x4 v[16]; float ss = 0.f;
#pragma unroll
        for (int i = 0; i < 16; ++i) { v[i] = *(const LAS f32x4*)(rp + 4 * i); ss += (v[i].x * v[i].x + v[i].y * v[i].y) + (v[i].z * v[i].z + v[i].w * v[i].w); }
        ss += xor1_f(ss);
        const float rinv = __builtin_amdgcn_rsqf(ss * (1.0f / 128.0f) + 1e-6f) * oscale;
        bf16* yp = Y + (size_t)(qrow0 + wq * 32 + q) * DM + 512 + h * 128 + half * 64;
        const f32x4* sgp = (const f32x4*)(sg + half * 64);
#pragma unroll
        for (int i = 0; i < 8; ++i) { const f32x4 a0 = v[2 * i] * sgp[2 * i] * rinv, a1 = v[2 * i + 1] * sgp[2 * i + 1] * rinv;
            v4u w; w.x = pk2(a0.x, a0.y); w.y = pk2(a0.z, a0.w); w.z = pk2(a1.x, a1.y); w.w = pk2(a1.z, a1.w); *(v4u*)(yp + 8 * i) = w; }
    }
    ATT_WAIT_BAR(0);
}

__device__ __forceinline__ void attn_unit16(LAS unsigned char* lds, const bf16* Z, int qrow0, int krow0, int NT, int h, float lam, float oscale, const float* sg, bf16* Y) {
    const int tid = fresh_tid(), lane = tid & 63, r16 = lane & 15, g = lane >> 4; const int wid = __builtin_amdgcn_readfirstlane(tid >> 6); const int mp = wid >> 2, wq = wid & 3;
    const unsigned lds0 = (unsigned)(uintptr_t)lds;
    const int dr = lane >> 4, dsl = lane & 15;
    const bf16* ks0 = Z + (size_t)(krow0 + 4 * wid + dr) * INW + K_OFF + h * 128 + (dsl ^ ((4 * wid + dr) & 15)) * 8;
    const bf16* vs0 = Z + (size_t)(krow0 + 4 * wid + dr) * INW + V_OFF + h * 128 + (dsl ^ (dr << 2) ^ ((wid & 1) << 1)) * 8;
#define DMA_K(t) do { const size_t off_ = (size_t)(t) * 64 * INW; const unsigned sb_ = lds0 + (unsigned)((t) % 3) * 16384u + wid * 1024; \
        glds16(ks0 + off_, (unsigned)__builtin_amdgcn_readfirstlane(sb_)); glds16(ks0 + off_ + (size_t)32 * INW, (unsigned)__builtin_amdgcn_readfirstlane(sb_ + 8192)); } while (0)
#define DMA_V(t) do { const size_t off_ = (size_t)(t) * 64 * INW; const unsigned sb_ = lds0 + 49152u + (unsigned)((t) & 1) * 16384u + wid * 1024; \
        glds16(vs0 + off_, (unsigned)__builtin_amdgcn_readfirstlane(sb_)); glds16(vs0 + off_ + (size_t)32 * INW, (unsigned)__builtin_amdgcn_readfirstlane(sb_ + 8192)); } while (0)
    int kof[2];
    kof[0] = r16 * 256 + (((mp * 8 + g) ^ r16) << 4); kof[1] = r16 * 256 + (((mp * 8 + 4 + g) ^ r16) << 4);
    const int q4 = r16 >> 2, pq = r16 & 3;
    const int vrow = 49152 + (4 * g + q4) * 256 + (pq & 1) * 8, vx = (q4 << 2) ^ ((g & 1) << 1) ^ (pq >> 1);
    bf16x8 qf[2][2];
    { const bf16* qp = Z + (size_t)(qrow0 + wq * 32 + r16) * INW + Q_OFF + h * 128 + mp * 64 + g * 8;
#pragma unroll
        for (int qb = 0; qb < 2; ++qb)
#pragma unroll
            for (int ks = 0; ks < 2; ++ks) qf[qb][ks] = *(const bf16x8*)(qp + (size_t)qb * 16 * INW + ks * 32); }
    DMA_K(0); DMA_K(1);
    if (mp) __builtin_amdgcn_s_setprio(1);
    f32x4 o[2][8];
#pragma unroll
    for (int qb = 0; qb < 2; ++qb)
#pragma unroll
        for (int db = 0; db < 8; ++db) o[qb][db] = (f32x4){0.f, 0.f, 0.f, 0.f};
    const f32x4 zero4 = {0.f, 0.f, 0.f, 0.f};
    float l0 = 0.f, l1 = 0.f;
    v4u pw[2][2];
    f32x4 S[4][2];
#define ATT_QK(t) do { const LAS unsigned char* kp_ = lds + ((t) % 3) * 16384; \
        _Pragma("unroll") for (int kh = 0; kh < 2; ++kh) { bf16x8 kf_[2][2]; \
            _Pragma("unroll") for (int kb = 0; kb < 2; ++kb) _Pragma("unroll") for (int ks = 0; ks < 2; ++ks) kf_[kb][ks] = *(const LAS bf16x8*)(kp_ + kof[ks] + (2 * kh + kb) * 4096); \
            _Pragma("unroll") for (int kb = 0; kb < 2; ++kb) _Pragma("unroll") for (int qb = 0; qb < 2; ++qb) { \
                S[2 * kh + kb][qb] = __builtin_amdgcn_mfma_f32_16x16x32_bf16(kf_[kb][0], qf[qb][0], zero4, 0, 0, 0); \
                S[2 * kh + kb][qb] = __builtin_amdgcn_mfma_f32_16x16x32_bf16(kf_[kb][1], qf[qb][1], S[2 * kh + kb][qb], 0, 0, 0); } } } while (0)
#define ATT_EXPB(kb) do { _Pragma("unroll") for (int r = 0; r < 4; ++r) { S[kb][0][r] = __builtin_amdgcn_exp2f(S[kb][0][r]); S[kb][1][r] = __builtin_amdgcn_exp2f(S[kb][1][r]); sa_ += S[kb][0][r]; sb_ += S[kb][1][r]; } } while (0)
#define ATT_PACK() do { _Pragma("unroll") for (int qb = 0; qb < 2; ++qb) _Pragma("unroll") for (int s_ = 0; s_ < 2; ++s_) { \
        pw[qb][s_][0] = cvtpk_s(S[2 * s_][qb][0], S[2 * s_][qb][1]); pw[qb][s_][1] = cvtpk_s(S[2 * s_][qb][2], S[2 * s_][qb][3]); \
        pw[qb][s_][2] = cvtpk_s(S[2 * s_ + 1][qb][0], S[2 * s_ + 1][qb][1]); pw[qb][s_][3] = cvtpk_s(S[2 * s_ + 1][qb][2], S[2 * s_ + 1][qb][3]); } } while (0)
#define ATT_VLOAD(V, t, dg) do { const LAS unsigned char* vp_ = lds + ((t) & 1) * 16384 + vrow; \
        _Pragma("unroll") for (int dbl = 0; dbl < 2; ++dbl) { const int va_ = ((2 * (2 * (dg) + dbl)) ^ vx) << 4; \
            _Pragma("unroll") for (int s_ = 0; s_ < 2; ++s_) { V[(dbl * 2 + s_) * 2] = vtr(vp_ + va_ + s_ * 8192); V[(dbl * 2 + s_) * 2 + 1] = vtr(vp_ + va_ + s_ * 8192 + 4096); } } } while (0)
#define VFR(V, i) (bf16x8){V[2 * (i)][0], V[2 * (i)][1], V[2 * (i)][2], V[2 * (i)][3], V[2 * (i) + 1][0], V[2 * (i) + 1][1], V[2 * (i) + 1][2], V[2 * (i) + 1][3]}
#define ATT_PVG(V, dg) do { _Pragma("unroll") for (int dbl = 0; dbl < 2; ++dbl) _Pragma("unroll") for (int qb = 0; qb < 2; ++qb) _Pragma("unroll") for (int s_ = 0; s_ < 2; ++s_) \
            o[qb][2 * (dg) + dbl] = __builtin_amdgcn_mfma_f32_16x16x32_bf16(__builtin_bit_cast(bf16x8, pw[qb][s_]), VFR(V, dbl * 2 + s_), o[qb][2 * (dg) + dbl], 0, 0, 0); } while (0)
#define ATT_PVX(V, dg) do { ATT_PVG(V, dg); ATT_EXPB(dg); \
        _Pragma("unroll") for (int i_ = 0; i_ < 4; ++i_) { __builtin_amdgcn_sched_group_barrier(0x008, 2, 0); __builtin_amdgcn_sched_group_barrier(0x400, 2, 0); __builtin_amdgcn_sched_group_barrier(0x002, 2, 0); } \
        __builtin_amdgcn_sched_barrier(0); } while (0)
#define ATT_TOP(t) do { if ((t) + 1 < NT) ATT_WAIT_BAR(2); else ATT_WAIT_BAR(0); DMA_V(t); if ((t) + 2 < NT) DMA_K((t) + 2); } while (0)
#define ATT_LGKM(n) asm volatile("s_waitcnt lgkmcnt(" #n ")" ::: "memory")
    { float sa_ = 0.f, sb_ = 0.f; ATT_TOP(0); ATT_QK(0); ATT_EXPB(0); ATT_EXPB(1); ATT_EXPB(2); ATT_EXPB(3); l0 += sa_; l1 += sb_; ATT_PACK(); }
    s16x4 va[8], vb[8];
    for (int t = 1; t < NT; ++t) {
        float sa_ = 0.f, sb_ = 0.f;
        ATT_TOP(t);
        ATT_VLOAD(va, t - 1, 0); __builtin_amdgcn_sched_barrier(0);
        ATT_QK(t); __builtin_amdgcn_sched_barrier(0);
        ATT_VLOAD(vb, t - 1, 1); ATT_LGKM(8); __builtin_amdgcn_sched_barrier(0);
        ATT_PVX(va, 0);
        ATT_VLOAD(va, t - 1, 2); ATT_LGKM(8); __builtin_amdgcn_sched_barrier(0);
        ATT_PVX(vb, 1);
        ATT_VLOAD(vb, t - 1, 3); ATT_LGKM(8); __builtin_amdgcn_sched_barrier(0);
        ATT_PVX(va, 2);
        ATT_LGKM(0); __builtin_amdgcn_sched_barrier(0);
        ATT_PVX(vb, 3);
        l0 += sa_; l1 += sb_;
        ATT_PACK(); }
    ATT_WAIT_BAR(0);
    ATT_VLOAD(va, NT - 1, 0); ATT_VLOAD(vb, NT - 1, 1); ATT_LGKM(8); ATT_PVG(va, 0); __builtin_amdgcn_sched_barrier(0);
    ATT_VLOAD(va, NT - 1, 2); ATT_LGKM(8); ATT_PVG(vb, 1); __builtin_amdgcn_sched_barrier(0);
    ATT_VLOAD(vb, NT - 1, 3); ATT_LGKM(8); ATT_PVG(va, 2); __builtin_amdgcn_sched_barrier(0);
    ATT_LGKM(0); ATT_PVG(vb, 3);
#undef DMA_K
#undef DMA_V
#undef ATT_QK
#undef ATT_EXPB
#undef ATT_PACK
#undef ATT_VLOAD
#undef VFR
#undef ATT_PVG
#undef ATT_PVX
#undef ATT_TOP
#undef ATT_LGKM
    __builtin_amdgcn_s_setprio(0);
    l0 += xor16_f(l0); l0 = sum32_f(l0); l1 += xor16_f(l1); l1 = sum32_f(l1);
    LAS float* wsf = (LAS float*)(lds + ATT_WS) + wid * 64;
    if (g == 0) { wsf[r16] = l0; wsf[16 + r16] = l1; }
    LDS_WAIT();
    float rl[2][4];
#pragma unroll
    for (int qb = 0; qb < 2; ++qb)
#pragma unroll
        for (int r = 0; r < 4; ++r) rl[qb][r] = __builtin_amdgcn_rcpf(wsf[16 * qb + 4 * g + r]) * (mp ? lam : 1.0f);
    ATT_WAIT_BAR(0);
    LAS float* stg = (LAS float*)lds + wq * (32 * 132);
    if (mp == 1) {
#pragma unroll
        for (int qb = 0; qb < 2; ++qb)
#pragma unroll
            for (int db = 0; db < 8; ++db)
#pragma unroll
                for (int r = 0; r < 4; ++r) stg[(16 * qb + 4 * g + r) * 132 + 16 * db + r16] = o[qb][db][r] * rl[qb][r];
    }
    ATT_WAIT_BAR(0);
    if (mp == 0) {
#pragma unroll
        for (int qb = 0; qb < 2; ++qb)
#pragma unroll
            for (int db = 0; db < 8; ++db)
#pragma unroll
                for (int r = 0; r < 4; ++r) { const int ix = (16 * qb + 4 * g + r) * 132 + 16 * db + r16; stg[ix] = o[qb][db][r] * rl[qb][r] - stg[ix]; }
        LDS_WAIT();
        const int q = lane >> 1, half = lane & 1; const LAS float* rp = stg + q * 132 + half * 64;
        f32x4 v[16]; float ss = 0.f;
#pragma unroll
        for (int i = 0; i < 16; ++i) { v[i] = *(const LAS f32x4*)(rp + 4 * i); ss += (v[i].x * v[i].x + v[i].y * v[i].y) + (v[i].z * v[i].z + v[i].w * v[i].w); }
        ss += xor1_f(ss);
        const float rinv = __builtin_amdgcn_rsqf(ss * (1.0f / 128.0f) + 1e-6f) * oscale;
        bf16* yp = Y + (size_t)(qrow0 + wq * 32 + q) * DM + 512 + h * 128 + half * 64;
        const f32x4* sgp = (const f32x4*)(sg + half * 64);
#pragma unroll
        for (int i = 0; i < 8; ++i) { const f32x4 a0 = v[2 * i] * sgp[2 * i] * rinv, a1 = v[2 * i + 1] * sgp[2 * i + 1] * rinv;
            v4u w; w.x = pk2(a0.x, a0.y); w.y = pk2(a0.z, a0.w); w.z = pk2(a1.x, a1.y); w.w = pk2(a1.z, a1.w); *(v4u*)(yp + 8 * i) = w; }
    }
    ATT_WAIT_BAR(0);
}

__device__ __forceinline__ void phase_mixers(const Args& a, int li, LAS unsigned char* lds, int G, int bx) {
    unsigned char* ws = fresh_ptr(a.ws);
    for (int rep = 0; rep <= DUP_HY; ++rep) if (PHEN(13)) for (int c = bx; c < 256; c += G) { const int v = G == 256 ? (((c & 7) << 5) | (c >> 3)) : c; hyena_unit(a, li, v >> 1, v & 1, lds); }
    for (int rep = 0; rep <= DUP_POOL; ++rep) if (PHEN(14)) { pool_load_lin(a, li, lds);
    for (int p = bx; p < 512; p += G) pool_unit(a, li, p, lds);
    for (int cp = bx; cp < 256; cp += G) pool_ctx_pair(a, li, cp, lds); }
    if (!PHEN(15)) return;
    const float* qkg = AIN(22) + li * 128; const float* dl = AIN(23) + li * 256; const float* sg = AIN(24) + li * 128;
    float mq = 0.f, mk = 0.f, d1 = 0.f, d2 = 0.f;
    for (int q = 0; q < 64; ++q) { mq = __builtin_fmaxf(mq, __builtin_fabsf(qkg[q])); mk = __builtin_fmaxf(mk, __builtin_fabsf(qkg[64 + q])); d1 += dl[q] * dl[64 + q]; d2 += dl[128 + q] * dl[192 + q]; }
    const float lam_init = 0.8f - 0.6f * __expf(-0.3f * (float)li);
    const float lam = __expf(d1) - __expf(d2) + lam_init;
    const float negb = -(64.0f * mq * mk * C2);
    const bf16* Z = (const bf16*)(ws + WS_Z); bf16* Y = (bf16*)(ws + WS_Y);
    for (int rep = 0; rep <= DUP_ATT; ++rep)
    for (int i = 0; i * G + bx < 1024; ++i) {
        int bh, qb;
        if (G == 256) { const int vcu = (bx & 7) * 32 + (bx >> 3); bh = vcu >> 5; qb = (vcu & 31) + 32 * i; } else { const int u = i * G + bx; bh = u >> 7; qb = u & 127; }
        const int b = bh >> 2, h = bh & 3;
        attn_unit16(lds, Z, b * RB + CTXL + qb * 128, b * RB, RB / 64, h, lam, 1.0f - lam_init, sg, Y);
    }
    if (li < DEPTH - 1) for (int u = bx; u < 16; u += G) { const int b = u >> 3, h = (u >> 1) & 3, qh = u & 1;
        attn_unit16(lds, Z, b * RB + qh * 128, b * RB, CTXL / 64, h, lam, 1.0f - lam_init, sg, Y); }
}

constexpr int NPHASES = 2 * 9 + 2 * 13 - 6;
__global__ void __launch_bounds__(NTHR, 2) fwd(Args a) {
    extern __shared__ __attribute__((aligned(16))) unsigned char lds_raw[];
    LAS unsigned char* lds = (LAS unsigned char*)lds_raw;
    volatile LAS unsigned* MISC = (volatile LAS unsigned*)(lds + MISC_OFF);
    const int tid = threadIdx.x, G = gridDim.x, bx = blockIdx.x;
    if (tid < 128) MISC[tid] = 0u;
    if (tid < 64) ((LAS unsigned*)(lds + PTAB_OFF))[tid] = ((const __attribute__((address_space(4))) unsigned*)__builtin_amdgcn_kernarg_segment_ptr())[tid];
    __syncthreads();
    const int lo = a.ph_lo, hi = a.ph_hi;
    unsigned* ctl = (unsigned*)(fresh_ptr(a.ws) + WS_CTL);
    XcdBarrier bar; bar.bar = ctl + CW_BAR; bar.x = 0; bar.st = MISC + 8;
    if (hi - lo > 1) bar = xcd_barrier_post(ctl + CW_BAR, MISC + 8);
    int ph = 0;
#define ON() (ph >= lo && ph < hi)
#define ENDPH() do { if (ON() && ph + 1 < hi) xcd_barrier(bar); ++ph; } while (0)
#define WSP(off) (fresh_ptr(a.ws) + (off))
#define XN ((bf16*)WSP(WS_XN))
#define Zb ((bf16*)WSP(WS_Z))
#define Yb ((bf16*)WSP(WS_Y))
#define HID ((bf16*)WSP(WS_HID))
#define win_t ((bf16*)WSP(WS_WIN))
#define wout_t ((bf16*)WSP(WS_WOUT))
#define wup_t ((bf16*)WSP(WS_WUP))
#define wdn_t ((bf16*)WSP(WS_WDN))
#define hctx ((float*)WSP(WS_HCTX))
#define WSB WSP(0)
#define modl ((const float*)WSP(WS_MOD) + (size_t)li * 3 * 6144)
    for (int li = 0; li < DEPTH; ++li) {
        const bool moe = (li & 1) != 0;
        const float* xlat = li == 0 ? AIN(0) : (const float*)fresh_ptr(a.out);
        if (li == 0) {
            if (PHEN(0) && ON()) phase_prep_a(a, li, lds, G, bx);
            ENDPH();
            if (PHEN(1) && ON()) phase_prep_b(a, li, lds, G, bx);
            ENDPH();
            if (PHEN(2) && ON()) phase_norm(a, li, 0, xlat, lds, G, bx);
            ENDPH();
        } else {
            if (ON()) { if (PHEN(0)) phase_prep_a(a, li, lds, G, bx); if (PHEN(1)) phase_prep_b(a, li, lds, G, bx); if (PHEN(2)) phase_norm(a, li, 0, xlat, lds, G, bx); }
            ENDPH();
        }
        for (int rep = 0; rep <= DUP_GEMM; ++rep) if (PHEN(3) && ON()) { pg8::Gemm g{XN, win_t, MROWS, INW, DM}; pg8::StaticOrder S; S.init(MROWS, INW, DM, G, bx);
            EpiIn E{Zb, (bf16*)(WSB + WS_ZT), (bf16*)(WSB + WS_ZTC), (const float*)(WSB + WS_ROPE), (const float*)(WSB + WS_ROPE) + 4096, AIN(22) + li * 128};
            pg8::gemm_phase<EpiIn, pg8::StaticOrder, true, true>(lds, g, S, E); }
        ENDPH();
        if (PHEN(4) && ON()) phase_mixers(a, li, lds, G, bx);
        ENDPH();
#if DUP_ADD
        if (PHEN(5) && ON()) { pg8::Gemm g{Yb, wout_t, MROWS, DM, DM}; SplitTailOrder S; S.init(DM, DM, G, bx);
            EpiRes E{xlat, a.out, hctx, modl + 2 * DM, DM / 64, (float*)(WSB + WS_SLAB), 0.f};
            pg8::gemm_phase<EpiRes, SplitTailOrder, true, true>(lds, g, S, E); }
#endif
        if (PHEN(5) && ON()) { pg8::Gemm g{Yb, wout_t, MROWS, DM, DM}; SplitTailOrder S; S.init(DM, DM, G, bx);
            EpiRes E{xlat, a.out, hctx, modl + 2 * DM, DM / 64, (float*)(WSB + WS_SLAB), 1.f};
            pg8::gemm_phase<EpiRes, SplitTailOrder, true, true>(lds, g, S, E); }
        ENDPH();
        if (!moe) {
            if (PHEN(6) && ON()) phase_norm(a, li, 3, a.out, lds, G, bx);
            ENDPH();
            for (int rep = 0; rep <= DUP_GEMM; ++rep) if (PHEN(7) && ON()) { pg8::Gemm g{XN, wup_t, MROWS, 2 * DFF, DM}; pg8::StaticOrder S; S.init(MROWS, 2 * DFF, DM, G, bx);
                EpiGlu E{HID, DFF, DFF / 128};
                pg8::gemm_phase<EpiGlu, pg8::StaticOrder, true, true>(lds, g, S, E); }
            ENDPH();
#if DUP_ADD
            if (PHEN(8) && ON()) { pg8::Gemm g{HID, wdn_t, MROWS, DM, DFF}; SplitTailOrder S; S.init(DM, DFF, G, bx);
                EpiRes E{a.out, a.out, hctx, modl + 5 * DM, DFF / 64, (float*)(WSB + WS_SLAB), 0.f};
                pg8::gemm_phase<EpiRes, SplitTailOrder, true, true>(lds, g, S, E); }
#endif
            if (PHEN(8) && ON()) { pg8::Gemm g{HID, wdn_t, MROWS, DM, DFF}; SplitTailOrder S; S.init(DM, DFF, G, bx);
                EpiRes E{a.out, a.out, hctx, modl + 5 * DM, DFF / 64, (float*)(WSB + WS_SLAB), 1.f};
                pg8::gemm_phase<EpiRes, SplitTailOrder, true, true>(lds, g, S, E); }
            ENDPH();
        } else {
            const LAS int* tab = (const LAS int*)(lds + TAB_OFF);
            if (PHEN(9) && ON()) phase_norm_router(a, li, a.out, lds, G, bx);
            ENDPH();
            if (PHEN(10) && ON()) phase_moe_gather(a, li, lds, G, bx);
            ENDPH();
            for (int rep = 0; rep <= DUP_GEMM; ++rep) if (PHEN(11) && ON()) { moe_tables(a, li >> 1, lds, G, bx);
                pg8::Gemm g{(const bf16*)(WSB + WS_AG), wup_t, 0, 0, DM}; MoeOrder S{G, bx, 2 * DFE / 256, 0, tab[16] * (2 * DFE / 256), tab, DM / 64};
                EpiGlu E{HID, DFE, DFE / 128};
                pg8::gemm_phase<EpiGlu, MoeOrder, true, true>(lds, g, S, E); }
            ENDPH();
            for (int k = 0; k < 2; ++k) {
#if DUP_ADD
                if (PHEN(12) && ON()) { moe_tables(a, li >> 1, lds, G, bx);
                    pg8::Gemm g{HID, wdn_t, 0, 0, DFE}; MoeDownOrder S; S.init(G, bx, k, tab);
                    EpiMoeDown E{a.out, hctx, modl + 5 * DM, (const int*)(WSB + WS_RTOK), (const float*)(WSB + WS_RGATE), tab, (float*)(WSB + WS_SLAB), 0.f};
                    pg8::gemm_phase<EpiMoeDown, MoeDownOrder, true, true>(lds, g, S, E); }
#endif
                if (PHEN(12) && ON()) { moe_tables(a, li >> 1, lds, G, bx);
                    pg8::Gemm g{HID, wdn_t, 0, 0, DFE}; MoeDownOrder S; S.init(G, bx, k, tab);
                    EpiMoeDown E{a.out, hctx, modl + 5 * DM, (const int*)(WSB + WS_RTOK), (const float*)(WSB + WS_RGATE), tab, (float*)(WSB + WS_SLAB), 1.f};
                    pg8::gemm_phase<EpiMoeDown, MoeDownOrder, true, true>(lds, g, S, E); }
                ENDPH();
            }
            for (int k = 0; k < 2; ++k) { if (ON()) phase_moe_fix(a, li, k, lds, G, bx); ENDPH(); }
        }
    }
#undef ON
#undef ENDPH
#undef WSP
#undef XN
#undef Zb
#undef Yb
#undef HID
#undef win_t
#undef wout_t
#undef wup_t
#undef wdn_t
#undef hctx
#undef WSB
#undef modl
}

extern "C" void kernel_launch(void* const* d_in, const int* in_sizes, int n_in, void* d_out, int out_size, void* d_ws, size_t ws_size, hipStream_t stream) {
    static int grid = 0;
    if (grid == 0) {
        if (n_in != 32 || in_sizes[0] != NB * SEQ * DM || out_size != NB * SEQ * DM || ws_size < WS_END) {
            fprintf(stderr, "kernel_launch: unexpected problem: n_in %d in0 %d out %d ws %zu (need %zu)\n", n_in, n_in > 0 ? in_sizes[0] : -1, out_size, ws_size, (size_t)WS_END); grid = -1; return; }
        int dev = 0, cus = 0, per_cu = 0;
        if (hipGetDevice(&dev) != hipSuccess || hipDeviceGetAttribute(&cus, hipDeviceAttributeMultiprocessorCount, dev) != hipSuccess) { grid = -1; return; }
        if (hipFuncSetAttribute((const void*)fwd, hipFuncAttributeMaxDynamicSharedMemorySize, LDS_BYTES) != hipSuccess) { fprintf(stderr, "kernel_launch: hipFuncSetAttribute failed\n"); grid = -1; return; }
        if (hipOccupancyMaxActiveBlocksPerMultiprocessor(&per_cu, (const void*)fwd, NTHR, LDS_BYTES) != hipSuccess || per_cu < 1) { fprintf(stderr, "kernel_launch: occupancy query says %d\n", per_cu); }
        (void)hipGetLastError();
        grid = cus;
    }
    if (grid < 0) return;
    (void)hipMemsetAsync((char*)d_ws + WS_CTL, 0, CTL_ZERO_BYTES, stream);
    Args a{};
    for (int i = 0; i < 32; ++i) a.in[i] = (const float*)d_in[i];
    a.out = (float*)d_out; a.ws = (unsigned char*)d_ws;
#if MK_ONE_LAUNCH
    a.ph_lo = 0; a.ph_hi = NPHASES;
    hipLaunchKernelGGL(fwd, dim3(grid), dim3(NTHR), LDS_BYTES, stream, a);
#else
    for (int p = 0; p < NPHASES; ++p) { a.ph_lo = p; a.ph_hi = p + 1; hipLaunchKernelGGL(fwd, dim3(grid), dim3(NTHR), LDS_BYTES, stream, a); }
#endif
}
```
